# Optimizing an MI355X kernel written in HIP

```python
import jax, jax.numpy as jnp
from jax import lax
import numpy as np

D_MODEL = 1024
BATCH = 4
SEQ = 4096
DEPTH = 1

CHUNK = 64
N_PREV_CHUNKS = 8
BAND_CHUNKS = N_PREV_CHUNKS + 1
N_HEADS = 16
HEAD_DIM = 64
D_ATTN = N_HEADS * HEAD_DIM
D_CONV = D_MODEL
CONV_WIDTH = 3
MAX_REL = 256
D_FF = 4 * D_MODEL
N_BRANCHES = 2
EPS = 1e-6
NEG_INF = -1e30

kernel_name = "chunk_causal_hybrid_attn_shortconv_block"


def rms_norm(x, g):
    xf = x.astype(jnp.float32)
    y = xf * lax.rsqrt(jnp.mean(xf * xf, axis=-1, keepdims=True) + EPS)
    return (y * g.astype(jnp.float32)).astype(x.dtype)


def chunk_band(t):
    b, nc, c, h, dh = t.shape
    tp = jnp.pad(t, ((0, 0), (N_PREV_CHUNKS, 0), (0, 0), (0, 0), (0, 0)))
    band = jnp.stack([tp[:, o:o + nc] for o in range(BAND_CHUNKS)], axis=2)
    return band.reshape(b, nc, BAND_CHUNKS * c, h, dh)


def chunked_relpos_attention(q, k, v, q_norm_g, k_norm_g, rel_bias):
    b, s, _ = q.shape
    nc = s // CHUNK
    kw = BAND_CHUNKS * CHUNK
    q = rms_norm(q.reshape(b, nc, CHUNK, N_HEADS, HEAD_DIM), q_norm_g)
    k = rms_norm(k.reshape(b, nc, CHUNK, N_HEADS, HEAD_DIM), k_norm_g)
    v = v.reshape(b, nc, CHUNK, N_HEADS, HEAD_DIM)
    kb = chunk_band(k)
    vb = chunk_band(v)

    q_idx = jnp.arange(CHUNK)[:, None]
    k_idx = jnp.arange(kw)[None, :]
    dist = q_idx - k_idx + N_PREV_CHUNKS * CHUNK
    rel_idx = jnp.clip(dist, -MAX_REL, MAX_REL) + MAX_REL
    bias = rel_bias[:, rel_idx].astype(jnp.float32)

    key_chunk = jnp.arange(nc)[:, None] + (jnp.arange(kw) // CHUNK)[None, :] - N_PREV_CHUNKS
    valid = key_chunk >= 0

    scale = HEAD_DIM ** -0.5
    scores = jnp.einsum('bnqhd,bnkhd->bnhqk', q, kb).astype(jnp.float32) * scale
    scores = scores + bias[None, None]
    scores = jnp.where(valid[None, :, None, None, :], scores, NEG_INF)
    probs = jax.nn.softmax(scores, axis=-1).astype(vb.dtype)
    out = jnp.einsum('bnhqk,bnkhd->bnqhd', probs, vb)
    return out.reshape(b, s, D_ATTN)


def gated_short_conv(bg, cg, xc, conv_w, conv_b):
    s = xc.shape[1]
    u = cg * xc
    up = jnp.pad(u, ((0, 0), (CONV_WIDTH - 1, 0), (0, 0)))
    conv = conv_b + sum(conv_w[j] * up[:, j:j + s] for j in range(CONV_WIDTH))
    return bg * conv


def setup_inputs(seed: int = 0) -> dict:
    key = jax.random.key(seed)
    ks = jax.random.split(key, 20)
    f32 = jnp.float32
    d_in = 3 * D_ATTN + 3 * D_CONV
    return {
        "x": jax.random.normal(ks[0], (BATCH, SEQ, D_MODEL), f32),
        "norm1_g": 1.0 + 0.05 * jax.random.normal(ks[1], (D_MODEL,), f32),
        "w_in": jax.random.normal(ks[2], (D_MODEL, d_in), f32) * D_MODEL ** -0.5,
        "q_norm_g": 1.0 + 0.05 * jax.random.normal(ks[3], (HEAD_DIM,), f32),
        "k_norm_g": 1.0 + 0.05 * jax.random.normal(ks[4], (HEAD_DIM,), f32),
        "rel_bias": 0.5 * jax.random.normal(ks[5], (N_HEADS, 2 * MAX_REL + 1), f32),
        "conv_w": jax.random.normal(ks[6], (CONV_WIDTH, D_CONV), f32) * CONV_WIDTH ** -0.5,
        "conv_b": 0.02 * jax.random.normal(ks[7], (D_CONV,), f32),
        "w_attn_proj": jax.random.normal(ks[8], (D_ATTN, D_MODEL), f32) * D_ATTN ** -0.5,
        "w_conv_proj": jax.random.normal(ks[9], (D_CONV, D_MODEL), f32) * D_CONV ** -0.5,
        "w_gate": jax.random.normal(ks[10], (D_MODEL, N_BRANCHES * D_MODEL), f32) * D_MODEL ** -0.5,
        "b_gate": 0.02 * jax.random.normal(ks[11], (N_BRANCHES * D_MODEL,), f32),
        "w_out": jax.random.normal(ks[12], (D_MODEL, D_MODEL), f32) * D_MODEL ** -0.5,
        "norm2_g": 1.0 + 0.05 * jax.random.normal(ks[13], (D_MODEL,), f32),
        "w_up": jax.random.normal(ks[14], (D_MODEL, D_FF), f32) * D_MODEL ** -0.5,
        "w_down": jax.random.normal(ks[15], (D_FF, D_MODEL), f32) * D_FF ** -0.5,
    }


def reference(x, norm1_g, w_in, q_norm_g, k_norm_g, rel_bias, conv_w, conv_b,
              w_attn_proj, w_conv_proj, w_gate, b_gate, w_out, norm2_g, w_up, w_down):
    for _ in range(DEPTH):
        h = rms_norm(x, norm1_g)
        proj = jnp.einsum('bsd,de->bse', h, w_in)
        q, k, v, bg, cg, xc = jnp.split(
            proj,
            [D_ATTN, 2 * D_ATTN, 3 * D_ATTN,
             3 * D_ATTN + D_CONV, 3 * D_ATTN + 2 * D_CONV],
            axis=-1)

        y_attn = chunked_relpos_attention(q, k, v, q_norm_g, k_norm_g, rel_bias)
        y_conv = gated_short_conv(bg, cg, xc, conv_w, conv_b)

        y_attn = jnp.einsum('bse,ed->bsd', y_attn, w_attn_proj)
        y_conv = jnp.einsum('bse,ed->bsd', y_conv, w_conv_proj)

        gates = jax.nn.sigmoid(jnp.einsum('bsd,de->bse', h, w_gate) + b_gate)
        g_attn, g_conv = jnp.split(gates, 2, axis=-1)
        merged = g_attn * y_attn + g_conv * y_conv
        x = x + jnp.einsum('bsd,de->bse', merged, w_out)

        h2 = rms_norm(x, norm2_g)
        u = jnp.square(jax.nn.relu(jnp.einsum('bsd,df->bsf', h2, w_up)))
        x = x + jnp.einsum('bsf,fd->bsd', u, w_down)
    return x
```

```cpp
#include <hip/hip_runtime.h>
#include <cstdio>
#include <cstdint>
namespace pg8 {
#define PG8_LAS __attribute__((address_space(3)))
typedef unsigned short bf16_t;
typedef short bf16x8 __attribute__((ext_vector_type(8)));
typedef float f32x4 __attribute__((ext_vector_type(4)));
typedef unsigned u32x4 __attribute__((ext_vector_type(4)));
constexpr int BM = 256, BK = 64, HALF = 128, HTB = HALF * BK * 2  , STAGE_BYTES = 8 * HTB, NXCD = 8, WGM = 8;

__host__ __device__ __forceinline__ int lds_byte(int r, int c) { const int st = (r >> 4) * 2 + (c >> 5), rr = r & 15, cc = c & 31, ob = rr * 64 + cc * 2; return st * 1024 + (ob ^ (((ob >> 9) & 1) << 5)); }
__host__ __device__ __forceinline__ void stage_rc(int b, int& R, int& C) { const int st = b / 1024, sb = b % 1024, swz = sb ^ (((sb >> 9) & 1) << 5); R = (st >> 1) * 16 + swz / 64; C = (st & 1) * 32 + (swz % 64) / 2; }
__host__ __device__ __forceinline__ int perm32(int rho) { const int n = rho >> 4, i = rho & 15; return 8 * (i >> 2) + 4 * n + (i & 3); }

struct Unit { int pm, pn; };
struct Gemm { const bf16_t* A; const bf16_t* Bt; int M, N, K; };

struct StaticOrder {
    int nM, nN, nwg, G, c;
    __host__ __device__ void init(int M, int N, int G_, int c_) { nM = M / BM; nN = N / BM; nwg = nM * nN; G = G_; c = c_; }
    __host__ __device__ bool next(int i, Unit& u) const {
        const long L = (long)i * G + c; if (L >= nwg) return false;
        int wgid = (int)L; { const int q = nwg / NXCD, r = nwg % NXCD, xcd = wgid % NXCD, off = wgid / NXCD; wgid = (xcd < r ? xcd * (q + 1) : r * (q + 1) + (xcd - r) * q) + off; }
        const int nig = WGM * nN, gid = wgid / nig, fm = gid * WGM, gsz = (nM - fm) < WGM ? (nM - fm) : WGM;
        u.pm = fm + ((wgid % nig) % gsz); u.pn = (wgid % nig) / gsz; return true;
    }
    __device__ __forceinline__ void a_ready(const Unit&) const {}
    __device__ __forceinline__ void done(const Unit&) const {}
};

__device__ __forceinline__ unsigned cvt_pk_bf16(float lo, float hi) { unsigned r; asm volatile("v_cvt_pk_bf16_f32 %0, %1, %2" : "=v"(r) : "v"(lo), "v"(hi)); return r; }
typedef float f32x2 __attribute__((ext_vector_type(2)));
typedef unsigned u32x2 __attribute__((ext_vector_type(2)));
__device__ __forceinline__ float bf_lo(unsigned w) { return __uint_as_float(w << 16); }
__device__ __forceinline__ float bf_hi(unsigned w) { return __uint_as_float(w & 0xffff0000u); }
__device__ __forceinline__ u32x4 pack8(f32x4 a, f32x4 b) { u32x4 w; w.x = cvt_pk_bf16(a[0], a[1]); w.y = cvt_pk_bf16(a[2], a[3]); w.z = cvt_pk_bf16(b[0], b[1]); w.w = cvt_pk_bf16(b[2], b[3]); return w; }
__device__ __forceinline__ void unpack8(u32x4 w, f32x4& a, f32x4& b) { a = (f32x4){bf_lo(w.x), bf_hi(w.x), bf_lo(w.y), bf_hi(w.y)}; b = (f32x4){bf_lo(w.z), bf_hi(w.z), bf_lo(w.w), bf_hi(w.w)}; }
constexpr float QK_C2 = 0.125f * 1.4426950408889634f;
constexpr float RMS_EPS = 1e-6f;

struct EpiP1 {
    static constexpr bool PERM = true, AFTER_DRAIN = false;
    bf16_t *Q, *Kb, *V, *BG, *U1, *G; const float *gq, *gk, *bgate;
    __device__ __forceinline__ void operator()(const f32x4 (&acc)[2][2][4][2], const Unit& u, int wr, int wc, int fr, int fq) const {
        const int pn = u.pn; const int row0 = u.pm * BM + wr * 64 + fr;
        if (pn < 8) {
            const bool isq = pn < 4; const float* g = isq ? gq : gk; bf16_t* O = isq ? Q : Kb; const float sc = isq ? QK_C2 : 1.f;
            const int head = 4 * (pn & 3) + wc;
            f32x4 gv[2][2];
#pragma unroll
            for (int bj = 0; bj < 2; ++bj)
#pragma unroll
                for (int n = 0; n < 2; ++n) gv[bj][n] = *(const f32x4*)(g + 32 * bj + 8 * fq + 4 * n) * sc;
#pragma unroll
            for (int ai = 0; ai < 2; ++ai)
#pragma unroll
                for (int m = 0; m < 4; ++m) {
                    float s = 0.f;
#pragma unroll
                    for (int bj = 0; bj < 2; ++bj)
#pragma unroll
                        for (int n = 0; n < 2; ++n) { const f32x4 x = acc[ai][bj][m][n]; s += (x[0] * x[0] + x[1] * x[1]) + (x[2] * x[2] + x[3] * x[3]); }
                    s += __shfl_xor(s, 16); s += __shfl_xor(s, 32);
                    const float rs = 1.0f / sqrtf(s * (1.0f / 64.0f) + RMS_EPS);
                    bf16_t* rowp = O + (size_t)(row0 + ai * HALF + m * 16) * 1024 + head * 64 + 8 * fq;
#pragma unroll
                    for (int bj = 0; bj < 2; ++bj) *(u32x4*)(rowp + 32 * bj) = pack8(acc[ai][bj][m][0] * rs * gv[bj][0], acc[ai][bj][m][1] * rs * gv[bj][1]);
                }
        } else if (pn < 16) {
            bf16_t* O = (pn < 12) ? V : BG; const int col0 = 256 * (pn & 3) + wc * 32 + 8 * fq;
#pragma unroll
            for (int ai = 0; ai < 2; ++ai)
#pragma unroll
                for (int m = 0; m < 4; ++m) { bf16_t* rowp = O + (size_t)(row0 + ai * HALF + m * 16) * 1024 + col0;
#pragma unroll
                    for (int bj = 0; bj < 2; ++bj) *(u32x4*)(rowp + bj * HALF) = pack8(acc[ai][bj][m][0], acc[ai][bj][m][1]); }
        } else if (pn < 24) {
            const int col0 = 128 * (pn - 16) + wc * 32 + 8 * fq;
#pragma unroll
            for (int ai = 0; ai < 2; ++ai)
#pragma unroll
                for (int m = 0; m < 4; ++m)
                    *(u32x4*)(U1 + (size_t)(row0 + ai * HALF + m * 16) * 1024 + col0) = pack8(acc[ai][0][m][0] * acc[ai][1][m][0], acc[ai][0][m][1] * acc[ai][1][m][1]);
        } else {
            const int col0 = 256 * (pn - 24) + wc * 32 + 8 * fq;
            f32x4 bv[2][2];
#pragma unroll
            for (int bj = 0; bj < 2; ++bj)
#pragma unroll
                for (int n = 0; n < 2; ++n) bv[bj][n] = *(const f32x4*)(bgate + col0 + bj * HALF + 4 * n);
#pragma unroll
            for (int ai = 0; ai < 2; ++ai)
#pragma unroll
                for (int m = 0; m < 4; ++m) { bf16_t* rowp = G + (size_t)(row0 + ai * HALF + m * 16) * 2048 + col0;
#pragma unroll
                    for (int bj = 0; bj < 2; ++bj) { f32x4 v[2];
#pragma unroll
                        for (int n = 0; n < 2; ++n) { const f32x4 z = (acc[ai][bj][m][n] + bv[bj][n]) * (-1.4426950408889634f);
#pragma unroll
                            for (int e = 0; e < 4; ++e) v[n][e] = __builtin_amdgcn_rcpf(1.0f + __builtin_amdgcn_exp2f(z[e])); }
                        *(u32x4*)(rowp + bj * HALF) = pack8(v[0], v[1]); } }
        }
    }
};
template <bool ADD> struct EpiGate {
    static constexpr bool PERM = true, AFTER_DRAIN = false;
    const bf16_t* G; bf16_t* MG; int goff;
    __device__ __forceinline__ void operator()(const f32x4 (&acc)[2][2][4][2], const Unit& u, int wr, int wc, int fr, int fq) const {
        const int row0 = u.pm * BM + wr * 64 + fr, col0 = u.pn * BM + wc * 32 + 8 * fq;
#pragma unroll
        for (int ai = 0; ai < 2; ++ai)
#pragma unroll
            for (int m = 0; m < 4; ++m) { const size_t r = (size_t)(row0 + ai * HALF + m * 16);
#pragma unroll
                for (int bj = 0; bj < 2; ++bj) { f32x4 g0, g1; unpack8(*(const u32x4*)(G + r * 2048 + goff + col0 + bj * HALF), g0, g1);
                    f32x4 v0 = acc[ai][bj][m][0] * g0, v1 = acc[ai][bj][m][1] * g1;
                    bf16_t* p = MG + r * 1024 + col0 + bj * HALF;
                    if (ADD) { f32x4 a0, a1; unpack8(*(const u32x4*)p, a0, a1); v0 += a0; v1 += a1; }
                    *(u32x4*)p = pack8(v0, v1); } }
    }
};
struct EpiRes1 {
    static constexpr bool PERM = false, AFTER_DRAIN = false;
    const float* x; float* out; bf16_t* x1b; float* SS;
    __device__ __forceinline__ void operator()(const f32x4 (&acc)[2][2][4][2], const Unit& u, int wr, int wc, int fr, int fq) const {
        const int row0 = u.pm * BM + wr * 64 + fr, col0 = u.pn * BM + wc * 32 + 4 * fq;
#pragma unroll
        for (int ai = 0; ai < 2; ++ai)
#pragma unroll
            for (int m = 0; m < 4; ++m) { const size_t r = (size_t)(row0 + ai * HALF + m * 16); const size_t off = r * 1024 + col0; float s = 0.f;
#pragma unroll
                for (int bj = 0; bj < 2; ++bj)
#pragma unroll
                    for (int n = 0; n < 2; ++n) { const f32x4 v = *(const f32x4*)(x + off + bj * HALF + n * 16) + acc[ai][bj][m][n];
                        *(f32x4*)(out + off + bj * HALF + n * 16) = v; s += (v[0] * v[0] + v[1] * v[1]) + (v[2] * v[2] + v[3] * v[3]);
                        u32x2 w; w.x = cvt_pk_bf16(v[0], v[1]); w.y = cvt_pk_bf16(v[2], v[3]); *(u32x2*)(x1b + off + bj * HALF + n * 16) = w; }
                s += __shfl_xor(s, 16); s += __shfl_xor(s, 32);
                if (fq == 0) SS[r * 16 + 4 * u.pn + wc] = s;
                if (m & 1) asm volatile("" ::: "memory"); }
    }
};
struct EpiUp {
    static constexpr bool PERM = true, AFTER_DRAIN = false;
    const float* SS; bf16_t* UU;
    __device__ __forceinline__ void operator()(const f32x4 (&acc)[2][2][4][2], const Unit& u, int wr, int wc, int fr, int fq) const {
        const int row0 = u.pm * BM + wr * 64 + fr, col0 = u.pn * BM + wc * 32 + 8 * fq;
#pragma unroll
        for (int ai = 0; ai < 2; ++ai)
#pragma unroll
            for (int m = 0; m < 4; ++m) { const size_t r = (size_t)(row0 + ai * HALF + m * 16);
                const f32x4* sp = (const f32x4*)(SS + r * 16); const f32x4 s4 = (sp[0] + sp[1]) + (sp[2] + sp[3]);
                const float rs = 1.0f / sqrtf(((s4[0] + s4[1]) + (s4[2] + s4[3])) * (1.0f / 1024.0f) + RMS_EPS);
#pragma unroll
                for (int bj = 0; bj < 2; ++bj) { f32x4 v[2];
#pragma unroll
                    for (int n = 0; n < 2; ++n) { const f32x4 z = acc[ai][bj][m][n] * rs;
#pragma unroll
                        for (int e = 0; e < 4; ++e) { const float t = fmaxf(z[e], 0.f); v[n][e] = t * t; } }
                    *(u32x4*)(UU + r * 4096 + col0 + bj * HALF) = pack8(v[0], v[1]); } }
    }
};
struct EpiRes2 {
    static constexpr bool PERM = false, AFTER_DRAIN = false;
    float* out;
    __device__ __forceinline__ void operator()(const f32x4 (&acc)[2][2][4][2], const Unit& u, int wr, int wc, int fr, int fq) const {
        const int row0 = u.pm * BM + wr * 64 + fr, col0 = u.pn * BM + wc * 32 + 4 * fq;
#pragma unroll
        for (int ai = 0; ai < 2; ++ai)
#pragma unroll
            for (int m = 0; m < 4; ++m) { const size_t off = (size_t)(row0 + ai * HALF + m * 16) * 1024 + col0;
#pragma unroll
                for (int bj = 0; bj < 2; ++bj)
#pragma unroll
                    for (int n = 0; n < 2; ++n) { float* p = out + off + bj * HALF + n * 16; *(f32x4*)p = *(const f32x4*)p + acc[ai][bj][m][n]; }
                if (m & 1) asm volatile("" ::: "memory"); }
    }
};

template <class Epi, class Sched, bool ALIGN_EPI = false, bool SP2 = false>
__device__ __forceinline__ void gemm_phase(PG8_LAS unsigned char* lds, const Gemm g, const Sched& S, const Epi& E) {
    const int tid = threadIdx.x, wid = __builtin_amdgcn_readfirstlane(tid >> 6), lane = tid & 63, wr = wid >> 2, wc = wid & 3, fr = lane & 15, fq = lane >> 4;
    const int K = g.K, nt = K / BK;
    unsigned voffA[2], voffB[2];
#pragma unroll
    for (int i = 0; i < 2; ++i) { int R, C; stage_rc(tid * 16 + i * 8192, R, C); const int Rb = Epi::PERM ? ((R & ~31) + perm32(R & 31)) : R;
        voffA[i] = (unsigned)(R * K + C) * 2u; voffB[i] = (unsigned)(Rb * K + C) * 2u; }
    const size_t kstep = (size_t)(BK * 2);
    const size_t hstep = (size_t)HALF * K * 2;
    const size_t tstep = 2 * hstep;
    const unsigned ldsw = (unsigned)wid * 1024u;
    const int aoff = lds_byte(wr * 64 + fr, fq * 8), boff = lds_byte(wc * 32 + fr, fq * 8);
#define PG8_SA(b, h) (((b) * 2 + (h)) * HTB)
#define PG8_SB(b, h) ((4 + (b) * 2 + (h)) * HTB)
#define PG8_STAGE(bufoff, gbase, voff) do { _Pragma("unroll") for (int _i = 0; _i < 2; ++_i) \
        __builtin_amdgcn_global_load_lds((const unsigned*)((const char*)(gbase) + (voff)[_i]), (PG8_LAS unsigned*)(lds + (bufoff) + ldsw + _i * 8192), 16, 0, 0); } while (0)
#define PG8_LDA(dst, b, h) do { _Pragma("unroll") for (int m = 0; m < 4; ++m) _Pragma("unroll") for (int k = 0; k < 2; ++k) dst[m][k] = *(const PG8_LAS bf16x8*)(lds + PG8_SA(b, h) + aoff + m * 2048 + k * 1024); } while (0)
#define PG8_LDB(dst, b, h) do { _Pragma("unroll") for (int n = 0; n < 2; ++n) _Pragma("unroll") for (int k = 0; k < 2; ++k) dst[n][k] = *(const PG8_LAS bf16x8*)(lds + PG8_SB(b, h) + boff + n * 2048 + k * 1024); } while (0)
#define PG8_MMA(ai, bj, At, Bt) do { __builtin_amdgcn_s_setprio(1); _Pragma("unroll") for (int m = 0; m < 4; ++m) _Pragma("unroll") for (int n = 0; n < 2; ++n) _Pragma("unroll") for (int k = 0; k < 2; ++k) \
        acc[ai][bj][m][n] = __builtin_amdgcn_mfma_f32_16x16x32_bf16(Bt[n][k], At[m][k], acc[ai][bj][m][n], 0, 0, 0); __builtin_amdgcn_s_setprio(0); } while (0)
#define PG8_WAIT_V(n) asm volatile("s_waitcnt vmcnt(" #n ")" ::: "memory")
#define PG8_WAIT_L(n) asm volatile("s_waitcnt lgkmcnt(" #n ")" ::: "memory")
#define PG8_BAR __builtin_amdgcn_s_barrier()
#define PG8_SCHED __builtin_amdgcn_sched_barrier(0)
    Unit cur, nxt; int ui = 0;
    if (!S.next(0, cur)) return;
    f32x4 acc[2][2][4][2];
#pragma unroll
    for (int a = 0; a < 2; ++a)
#pragma unroll
        for (int b = 0; b < 2; ++b)
#pragma unroll
            for (int m = 0; m < 4; ++m)
#pragma unroll
                for (int n = 0; n < 2; ++n) acc[a][b][m][n] = (f32x4){0.f, 0.f, 0.f, 0.f};
    bf16x8 At[4][2], B0[2][2], B1[2][2];
    const char* cA = (const char*)g.A + (size_t)cur.pm * tstep; const char* cB = (const char*)g.Bt + (size_t)cur.pn * tstep;
    S.a_ready(cur);
    if constexpr (SP2) {
        PG8_STAGE(PG8_SB(0, 0), cB, voffB); PG8_STAGE(PG8_SB(0, 1), cB + hstep, voffB); PG8_STAGE(PG8_SA(0, 0), cA, voffA); PG8_STAGE(PG8_SA(0, 1), cA + hstep, voffA);
        if (wr == 1) PG8_BAR;
        PG8_WAIT_V(2); PG8_BAR;
        PG8_STAGE(PG8_SB(1, 0), cB + kstep, voffB); PG8_STAGE(PG8_SA(1, 0), cA + kstep, voffA); PG8_STAGE(PG8_SB(1, 1), cB + hstep + kstep, voffB);
        PG8_WAIT_V(6); PG8_BAR;
    } else {
        PG8_STAGE(PG8_SB(0, 0), cB, voffB); PG8_STAGE(PG8_SA(0, 0), cA, voffA); PG8_STAGE(PG8_SB(0, 1), cB + hstep, voffB); PG8_STAGE(PG8_SA(0, 1), cA + hstep, voffA);
        if (wr == 1) PG8_BAR;
        PG8_WAIT_V(4); PG8_BAR;
        PG8_STAGE(PG8_SB(1, 0), cB + kstep, voffB); PG8_STAGE(PG8_SA(1, 0), cA + kstep, voffA); PG8_STAGE(PG8_SB(1, 1), cB + hstep + kstep, voffB);
        PG8_WAIT_V(6); PG8_BAR;
    }
    for (;;) {
        const bool has_next = S.next(ui + 1, nxt);
        const char* nA = has_next ? (const char*)g.A + (size_t)nxt.pm * tstep : cA; const char* nB = has_next ? (const char*)g.Bt + (size_t)nxt.pn * tstep : cB;
        for (int t = 0; t < nt; t += 2) {
            const bool last = (t == nt - 2);
            const char* a1 = cA + (size_t)(t + 1) * kstep;
            const char* a2 = last ? nA : cA + (size_t)(t + 2) * kstep; const char* b2 = last ? nB : cB + (size_t)(t + 2) * kstep;
            const char* a3 = a2 + kstep; const char* b3 = b2 + kstep;
            if (last && has_next) S.a_ready(nxt);
            if constexpr (SP2) {
            PG8_LDB(B0, 0, 0); PG8_LDB(B1, 0, 1); PG8_SCHED; PG8_LDA(At, 0, 0); PG8_STAGE(PG8_SA(1, 1), a1 + hstep, voffA);
            PG8_WAIT_V(8); PG8_WAIT_L(0); PG8_BAR; PG8_MMA(0, 0, At, B0); PG8_MMA(0, 1, At, B1); PG8_BAR; PG8_SCHED;
            PG8_LDA(At, 0, 1); PG8_STAGE(PG8_SB(0, 0), b2, voffB); PG8_STAGE(PG8_SB(0, 1), b2 + hstep, voffB); PG8_STAGE(PG8_SA(0, 0), a2, voffA);
            PG8_WAIT_V(8); PG8_WAIT_L(0); PG8_BAR; PG8_MMA(1, 0, At, B0); PG8_MMA(1, 1, At, B1); PG8_BAR; PG8_SCHED;
            PG8_LDB(B0, 1, 0); PG8_LDB(B1, 1, 1); PG8_SCHED; PG8_LDA(At, 1, 0); PG8_STAGE(PG8_SA(0, 1), a2 + hstep, voffA);
            PG8_WAIT_V(8); PG8_WAIT_L(0); PG8_BAR; PG8_MMA(0, 0, At, B0); PG8_MMA(0, 1, At, B1); PG8_BAR; PG8_SCHED;
            PG8_LDA(At, 1, 1); PG8_STAGE(PG8_SB(1, 0), b3, voffB); PG8_STAGE(PG8_SB(1, 1), b3 + hstep, voffB); PG8_STAGE(PG8_SA(1, 0), a3, voffA);
            PG8_WAIT_V(8); PG8_WAIT_L(0); PG8_BAR; PG8_MMA(1, 0, At, B0); PG8_MMA(1, 1, At, B1); PG8_BAR; PG8_SCHED;
            } else {
            PG8_LDB(B0, 0, 0); PG8_SCHED; PG8_LDA(At, 0, 0); PG8_STAGE(PG8_SA(1, 1), a1 + hstep, voffA);
            PG8_WAIT_L(8); PG8_BAR; PG8_WAIT_L(0); PG8_MMA(0, 0, At, B0); PG8_BAR; PG8_SCHED;
            PG8_LDB(B1, 0, 1); PG8_STAGE(PG8_SB(0, 0), b2, voffB);
            PG8_BAR; PG8_WAIT_L(0); PG8_MMA(0, 1, At, B1); PG8_BAR;
            PG8_LDA(At, 0, 1); PG8_STAGE(PG8_SA(0, 0), a2, voffA);
            PG8_BAR; PG8_WAIT_L(0); PG8_MMA(1, 0, At, B0); PG8_BAR; PG8_SCHED;
            PG8_STAGE(PG8_SB(0, 1), b2 + hstep, voffB);
            PG8_WAIT_V(6); PG8_BAR; PG8_MMA(1, 1, At, B1); PG8_BAR;
            PG8_LDB(B0, 1, 0); PG8_SCHED; PG8_LDA(At, 1, 0); PG8_STAGE(PG8_SA(0, 1), a2 + hstep, voffA);
            PG8_WAIT_L(8); PG8_BAR; PG8_WAIT_L(0); PG8_MMA(0, 0, At, B0); PG8_BAR; PG8_SCHED;
            PG8_LDB(B1, 1, 1); PG8_STAGE(PG8_SB(1, 0), b3, voffB);
            PG8_BAR; PG8_WAIT_L(0); PG8_MMA(0, 1, At, B1); PG8_BAR;
            PG8_LDA(At, 1, 1); PG8_STAGE(PG8_SA(1, 0), a3, voffA);
            PG8_BAR; PG8_WAIT_L(0); PG8_MMA(1, 0, At, B0); PG8_BAR; PG8_SCHED;
            PG8_STAGE(PG8_SB(1, 1), b3 + hstep, voffB);
            PG8_WAIT_V(6); PG8_BAR; PG8_MMA(1, 1, At, B1); PG8_BAR;
            }
        }
        if constexpr (ALIGN_EPI) { if (wr == 0) PG8_BAR; }
        if constexpr (!Epi::AFTER_DRAIN) { E(acc, cur, wr, wc, fr, fq); S.done(cur); }
        if (!has_next) break;
#pragma unroll
        for (int a = 0; a < 2; ++a)
#pragma unroll
            for (int b = 0; b < 2; ++b)
#pragma unroll
                for (int m = 0; m < 4; ++m)
#pragma unroll
                    for (int n = 0; n < 2; ++n) acc[a][b][m][n] = (f32x4){0.f, 0.f, 0.f, 0.f};
        cur = nxt; cA = nA; cB = nB; ++ui;
        if constexpr (ALIGN_EPI) { if (wr == 1) PG8_BAR; }
    }
    PG8_WAIT_V(0);
    if constexpr (!ALIGN_EPI) { if (wr == 0) PG8_BAR; }
    PG8_BAR;
    if constexpr (Epi::AFTER_DRAIN) { E.fused(acc, cur, wr, wc, fr, fq, lds, wid, lane); S.done(cur); }
#undef PG8_SA
#undef PG8_SB
#undef PG8_STAGE
#undef PG8_LDA
#undef PG8_LDB
#undef PG8_MMA
#undef PG8_WAIT_V
#undef PG8_WAIT_L
#undef PG8_BAR
#undef PG8_SCHED
}
}

namespace attn {
using bf16 = unsigned short;
using bf16x8 = __attribute__((ext_vector_type(8))) short;
using s16x4 = __attribute__((ext_vector_type(4))) short;
using f32x16 = __attribute__((ext_vector_type(16))) float;
using u32x4 = __attribute__((ext_vector_type(4))) unsigned;
constexpr int SEQ = 4096, DM = 1024, NSLOT = 3, SLOTB = 8192, NREL = 513;
constexpr int LDS_K = 0, LDS_V = NSLOT * SLOTB, LDS_WS = 2 * NSLOT * SLOTB, LDS_OST = LDS_WS + 8 * 64 * 4, LDS_BIAS = LDS_OST + 8 * 4096, LDS_BYTES = LDS_BIAS + 384 * 4;
constexpr float LOG2E = 1.4426950408889634f;
__device__ __forceinline__ int crow(int r, int hi) { return (r & 3) + 8 * (r >> 2) + 4 * hi; }
#define SBAR() __builtin_amdgcn_sched_barrier(0)
__device__ __forceinline__ void glds16(const void* gsrc, unsigned lds_dst) { unsigned keep;
  asm volatile("s_mov_b32 %0, m0\n\ts_mov_b32 m0, %2\n\ts_nop 0\n\tglobal_load_lds_dwordx4 %1, off\n\ts_mov_b32 m0, %0" : "=&s"(keep) : "v"(gsrc), "s"(lds_dst) : "memory"); }
typedef float f32x2_t __attribute__((ext_vector_type(2))); typedef __bf16 bf16x2_t __attribute__((ext_vector_type(2)));
__device__ __forceinline__ unsigned cvtpk_s(float lo, float hi) { f32x2_t v = {lo, hi}; bf16x2_t b = __builtin_convertvector(v, bf16x2_t); return __builtin_bit_cast(unsigned, b); }
typedef __attribute__((address_space(3))) const char* lds_cptr;
__device__ __forceinline__ void kload8(bf16x8* kf, lds_cptr kp) {
  kf[0] = *(const __attribute__((address_space(3))) bf16x8*)(kp);        kf[1] = *(const __attribute__((address_space(3))) bf16x8*)(kp + 512);
  kf[2] = *(const __attribute__((address_space(3))) bf16x8*)(kp + 2048); kf[3] = *(const __attribute__((address_space(3))) bf16x8*)(kp + 2560);
  kf[4] = *(const __attribute__((address_space(3))) bf16x8*)(kp + 4096); kf[5] = *(const __attribute__((address_space(3))) bf16x8*)(kp + 4608);
  kf[6] = *(const __attribute__((address_space(3))) bf16x8*)(kp + 6144); kf[7] = *(const __attribute__((address_space(3))) bf16x8*)(kp + 6656);
}
__device__ __forceinline__ void pv(f32x16* o, int vb, bf16x8 pa0, bf16x8 pa1, bf16x8 pa2, bf16x8 pa3) {
  #pragma unroll
  for (int d0 = 0; d0 < 2; ++d0) { s16x4 lo[4], hi[4];
    #pragma unroll
    for (int ks = 0; ks < 4; ++ks) {
      asm volatile("ds_read_b64_tr_b16 %0,%1 offset:%c2" : "=&v"(lo[ks]) : "v"(vb), "i"(d0 * 4096 + ks * 1024) : "memory");
      asm volatile("ds_read_b64_tr_b16 %0,%1 offset:%c2" : "=&v"(hi[ks]) : "v"(vb), "i"(d0 * 4096 + ks * 1024 + 512) : "memory"); }
    asm volatile("s_waitcnt lgkmcnt(0)" ::: "memory"); SBAR();
    #define PK(k) (bf16x8){lo[k][0], lo[k][1], lo[k][2], lo[k][3], hi[k][0], hi[k][1], hi[k][2], hi[k][3]}
    o[d0] = __builtin_amdgcn_mfma_f32_32x32x16_bf16(pa0, PK(0), o[d0], 0, 0, 0);
    o[d0] = __builtin_amdgcn_mfma_f32_32x32x16_bf16(pa1, PK(1), o[d0], 0, 0, 0);
    o[d0] = __builtin_amdgcn_mfma_f32_32x32x16_bf16(pa2, PK(2), o[d0], 0, 0, 0);
    o[d0] = __builtin_amdgcn_mfma_f32_32x32x16_bf16(pa3, PK(3), o[d0], 0, 0, 0);
    #undef PK
  }
}
__device__ __forceinline__ float wmax(float v) {
#pragma unroll
  for (int o = 1; o < 64; o <<= 1) v = fmaxf(v, __shfl_xor(v, o));
  return v;
}
__device__ __forceinline__ void attn_unit(int b, int h, int g, const bf16* Q, const bf16* __restrict__ K, const bf16* __restrict__ V, bf16* O,
                                          const float* __restrict__ relb, const float* __restrict__ gq, const float* __restrict__ gk, char* shm) {
  const int tid = threadIdx.x, lane = tid & 63, r32 = lane & 31, hi = lane >> 5; const int wid = __builtin_amdgcn_readfirstlane(tid >> 6);
  const long rowbase = (long)b * SEQ; const int q0 = g * 256;
  const int kc_lo = (4 * g - 8) > 0 ? (4 * g - 8) : 0, NT = 4 * g + 4 - kc_lo;
  const bf16* Qw = Q + (rowbase + q0 + wid * 32) * DM + h * 64;
  const bf16* Kh = K + (rowbase + 64 * kc_lo) * DM + h * 64; const bf16* Vh = V + (rowbase + 64 * kc_lo) * DM + h * 64;
  const unsigned lds0 = (unsigned)(uintptr_t)shm;
  float* wsf = (float*)(shm + LDS_WS) + wid * 64;
  float* biasT = (float*)(shm + LDS_BIAS);
  const bf16* ksrc = Kh + (long)lane * DM + wid * 8;
  const bf16* vsrc = Vh + (long)(16 * (wid & 3) + (lane >> 2)) * DM + (wid >> 2) * 32 + (lane & 3) * 8;
  const unsigned kdst = lds0 + LDS_K + wid * 1024, vdst = lds0 + LDS_V + wid * 1024;
  #define DMA_K(t, slot) glds16(ksrc + (long)(t) * 64 * DM, (unsigned)__builtin_amdgcn_readfirstlane(kdst + (slot)))
  #define DMA_V(t, slot) glds16(vsrc + (long)(t) * 64 * DM, (unsigned)__builtin_amdgcn_readfirstlane(vdst + (slot)))
  const int vb0 = (int)(lds0 + LDS_V) + ((lane >> 4) & 1) * 32 + (lane & 3) * 8 + (4 * hi + ((lane & 15) >> 2)) * 64;
  const lds_cptr shm3 = (lds_cptr)shm; const lds_cptr kp0 = shm3 + LDS_K + hi * 1024 + r32 * 16;
  asm volatile("s_waitcnt vmcnt(0)" ::: "memory");
  DMA_K(0, 0); DMA_V(0, 0); DMA_K(1, SLOTB); DMA_V(1, SLOTB);
  bf16x8 qr[4];
  #pragma unroll
  for (int d0 = 0; d0 < 4; ++d0) qr[d0] = *reinterpret_cast<const bf16x8*>(&Qw[(long)r32 * DM + d0 * 16 + hi * 8]);
  float m2;
  { const float mq = wmax(fabsf(gq[lane])), mk = wmax(fabsf(gk[lane])); float mb = -3.0e38f;
    for (int i = lane; i < NREL; i += 64) mb = fmaxf(mb, relb[h * NREL + i]);
    mb = wmax(mb); m2 = (8.0f * mq * mk + mb) * LOG2E; }
  for (int i = tid; i < 384; i += 512) biasT[i] = relb[h * NREL + (i < 64 ? 512 : 576 - i)] * LOG2E - m2;
  f32x16 o[2]; o[0] = f32x16{}; o[1] = f32x16{}; float l_reg = 0.f;
  const int qpos = 32 * (wid & 1) + r32;
  const int cch = 4 * g + (wid >> 1);
  asm volatile("s_waitcnt vmcnt(0) lgkmcnt(0)\n\ts_barrier" ::: "memory");
  int sl_cur = 0, sl_nn = 2 * SLOTB;
  for (int t = 0; t < NT; ++t) {
    if (t + 2 < NT) { DMA_K(t + 2, sl_nn); DMA_V(t + 2, sl_nn); }
    const int jrel = kc_lo + t - cch + 8;
    if (jrel >= 0 && jrel <= 8) {
      f32x16 p0, p1;
      if (jrel <= 3) { const float c0 = biasT[0];
        #pragma unroll
        for (int r = 0; r < 16; ++r) { p0[r] = c0; p1[r] = c0; } }
      else { const float* a = biasT + (64 + 4 * hi - qpos + 64 * (jrel - 4));
        #pragma unroll
        for (int r = 0; r < 16; ++r) { p0[r] = a[(r & 3) + 8 * (r >> 2)]; p1[r] = a[(r & 3) + 8 * (r >> 2) + 32]; } }
      bf16x8 kf[8]; kload8(kf, kp0 + sl_cur);
      #pragma unroll
      for (int d0 = 0; d0 < 4; ++d0) { p0 = __builtin_amdgcn_mfma_f32_32x32x16_bf16(kf[2 * d0], qr[d0], p0, 0, 0, 0); p1 = __builtin_amdgcn_mfma_f32_32x32x16_bf16(kf[2 * d0 + 1], qr[d0], p1, 0, 0, 0); }
      float sacc = 0.f;
      #pragma unroll
      for (int r = 0; r < 16; ++r) { p0[r] = __builtin_amdgcn_exp2f(p0[r]); p1[r] = __builtin_amdgcn_exp2f(p1[r]); sacc += p0[r] + p1[r]; }
      l_reg += sacc;
      u32x4 pw0, pw1, pw2, pw3;
      pw0 = (u32x4){cvtpk_s(p0[0], p0[1]), cvtpk_s(p0[2], p0[3]), cvtpk_s(p0[4], p0[5]), cvtpk_s(p0[6], p0[7])};
      pw1 = (u32x4){cvtpk_s(p0[8], p0[9]), cvtpk_s(p0[10], p0[11]), cvtpk_s(p0[12], p0[13]), cvtpk_s(p0[14], p0[15])};
      pw2 = (u32x4){cvtpk_s(p1[0], p1[1]), cvtpk_s(p1[2], p1[3]), cvtpk_s(p1[4], p1[5]), cvtpk_s(p1[6], p1[7])};
      pw3 = (u32x4){cvtpk_s(p1[8], p1[9]), cvtpk_s(p1[10], p1[11]), cvtpk_s(p1[12], p1[13]), cvtpk_s(p1[14], p1[15])};
      SBAR();
      pv(o, vb0 + sl_cur, __builtin_bit_cast(bf16x8, pw0), __builtin_bit_cast(bf16x8, pw1), __builtin_bit_cast(bf16x8, pw2), __builtin_bit_cast(bf16x8, pw3));
    }
    if (t + 2 < NT) asm volatile("s_waitcnt vmcnt(2) lgkmcnt(0)\n\ts_barrier" ::: "memory");
    else            asm volatile("s_waitcnt vmcnt(0) lgkmcnt(0)\n\ts_barrier" ::: "memory");
    sl_cur = (sl_cur == (NSLOT - 1) * SLOTB) ? 0 : sl_cur + SLOTB; sl_nn = (sl_nn == (NSLOT - 1) * SLOTB) ? 0 : sl_nn + SLOTB;
  }
  { auto rr = __builtin_amdgcn_permlane32_swap(__float_as_uint(l_reg), __float_as_uint(l_reg), false, false); l_reg = __uint_as_float(rr[0]) + __uint_as_float(rr[1]); }
  if (hi == 0) wsf[32 + r32] = l_reg; asm volatile("s_waitcnt lgkmcnt(0)" ::: "memory");
  float rli[16];
  #pragma unroll
  for (int r = 0; r < 16; ++r) rli[r] = __builtin_amdgcn_rcpf(wsf[32 + crow(r, hi)]);
  bf16* Ow = O + (rowbase + q0 + wid * 32) * DM + h * 64;
  { bf16* stg = (bf16*)(shm + LDS_OST) + wid * 2048;
    #pragma unroll
    for (int r = 0; r < 16; ++r) { const int orow = crow(r, hi);
      #pragma unroll
      for (int d0 = 0; d0 < 2; ++d0) stg[orow * 64 + d0 * 32 + r32] = (bf16)(cvtpk_s(o[d0][r] * rli[r], 0.f) & 0xffffu); }
    asm volatile("s_waitcnt lgkmcnt(0)" ::: "memory");
    #pragma unroll
    for (int i = 0; i < 4; ++i) { const int row = i * 8 + (lane >> 3), ch = lane & 7; const u32x4 v = *(const u32x4*)(stg + row * 64 + ch * 8); *(u32x4*)(Ow + (long)row * DM + ch * 8) = v; } }
  asm volatile("s_waitcnt lgkmcnt(0)\n\ts_barrier" ::: "memory");
  #undef DMA_K
  #undef DMA_V
}
#undef SBAR
}

#include <hip/hip_cooperative_groups.h>
namespace cg = cooperative_groups;
constexpr int NWAVES = 8;
constexpr int BATCH = 4, SEQ = 4096, D = 1024, FF = 4096, M = BATCH * SEQ, NIN = 8192;
constexpr size_t MiB = 1u << 20;
constexpr size_t WS_SS = 1 * MiB;
constexpr size_t WS_W1 = 2 * MiB, WS_WA = 18 * MiB, WS_WC = 20 * MiB, WS_WO = 22 * MiB, WS_WUP = 24 * MiB, WS_WDN = 32 * MiB;
constexpr size_t WS_V = 40 * MiB  , WS_H = 72 * MiB  , WS_Q = 104 * MiB, WS_K = 136 * MiB  , WS_BG = 168 * MiB  , WS_U1 = 200 * MiB;
constexpr size_t WS_UU = 72 * MiB;
constexpr size_t WS_END = 232 * MiB;
constexpr int LDS_BYTES = 147456;
#define GAS __attribute__((address_space(1)))
#define LAS __attribute__((address_space(3)))
typedef unsigned short bf16;
typedef unsigned v4u __attribute__((ext_vector_type(4)));
typedef float f32x4 __attribute__((ext_vector_type(4)));
#define LDS_WAIT() asm volatile("s_waitcnt lgkmcnt(0)" ::: "memory")
__device__ __forceinline__ unsigned f2bf(float f) { unsigned u = __builtin_bit_cast(unsigned, f); return (u + 0x7fffu + ((u >> 16) & 1u)) >> 16; }
__device__ __forceinline__ unsigned pk2(float lo, float hi) { return f2bf(lo) | (f2bf(hi) << 16); }
__device__ __forceinline__ float wave_sum(float v) {
#pragma unroll
    for (int o = 1; o < 64; o <<= 1) v += __shfl_xor(v, o);
    return v;
}
__device__ __forceinline__ void tr_item(const float* W, int ldw, int col0, int k0, bf16* WT, int Kd, int drow0, const float* kscale, LAS float* scr, int lane) {
#pragma unroll 8
    for (int i = 0; i < 32; ++i) { const int kk = 2 * i + (lane >> 5); float v = W[(size_t)(k0 + kk) * ldw + col0 + (lane & 31)]; if (kscale) v *= kscale[k0 + kk]; scr[kk * 33 + (lane & 31)] = v; }
    LDS_WAIT(); asm volatile("" ::: "memory");
    const int c = lane & 7;
#pragma unroll
    for (int j = 0; j < 4; ++j) { const int n = (lane >> 3) + 8 * j; const LAS float* s = scr + (8 * c) * 33 + n;
        v4u o; o.x = pk2(s[0 * 33], s[1 * 33]); o.y = pk2(s[2 * 33], s[3 * 33]); o.z = pk2(s[4 * 33], s[5 * 33]); o.w = pk2(s[6 * 33], s[7 * 33]);
        *(v4u*)(WT + (size_t)(drow0 + n) * Kd + k0 + 8 * c) = o; }
    LDS_WAIT(); asm volatile("" ::: "memory");
}

struct Args { const float* in[16]; float* out; unsigned char* ws; };
__global__ void __launch_bounds__(NWAVES * 64, 2) fwd(Args a) {
    extern __shared__ __attribute__((aligned(16))) unsigned char lds[];
    cg::grid_group grid = cg::this_grid();
    LAS unsigned char* ldsp = (LAS unsigned char*)lds;
    const int tid = threadIdx.x, lane = tid & 63, wave = __builtin_amdgcn_readfirstlane(tid >> 6);
    const int G = gridDim.x, bx = blockIdx.x, vcu = (G % 8 == 0) ? (bx % 8) * (G / 8) + bx / 8 : bx;
    unsigned char* ws = a.ws;
    const float* x = a.in[0];
    bf16 *W1 = (bf16*)(ws + WS_W1), *WA = (bf16*)(ws + WS_WA), *WC = (bf16*)(ws + WS_WC), *WO = (bf16*)(ws + WS_WO), *WUP = (bf16*)(ws + WS_WUP), *WDN = (bf16*)(ws + WS_WDN);
    bf16 *Vb = (bf16*)(ws + WS_V), *X1B = (bf16*)(ws + WS_V), *Hb = (bf16*)(ws + WS_H), *AO = (bf16*)(ws + WS_H), *Qb = (bf16*)(ws + WS_Q), *Kb = (bf16*)(ws + WS_K), *MG = (bf16*)(ws + WS_K);
    bf16 *BG = (bf16*)(ws + WS_BG), *U1 = (bf16*)(ws + WS_U1), *UU = (bf16*)(ws + WS_UU), *Gt = (bf16*)a.out;
    float* SS = (float*)(ws + WS_SS);

    {
        LAS float* scr = (LAS float*)(ldsp + wave * 16384);
        const int gw = vcu * NWAVES + wave, NGW = G * NWAVES;
        constexpr int I_1 = 16 * 256, I_S = 16 * 32, I_UP = 16 * 128, I_DN = 64 * 32, NITEMS = I_1 + 3 * I_S + I_UP + I_DN;
        for (int it = gw; it < NITEMS; it += NGW) {
            int r = it;
            if (r < I_1) { const int db = r & 255, kb = r >> 8, pn = db >> 3, pb = db & 7, bj = pb >> 2, wcc = pb & 3; const float* W = a.in[2]; int ldw = 6144, col;
                if (pn < 4) col = (4 * pn + wcc) * 64 + 32 * bj;
                else if (pn < 8) col = 1024 + (4 * (pn - 4) + wcc) * 64 + 32 * bj;
                else if (pn < 12) col = 2048 + 256 * (pn - 8) + 32 * pb;
                else if (pn < 16) col = 3072 + 256 * (pn - 12) + 32 * pb;
                else if (pn < 24) col = (bj ? 5120 : 4096) + 128 * (pn - 16) + 32 * wcc;
                else { W = a.in[10]; ldw = 2048; col = 256 * (pn - 24) + 32 * pb; }
                tr_item(W, ldw, col, 64 * kb, W1, D, 32 * db, nullptr, scr, lane); continue; } r -= I_1;
            if (r < I_S) { tr_item(a.in[8], D, 32 * (r & 31), 64 * (r >> 5), WA, D, 32 * (r & 31), nullptr, scr, lane); continue; } r -= I_S;
            if (r < I_S) { tr_item(a.in[9], D, 32 * (r & 31), 64 * (r >> 5), WC, D, 32 * (r & 31), nullptr, scr, lane); continue; } r -= I_S;
            if (r < I_S) { tr_item(a.in[12], D, 32 * (r & 31), 64 * (r >> 5), WO, D, 32 * (r & 31), nullptr, scr, lane); continue; } r -= I_S;
            if (r < I_UP) { tr_item(a.in[14], FF, 32 * (r & 127), 64 * (r >> 7), WUP, D, 32 * (r & 127), a.in[13], scr, lane); continue; } r -= I_UP;
            tr_item(a.in[15], D, 32 * (r & 31), 64 * (r >> 5), WDN, FF, 32 * (r & 31), nullptr, scr, lane);
        }
        const float* g1 = a.in[1];
        f32x4 gv[4];
#pragma unroll
        for (int j = 0; j < 4; ++j) gv[j] = ((const f32x4*)g1)[lane + 64 * j];
        for (int m = gw; m < M; m += NGW) {
            const f32x4* xr = (const f32x4*)(x + (size_t)m * D) + lane; f32x4 v[4]; float s = 0.f;
#pragma unroll
            for (int j = 0; j < 4; ++j) { v[j] = xr[64 * j]; s += (v[j].x * v[j].x + v[j].y * v[j].y) + (v[j].z * v[j].z + v[j].w * v[j].w); }
            const float rs = 1.0f / sqrtf(wave_sum(s) * (1.0f / D) + 1e-6f);
            unsigned long long* o8 = (unsigned long long*)(Hb + (size_t)m * D) + lane;
#pragma unroll
            for (int j = 0; j < 4; ++j) { const f32x4 y = v[j] * rs * gv[j]; o8[64 * j] = (unsigned long long)pk2(y.x, y.y) | ((unsigned long long)pk2(y.z, y.w) << 32); }
        }
    }
    grid.sync();

    {
        pg8::Gemm g{Hb, W1, M, NIN, D}; pg8::StaticOrder S; S.init(M, NIN, G, bx);
        pg8::EpiP1 E{Qb, Kb, Vb, BG, U1, Gt, a.in[3], a.in[4], a.in[11]};
        pg8::gemm_phase<pg8::EpiP1, pg8::StaticOrder, true, true>(ldsp, g, S, E);
    }
    grid.sync();

    {
        for (int L = vcu; L < 1024; L += G) { const int bh = (L & 255) >> 2, gq4 = (L & 3) + 4 * (L >> 8);
            attn::attn_unit(bh >> 4, bh & 15, gq4, Qb, Kb, Vb, AO, a.in[5], a.in[3], a.in[4], (char*)lds); }
        const float* cw = a.in[6]; const float* cb = a.in[7];
        for (int item = vcu * 512 + tid; item < 131072; item += G * 512) {
            const int c8 = (item & 127) * 8, t0 = (item >> 7) * 16;
            float w0[8], w1[8], w2[8], b0[8], u1[8], u2[8];
#pragma unroll
            for (int e = 0; e < 8; ++e) { w0[e] = cw[c8 + e]; w1[e] = cw[1024 + c8 + e]; w2[e] = cw[2048 + c8 + e]; b0[e] = cb[c8 + e]; u1[e] = 0.f; u2[e] = 0.f; }
            if ((t0 & (SEQ - 1)) != 0) { f32x4 p, q; pg8::unpack8(*(const v4u*)(U1 + (size_t)(t0 - 2) * D + c8), p, q);
#pragma unroll
                for (int e = 0; e < 4; ++e) { u2[e] = p[e]; u2[4 + e] = q[e]; }
                pg8::unpack8(*(const v4u*)(U1 + (size_t)(t0 - 1) * D + c8), p, q);
#pragma unroll
                for (int e = 0; e < 4; ++e) { u1[e] = p[e]; u1[4 + e] = q[e]; } }
#pragma unroll 4
            for (int i = 0; i < 16; ++i) { const size_t off = (size_t)(t0 + i) * D + c8; f32x4 p, q, bp, bq; float u0[8], bgv[8], y[8];
                pg8::unpack8(*(const v4u*)(U1 + off), p, q); pg8::unpack8(*(const v4u*)(BG + off), bp, bq);
#pragma unroll
                for (int e = 0; e < 4; ++e) { u0[e] = p[e]; u0[4 + e] = q[e]; bgv[e] = bp[e]; bgv[4 + e] = bq[e]; }
#pragma unroll
                for (int e = 0; e < 8; ++e) { y[e] = bgv[e] * (b0[e] + w0[e] * u2[e] + w1[e] * u1[e] + w2[e] * u0[e]); u2[e] = u1[e]; u1[e] = u0[e]; }
                v4u o; o.x = pk2(y[0], y[1]); o.y = pk2(y[2], y[3]); o.z = pk2(y[4], y[5]); o.w = pk2(y[6], y[7]); *(v4u*)(BG + off) = o; }
        }
    }
    grid.sync();

    {
        pg8::StaticOrder S; S.init(M, D, G, bx);
        { pg8::Gemm g{AO, WA, M, D, D}; pg8::EpiGate<false> E{Gt, MG, 0}; pg8::gemm_phase<pg8::EpiGate<false>, pg8::StaticOrder, true, true>(ldsp, g, S, E); }
        { pg8::Gemm g{BG, WC, M, D, D}; pg8::EpiGate<true> E{Gt, MG, 1024}; pg8::gemm_phase<pg8::EpiGate<true>, pg8::StaticOrder, true, true>(ldsp, g, S, E); }
    }
    grid.sync();

    {
        pg8::Gemm g{MG, WO, M, D, D}; pg8::StaticOrder S; S.init(M, D, G, bx);
        pg8::EpiRes1 E{x, a.out, X1B, SS};
        pg8::gemm_phase<pg8::EpiRes1, pg8::StaticOrder, true, true>(ldsp, g, S, E);
    }
    grid.sync();

    {
        pg8::Gemm g{X1B, WUP, M, FF, D}; pg8::StaticOrder S; S.init(M, FF, G, bx);
        pg8::EpiUp E{SS, UU};
        pg8::gemm_phase<pg8::EpiUp, pg8::StaticOrder, true, true>(ldsp, g, S, E);
    }
    grid.sync();

    {
        pg8::Gemm g{UU, WDN, M, D, FF}; pg8::StaticOrder S; S.init(M, D, G, bx);
        pg8::EpiRes2 E{a.out};
        pg8::gemm_phase<pg8::EpiRes2, pg8::StaticOrder, true, true>(ldsp, g, S, E);
    }
}

extern "C" void kernel_launch(void* const* d_in, const int* in_sizes, int n_in, void* d_out, int out_size, void* d_ws, size_t ws_size, hipStream_t stream) {
    static int grid = 0;
    if (grid == 0) {
        if (n_in != 16 || out_size != M * D || ws_size < WS_END) { fprintf(stderr, "kernel_launch: unexpected shapes (n_in %d, out %d, ws %zu)\n", n_in, out_size, ws_size); grid = -1; return; }
        int dev = 0, cus = 0, per_cu = 0;
        hipGetDevice(&dev); hipDeviceGetAttribute(&cus, hipDeviceAttributeMultiprocessorCount, dev);
        if (hipFuncSetAttribute((const void*)fwd, hipFuncAttributeMaxDynamicSharedMemorySize, LDS_BYTES) != hipSuccess) { fprintf(stderr, "kernel_launch: hipFuncSetAttribute failed\n"); grid = -1; return; }
        if (hipOccupancyMaxActiveBlocksPerMultiprocessor(&per_cu, (const void*)fwd, NWAVES * 64, LDS_BYTES) != hipSuccess || per_cu < 1) { fprintf(stderr, "kernel_launch: occupancy query says %d\n", per_cu); per_cu = 1; }
        (void)hipGetLastError();
        grid = cus * 1;
    }
    if (grid < 0) return;
    Args a{};
    for (int i = 0; i < 16; ++i) a.in[i] = (const float*)d_in[i];
    a.out = (float*)d_out; a.ws = (unsigned char*)d_ws;
    void* args[] = {&a};
    hipError_t e = hipLaunchCooperativeKernel((const void*)fwd, dim3(grid), dim3(NWAVES * 64), args, LDS_BYTES, stream);
    if (e != hipSuccess) fprintf(stderr, "kernel_launch: cooperative launch failed: %s (grid %d)\n", hipGetErrorString(e), grid);
}
```

```cpp
#include <hip/hip_runtime.h>
#include <cstdio>
#include <cstdint>
#define MONO_BAR 1
namespace pg8 {
#define PG8_LAS __attribute__((address_space(3)))
typedef unsigned short bf16_t;
typedef short bf16x8 __attribute__((ext_vector_type(8)));
typedef float f32x4 __attribute__((ext_vector_type(4)));
typedef unsigned u32x4 __attribute__((ext_vector_type(4)));
constexpr int BM = 256, BK = 64, HALF = 128, HTB = HALF * BK * 2  , STAGE_BYTES = 8 * HTB, NXCD = 8, WGM = 8;

__host__ __device__ __forceinline__ int lds_byte(int r, int c) { const int st = (r >> 4) * 2 + (c >> 5), rr = r & 15, cc = c & 31, ob = rr * 64 + cc * 2; return st * 1024 + (ob ^ (((ob >> 9) & 1) << 5)); }
__host__ __device__ __forceinline__ void stage_rc(int b, int& R, int& C) { const int st = b / 1024, sb = b % 1024, swz = sb ^ (((sb >> 9) & 1) << 5); R = (st >> 1) * 16 + swz / 64; C = (st & 1) * 32 + (swz % 64) / 2; }
__host__ __device__ __forceinline__ int perm32(int rho) { const int n = rho >> 4, i = rho & 15; return 8 * (i >> 2) + 4 * n + (i & 3); }

struct Unit { int pm, pn; };
struct Gemm { const bf16_t* A; const bf16_t* Bt; int M, N, K; };

struct StaticOrder {
    int nM, nN, nwg, G, c;
    __host__ __device__ void init(int M, int N, int G_, int c_) { nM = M / BM; nN = N / BM; nwg = nM * nN; G = G_; c = c_; }
    __host__ __device__ bool next(int i, Unit& u) const {
        const long L = (long)i * G + c; if (L >= nwg) return false;
        int wgid = (int)L; { const int q = nwg / NXCD, r = nwg % NXCD, xcd = wgid % NXCD, off = wgid / NXCD; wgid = (xcd < r ? xcd * (q + 1) : r * (q + 1) + (xcd - r) * q) + off; }
        const int nig = WGM * nN, gid = wgid / nig, fm = gid * WGM, gsz = (nM - fm) < WGM ? (nM - fm) : WGM;
        u.pm = fm + ((wgid % nig) % gsz); u.pn = (wgid % nig) / gsz; return true;
    }
    __device__ __forceinline__ void a_ready(const Unit&) const {}
    __device__ __forceinline__ void done(const Unit&) const {}
};

__device__ __forceinline__ unsigned cvt_pk_bf16(float lo, float hi) { unsigned r; asm volatile("v_cvt_pk_bf16_f32 %0, %1, %2" : "=v"(r) : "v"(lo), "v"(hi)); return r; }
typedef float f32x2 __attribute__((ext_vector_type(2)));
#ifndef WT_STORES
#define WT_STORES 1
#endif
__device__ __forceinline__ void st16(void* p, u32x4 v) {
#if WT_STORES
    asm volatile("global_store_dwordx4 %0, %1, off sc1\n\ts_nop 1" :: "v"(p), "v"(v) : "memory");
#else
    *(u32x4*)p = v;
#endif
}
typedef unsigned u32x2w __attribute__((ext_vector_type(2)));
__device__ __forceinline__ void st8(void* p, u32x2w v) {
#if WT_STORES
    asm volatile("global_store_dwordx2 %0, %1, off sc1\n\ts_nop 1" :: "v"(p), "v"(v) : "memory");
#else
    *(u32x2w*)p = v;
#endif
}
typedef unsigned u32x2 __attribute__((ext_vector_type(2)));
__device__ __forceinline__ float bf_lo(unsigned w) { return __uint_as_float(w << 16); }
__device__ __forceinline__ float bf_hi(unsigned w) { return __uint_as_float(w & 0xffff0000u); }
__device__ __forceinline__ u32x4 pack8(f32x4 a, f32x4 b) { u32x4 w; w.x = cvt_pk_bf16(a[0], a[1]); w.y = cvt_pk_bf16(a[2], a[3]); w.z = cvt_pk_bf16(b[0], b[1]); w.w = cvt_pk_bf16(b[2], b[3]); return w; }
__device__ __forceinline__ void unpack8(u32x4 w, f32x4& a, f32x4& b) { a = (f32x4){bf_lo(w.x), bf_hi(w.x), bf_lo(w.y), bf_hi(w.y)}; b = (f32x4){bf_lo(w.z), bf_hi(w.z), bf_lo(w.w), bf_hi(w.w)}; }
constexpr float QK_C2 = 0.125f * 1.4426950408889634f;
constexpr float RMS_EPS = 1e-6f;

struct EpiP1 {
    static constexpr bool PERM = true, AFTER_DRAIN = false;
    bf16_t *Q, *Kb, *V, *BG, *U1, *G; const float *gq, *gk, *bgate;
    __device__ __forceinline__ void operator()(const f32x4 (&acc)[2][2][4][2], const Unit& u, int wr, int wc, int fr, int fq) const {
        const int pn = u.pn; const int row0 = u.pm * BM + wr * 64 + fr;
        if (pn < 8) {
            const bool isq = pn < 4; const float* g = isq ? gq : gk; bf16_t* O = isq ? Q : Kb; const float sc = isq ? QK_C2 : 1.f;
            const int head = 4 * (pn & 3) + wc;
            f32x4 gv[2][2];
#pragma unroll
            for (int bj = 0; bj < 2; ++bj)
#pragma unroll
                for (int n = 0; n < 2; ++n) gv[bj][n] = *(const f32x4*)(g + 32 * bj + 8 * fq + 4 * n) * sc;
#pragma unroll
            for (int ai = 0; ai < 2; ++ai)
#pragma unroll
                for (int m = 0; m < 4; ++m) {
                    float s = 0.f;
#pragma unroll
                    for (int bj = 0; bj < 2; ++bj)
#pragma unroll
                        for (int n = 0; n < 2; ++n) { const f32x4 x = acc[ai][bj][m][n]; s += (x[0] * x[0] + x[1] * x[1]) + (x[2] * x[2] + x[3] * x[3]); }
                    s += __shfl_xor(s, 16); s += __shfl_xor(s, 32);
                    const float rs = 1.0f / sqrtf(s * (1.0f / 64.0f) + RMS_EPS);
                    bf16_t* rowp = O + (size_t)(row0 + ai * HALF + m * 16) * 1024 + head * 64 + 8 * fq;
#pragma unroll
                    for (int bj = 0; bj < 2; ++bj) st16(rowp + 32 * bj, pack8(acc[ai][bj][m][0] * rs * gv[bj][0], acc[ai][bj][m][1] * rs * gv[bj][1]));
                }
        } else if (pn < 16) {
            bf16_t* O = (pn < 12) ? V : BG; const int col0 = 256 * (pn & 3) + wc * 32 + 8 * fq;
#pragma unroll
            for (int ai = 0; ai < 2; ++ai)
#pragma unroll
                for (int m = 0; m < 4; ++m) { bf16_t* rowp = O + (size_t)(row0 + ai * HALF + m * 16) * 1024 + col0;
#pragma unroll
                    for (int bj = 0; bj < 2; ++bj) st16(rowp + bj * HALF, pack8(acc[ai][bj][m][0], acc[ai][bj][m][1])); }
        } else if (pn < 24) {
            const int col0 = 128 * (pn - 16) + wc * 32 + 8 * fq;
#pragma unroll
            for (int ai = 0; ai < 2; ++ai)
#pragma unroll
                for (int m = 0; m < 4; ++m)
                    st16(U1 + (size_t)(row0 + ai * HALF + m * 16) * 1024 + col0, pack8(acc[ai][0][m][0] * acc[ai][1][m][0], acc[ai][0][m][1] * acc[ai][1][m][1]));
        } else {
            const int col0 = 256 * (pn - 24) + wc * 32 + 8 * fq;
            f32x4 bv[2][2];
#pragma unroll
            for (int bj = 0; bj < 2; ++bj)
#pragma unroll
                for (int n = 0; n < 2; ++n) bv[bj][n] = *(const f32x4*)(bgate + col0 + bj * HALF + 4 * n);
#pragma unroll
            for (int ai = 0; ai < 2; ++ai)
#pragma unroll
                for (int m = 0; m < 4; ++m) { bf16_t* rowp = G + (size_t)(row0 + ai * HALF + m * 16) * 2048 + col0;
#pragma unroll
                    for (int bj = 0; bj < 2; ++bj) { f32x4 v[2];
#pragma unroll
                        for (int n = 0; n < 2; ++n) { const f32x4 z = (acc[ai][bj][m][n] + bv[bj][n]) * (-1.4426950408889634f);
#pragma unroll
                            for (int e = 0; e < 4; ++e) v[n][e] = __builtin_amdgcn_rcpf(1.0f + __builtin_amdgcn_exp2f(z[e])); }
                        st16(rowp + bj * HALF, pack8(v[0], v[1])); } }
        }
    }
};
template <bool ADD> struct EpiGate {
    static constexpr bool PERM = true, AFTER_DRAIN = false;
    const bf16_t* G; bf16_t* MG; int goff;
    __device__ __forceinline__ void operator()(const f32x4 (&acc)[2][2][4][2], const Unit& u, int wr, int wc, int fr, int fq) const {
        const int row0 = u.pm * BM + wr * 64 + fr, col0 = u.pn * BM + wc * 32 + 8 * fq;
#pragma unroll
        for (int ai = 0; ai < 2; ++ai)
#pragma unroll
            for (int m = 0; m < 4; ++m) { const size_t r = (size_t)(row0 + ai * HALF + m * 16);
#pragma unroll
                for (int bj = 0; bj < 2; ++bj) { f32x4 g0, g1; unpack8(*(const u32x4*)(G + r * 2048 + goff + col0 + bj * HALF), g0, g1);
                    f32x4 v0 = acc[ai][bj][m][0] * g0, v1 = acc[ai][bj][m][1] * g1;
                    bf16_t* p = MG + r * 1024 + col0 + bj * HALF;
                    if (ADD) { f32x4 a0, a1; unpack8(*(const u32x4*)p, a0, a1); v0 += a0; v1 += a1; }
                    *(u32x4*)p = pack8(v0, v1); } }
    }
};
struct PairOrder {
    StaticOrder S;
    __device__ bool next(int i, Unit& u) const { Unit b; if (!S.next(i >> 1, b)) return false; u.pm = b.pm + ((i & 1) ? 64 : 0); u.pn = b.pn + ((i & 1) ? 4 : 0); return true; }
    __device__ __forceinline__ void a_ready(const Unit&) const {}
    __device__ __forceinline__ void done(const Unit&) const {}
};
struct EpiGate2 {
    static constexpr bool PERM = true, AFTER_DRAIN = false;
    const bf16_t* G; bf16_t* MG;
    __device__ __forceinline__ void operator()(const f32x4 (&acc)[2][2][4][2], const Unit& u, int wr, int wc, int fr, int fq) const {
        const bool second = u.pm >= 64; const int pm = second ? u.pm - 64 : u.pm, pn = second ? u.pn - 4 : u.pn, goff = second ? 0 : 1024;
        const int row0 = pm * BM + wr * 64 + fr, col0 = pn * BM + wc * 32 + 8 * fq;
#pragma unroll
        for (int ai = 0; ai < 2; ++ai) {
            u32x4 gl[4][2], ml[4][2];
#pragma unroll
            for (int m = 0; m < 4; ++m) { const size_t r = (size_t)(row0 + ai * HALF + m * 16);
#pragma unroll
                for (int bj = 0; bj < 2; ++bj) { gl[m][bj] = *(const u32x4*)(G + r * 2048 + goff + col0 + bj * HALF); if (second) ml[m][bj] = *(const u32x4*)(MG + r * 1024 + col0 + bj * HALF); } }
#pragma unroll
            for (int m = 0; m < 4; ++m) { const size_t r = (size_t)(row0 + ai * HALF + m * 16);
#pragma unroll
                for (int bj = 0; bj < 2; ++bj) { f32x4 g0, g1; unpack8(gl[m][bj], g0, g1);
                    f32x4 v0 = acc[ai][bj][m][0] * g0, v1 = acc[ai][bj][m][1] * g1;
                    bf16_t* p = MG + r * 1024 + col0 + bj * HALF;
                    if (second) { f32x4 a0, a1; unpack8(ml[m][bj], a0, a1); v0 += a0; v1 += a1; st16(p, pack8(v0, v1)); } else *(u32x4*)p = pack8(v0, v1); } }
        }
    }
};
#ifndef STORE_X1_F32
#define STORE_X1_F32 0
#endif
struct EpiRes1 {
    static constexpr bool PERM = false, AFTER_DRAIN = false;
    const float* x; float* out; bf16_t* x1b; float* SS;
    __device__ __forceinline__ void operator()(const f32x4 (&acc)[2][2][4][2], const Unit& u, int wr, int wc, int fr, int fq) const {
        const int row0 = u.pm * BM + wr * 64 + fr, col0 = u.pn * BM + wc * 32 + 4 * fq;
#pragma unroll
        for (int ai = 0; ai < 2; ++ai) {
            f32x4 xv[4][2][2];
#pragma unroll
            for (int m = 0; m < 4; ++m) { const size_t off = (size_t)(row0 + ai * HALF + m * 16) * 1024 + col0;
#pragma unroll
                for (int bj = 0; bj < 2; ++bj)
#pragma unroll
                    for (int n = 0; n < 2; ++n) xv[m][bj][n] = *(const f32x4*)(x + off + bj * HALF + n * 16); }
#pragma unroll
            for (int m = 0; m < 4; ++m) { const size_t r = (size_t)(row0 + ai * HALF + m * 16); const size_t off = r * 1024 + col0; float s = 0.f;
#pragma unroll
                for (int bj = 0; bj < 2; ++bj)
#pragma unroll
                    for (int n = 0; n < 2; ++n) { const f32x4 v = xv[m][bj][n] + acc[ai][bj][m][n];
                        if (STORE_X1_F32) *(f32x4*)(out + off + bj * HALF + n * 16) = v; s += (v[0] * v[0] + v[1] * v[1]) + (v[2] * v[2] + v[3] * v[3]);
                        u32x2 w; w.x = cvt_pk_bf16(v[0], v[1]); w.y = cvt_pk_bf16(v[2], v[3]); st8(x1b + off + bj * HALF + n * 16, w); }
                s += __shfl_xor(s, 16); s += __shfl_xor(s, 32);
                if (fq == 0) SS[r * 16 + 4 * u.pn + wc] = s; }
            asm volatile("" ::: "memory");
        }
    }
};
struct EpiUp {
    static constexpr bool PERM = true, AFTER_DRAIN = false;
    const float* SS; bf16_t* UU;
    __device__ __forceinline__ void operator()(const f32x4 (&acc)[2][2][4][2], const Unit& u, int wr, int wc, int fr, int fq) const {
        const int row0 = u.pm * BM + wr * 64 + fr, col0 = u.pn * BM + wc * 32 + 8 * fq;
#pragma unroll
        for (int ai = 0; ai < 2; ++ai)
#pragma unroll
            for (int m = 0; m < 4; ++m) { const size_t r = (size_t)(row0 + ai * HALF + m * 16);
                const f32x4* sp = (const f32x4*)(SS + r * 16); const f32x4 s4 = (sp[0] + sp[1]) + (sp[2] + sp[3]);
                const float rs = 1.0f / sqrtf(((s4[0] + s4[1]) + (s4[2] + s4[3])) * (1.0f / 1024.0f) + RMS_EPS);
#pragma unroll
                for (int bj = 0; bj < 2; ++bj) { f32x4 v[2];
#pragma unroll
                    for (int n = 0; n < 2; ++n) { const f32x4 z = acc[ai][bj][m][n] * rs;
#pragma unroll
                        for (int e = 0; e < 4; ++e) { const float t = fmaxf(z[e], 0.f); v[n][e] = t * t; } }
                    st16(UU + r * 4096 + col0 + bj * HALF, pack8(v[0], v[1])); } }
    }
};
struct EpiRes2 {
    static constexpr bool PERM = false, AFTER_DRAIN = false;
    float* out; const bf16_t* x1b;
    __device__ __forceinline__ void operator()(const f32x4 (&acc)[2][2][4][2], const Unit& u, int wr, int wc, int fr, int fq) const {
        const int row0 = u.pm * BM + wr * 64 + fr, col0 = u.pn * BM + wc * 32 + 4 * fq;
#pragma unroll
        for (int ai = 0; ai < 2; ++ai)
#pragma unroll
            for (int m = 0; m < 4; ++m) { const size_t off = (size_t)(row0 + ai * HALF + m * 16) * 1024 + col0;
#pragma unroll
                for (int bj = 0; bj < 2; ++bj)
#pragma unroll
                    for (int n = 0; n < 2; ++n) { float* p = out + off + bj * HALF + n * 16;
#if STORE_X1_F32
                        const f32x4 b = *(const f32x4*)p;
#else
                        const u32x2 w = *(const u32x2*)(x1b + off + bj * HALF + n * 16); const f32x4 b = {bf_lo(w.x), bf_hi(w.x), bf_lo(w.y), bf_hi(w.y)};
#endif
                        *(f32x4*)p = b + acc[ai][bj][m][n]; }
                if (m == 3) asm volatile("" ::: "memory"); }
    }
};

template <class Epi, class Sched, bool ALIGN_EPI = false, bool SP2 = false>
__device__ __forceinline__ void gemm_phase(PG8_LAS unsigned char* lds, const Gemm g, const Sched& S, const Epi& E) {
    int tid_ = threadIdx.x; asm volatile("" : "+v"(tid_));
    const int tid = tid_, wid = __builtin_amdgcn_readfirstlane(tid >> 6), lane = tid & 63, wr = wid >> 2, wc = wid & 3, fr = lane & 15, fq = lane >> 4;
    const int K = g.K, nt = K / BK;
    unsigned voffA[2], voffB[2];
#pragma unroll
    for (int i = 0; i < 2; ++i) { int R, C; stage_rc(tid * 16 + i * 8192, R, C); const int Rb = Epi::PERM ? ((R & ~31) + perm32(R & 31)) : R;
        voffA[i] = (unsigned)(R * K + C) * 2u; voffB[i] = (unsigned)(Rb * K + C) * 2u; }
    const size_t kstep = (size_t)(BK * 2);
    const size_t hstep = (size_t)HALF * K * 2;
    const size_t tstep = 2 * hstep;
    const unsigned ldsw = (unsigned)wid * 1024u;
    const int aoff = lds_byte(wr * 64 + fr, fq * 8), boff = lds_byte(wc * 32 + fr, fq * 8);
#define PG8_SA(b, h) (((b) * 2 + (h)) * HTB)
#define PG8_SB(b, h) ((4 + (b) * 2 + (h)) * HTB)
#define PG8_STAGE(bufoff, gbase, voff) do { _Pragma("unroll") for (int _i = 0; _i < 2; ++_i) \
        __builtin_amdgcn_global_load_lds((const unsigned*)((const char*)(gbase) + (voff)[_i]), (PG8_LAS unsigned*)(lds + (bufoff) + ldsw + _i * 8192), 16, 0, 0); } while (0)
#define PG8_LDA(dst, b, h) do { _Pragma("unroll") for (int m = 0; m < 4; ++m) _Pragma("unroll") for (int k = 0; k < 2; ++k) dst[m][k] = *(const PG8_LAS bf16x8*)(lds + PG8_SA(b, h) + aoff + m * 2048 + k * 1024); } while (0)
#define PG8_LDB(dst, b, h) do { _Pragma("unroll") for (int n = 0; n < 2; ++n) _Pragma("unroll") for (int k = 0; k < 2; ++k) dst[n][k] = *(const PG8_LAS bf16x8*)(lds + PG8_SB(b, h) + boff + n * 2048 + k * 1024); } while (0)
#define PG8_MMA(ai, bj, At, Bt) do { __builtin_amdgcn_s_setprio(1); _Pragma("unroll") for (int m = 0; m < 4; ++m) _Pragma("unroll") for (int n = 0; n < 2; ++n) _Pragma("unroll") for (int k = 0; k < 2; ++k) \
        acc[ai][bj][m][n] = __builtin_amdgcn_mfma_f32_16x16x32_bf16(Bt[n][k], At[m][k], acc[ai][bj][m][n], 0, 0, 0); __builtin_amdgcn_s_setprio(0); } while (0)
#define PG8_WAIT_V(n) asm volatile("s_waitcnt vmcnt(" #n ")" ::: "memory")
#define PG8_WAIT_L(n) asm volatile("s_waitcnt lgkmcnt(" #n ")" ::: "memory")
#define PG8_BAR __builtin_amdgcn_s_barrier()
#define PG8_SCHED __builtin_amdgcn_sched_barrier(0)
    Unit cur, nxt; int ui = 0;
    if (!S.next(0, cur)) return;
    f32x4 acc[2][2][4][2];
#pragma unroll
    for (int a = 0; a < 2; ++a)
#pragma unroll
        for (int b = 0; b < 2; ++b)
#pragma unroll
            for (int m = 0; m < 4; ++m)
#pragma unroll
                for (int n = 0; n < 2; ++n) acc[a][b][m][n] = (f32x4){0.f, 0.f, 0.f, 0.f};
    bf16x8 At[4][2], B0[2][2], B1[2][2];
    const char* cA = (const char*)g.A + (size_t)cur.pm * tstep; const char* cB = (const char*)g.Bt + (size_t)cur.pn * tstep;
    S.a_ready(cur);
    if constexpr (SP2) {
        PG8_STAGE(PG8_SB(0, 0), cB, voffB); PG8_STAGE(PG8_SB(0, 1), cB + hstep, voffB); PG8_STAGE(PG8_SA(0, 0), cA, voffA); PG8_STAGE(PG8_SA(0, 1), cA + hstep, voffA);
        if (wr == 1) PG8_BAR;
        PG8_WAIT_V(2); PG8_BAR;
        PG8_STAGE(PG8_SB(1, 0), cB + kstep, voffB); PG8_STAGE(PG8_SA(1, 0), cA + kstep, voffA); PG8_STAGE(PG8_SB(1, 1), cB + hstep + kstep, voffB);
        PG8_WAIT_V(6); PG8_BAR;
    } else {
        PG8_STAGE(PG8_SB(0, 0), cB, voffB); PG8_STAGE(PG8_SA(0, 0), cA, voffA); PG8_STAGE(PG8_SB(0, 1), cB + hstep, voffB); PG8_STAGE(PG8_SA(0, 1), cA + hstep, voffA);
        if (wr == 1) PG8_BAR;
        PG8_WAIT_V(4); PG8_BAR;
        PG8_STAGE(PG8_SB(1, 0), cB + kstep, voffB); PG8_STAGE(PG8_SA(1, 0), cA + kstep, voffA); PG8_STAGE(PG8_SB(1, 1), cB + hstep + kstep, voffB);
        PG8_WAIT_V(6); PG8_BAR;
    }
    for (;;) {
        const bool has_next = S.next(ui + 1, nxt);
        const char* nA = has_next ? (const char*)g.A + (size_t)nxt.pm * tstep : cA; const char* nB = has_next ? (const char*)g.Bt + (size_t)nxt.pn * tstep : cB;
        for (int t = 0; t < nt; t += 2) {
            const bool last = (t == nt - 2);
            const char* a1 = cA + (size_t)(t + 1) * kstep;
            const char* a2 = last ? nA : cA + (size_t)(t + 2) * kstep; const char* b2 = last ? nB : cB + (size_t)(t + 2) * kstep;
            const char* a3 = a2 + kstep; const char* b3 = b2 + kstep;
            if (last && has_next) S.a_ready(nxt);
            if constexpr (SP2) {
            PG8_LDB(B0, 0, 0); PG8_LDB(B1, 0, 1); PG8_SCHED; PG8_LDA(At, 0, 0); PG8_STAGE(PG8_SA(1, 1), a1 + hstep, voffA);
            PG8_WAIT_V(8); PG8_WAIT_L(0); PG8_BAR; PG8_MMA(0, 0, At, B0); PG8_MMA(0, 1, At, B1); PG8_BAR; PG8_SCHED;
            PG8_LDA(At, 0, 1); PG8_STAGE(PG8_SB(0, 0), b2, voffB); PG8_STAGE(PG8_SB(0, 1), b2 + hstep, voffB); PG8_STAGE(PG8_SA(0, 0), a2, voffA);
            PG8_WAIT_V(8); PG8_WAIT_L(0); PG8_BAR; PG8_MMA(1, 0, At, B0); PG8_MMA(1, 1, At, B1); PG8_BAR; PG8_SCHED;
            PG8_LDB(B0, 1, 0); PG8_LDB(B1, 1, 1); PG8_SCHED; PG8_LDA(At, 1, 0); PG8_STAGE(PG8_SA(0, 1), a2 + hstep, voffA);
            PG8_WAIT_V(8); PG8_WAIT_L(0); PG8_BAR; PG8_MMA(0, 0, At, B0); PG8_MMA(0, 1, At, B1); PG8_BAR; PG8_SCHED;
            PG8_LDA(At, 1, 1); PG8_STAGE(PG8_SB(1, 0), b3, voffB); PG8_STAGE(PG8_SB(1, 1), b3 + hstep, voffB); PG8_STAGE(PG8_SA(1, 0), a3, voffA);
            PG8_WAIT_V(8); PG8_WAIT_L(0); PG8_BAR; PG8_MMA(1, 0, At, B0); PG8_MMA(1, 1, At, B1); PG8_BAR; PG8_SCHED;
            } else {
            PG8_LDB(B0, 0, 0); PG8_SCHED; PG8_LDA(At, 0, 0); PG8_STAGE(PG8_SA(1, 1), a1 + hstep, voffA);
            PG8_WAIT_L(8); PG8_BAR; PG8_WAIT_L(0); PG8_MMA(0, 0, At, B0); PG8_BAR; PG8_SCHED;
            PG8_LDB(B1, 0, 1); PG8_STAGE(PG8_SB(0, 0), b2, voffB);
            PG8_BAR; PG8_WAIT_L(0); PG8_MMA(0, 1, At, B1); PG8_BAR;
            PG8_LDA(At, 0, 1); PG8_STAGE(PG8_SA(0, 0), a2, voffA);
            PG8_BAR; PG8_WAIT_L(0); PG8_MMA(1, 0, At, B0); PG8_BAR; PG8_SCHED;
            PG8_STAGE(PG8_SB(0, 1), b2 + hstep, voffB);
            PG8_WAIT_V(6); PG8_BAR; PG8_MMA(1, 1, At, B1); PG8_BAR;
            PG8_LDB(B0, 1, 0); PG8_SCHED; PG8_LDA(At, 1, 0); PG8_STAGE(PG8_SA(0, 1), a2 + hstep, voffA);
            PG8_WAIT_L(8); PG8_BAR; PG8_WAIT_L(0); PG8_MMA(0, 0, At, B0); PG8_BAR; PG8_SCHED;
            PG8_LDB(B1, 1, 1); PG8_STAGE(PG8_SB(1, 0), b3, voffB);
            PG8_BAR; PG8_WAIT_L(0); PG8_MMA(0, 1, At, B1); PG8_BAR;
            PG8_LDA(At, 1, 1); PG8_STAGE(PG8_SA(1, 0), a3, voffA);
            PG8_BAR; PG8_WAIT_L(0); PG8_MMA(1, 0, At, B0); PG8_BAR; PG8_SCHED;
            PG8_STAGE(PG8_SB(1, 1), b3 + hstep, voffB);
            PG8_WAIT_V(6); PG8_BAR; PG8_MMA(1, 1, At, B1); PG8_BAR;
            }
        }
        if constexpr (ALIGN_EPI) { if (wr == 0) PG8_BAR; }
        if constexpr (!Epi::AFTER_DRAIN) { E(acc, cur, wr, wc, fr, fq); S.done(cur); }
        if (!has_next) break;
#pragma unroll
        for (int a = 0; a < 2; ++a)
#pragma unroll
            for (int b = 0; b < 2; ++b)
#pragma unroll
                for (int m = 0; m < 4; ++m)
#pragma unroll
                    for (int n = 0; n < 2; ++n) acc[a][b][m][n] = (f32x4){0.f, 0.f, 0.f, 0.f};
        cur = nxt; cA = nA; cB = nB; ++ui;
        if constexpr (ALIGN_EPI) { if (wr == 1) PG8_BAR; }
    }
    PG8_WAIT_V(0);
    if constexpr (!ALIGN_EPI) { if (wr == 0) PG8_BAR; }
    PG8_BAR;
    if constexpr (Epi::AFTER_DRAIN) { E.fused(acc, cur, wr, wc, fr, fq, lds, wid, lane); S.done(cur); }
#undef PG8_SA
#undef PG8_SB
#undef PG8_STAGE
#undef PG8_LDA
#undef PG8_LDB
#undef PG8_MMA
#undef PG8_WAIT_V
#undef PG8_WAIT_L
#undef PG8_BAR
#undef PG8_SCHED
}
}

namespace attn {
using bf16 = unsigned short;
using bf16x8 = __attribute__((ext_vector_type(8))) short;
using s16x4 = __attribute__((ext_vector_type(4))) short;
using f32x16 = __attribute__((ext_vector_type(16))) float;
using u32x4 = __attribute__((ext_vector_type(4))) unsigned;
using f32x4 = __attribute__((ext_vector_type(4))) float;
constexpr int SEQ = 4096, DM = 1024, NSLOT = 6, SLOTB = 8192, NREL = 513;
constexpr int LDS_K = 0, LDS_V = NSLOT * SLOTB, LDS_WS = 2 * NSLOT * SLOTB, LDS_OST = LDS_WS + 8 * 64 * 4, LDS_BIAS = LDS_OST + 8 * 4096, BIAS_CS = 400  , LDS_BYTES = LDS_BIAS + 4 * BIAS_CS * 4;
constexpr float LOG2E = 1.4426950408889634f;
__device__ __forceinline__ int crow(int r, int hi) { return (r & 3) + 8 * (r >> 2) + 4 * hi; }
#define SBAR() __builtin_amdgcn_sched_barrier(0)
__device__ __forceinline__ void glds16(const void* gsrc, unsigned lds_dst) { unsigned keep;
  asm volatile("s_mov_b32 %0, m0\n\ts_mov_b32 m0, %2\n\ts_nop 0\n\tglobal_load_lds_dwordx4 %1, off\n\ts_mov_b32 m0, %0" : "=&s"(keep) : "v"(gsrc), "s"(lds_dst) : "memory"); }
typedef float f32x2_t __attribute__((ext_vector_type(2))); typedef __bf16 bf16x2_t __attribute__((ext_vector_type(2)));
__device__ __forceinline__ unsigned cvtpk_s(float lo, float hi) { f32x2_t v = {lo, hi}; bf16x2_t b = __builtin_convertvector(v, bf16x2_t); return __builtin_bit_cast(unsigned, b); }
typedef __attribute__((address_space(3))) const char* lds_cptr;
__device__ __forceinline__ void kload8(bf16x8* kf, lds_cptr kp) {
  kf[0] = *(const __attribute__((address_space(3))) bf16x8*)(kp);        kf[1] = *(const __attribute__((address_space(3))) bf16x8*)(kp + 512);
  kf[2] = *(const __attribute__((address_space(3))) bf16x8*)(kp + 2048); kf[3] = *(const __attribute__((address_space(3))) bf16x8*)(kp + 2560);
  kf[4] = *(const __attribute__((address_space(3))) bf16x8*)(kp + 4096); kf[5] = *(const __attribute__((address_space(3))) bf16x8*)(kp + 4608);
  kf[6] = *(const __attribute__((address_space(3))) bf16x8*)(kp + 6144); kf[7] = *(const __attribute__((address_space(3))) bf16x8*)(kp + 6656);
}
__device__ __forceinline__ void pv(f32x16* o, int vb, bf16x8 pa0, bf16x8 pa1, bf16x8 pa2, bf16x8 pa3) {
  #pragma unroll
  for (int d0 = 0; d0 < 2; ++d0) { s16x4 lo[4], hi[4];
    #pragma unroll
    for (int ks = 0; ks < 4; ++ks) {
      asm volatile("ds_read_b64_tr_b16 %0,%1 offset:%c2" : "=&v"(lo[ks]) : "v"(vb), "i"(d0 * 4096 + ks * 1024) : "memory");
      asm volatile("ds_read_b64_tr_b16 %0,%1 offset:%c2" : "=&v"(hi[ks]) : "v"(vb), "i"(d0 * 4096 + ks * 1024 + 512) : "memory"); }
    asm volatile("s_waitcnt lgkmcnt(0)" ::: "memory"); SBAR();
    #define PK(k) (bf16x8){lo[k][0], lo[k][1], lo[k][2], lo[k][3], hi[k][0], hi[k][1], hi[k][2], hi[k][3]}
    o[d0] = __builtin_amdgcn_mfma_f32_32x32x16_bf16(pa0, PK(0), o[d0], 0, 0, 0);
    o[d0] = __builtin_amdgcn_mfma_f32_32x32x16_bf16(pa1, PK(1), o[d0], 0, 0, 0);
    o[d0] = __builtin_amdgcn_mfma_f32_32x32x16_bf16(pa2, PK(2), o[d0], 0, 0, 0);
    o[d0] = __builtin_amdgcn_mfma_f32_32x32x16_bf16(pa3, PK(3), o[d0], 0, 0, 0);
    #undef PK
  }
}
__device__ __forceinline__ float wmax(float v) {
#pragma unroll
  for (int o = 1; o < 64; o <<= 1) v = fmaxf(v, __shfl_xor(v, o));
  return v;
}
__device__ __forceinline__ void attn_unit(int b, int h, int g, const bf16* Q, const bf16* __restrict__ K, const bf16* __restrict__ V, bf16* O,
                                          const float* __restrict__ relb, const float* __restrict__ gq, const float* __restrict__ gk, char* shm) {
  int tid_ = threadIdx.x; asm volatile("" : "+v"(tid_));
  const int tid = tid_, lane = tid & 63, r32 = lane & 31, hi = lane >> 5; const int wid = __builtin_amdgcn_readfirstlane(tid >> 6);
  const long rowbase = (long)b * SEQ; const int q0 = g * 256;
  const int kc_lo = (4 * g - 8) > 0 ? (4 * g - 8) : 0, NT = 4 * g + 4 - kc_lo;
  const bf16* Qw = Q + (rowbase + q0 + wid * 32) * DM + h * 64;
  const bf16* Kh = K + (rowbase + 64 * kc_lo) * DM + h * 64; const bf16* Vh = V + (rowbase + 64 * kc_lo) * DM + h * 64;
  const unsigned lds0 = (unsigned)(uintptr_t)shm;
  float* wsf = (float*)(shm + LDS_WS) + wid * 64;
  float* biasT = (float*)(shm + LDS_BIAS);
  const bf16* ksrc = Kh + (long)lane * DM + wid * 8;
  const bf16* vsrc = Vh + (long)(16 * (wid & 3) + (lane >> 2)) * DM + (wid >> 2) * 32 + (lane & 3) * 8;
  const unsigned kdst = lds0 + LDS_K + wid * 1024, vdst = lds0 + LDS_V + wid * 1024;
  #define DMA_K(t, slot) glds16(ksrc + (long)(t) * 64 * DM, (unsigned)__builtin_amdgcn_readfirstlane(kdst + (slot)))
  #define DMA_V(t, slot) glds16(vsrc + (long)(t) * 64 * DM, (unsigned)__builtin_amdgcn_readfirstlane(vdst + (slot)))
  const int vb0 = (int)(lds0 + LDS_V) + ((lane >> 4) & 1) * 32 + (lane & 3) * 8 + (4 * hi + ((lane & 15) >> 2)) * 64;
  const lds_cptr shm3 = (lds_cptr)shm; const lds_cptr kp0 = shm3 + LDS_K + hi * 1024 + r32 * 16;
  asm volatile("s_waitcnt vmcnt(0)" ::: "memory");
  const bool full = (g >= 2); const int nsteps = full ? 9 : NT;
  #define LOAD_TILE(i) (full ? ((i) < 6 ? (((i) & 1) ? ((i) >> 1) + 9 : ((i) >> 1)) : (i) - 3) : (i))
  #define ISSUE_LOAD(i) do { const int i_ = (i); const int tl_ = LOAD_TILE(i_); const int sb_ = (i_ % NSLOT) * SLOTB; DMA_K(tl_, sb_); DMA_V(tl_, sb_); } while (0)
  ISSUE_LOAD(0); ISSUE_LOAD(1); if (full) { ISSUE_LOAD(2); ISSUE_LOAD(3); }
  bf16x8 qr[4];
  #pragma unroll
  for (int d0 = 0; d0 < 4; ++d0) qr[d0] = *reinterpret_cast<const bf16x8*>(&Qw[(long)r32 * DM + d0 * 16 + hi * 8]);
  float m2;
  { const float mq = wmax(fabsf(gq[lane])), mk = wmax(fabsf(gk[lane])); float mb = -3.0e38f;
    for (int i = lane; i < NREL; i += 64) mb = fmaxf(mb, relb[h * NREL + i]);
    mb = wmax(mb); m2 = (8.0f * mq * mk + mb) * LOG2E; }
  for (int i = tid; i < 4 * 384; i += 512) { const int c = i / 384, j = i - c * 384, e = j + c; biasT[c * BIAS_CS + j] = (e < 384 ? relb[h * NREL + (e < 64 ? 512 : 576 - e)] : 0.f) * LOG2E - m2; }
  f32x16 o[2]; o[0] = f32x16{}; o[1] = f32x16{}; f32x16 lsum = f32x16{};
  const int qpos = 32 * (wid & 1) + r32;
  const int cch = 4 * g + (wid >> 1);
  asm volatile("s_waitcnt vmcnt(0) lgkmcnt(0)\n\ts_barrier" ::: "memory");
  for (int s = 0; s < nsteps; ++s) {
    int nis = 0;
    if (s + 2 < nsteps) { const int s2 = s + 2; if (full) { if (s2 < 3) { ISSUE_LOAD(2 * s2); ISSUE_LOAD(2 * s2 + 1); nis = 2; } else { ISSUE_LOAD(s2 + 3); nis = 1; } } else { ISSUE_LOAD(s2); nis = 1; } }
    int jrel = kc_lo + s - cch + 8, ld = full ? (s < 3 ? 2 * s : s + 3) : s;
    if (full && s < 3 && jrel < 0) { jrel += 9; ld += 1; }
    const int sl_cur = (ld % NSLOT) * SLOTB;
    if (jrel >= 0 && jrel <= 8) {
      s16x4 vlo[8], vhi[8]; { const int vb = vb0 + sl_cur;
        #pragma unroll
        for (int i_ = 0; i_ < 8; ++i_) {
          asm volatile("ds_read_b64_tr_b16 %0,%1 offset:%c2" : "=&v"(vlo[i_]) : "v"(vb), "i"((i_ >> 2) * 4096 + (i_ & 3) * 1024) : "memory");
          asm volatile("ds_read_b64_tr_b16 %0,%1 offset:%c2" : "=&v"(vhi[i_]) : "v"(vb), "i"((i_ >> 2) * 4096 + (i_ & 3) * 1024 + 512) : "memory"); } }
      f32x16 p0, p1;
      if (jrel <= 3) { const float c0 = biasT[0];
        #pragma unroll
        for (int r = 0; r < 16; ++r) { p0[r] = c0; p1[r] = c0; } }
      else { const int i0 = 64 + 4 * hi - qpos + 64 * (jrel - 4), cs = i0 & 3; const f32x4* a4 = (const f32x4*)(biasT + cs * BIAS_CS + (i0 - cs));
        #pragma unroll
        for (int q4 = 0; q4 < 4; ++q4) { const f32x4 b0 = a4[2 * q4], b1 = a4[2 * q4 + 8];
          #pragma unroll
          for (int e = 0; e < 4; ++e) { p0[4 * q4 + e] = b0[e]; p1[4 * q4 + e] = b1[e]; } } }
      bf16x8 kf[8]; kload8(kf, kp0 + sl_cur);
      #pragma unroll
      for (int d0 = 0; d0 < 4; ++d0) { p0 = __builtin_amdgcn_mfma_f32_32x32x16_bf16(kf[2 * d0], qr[d0], p0, 0, 0, 0); p1 = __builtin_amdgcn_mfma_f32_32x32x16_bf16(kf[2 * d0 + 1], qr[d0], p1, 0, 0, 0); }
      #pragma unroll
      for (int r = 0; r < 16; ++r) { p0[r] = __builtin_amdgcn_exp2f(p0[r]); p1[r] = __builtin_amdgcn_exp2f(p1[r]); }
      lsum += p0 + p1;
      u32x4 pw0, pw1, pw2, pw3;
      pw0 = (u32x4){cvtpk_s(p0[0], p0[1]), cvtpk_s(p0[2], p0[3]), cvtpk_s(p0[4], p0[5]), cvtpk_s(p0[6], p0[7])};
      pw1 = (u32x4){cvtpk_s(p0[8], p0[9]), cvtpk_s(p0[10], p0[11]), cvtpk_s(p0[12], p0[13]), cvtpk_s(p0[14], p0[15])};
      pw2 = (u32x4){cvtpk_s(p1[0], p1[1]), cvtpk_s(p1[2], p1[3]), cvtpk_s(p1[4], p1[5]), cvtpk_s(p1[6], p1[7])};
      pw3 = (u32x4){cvtpk_s(p1[8], p1[9]), cvtpk_s(p1[10], p1[11]), cvtpk_s(p1[12], p1[13]), cvtpk_s(p1[14], p1[15])};
      SBAR();
      asm volatile("s_waitcnt lgkmcnt(0)" ::: "memory"); SBAR();
      #define VF(i_) (bf16x8){vlo[i_][0], vlo[i_][1], vlo[i_][2], vlo[i_][3], vhi[i_][0], vhi[i_][1], vhi[i_][2], vhi[i_][3]}
      o[0] = __builtin_amdgcn_mfma_f32_32x32x16_bf16(__builtin_bit_cast(bf16x8, pw0), VF(0), o[0], 0, 0, 0); o[1] = __builtin_amdgcn_mfma_f32_32x32x16_bf16(__builtin_bit_cast(bf16x8, pw0), VF(4), o[1], 0, 0, 0);
      o[0] = __builtin_amdgcn_mfma_f32_32x32x16_bf16(__builtin_bit_cast(bf16x8, pw1), VF(1), o[0], 0, 0, 0); o[1] = __builtin_amdgcn_mfma_f32_32x32x16_bf16(__builtin_bit_cast(bf16x8, pw1), VF(5), o[1], 0, 0, 0);
      o[0] = __builtin_amdgcn_mfma_f32_32x32x16_bf16(__builtin_bit_cast(bf16x8, pw2), VF(2), o[0], 0, 0, 0); o[1] = __builtin_amdgcn_mfma_f32_32x32x16_bf16(__builtin_bit_cast(bf16x8, pw2), VF(6), o[1], 0, 0, 0);
      o[0] = __builtin_amdgcn_mfma_f32_32x32x16_bf16(__builtin_bit_cast(bf16x8, pw3), VF(3), o[0], 0, 0, 0); o[1] = __builtin_amdgcn_mfma_f32_32x32x16_bf16(__builtin_bit_cast(bf16x8, pw3), VF(7), o[1], 0, 0, 0);
      #undef VF
    }
    if (nis == 2)      asm volatile("s_waitcnt vmcnt(4) lgkmcnt(0)\n\ts_barrier" ::: "memory");
    else if (nis == 1) asm volatile("s_waitcnt vmcnt(2) lgkmcnt(0)\n\ts_barrier" ::: "memory");
    else               asm volatile("s_waitcnt vmcnt(0) lgkmcnt(0)\n\ts_barrier" ::: "memory");
  }
  #undef LOAD_TILE
  #undef ISSUE_LOAD
  float l_reg = 0.f;
  #pragma unroll
  for (int r = 0; r < 16; ++r) l_reg += lsum[r];
  { auto rr = __builtin_amdgcn_permlane32_swap(__float_as_uint(l_reg), __float_as_uint(l_reg), false, false); l_reg = __uint_as_float(rr[0]) + __uint_as_float(rr[1]); }
  if (hi == 0) wsf[32 + r32] = l_reg; asm volatile("s_waitcnt lgkmcnt(0)" ::: "memory");
  float rli[16];
  #pragma unroll
  for (int r = 0; r < 16; ++r) rli[r] = __builtin_amdgcn_rcpf(wsf[32 + crow(r, hi)]);
  bf16* Ow = O + (rowbase + q0 + wid * 32) * DM + h * 64;
  { bf16* stg = (bf16*)(shm + LDS_OST) + wid * 2048;
    #pragma unroll
    for (int r = 0; r < 16; ++r) { const int orow = crow(r, hi);
      #pragma unroll
      for (int d0 = 0; d0 < 2; ++d0) stg[orow * 64 + d0 * 32 + r32] = (bf16)(cvtpk_s(o[d0][r] * rli[r], 0.f) & 0xffffu); }
    asm volatile("s_waitcnt lgkmcnt(0)" ::: "memory");
    #pragma unroll
    for (int i = 0; i < 4; ++i) { const int row = i * 8 + (lane >> 3), ch = lane & 7; const u32x4 v = *(const u32x4*)(stg + row * 64 + ch * 8); pg8::st16(Ow + (long)row * DM + ch * 8, v); } }
  asm volatile("s_waitcnt lgkmcnt(0)\n\ts_barrier" ::: "memory");
  #undef DMA_K
  #undef DMA_V
}
#undef SBAR
}

#define GAS __attribute__((address_space(1)))
#define LAS __attribute__((address_space(3)))
typedef unsigned short bf16;
typedef unsigned v4u __attribute__((ext_vector_type(4)));
typedef float f32x4 __attribute__((ext_vector_type(4)));
typedef short bf16x8 __attribute__((ext_vector_type(8)));
typedef GAS unsigned gu32;
typedef GAS unsigned long long gu64;
#define RLX_AGENT __ATOMIC_RELAXED, __HIP_MEMORY_SCOPE_AGENT
#define LDS_WAIT() asm volatile("s_waitcnt lgkmcnt(0)" ::: "memory")
#define VM_WAIT() asm volatile("s_waitcnt vmcnt(0)" ::: "memory")
__device__ __forceinline__ unsigned long long rt() { return __builtin_amdgcn_s_memrealtime(); }
#define XB_TMO      128
#define XB_XCNT(j)  (256  + 64 * (j))
#define XB_XSUB(j)  (1280 + 64 * (j))
#define XB_XGEN(j)  (2304 + 64 * (j))
#define XB_TOP      3328
#define XB_TOPGEN   3392
#define XCD_BAR_WORDS 3456
#define XB_SPIN_CAP (1u << 18)

__device__ __forceinline__ unsigned xb_ld(unsigned* p)              { return __hip_atomic_load(p, __ATOMIC_RELAXED, __HIP_MEMORY_SCOPE_AGENT); }
__device__ __forceinline__ unsigned xb_add(unsigned* p, unsigned v) { return __hip_atomic_fetch_add(p, v, __ATOMIC_RELAXED, __HIP_MEMORY_SCOPE_AGENT); }
__device__ __forceinline__ unsigned xb_xcc_id() { return (unsigned)__builtin_amdgcn_s_getreg((3 << 11) | 20) & 0xFu; }
#define XB_SPIN(cond, bar) do { unsigned _sp = 0; while (cond) { __builtin_amdgcn_s_sleep(1); \
    if ((++_sp & 255u) == 0u) { if (xb_ld(&(bar)[XB_TMO])) break; if (_sp > XB_SPIN_CAP) { atomicAdd(&(bar)[XB_TMO], 1u); break; } } } } while (0)

struct XcdBarrier {
    unsigned* bar; unsigned x;
    volatile LAS unsigned* st;
};

__device__ __forceinline__ XcdBarrier xcd_barrier_post(unsigned* bar, volatile LAS unsigned* st) {
    XcdBarrier b; b.bar = bar; b.x = xb_xcc_id(); b.st = st;
    if (threadIdx.x == 0) (void)xb_add(&bar[XB_XCNT(b.x)], 1u);
    return b;
}
__device__ __forceinline__ void xcd_barrier_complete(unsigned* bar, unsigned x, unsigned& nloc, unsigned& nx) {
    const unsigned G = gridDim.x * gridDim.y * gridDim.z;
    unsigned sum, cnt, mine, sp = 0u;
    for (;;) {
        sum = 0u; cnt = 0u; mine = 0u;
#pragma unroll
        for (unsigned j = 0; j < 16; ++j) { const unsigned c = xb_ld(&bar[XB_XCNT(j)]); sum += c; cnt += (c > 0u) ? 1u : 0u; mine = (j == x) ? c : mine; }
        if (sum == G) break;
        __builtin_amdgcn_s_sleep(1);
        if ((++sp & 255u) == 0u) { if (xb_ld(&bar[XB_TMO])) break; if (sp > XB_SPIN_CAP) { atomicAdd(&bar[XB_TMO], 1u); break; } }
    }
    nloc = mine > 0u ? mine : 1u; nx = cnt > 0u ? cnt : 1u;
}

__device__ __forceinline__ void xcd_barrier(const XcdBarrier& b) {
    asm volatile("s_waitcnt vmcnt(0)" ::: "memory");
    __syncthreads();
    if (threadIdx.x == 0) {
        unsigned* bar = b.bar;
        __builtin_amdgcn_s_waitcnt(0);
        unsigned nloc = b.st[0], nx = b.st[1];
        if (nloc == 0u) { xcd_barrier_complete(bar, b.x, nloc, nx); b.st[0] = nloc; b.st[1] = nx; }
        __builtin_amdgcn_fence(__ATOMIC_RELEASE, "agent");
        asm volatile("s_waitcnt vmcnt(0)" ::: "memory");
        const unsigned old = xb_add(&bar[XB_XSUB(b.x)], 1u);
        const unsigned gen = old / nloc;
        if (old + 1u == (gen + 1u) * nloc) {
            __builtin_amdgcn_fence(__ATOMIC_RELEASE, "agent");
            asm volatile("s_waitcnt vmcnt(0)" ::: "memory");
            const unsigned og = xb_add(&bar[XB_TOP], 1u);
            const unsigned tg = og / nx;
            if (og + 1u == (tg + 1u) * nx) xb_add(&bar[XB_TOPGEN], 1u);
            else XB_SPIN(xb_ld(&bar[XB_TOPGEN]) == tg, bar);
            __builtin_amdgcn_fence(__ATOMIC_ACQUIRE, "agent");
            xb_add(&bar[XB_XGEN(b.x)], 1u);
            asm volatile("s_waitcnt vmcnt(0)" ::: "memory");
        } else {
            XB_SPIN(xb_ld(&bar[XB_XGEN(b.x)]) == gen, bar);
            __builtin_amdgcn_fence(__ATOMIC_ACQUIRE, "agent");
            asm volatile("s_waitcnt vmcnt(0)" ::: "memory");
        }
    }
    __syncthreads();
}
#include <hip/hip_cooperative_groups.h>
namespace cg = cooperative_groups;
constexpr int NWAVES = 8;
constexpr int BATCH = 4, SEQ = 4096, D = 1024, FF = 4096, M = BATCH * SEQ, NIN = 8192;
constexpr size_t MiB = 1u << 20;
constexpr size_t WS_SS = 1 * MiB;
constexpr size_t WS_W1 = 2 * MiB, WS_WC = 18 * MiB, WS_WA = 20 * MiB  , WS_WO = 22 * MiB, WS_WUP = 24 * MiB, WS_WDN = 32 * MiB;
constexpr size_t WS_V = 40 * MiB  , WS_H = 72 * MiB  , WS_Q = 104 * MiB, WS_K = 136 * MiB  , WS_BG = 168 * MiB  , WS_U1 = 200 * MiB;
constexpr size_t WS_UU = 72 * MiB;
constexpr size_t WS_END = 232 * MiB;
constexpr int LDS_BYTES = 147456;
constexpr int LDSCTL_OFF = 131072, MISC_OFF = LDSCTL_OFF + 320;
constexpr size_t WS_CTL = 0, CTL_ZERO_BYTES = 65536; constexpr int CW_BAR = 4096;
__device__ __forceinline__ unsigned f2bf(float f) { unsigned u = __builtin_bit_cast(unsigned, f); return (u + 0x7fffu + ((u >> 16) & 1u)) >> 16; }
__device__ __forceinline__ unsigned pk2(float lo, float hi) { return f2bf(lo) | (f2bf(hi) << 16); }
__device__ __forceinline__ float wave_sum(float v) {
#pragma unroll
    for (int o = 1; o < 64; o <<= 1) v += __shfl_xor(v, o);
    return v;
}
__device__ __forceinline__ void tr_item(const float* W, int ldw, int col0, int k0, bf16* WT, int Kd, int drow0, const float* kscale, LAS float* scr, int lane) {
    float tv[32];
#pragma unroll
    for (int i = 0; i < 32; ++i) { const int kk = 2 * i + (lane >> 5); tv[i] = W[(size_t)(k0 + kk) * ldw + col0 + (lane & 31)]; }
#pragma unroll
    for (int i = 0; i < 32; ++i) { const int kk = 2 * i + (lane >> 5); float v = tv[i]; if (kscale) v *= kscale[k0 + kk]; scr[kk * 33 + (lane & 31)] = v; }
    LDS_WAIT(); asm volatile("" ::: "memory");
    const int c = lane & 7;
#pragma unroll
    for (int j = 0; j < 4; ++j) { const int n = (lane >> 3) + 8 * j; const LAS float* s = scr + (8 * c) * 33 + n;
        v4u o; o.x = pk2(s[0 * 33], s[1 * 33]); o.y = pk2(s[2 * 33], s[3 * 33]); o.z = pk2(s[4 * 33], s[5 * 33]); o.w = pk2(s[6 * 33], s[7 * 33]);
        pg8::st16(WT + (size_t)(drow0 + n) * Kd + k0 + 8 * c, o); }
    LDS_WAIT(); asm volatile("" ::: "memory");
}

#ifndef PH_MASK
#define PH_MASK 127
#endif
#ifndef REP_P1
#define REP_P1 1
#endif
#ifndef REP_ATT
#define REP_ATT 1
#endif
#ifndef REP_P3
#define REP_P3 1
#endif
#ifndef REP_P4
#define REP_P4 1
#endif
#ifndef REP_P5
#define REP_P5 1
#endif
#ifndef EXTRA_SYNC
#define EXTRA_SYNC 0
#endif
__device__ unsigned g_panel_cnt[64 * 64];
__device__ unsigned g_bar_cnt = 0u, g_bar_gen = 0u, g_done_cnt = 0u;
struct Args { const float* in[16]; float* out; unsigned char* ws; };
__global__ void __launch_bounds__(NWAVES * 64, 2) fwd(Args a) {
    extern __shared__ __attribute__((aligned(16))) unsigned char lds[];
    cg::grid_group grid = cg::this_grid();
    LAS unsigned char* ldsp = (LAS unsigned char*)lds;
    const int tid = threadIdx.x, lane = tid & 63, wave = __builtin_amdgcn_readfirstlane(tid >> 6);
    const int G = gridDim.x, bx = blockIdx.x, vcu = (G % 8 == 0) ? (bx % 8) * (G / 8) + bx / 8 : bx;
    unsigned char* ws = a.ws;
    const float* x = a.in[0];
    bf16 *W1 = (bf16*)(ws + WS_W1), *WA = (bf16*)(ws + WS_WA), *WC = (bf16*)(ws + WS_WC), *WO = (bf16*)(ws + WS_WO), *WUP = (bf16*)(ws + WS_WUP), *WDN = (bf16*)(ws + WS_WDN);
    bf16 *Vb = (bf16*)(ws + WS_V), *X1B = (bf16*)(ws + WS_V), *Hb = (bf16*)(ws + WS_H), *YC = (bf16*)(ws + WS_H)  , *Qb = (bf16*)(ws + WS_Q), *AO = (bf16*)(ws + WS_Q)  , *Kb = (bf16*)(ws + WS_K), *MG = (bf16*)(ws + WS_K);
    bf16 *BG = (bf16*)(ws + WS_BG), *U1 = (bf16*)(ws + WS_U1), *UU = (bf16*)(ws + WS_UU), *Gt = (bf16*)a.out;
    float* SS = (float*)(ws + WS_SS);
    for (int u = tid; u < (LDS_BYTES - LDSCTL_OFF) / 4; u += NWAVES * 64) ((LAS unsigned*)(ldsp + LDSCTL_OFF))[u] = 0u;
    __syncthreads();
    if (a.out == nullptr) grid.sync();
#if defined(MONO_BAR)
    const bool grouped = (G == 256);
    const unsigned NSEAMS = (grouped ? 4u : 6u) + EXTRA_SYNC;
    unsigned bar_epoch = 0u, bar_base = 0u;
#define GRID_BAR() do { asm volatile("s_waitcnt vmcnt(0)" ::: "memory"); __syncthreads(); \
    ++bar_epoch; \
    if (tid == 0) { \
        __builtin_amdgcn_fence(__ATOMIC_RELEASE, "agent"); asm volatile("s_waitcnt vmcnt(0)" ::: "memory"); \
        const unsigned old_ = xb_add(&g_bar_cnt, 1u); \
        if (bar_epoch == 1u) bar_base = old_ - old_ % (NSEAMS * (unsigned)G); \
        const unsigned tgt_ = bar_epoch * (unsigned)G; unsigned sp_ = 0u; \
        while (xb_ld(&g_bar_cnt) - bar_base < tgt_) { __builtin_amdgcn_s_sleep(1); if (++sp_ > (1u << 22)) break; } \
        __builtin_amdgcn_fence(__ATOMIC_ACQUIRE, "agent"); asm volatile("s_waitcnt vmcnt(0)" ::: "memory"); } \
    __syncthreads(); } while (0)
    unsigned grp_epoch = 0u, grp_base = 0u;
#define GROUP_BAR(pm_) do { asm volatile("s_waitcnt vmcnt(0)" ::: "memory"); __syncthreads(); \
    ++grp_epoch; \
    if (tid == 0) { unsigned* pc_ = &g_panel_cnt[64 * (pm_)]; \
        __builtin_amdgcn_fence(__ATOMIC_RELEASE, "agent"); asm volatile("s_waitcnt vmcnt(0)" ::: "memory"); \
        const unsigned old_ = xb_add(pc_, 1u); \
        if (grp_epoch == 1u) grp_base = old_ - old_ % 8u; \
        const unsigned tgt_ = grp_epoch * 4u; unsigned sp_ = 0u; \
        while (xb_ld(pc_) - grp_base < tgt_) { __builtin_amdgcn_s_sleep(1); if (++sp_ > (1u << 22)) break; } \
        __builtin_amdgcn_fence(__ATOMIC_ACQUIRE, "agent"); asm volatile("s_waitcnt vmcnt(0)" ::: "memory"); } \
    __syncthreads(); } while (0)
#elif defined(GEN_BAR)
#define GRID_BAR() do { asm volatile("s_waitcnt vmcnt(0)" ::: "memory"); __syncthreads(); \
    if (tid == 0) { \
        __builtin_amdgcn_fence(__ATOMIC_RELEASE, "agent"); asm volatile("s_waitcnt vmcnt(0)" ::: "memory"); \
        unsigned g0_ = xb_ld(&g_bar_gen); asm volatile("s_waitcnt vmcnt(0)" : "+v"(g0_) :: "memory");            \
        unsigned old_ = xb_add(&g_bar_cnt, 1u); asm volatile("s_waitcnt vmcnt(0)" : "+v"(old_) :: "memory"); \
        if (old_ == (unsigned)G - 1u) { __hip_atomic_store(&g_bar_cnt, 0u, RLX_AGENT); asm volatile("s_waitcnt vmcnt(0)" ::: "memory"); xb_add(&g_bar_gen, 1u); } \
        else { unsigned sp_ = 0u; while (xb_ld(&g_bar_gen) == g0_) { __builtin_amdgcn_s_sleep(1); if (++sp_ > (1u << 22)) break; } } \
        __builtin_amdgcn_fence(__ATOMIC_ACQUIRE, "agent"); asm volatile("s_waitcnt vmcnt(0)" ::: "memory"); } \
    __syncthreads(); } while (0)
#elif defined(CG_ALL)
#define GRID_BAR() do { asm volatile("s_waitcnt vmcnt(0)" ::: "memory"); grid.sync(); } while (0)
#elif defined(SIMPLE_BAR)
    unsigned bar_epoch = 0u;
#define GRID_BAR() do { asm volatile("s_waitcnt vmcnt(0)" ::: "memory"); __syncthreads(); \
    ++bar_epoch; \
    if (tid == 0) { unsigned* cnt_ = (unsigned*)(ws + WS_CTL) + CW_BAR + XB_TOP; \
        __builtin_amdgcn_fence(__ATOMIC_RELEASE, "agent"); asm volatile("s_waitcnt vmcnt(0)" ::: "memory"); \
        xb_add(cnt_, 1u); unsigned sp_ = 0u; \
        while (xb_ld(cnt_) < bar_epoch * (unsigned)G) { __builtin_amdgcn_s_sleep(1); if (++sp_ > (1u << 22)) break; } \
        __builtin_amdgcn_fence(__ATOMIC_ACQUIRE, "agent"); asm volatile("s_waitcnt vmcnt(0)" ::: "memory"); } \
    __syncthreads(); } while (0)
#else
#define GRID_BAR() xcd_barrier(bar)
#endif

#ifndef DUP_P0
#define DUP_P0 1
#endif
    for (int rep0 = 0; rep0 < DUP_P0; ++rep0) {
        LAS float* scr = (LAS float*)(ldsp + wave * 16384);
        const int gw = vcu * NWAVES + wave, NGW = G * NWAVES;
        constexpr int I_1 = 16 * 256, I_S = 16 * 32, I_UP = 16 * 128, I_DN = 64 * 32, NITEMS = I_1 + 3 * I_S + I_UP + I_DN;
        for (int it = gw; it < NITEMS; it += NGW) {
            int r = it;
            if (r < I_1) { const int db = r & 255, kb = r >> 8, pn = db >> 3, pb = db & 7, bj = pb >> 2, wcc = pb & 3; const float* W = a.in[2]; int ldw = 6144, col;
                if (pn < 4) col = (4 * pn + wcc) * 64 + 32 * bj;
                else if (pn < 8) col = 1024 + (4 * (pn - 4) + wcc) * 64 + 32 * bj;
                else if (pn < 12) col = 2048 + 256 * (pn - 8) + 32 * pb;
                else if (pn < 16) col = 3072 + 256 * (pn - 12) + 32 * pb;
                else if (pn < 24) col = (bj ? 5120 : 4096) + 128 * (pn - 16) + 32 * wcc;
                else { W = a.in[10]; ldw = 2048; col = 256 * (pn - 24) + 32 * pb; }
                tr_item(W, ldw, col, 64 * kb, W1, D, 32 * db, nullptr, scr, lane); continue; } r -= I_1;
            if (r < I_S) { tr_item(a.in[8], D, 32 * (r & 31), 64 * (r >> 5), WA, D, 32 * (r & 31), nullptr, scr, lane); continue; } r -= I_S;
            if (r < I_S) { tr_item(a.in[9], D, 32 * (r & 31), 64 * (r >> 5), WC, D, 32 * (r & 31), nullptr, scr, lane); continue; } r -= I_S;
            if (r < I_S) { tr_item(a.in[12], D, 32 * (r & 31), 64 * (r >> 5), WO, D, 32 * (r & 31), nullptr, scr, lane); continue; } r -= I_S;
            if (r < I_UP) { tr_item(a.in[14], FF, 32 * (r & 127), 64 * (r >> 7), WUP, D, 32 * (r & 127), a.in[13], scr, lane); continue; } r -= I_UP;
            tr_item(a.in[15], D, 32 * (r & 31), 64 * (r >> 5), WDN, FF, 32 * (r & 31), nullptr, scr, lane);
        }
        const float* g1 = a.in[1];
        f32x4 gv[4];
#pragma unroll
        for (int j = 0; j < 4; ++j) gv[j] = ((const f32x4*)g1)[lane + 64 * j];
        for (int m0 = gw; m0 < M; m0 += 2 * NGW) {
            const int m1 = m0 + NGW;
            const bool has1 = m1 < M;
            const f32x4* xr0 = (const f32x4*)(x + (size_t)m0 * D) + lane; const f32x4* xr1 = (const f32x4*)(x + (size_t)(has1 ? m1 : m0) * D) + lane;
            f32x4 v0[4], v1[4]; float s0 = 0.f, s1 = 0.f;
#pragma unroll
            for (int j = 0; j < 4; ++j) { v0[j] = xr0[64 * j]; v1[j] = xr1[64 * j]; }
#pragma unroll
            for (int j = 0; j < 4; ++j) { s0 += (v0[j].x * v0[j].x + v0[j].y * v0[j].y) + (v0[j].z * v0[j].z + v0[j].w * v0[j].w); s1 += (v1[j].x * v1[j].x + v1[j].y * v1[j].y) + (v1[j].z * v1[j].z + v1[j].w * v1[j].w); }
            const float rs0 = 1.0f / sqrtf(wave_sum(s0) * (1.0f / D) + 1e-6f), rs1 = 1.0f / sqrtf(wave_sum(s1) * (1.0f / D) + 1e-6f);
            unsigned long long* o80 = (unsigned long long*)(Hb + (size_t)m0 * D) + lane; unsigned long long* o81 = (unsigned long long*)(Hb + (size_t)m1 * D) + lane;
#pragma unroll
            for (int j = 0; j < 4; ++j) { const f32x4 y = v0[j] * rs0 * gv[j]; pg8::st8(o80 + 64 * j, (pg8::u32x2w){pk2(y.x, y.y), pk2(y.z, y.w)}); }
            if (has1) {
#pragma unroll
                for (int j = 0; j < 4; ++j) { const f32x4 y = v1[j] * rs1 * gv[j]; pg8::st8(o81 + 64 * j, (pg8::u32x2w){pk2(y.x, y.y), pk2(y.z, y.w)}); } }
        }
    }
    GRID_BAR();
#if !defined(SIMPLE_BAR) && !defined(CG_ALL) && !defined(GEN_BAR) && !defined(MONO_BAR)
    const XcdBarrier bar = xcd_barrier_post((unsigned*)(ws + WS_CTL) + CW_BAR, (volatile LAS unsigned*)(ldsp + MISC_OFF) + 8);
#endif

    if (PH_MASK & 2) {
        pg8::Gemm g{Hb, W1, M, NIN, D}; pg8::StaticOrder S; S.init(M, NIN, G, bx);
        pg8::EpiP1 E{Qb, Kb, Vb, BG, U1, Gt, a.in[3], a.in[4], a.in[11]};
        pg8::gemm_phase<pg8::EpiP1, pg8::StaticOrder, true, true>(ldsp, g, S, E);
#ifdef DUP_P1
        { pg8::Gemm g2{Hb, W1, M, NIN, D}; pg8::StaticOrder S2; S2.init(M, NIN, G, bx); pg8::gemm_phase<pg8::EpiP1, pg8::StaticOrder, true, true>(ldsp, g2, S2, E); }
#endif
    }
    GRID_BAR();

    if (PH_MASK & 4) {
        for (int L = vcu; L < 1024 * REP_ATT; L += G) { const int bh = (L & 255) >> 2, gq4 = (L & 3) + 4 * ((L >> 8) & 3);
            attn::attn_unit(bh >> 4, bh & 15, gq4, Qb, Kb, Vb, AO, a.in[5], a.in[3], a.in[4], (char*)lds); }
        const float* cw = a.in[6]; const float* cb = a.in[7];
        for (int item = vcu * 512 + tid; item < 131072; item += G * 512) {
            const int c8 = (item & 127) * 8, t0 = (item >> 7) * 16;
            float w0[8], w1[8], w2[8], b0[8], u1[8], u2[8];
#pragma unroll
            for (int e = 0; e < 8; ++e) { w0[e] = cw[c8 + e]; w1[e] = cw[1024 + c8 + e]; w2[e] = cw[2048 + c8 + e]; b0[e] = cb[c8 + e]; u1[e] = 0.f; u2[e] = 0.f; }
            if ((t0 & (SEQ - 1)) != 0) { f32x4 p, q; pg8::unpack8(*(const v4u*)(U1 + (size_t)(t0 - 2) * D + c8), p, q);
#pragma unroll
                for (int e = 0; e < 4; ++e) { u2[e] = p[e]; u2[4 + e] = q[e]; }
                pg8::unpack8(*(const v4u*)(U1 + (size_t)(t0 - 1) * D + c8), p, q);
#pragma unroll
                for (int e = 0; e < 4; ++e) { u1[e] = p[e]; u1[4 + e] = q[e]; } }
            v4u ur[16], br[16];
#pragma unroll
            for (int i = 0; i < 16; ++i) { const size_t off = (size_t)(t0 + i) * D + c8; ur[i] = *(const v4u*)(U1 + off); br[i] = *(const v4u*)(BG + off); }
#pragma unroll
            for (int i = 0; i < 16; ++i) { const size_t off = (size_t)(t0 + i) * D + c8; f32x4 p, q, bp, bq; float u0[8], bgv[8], y[8];
                pg8::unpack8(ur[i], p, q); pg8::unpack8(br[i], bp, bq);
#pragma unroll
                for (int e = 0; e < 4; ++e) { u0[e] = p[e]; u0[4 + e] = q[e]; bgv[e] = bp[e]; bgv[4 + e] = bq[e]; }
#pragma unroll
                for (int e = 0; e < 8; ++e) { y[e] = bgv[e] * (b0[e] + w0[e] * u2[e] + w1[e] * u1[e] + w2[e] * u0[e]); u2[e] = u1[e]; u1[e] = u0[e]; }
                v4u o; o.x = pk2(y[0], y[1]); o.y = pk2(y[2], y[3]); o.z = pk2(y[4], y[5]); o.w = pk2(y[6], y[7]); pg8::st16(YC + off, o); }
        }
    }
    GRID_BAR();

    if (PH_MASK & 8) {
        static_assert(WS_Q == WS_H + (size_t)M * D * 2 && WS_WA == WS_WC + (size_t)D * D * 2, "P3 reads the stacked [YC ; AO] and [Wc ; Wa]");
        pg8::PairOrder S; S.S.init(M, D, G, bx);
        pg8::Gemm g{YC, WC, 2 * M, 2 * D, D}; pg8::EpiGate2 E{Gt, MG};
        pg8::gemm_phase<pg8::EpiGate2, pg8::PairOrder, true, true>(ldsp, g, S, E);
    }
    { pg8::StaticOrder S; S.init(M, D, G, bx); pg8::Unit u0; S.next(0, u0); if (grouped) GROUP_BAR(u0.pm); else GRID_BAR(); }

    if (PH_MASK & 16) {
        pg8::Gemm g{MG, WO, M, D, D}; pg8::StaticOrder S; S.init(M, D, G, bx);
        pg8::EpiRes1 E{x, a.out, X1B, SS};
        pg8::gemm_phase<pg8::EpiRes1, pg8::StaticOrder, true, true>(ldsp, g, S, E);
#ifdef DUP_P4
        pg8::gemm_phase<pg8::EpiRes1, pg8::StaticOrder, true, true>(ldsp, g, S, E);
#endif
    }
    GRID_BAR();

    if (PH_MASK & 32) {
        pg8::Gemm g{X1B, WUP, M, FF, D}; pg8::StaticOrder S; S.init(M, FF, G, bx);
        pg8::EpiUp E{SS, UU};
        pg8::gemm_phase<pg8::EpiUp, pg8::StaticOrder, true, true>(ldsp, g, S, E);
#ifdef DUP_P5
        pg8::gemm_phase<pg8::EpiUp, pg8::StaticOrder, true, true>(ldsp, g, S, E);
#endif
    }
    { pg8::StaticOrder S; S.init(M, D, G, bx); pg8::Unit u0; S.next(0, u0); if (grouped) GROUP_BAR(u0.pm); else GRID_BAR(); }

    for (int i = 0; i < EXTRA_SYNC; ++i) GRID_BAR();
    if (PH_MASK & 64) {
        pg8::Gemm g{UU, WDN, M, D, FF}; pg8::StaticOrder S; S.init(M, D, G, bx);
        pg8::EpiRes2 E{a.out, X1B};
        pg8::gemm_phase<pg8::EpiRes2, pg8::StaticOrder, true, true>(ldsp, g, S, E);
    }
#if defined(MONO_BAR)
    if (wave == 0) { unsigned old_ = 0u; if (lane == 0) old_ = xb_add(&g_done_cnt, 1u);
        old_ = (unsigned)__builtin_amdgcn_readfirstlane((int)old_);
        if (old_ == (unsigned)G - 1u) { __hip_atomic_store(&g_panel_cnt[64 * lane], 0u, RLX_AGENT);
            if (lane == 0) { __hip_atomic_store(&g_bar_cnt, 0u, RLX_AGENT); __hip_atomic_store(&g_done_cnt, 0u, RLX_AGENT); } } }
#endif
}

extern "C" void kernel_launch(void* const* d_in, const int* in_sizes, int n_in, void* d_out, int out_size, void* d_ws, size_t ws_size, hipStream_t stream) {
    static int grid = 0;
    if (grid == 0) {
        if (n_in != 16 || out_size != M * D || ws_size < WS_END) { fprintf(stderr, "kernel_launch: unexpected shapes (n_in %d, out %d, ws %zu)\n", n_in, out_size, ws_size); grid = -1; return; }
        int dev = 0, cus = 0, per_cu = 0;
        (void)hipGetDevice(&dev); (void)hipDeviceGetAttribute(&cus, hipDeviceAttributeMultiprocessorCount, dev);
        if (hipFuncSetAttribute((const void*)fwd, hipFuncAttributeMaxDynamicSharedMemorySize, LDS_BYTES) != hipSuccess) { fprintf(stderr, "kernel_launch: hipFuncSetAttribute failed\n"); grid = -1; return; }
        if (hipOccupancyMaxActiveBlocksPerMultiprocessor(&per_cu, (const void*)fwd, NWAVES * 64, LDS_BYTES) != hipSuccess || per_cu < 1) { fprintf(stderr, "kernel_launch: occupancy query says %d\n", per_cu); per_cu = 1; }
        (void)hipGetLastError();
        grid = cus * 1;
    }
    if (grid < 0) return;
#if !defined(GEN_BAR) && !defined(MONO_BAR)
    if (hipMemsetAsync((char*)d_ws + WS_CTL, 0, CTL_ZERO_BYTES, stream) != hipSuccess) { fprintf(stderr, "kernel_launch: memset of the barrier words failed\n"); return; }
#endif
    Args a{};
    for (int i = 0; i < 16; ++i) a.in[i] = (const float*)d_in[i];
    a.out = (float*)d_out; a.ws = (unsigned char*)d_ws;
    void* args[] = {&a};
    hipError_t e = hipLaunchCooperativeKernel((const void*)fwd, dim3(grid), dim3(NWAVES * 64), args, LDS_BYTES, stream);
    if (e != hipSuccess) fprintf(stderr, "kernel_launch: cooperative launch failed: %s (grid %d)\n", hipGetErrorString(e), grid);
}
```

```cpp
#include <hip/hip_runtime.h>
#include <cstdio>
#include <cstdint>
#define MONO_BAR 1
namespace pg8 {
#define PG8_LAS __attribute__((address_space(3)))
typedef unsigned short bf16_t;
typedef short bf16x8 __attribute__((ext_vector_type(8)));
typedef float f32x4 __attribute__((ext_vector_type(4)));
typedef unsigned u32x4 __attribute__((ext_vector_type(4)));
constexpr int BM = 256, BK = 64, HALF = 128, HTB = HALF * BK * 2  , STAGE_BYTES = 8 * HTB, NXCD = 8, WGM = 8;

__host__ __device__ __forceinline__ int lds_byte(int r, int c) { const int st = (r >> 4) * 2 + (c >> 5), rr = r & 15, cc = c & 31, ob = rr * 64 + cc * 2; return st * 1024 + (ob ^ (((ob >> 9) & 1) << 5)); }
__host__ __device__ __forceinline__ void stage_rc(int b, int& R, int& C) { const int st = b / 1024, sb = b % 1024, swz = sb ^ (((sb >> 9) & 1) << 5); R = (st >> 1) * 16 + swz / 64; C = (st & 1) * 32 + (swz % 64) / 2; }
__host__ __device__ __forceinline__ int perm32(int rho) { const int n = rho >> 4, i = rho & 15; return 8 * (i >> 2) + 4 * n + (i & 3); }

struct Unit { int pm, pn; };
struct Gemm { const bf16_t* A; const bf16_t* Bt; int M, N, K; };

struct StaticOrder {
    int nM, nN, nwg, G, c;
    __host__ __device__ void init(int M, int N, int G_, int c_) { nM = M / BM; nN = N / BM; nwg = nM * nN; G = G_; c = c_; }
    __host__ __device__ bool next(int i, Unit& u) const {
        const long L = (long)i * G + c; if (L >= nwg) return false;
        int wgid = (int)L; { const int q = nwg / NXCD, r = nwg % NXCD, xcd = wgid % NXCD, off = wgid / NXCD; wgid = (xcd < r ? xcd * (q + 1) : r * (q + 1) + (xcd - r) * q) + off; }
        const int nig = WGM * nN, gid = wgid / nig, fm = gid * WGM, gsz = (nM - fm) < WGM ? (nM - fm) : WGM;
        u.pm = fm + ((wgid % nig) % gsz); u.pn = (wgid % nig) / gsz; return true;
    }
    __device__ __forceinline__ void a_ready(const Unit&) const {}
    __device__ __forceinline__ void done(const Unit&) const {}
};

__device__ __forceinline__ unsigned cvt_pk_bf16(float lo, float hi) { unsigned r; asm volatile("v_cvt_pk_bf16_f32 %0, %1, %2" : "=v"(r) : "v"(lo), "v"(hi)); return r; }
typedef float f32x2 __attribute__((ext_vector_type(2)));
#ifndef WT_STORES
#define WT_STORES 1
#endif
__device__ __forceinline__ void st16(void* p, u32x4 v) {
#if WT_STORES
    asm volatile("global_store_dwordx4 %0, %1, off sc1\n\ts_nop 1" :: "v"(p), "v"(v) : "memory");
#else
    *(u32x4*)p = v;
#endif
}
typedef unsigned u32x2w __attribute__((ext_vector_type(2)));
__device__ __forceinline__ void st8(void* p, u32x2w v) {
#if WT_STORES
    asm volatile("global_store_dwordx2 %0, %1, off sc1\n\ts_nop 1" :: "v"(p), "v"(v) : "memory");
#else
    *(u32x2w*)p = v;
#endif
}
typedef unsigned u32x2 __attribute__((ext_vector_type(2)));
__device__ __forceinline__ float bf_lo(unsigned w) { return __uint_as_float(w << 16); }
__device__ __forceinline__ float bf_hi(unsigned w) { return __uint_as_float(w & 0xffff0000u); }
__device__ __forceinline__ u32x4 pack8(f32x4 a, f32x4 b) { u32x4 w; w.x = cvt_pk_bf16(a[0], a[1]); w.y = cvt_pk_bf16(a[2], a[3]); w.z = cvt_pk_bf16(b[0], b[1]); w.w = cvt_pk_bf16(b[2], b[3]); return w; }
__device__ __forceinline__ void unpack8(u32x4 w, f32x4& a, f32x4& b) { a = (f32x4){bf_lo(w.x), bf_hi(w.x), bf_lo(w.y), bf_hi(w.y)}; b = (f32x4){bf_lo(w.z), bf_hi(w.z), bf_lo(w.w), bf_hi(w.w)}; }
constexpr float QK_C2 = 0.125f * 1.4426950408889634f;
constexpr float RMS_EPS = 1e-6f;

struct EpiP1 {
    static constexpr bool PERM = true, AFTER_DRAIN = false;
    bf16_t *Q, *Kb, *V, *BG, *U1, *G; const float *gq, *gk, *bgate;
    __device__ __forceinline__ void operator()(const f32x4 (&acc)[2][2][4][2], const Unit& u, int wr, int wc, int fr, int fq) const {
        const int pn = u.pn; const int row0 = u.pm * BM + wr * 64 + fr;
        if (pn < 8) {
            const bool isq = pn < 4; const float* g = isq ? gq : gk; bf16_t* O = isq ? Q : Kb; const float sc = isq ? QK_C2 : 1.f;
            const int head = 4 * (pn & 3) + wc;
            f32x4 gv[2][2];
#pragma unroll
            for (int bj = 0; bj < 2; ++bj)
#pragma unroll
                for (int n = 0; n < 2; ++n) gv[bj][n] = *(const f32x4*)(g + 32 * bj + 8 * fq + 4 * n) * sc;
#pragma unroll
            for (int ai = 0; ai < 2; ++ai)
#pragma unroll
                for (int m = 0; m < 4; ++m) {
                    float s = 0.f;
#pragma unroll
                    for (int bj = 0; bj < 2; ++bj)
#pragma unroll
                        for (int n = 0; n < 2; ++n) { const f32x4 x = acc[ai][bj][m][n]; s += (x[0] * x[0] + x[1] * x[1]) + (x[2] * x[2] + x[3] * x[3]); }
                    s += __shfl_xor(s, 16); s += __shfl_xor(s, 32);
                    const float rs = 1.0f / sqrtf(s * (1.0f / 64.0f) + RMS_EPS);
                    bf16_t* rowp = O + (size_t)(row0 + ai * HALF + m * 16) * 1024 + head * 64 + 8 * fq;
#pragma unroll
                    for (int bj = 0; bj < 2; ++bj) st16(rowp + 32 * bj, pack8(acc[ai][bj][m][0] * rs * gv[bj][0], acc[ai][bj][m][1] * rs * gv[bj][1]));
                }
        } else if (pn < 16) {
            bf16_t* O = (pn < 12) ? V : BG; const int col0 = 256 * (pn & 3) + wc * 32 + 8 * fq;
#pragma unroll
            for (int ai = 0; ai < 2; ++ai)
#pragma unroll
                for (int m = 0; m < 4; ++m) { bf16_t* rowp = O + (size_t)(row0 + ai * HALF + m * 16) * 1024 + col0;
#pragma unroll
                    for (int bj = 0; bj < 2; ++bj) st16(rowp + bj * HALF, pack8(acc[ai][bj][m][0], acc[ai][bj][m][1])); }
        } else if (pn < 24) {
            const int col0 = 128 * (pn - 16) + wc * 32 + 8 * fq;
#pragma unroll
            for (int ai = 0; ai < 2; ++ai)
#pragma unroll
                for (int m = 0; m < 4; ++m)
                    st16(U1 + (size_t)(row0 + ai * HALF + m * 16) * 1024 + col0, pack8(acc[ai][0][m][0] * acc[ai][1][m][0], acc[ai][0][m][1] * acc[ai][1][m][1]));
        } else {
            const int col0 = 256 * (pn - 24) + wc * 32 + 8 * fq;
            f32x4 bv[2][2];
#pragma unroll
            for (int bj = 0; bj < 2; ++bj)
#pragma unroll
                for (int n = 0; n < 2; ++n) bv[bj][n] = *(const f32x4*)(bgate + col0 + bj * HALF + 4 * n);
#pragma unroll
            for (int ai = 0; ai < 2; ++ai)
#pragma unroll
                for (int m = 0; m < 4; ++m) { bf16_t* rowp = G + (size_t)(row0 + ai * HALF + m * 16) * 2048 + col0;
#pragma unroll
                    for (int bj = 0; bj < 2; ++bj) { f32x4 v[2];
#pragma unroll
                        for (int n = 0; n < 2; ++n) { const f32x4 z = (acc[ai][bj][m][n] + bv[bj][n]) * (-1.4426950408889634f);
#pragma unroll
                            for (int e = 0; e < 4; ++e) v[n][e] = __builtin_amdgcn_rcpf(1.0f + __builtin_amdgcn_exp2f(z[e])); }
                        st16(rowp + bj * HALF, pack8(v[0], v[1])); } }
        }
    }
};
template <bool ADD> struct EpiGate {
    static constexpr bool PERM = true, AFTER_DRAIN = false;
    const bf16_t* G; bf16_t* MG; int goff;
    __device__ __forceinline__ void operator()(const f32x4 (&acc)[2][2][4][2], const Unit& u, int wr, int wc, int fr, int fq) const {
        const int row0 = u.pm * BM + wr * 64 + fr, col0 = u.pn * BM + wc * 32 + 8 * fq;
#pragma unroll
        for (int ai = 0; ai < 2; ++ai)
#pragma unroll
            for (int m = 0; m < 4; ++m) { const size_t r = (size_t)(row0 + ai * HALF + m * 16);
#pragma unroll
                for (int bj = 0; bj < 2; ++bj) { f32x4 g0, g1; unpack8(*(const u32x4*)(G + r * 2048 + goff + col0 + bj * HALF), g0, g1);
                    f32x4 v0 = acc[ai][bj][m][0] * g0, v1 = acc[ai][bj][m][1] * g1;
                    bf16_t* p = MG + r * 1024 + col0 + bj * HALF;
                    if (ADD) { f32x4 a0, a1; unpack8(*(const u32x4*)p, a0, a1); v0 += a0; v1 += a1; }
                    *(u32x4*)p = pack8(v0, v1); } }
    }
};
struct PairOrder {
    StaticOrder S;
    __device__ bool next(int i, Unit& u) const { Unit b; if (!S.next(i >> 1, b)) return false; u.pm = b.pm + ((i & 1) ? 64 : 0); u.pn = b.pn + ((i & 1) ? 4 : 0); return true; }
    __device__ __forceinline__ void a_ready(const Unit&) const {}
    __device__ __forceinline__ void done(const Unit&) const {}
};
struct EpiGate2 {
    static constexpr bool PERM = true, AFTER_DRAIN = false;
    const bf16_t* G; bf16_t* MG;
    __device__ __forceinline__ void operator()(const f32x4 (&acc)[2][2][4][2], const Unit& u, int wr, int wc, int fr, int fq) const {
        const bool second = u.pm >= 64; const int pm = second ? u.pm - 64 : u.pm, pn = second ? u.pn - 4 : u.pn, goff = second ? 0 : 1024;
        const int row0 = pm * BM + wr * 64 + fr, col0 = pn * BM + wc * 32 + 8 * fq;
#pragma unroll
        for (int ai = 0; ai < 2; ++ai) {
            u32x4 gl[4][2], ml[4][2];
#pragma unroll
            for (int m = 0; m < 4; ++m) { const size_t r = (size_t)(row0 + ai * HALF + m * 16);
#pragma unroll
                for (int bj = 0; bj < 2; ++bj) { gl[m][bj] = *(const u32x4*)(G + r * 2048 + goff + col0 + bj * HALF); if (second) ml[m][bj] = *(const u32x4*)(MG + r * 1024 + col0 + bj * HALF); } }
#pragma unroll
            for (int m = 0; m < 4; ++m) { const size_t r = (size_t)(row0 + ai * HALF + m * 16);
#pragma unroll
                for (int bj = 0; bj < 2; ++bj) { f32x4 g0, g1; unpack8(gl[m][bj], g0, g1);
                    f32x4 v0 = acc[ai][bj][m][0] * g0, v1 = acc[ai][bj][m][1] * g1;
                    bf16_t* p = MG + r * 1024 + col0 + bj * HALF;
                    if (second) { f32x4 a0, a1; unpack8(ml[m][bj], a0, a1); v0 += a0; v1 += a1; } st16(p, pack8(v0, v1)); } }
        }
    }
};
#ifndef STORE_X1_F32
#define STORE_X1_F32 0
#endif
struct EpiRes1 {
    static constexpr bool PERM = false, AFTER_DRAIN = false;
    const float* x; float* out; bf16_t* x1b; float* SS;
    __device__ __forceinline__ void operator()(const f32x4 (&acc)[2][2][4][2], const Unit& u, int wr, int wc, int fr, int fq) const {
        const int row0 = u.pm * BM + wr * 64 + fr, col0 = u.pn * BM + wc * 32 + 4 * fq;
#pragma unroll
        for (int ai = 0; ai < 2; ++ai) {
            f32x4 xv[4][2][2];
#pragma unroll
            for (int m = 0; m < 4; ++m) { const size_t off = (size_t)(row0 + ai * HALF + m * 16) * 1024 + col0;
#pragma unroll
                for (int bj = 0; bj < 2; ++bj)
#pragma unroll
                    for (int n = 0; n < 2; ++n) xv[m][bj][n] = *(const f32x4*)(x + off + bj * HALF + n * 16); }
#pragma unroll
            for (int m = 0; m < 4; ++m) { const size_t r = (size_t)(row0 + ai * HALF + m * 16); const size_t off = r * 1024 + col0; float s = 0.f;
#pragma unroll
                for (int bj = 0; bj < 2; ++bj)
#pragma unroll
                    for (int n = 0; n < 2; ++n) { const f32x4 v = xv[m][bj][n] + acc[ai][bj][m][n];
                        if (STORE_X1_F32) *(f32x4*)(out + off + bj * HALF + n * 16) = v; s += (v[0] * v[0] + v[1] * v[1]) + (v[2] * v[2] + v[3] * v[3]);
                        u32x2 w; w.x = cvt_pk_bf16(v[0], v[1]); w.y = cvt_pk_bf16(v[2], v[3]); st8(x1b + off + bj * HALF + n * 16, w); }
                s += __shfl_xor(s, 16); s += __shfl_xor(s, 32);
                if (fq == 0) __hip_atomic_store(SS + r * 16 + 4 * u.pn + wc, s, __ATOMIC_RELAXED, __HIP_MEMORY_SCOPE_AGENT); }
            asm volatile("" ::: "memory");
        }
    }
};
struct EpiUp {
    static constexpr bool PERM = true, AFTER_DRAIN = false;
    const float* SS; bf16_t* UU;
    __device__ __forceinline__ void operator()(const f32x4 (&acc)[2][2][4][2], const Unit& u, int wr, int wc, int fr, int fq) const {
        const int row0 = u.pm * BM + wr * 64 + fr, col0 = u.pn * BM + wc * 32 + 8 * fq;
#pragma unroll
        for (int ai = 0; ai < 2; ++ai)
#pragma unroll
            for (int m = 0; m < 4; ++m) { const size_t r = (size_t)(row0 + ai * HALF + m * 16);
                const f32x4* sp = (const f32x4*)(SS + r * 16); const f32x4 s4 = (sp[0] + sp[1]) + (sp[2] + sp[3]);
                const float rs = 1.0f / sqrtf(((s4[0] + s4[1]) + (s4[2] + s4[3])) * (1.0f / 1024.0f) + RMS_EPS);
#pragma unroll
                for (int bj = 0; bj < 2; ++bj) { f32x4 v[2];
#pragma unroll
                    for (int n = 0; n < 2; ++n) { const f32x4 z = acc[ai][bj][m][n] * rs;
#pragma unroll
                        for (int e = 0; e < 4; ++e) { const float t = fmaxf(z[e], 0.f); v[n][e] = t * t; } }
                    st16(UU + r * 4096 + col0 + bj * HALF, pack8(v[0], v[1])); } }
    }
};
struct EpiRes2 {
    static constexpr bool PERM = false, AFTER_DRAIN = false;
    float* out; const bf16_t* x1b;
    __device__ __forceinline__ void operator()(const f32x4 (&acc)[2][2][4][2], const Unit& u, int wr, int wc, int fr, int fq) const {
        const int row0 = u.pm * BM + wr * 64 + fr, col0 = u.pn * BM + wc * 32 + 4 * fq;
#pragma unroll
        for (int ai = 0; ai < 2; ++ai)
#pragma unroll
            for (int m = 0; m < 4; ++m) { const size_t off = (size_t)(row0 + ai * HALF + m * 16) * 1024 + col0;
#pragma unroll
                for (int bj = 0; bj < 2; ++bj)
#pragma unroll
                    for (int n = 0; n < 2; ++n) { float* p = out + off + bj * HALF + n * 16;
#if STORE_X1_F32
                        const f32x4 b = *(const f32x4*)p;
#else
                        const u32x2 w = *(const u32x2*)(x1b + off + bj * HALF + n * 16); const f32x4 b = {bf_lo(w.x), bf_hi(w.x), bf_lo(w.y), bf_hi(w.y)};
#endif
                        *(f32x4*)p = b + acc[ai][bj][m][n]; }
                if (m == 3) asm volatile("" ::: "memory"); }
    }
};

template <class Epi, class Sched, bool ALIGN_EPI = false, bool SP2 = false>
__device__ __forceinline__ void gemm_phase(PG8_LAS unsigned char* lds, const Gemm g, const Sched& S, const Epi& E) {
    int tid_ = threadIdx.x; asm volatile("" : "+v"(tid_));
    const int tid = tid_, wid = __builtin_amdgcn_readfirstlane(tid >> 6), lane = tid & 63, wr = wid >> 2, wc = wid & 3, fr = lane & 15, fq = lane >> 4;
    const int K = g.K, nt = K / BK;
    unsigned voffA[2], voffB[2];
#pragma unroll
    for (int i = 0; i < 2; ++i) { int R, C; stage_rc(tid * 16 + i * 8192, R, C); const int Rb = Epi::PERM ? ((R & ~31) + perm32(R & 31)) : R;
        voffA[i] = (unsigned)(R * K + C) * 2u; voffB[i] = (unsigned)(Rb * K + C) * 2u; }
    const size_t kstep = (size_t)(BK * 2);
    const size_t hstep = (size_t)HALF * K * 2;
    const size_t tstep = 2 * hstep;
    const unsigned ldsw = (unsigned)wid * 1024u;
    const int aoff = lds_byte(wr * 64 + fr, fq * 8), boff = lds_byte(wc * 32 + fr, fq * 8);
#define PG8_SA(b, h) (((b) * 2 + (h)) * HTB)
#define PG8_SB(b, h) ((4 + (b) * 2 + (h)) * HTB)
#define PG8_STAGE(bufoff, gbase, voff) do { _Pragma("unroll") for (int _i = 0; _i < 2; ++_i) \
        __builtin_amdgcn_global_load_lds((const unsigned*)((const char*)(gbase) + (voff)[_i]), (PG8_LAS unsigned*)(lds + (bufoff) + ldsw + _i * 8192), 16, 0, 0); } while (0)
#define PG8_LDA(dst, b, h) do { _Pragma("unroll") for (int m = 0; m < 4; ++m) _Pragma("unroll") for (int k = 0; k < 2; ++k) dst[m][k] = *(const PG8_LAS bf16x8*)(lds + PG8_SA(b, h) + aoff + m * 2048 + k * 1024); } while (0)
#define PG8_LDB(dst, b, h) do { _Pragma("unroll") for (int n = 0; n < 2; ++n) _Pragma("unroll") for (int k = 0; k < 2; ++k) dst[n][k] = *(const PG8_LAS bf16x8*)(lds + PG8_SB(b, h) + boff + n * 2048 + k * 1024); } while (0)
#define PG8_MMA(ai, bj, At, Bt) do { __builtin_amdgcn_s_setprio(1); _Pragma("unroll") for (int m = 0; m < 4; ++m) _Pragma("unroll") for (int n = 0; n < 2; ++n) _Pragma("unroll") for (int k = 0; k < 2; ++k) \
        acc[ai][bj][m][n] = __builtin_amdgcn_mfma_f32_16x16x32_bf16(Bt[n][k], At[m][k], acc[ai][bj][m][n], 0, 0, 0); __builtin_amdgcn_s_setprio(0); } while (0)
#define PG8_WAIT_V(n) asm volatile("s_waitcnt vmcnt(" #n ")" ::: "memory")
#define PG8_WAIT_L(n) asm volatile("s_waitcnt lgkmcnt(" #n ")" ::: "memory")
#define PG8_BAR __builtin_amdgcn_s_barrier()
#define PG8_SCHED __builtin_amdgcn_sched_barrier(0)
    Unit cur, nxt; int ui = 0;
    if (!S.next(0, cur)) return;
    f32x4 acc[2][2][4][2];
#pragma unroll
    for (int a = 0; a < 2; ++a)
#pragma unroll
        for (int b = 0; b < 2; ++b)
#pragma unroll
            for (int m = 0; m < 4; ++m)
#pragma unroll
                for (int n = 0; n < 2; ++n) acc[a][b][m][n] = (f32x4){0.f, 0.f, 0.f, 0.f};
    bf16x8 At[4][2], B0[2][2], B1[2][2];
    const char* cA = (const char*)g.A + (size_t)cur.pm * tstep; const char* cB = (const char*)g.Bt + (size_t)cur.pn * tstep;
    S.a_ready(cur);
    if constexpr (SP2) {
        PG8_STAGE(PG8_SB(0, 0), cB, voffB); PG8_STAGE(PG8_SB(0, 1), cB + hstep, voffB); PG8_STAGE(PG8_SA(0, 0), cA, voffA); PG8_STAGE(PG8_SA(0, 1), cA + hstep, voffA);
        if (wr == 1) PG8_BAR;
        PG8_WAIT_V(2); PG8_BAR;
        PG8_STAGE(PG8_SB(1, 0), cB + kstep, voffB); PG8_STAGE(PG8_SA(1, 0), cA + kstep, voffA); PG8_STAGE(PG8_SB(1, 1), cB + hstep + kstep, voffB);
        PG8_WAIT_V(6); PG8_BAR;
    } else {
        PG8_STAGE(PG8_SB(0, 0), cB, voffB); PG8_STAGE(PG8_SA(0, 0), cA, voffA); PG8_STAGE(PG8_SB(0, 1), cB + hstep, voffB); PG8_STAGE(PG8_SA(0, 1), cA + hstep, voffA);
        if (wr == 1) PG8_BAR;
        PG8_WAIT_V(4); PG8_BAR;
        PG8_STAGE(PG8_SB(1, 0), cB + kstep, voffB); PG8_STAGE(PG8_SA(1, 0), cA + kstep, voffA); PG8_STAGE(PG8_SB(1, 1), cB + hstep + kstep, voffB);
        PG8_WAIT_V(6); PG8_BAR;
    }
    for (;;) {
        const bool has_next = S.next(ui + 1, nxt);
        const char* nA = has_next ? (const char*)g.A + (size_t)nxt.pm * tstep : cA; const char* nB = has_next ? (const char*)g.Bt + (size_t)nxt.pn * tstep : cB;
        for (int t = 0; t < nt; t += 2) {
            const bool last = (t == nt - 2);
            const char* a1 = cA + (size_t)(t + 1) * kstep;
            const char* a2 = last ? nA : cA + (size_t)(t + 2) * kstep; const char* b2 = last ? nB : cB + (size_t)(t + 2) * kstep;
            const char* a3 = a2 + kstep; const char* b3 = b2 + kstep;
            if (last && has_next) S.a_ready(nxt);
            if constexpr (SP2) {
            PG8_LDB(B0, 0, 0); PG8_LDB(B1, 0, 1); PG8_SCHED; PG8_LDA(At, 0, 0); PG8_STAGE(PG8_SA(1, 1), a1 + hstep, voffA);
            PG8_WAIT_V(8); PG8_WAIT_L(0); PG8_BAR; PG8_MMA(0, 0, At, B0); PG8_MMA(0, 1, At, B1); PG8_BAR; PG8_SCHED;
            PG8_LDA(At, 0, 1); PG8_STAGE(PG8_SB(0, 0), b2, voffB); PG8_STAGE(PG8_SB(0, 1), b2 + hstep, voffB); PG8_STAGE(PG8_SA(0, 0), a2, voffA);
            PG8_WAIT_V(8); PG8_WAIT_L(0); PG8_BAR; PG8_MMA(1, 0, At, B0); PG8_MMA(1, 1, At, B1); PG8_BAR; PG8_SCHED;
            PG8_LDB(B0, 1, 0); PG8_LDB(B1, 1, 1); PG8_SCHED; PG8_LDA(At, 1, 0); PG8_STAGE(PG8_SA(0, 1), a2 + hstep, voffA);
            PG8_WAIT_V(8); PG8_WAIT_L(0); PG8_BAR; PG8_MMA(0, 0, At, B0); PG8_MMA(0, 1, At, B1); PG8_BAR; PG8_SCHED;
            PG8_LDA(At, 1, 1); PG8_STAGE(PG8_SB(1, 0), b3, voffB); PG8_STAGE(PG8_SB(1, 1), b3 + hstep, voffB); PG8_STAGE(PG8_SA(1, 0), a3, voffA);
            PG8_WAIT_V(8); PG8_WAIT_L(0); PG8_BAR; PG8_MMA(1, 0, At, B0); PG8_MMA(1, 1, At, B1); PG8_BAR; PG8_SCHED;
            } else {
            PG8_LDB(B0, 0, 0); PG8_SCHED; PG8_LDA(At, 0, 0); PG8_STAGE(PG8_SA(1, 1), a1 + hstep, voffA);
            PG8_WAIT_L(8); PG8_BAR; PG8_WAIT_L(0); PG8_MMA(0, 0, At, B0); PG8_BAR; PG8_SCHED;
            PG8_LDB(B1, 0, 1); PG8_STAGE(PG8_SB(0, 0), b2, voffB);
            PG8_BAR; PG8_WAIT_L(0); PG8_MMA(0, 1, At, B1); PG8_BAR;
            PG8_LDA(At, 0, 1); PG8_STAGE(PG8_SA(0, 0), a2, voffA);
            PG8_BAR; PG8_WAIT_L(0); PG8_MMA(1, 0, At, B0); PG8_BAR; PG8_SCHED;
            PG8_STAGE(PG8_SB(0, 1), b2 + hstep, voffB);
            PG8_WAIT_V(6); PG8_BAR; PG8_MMA(1, 1, At, B1); PG8_BAR;
            PG8_LDB(B0, 1, 0); PG8_SCHED; PG8_LDA(At, 1, 0); PG8_STAGE(PG8_SA(0, 1), a2 + hstep, voffA);
            PG8_WAIT_L(8); PG8_BAR; PG8_WAIT_L(0); PG8_MMA(0, 0, At, B0); PG8_BAR; PG8_SCHED;
            PG8_LDB(B1, 1, 1); PG8_STAGE(PG8_SB(1, 0), b3, voffB);
            PG8_BAR; PG8_WAIT_L(0); PG8_MMA(0, 1, At, B1); PG8_BAR;
            PG8_LDA(At, 1, 1); PG8_STAGE(PG8_SA(1, 0), a3, voffA);
            PG8_BAR; PG8_WAIT_L(0); PG8_MMA(1, 0, At, B0); PG8_BAR; PG8_SCHED;
            PG8_STAGE(PG8_SB(1, 1), b3 + hstep, voffB);
            PG8_WAIT_V(6); PG8_BAR; PG8_MMA(1, 1, At, B1); PG8_BAR;
            }
        }
        if constexpr (ALIGN_EPI) { if (wr == 0) PG8_BAR; }
        if constexpr (!Epi::AFTER_DRAIN) { E(acc, cur, wr, wc, fr, fq); S.done(cur); }
        if (!has_next) break;
#pragma unroll
        for (int a = 0; a < 2; ++a)
#pragma unroll
            for (int b = 0; b < 2; ++b)
#pragma unroll
                for (int m = 0; m < 4; ++m)
#pragma unroll
                    for (int n = 0; n < 2; ++n) acc[a][b][m][n] = (f32x4){0.f, 0.f, 0.f, 0.f};
        cur = nxt; cA = nA; cB = nB; ++ui;
        if constexpr (ALIGN_EPI) { if (wr == 1) PG8_BAR; }
    }
    PG8_WAIT_V(0);
    if constexpr (!ALIGN_EPI) { if (wr == 0) PG8_BAR; }
    PG8_BAR;
    if constexpr (Epi::AFTER_DRAIN) { E.fused(acc, cur, wr, wc, fr, fq, lds, wid, lane); S.done(cur); }
#undef PG8_SA
#undef PG8_SB
#undef PG8_STAGE
#undef PG8_LDA
#undef PG8_LDB
#undef PG8_MMA
#undef PG8_WAIT_V
#undef PG8_WAIT_L
#undef PG8_BAR
#undef PG8_SCHED
}
}

namespace attn {
using bf16 = unsigned short;
using bf16x8 = __attribute__((ext_vector_type(8))) short;
using s16x4 = __attribute__((ext_vector_type(4))) short;
using f32x16 = __attribute__((ext_vector_type(16))) float;
using u32x4 = __attribute__((ext_vector_type(4))) unsigned;
using f32x4 = __attribute__((ext_vector_type(4))) float;
constexpr int SEQ = 4096, DM = 1024, NSLOT = 6, SLOTB = 8192, NREL = 513;
constexpr int LDS_K = 0, LDS_V = NSLOT * SLOTB, LDS_WS = 2 * NSLOT * SLOTB, LDS_OST = LDS_WS + 8 * 64 * 4, LDS_BIAS = LDS_OST + 8 * 4096, BIAS_CS = 400  , LDS_BYTES = LDS_BIAS + 4 * BIAS_CS * 4;
constexpr float LOG2E = 1.4426950408889634f;
__device__ __forceinline__ int crow(int r, int hi) { return (r & 3) + 8 * (r >> 2) + 4 * hi; }
#define SBAR() __builtin_amdgcn_sched_barrier(0)
__device__ __forceinline__ void glds16(const void* gsrc, unsigned lds_dst) { unsigned keep;
  asm volatile("s_mov_b32 %0, m0\n\ts_mov_b32 m0, %2\n\ts_nop 0\n\tglobal_load_lds_dwordx4 %1, off\n\ts_mov_b32 m0, %0" : "=&s"(keep) : "v"(gsrc), "s"(lds_dst) : "memory"); }
typedef float f32x2_t __attribute__((ext_vector_type(2))); typedef __bf16 bf16x2_t __attribute__((ext_vector_type(2)));
__device__ __forceinline__ unsigned cvtpk_s(float lo, float hi) { f32x2_t v = {lo, hi}; bf16x2_t b = __builtin_convertvector(v, bf16x2_t); return __builtin_bit_cast(unsigned, b); }
typedef __attribute__((address_space(3))) const char* lds_cptr;
__device__ __forceinline__ void kload8(bf16x8* kf, lds_cptr kp) {
  kf[0] = *(const __attribute__((address_space(3))) bf16x8*)(kp);        kf[1] = *(const __attribute__((address_space(3))) bf16x8*)(kp + 512);
  kf[2] = *(const __attribute__((address_space(3))) bf16x8*)(kp + 2048); kf[3] = *(const __attribute__((address_space(3))) bf16x8*)(kp + 2560);
  kf[4] = *(const __attribute__((address_space(3))) bf16x8*)(kp + 4096); kf[5] = *(const __attribute__((address_space(3))) bf16x8*)(kp + 4608);
  kf[6] = *(const __attribute__((address_space(3))) bf16x8*)(kp + 6144); kf[7] = *(const __attribute__((address_space(3))) bf16x8*)(kp + 6656);
}
__device__ __forceinline__ void pv(f32x16* o, int vb, bf16x8 pa0, bf16x8 pa1, bf16x8 pa2, bf16x8 pa3) {
  #pragma unroll
  for (int d0 = 0; d0 < 2; ++d0) { s16x4 lo[4], hi[4];
    #pragma unroll
    for (int ks = 0; ks < 4; ++ks) {
      asm volatile("ds_read_b64_tr_b16 %0,%1 offset:%c2" : "=&v"(lo[ks]) : "v"(vb), "i"(d0 * 4096 + ks * 1024) : "memory");
      asm volatile("ds_read_b64_tr_b16 %0,%1 offset:%c2" : "=&v"(hi[ks]) : "v"(vb), "i"(d0 * 4096 + ks * 1024 + 512) : "memory"); }
    asm volatile("s_waitcnt lgkmcnt(0)" ::: "memory"); SBAR();
    #define PK(k) (bf16x8){lo[k][0], lo[k][1], lo[k][2], lo[k][3], hi[k][0], hi[k][1], hi[k][2], hi[k][3]}
    o[d0] = __builtin_amdgcn_mfma_f32_32x32x16_bf16(pa0, PK(0), o[d0], 0, 0, 0);
    o[d0] = __builtin_amdgcn_mfma_f32_32x32x16_bf16(pa1, PK(1), o[d0], 0, 0, 0);
    o[d0] = __builtin_amdgcn_mfma_f32_32x32x16_bf16(pa2, PK(2), o[d0], 0, 0, 0);
    o[d0] = __builtin_amdgcn_mfma_f32_32x32x16_bf16(pa3, PK(3), o[d0], 0, 0, 0);
    #undef PK
  }
}
__device__ __forceinline__ float wmax(float v) {
#pragma unroll
  for (int o = 1; o < 64; o <<= 1) v = fmaxf(v, __shfl_xor(v, o));
  return v;
}
__device__ __forceinline__ void attn_unit(int b, int h, int g, const bf16* Q, const bf16* __restrict__ K, const bf16* __restrict__ V, bf16* O,
                                          const float* __restrict__ relb, const float* __restrict__ gq, const float* __restrict__ gk, char* shm) {
  int tid_ = threadIdx.x; asm volatile("" : "+v"(tid_));
  const int tid = tid_, lane = tid & 63, r32 = lane & 31, hi = lane >> 5; const int wid = __builtin_amdgcn_readfirstlane(tid >> 6);
  const long rowbase = (long)b * SEQ; const int q0 = g * 256;
  const int kc_lo = (4 * g - 8) > 0 ? (4 * g - 8) : 0, NT = 4 * g + 4 - kc_lo;
  const bf16* Qw = Q + (rowbase + q0 + wid * 32) * DM + h * 64;
  const bf16* Kh = K + (rowbase + 64 * kc_lo) * DM + h * 64; const bf16* Vh = V + (rowbase + 64 * kc_lo) * DM + h * 64;
  const unsigned lds0 = (unsigned)(uintptr_t)shm;
  float* wsf = (float*)(shm + LDS_WS) + wid * 64;
  float* biasT = (float*)(shm + LDS_BIAS);
  const bf16* ksrc = Kh + (long)lane * DM + wid * 8;
  const bf16* vsrc = Vh + (long)(16 * (wid & 3) + (lane >> 2)) * DM + (wid >> 2) * 32 + (lane & 3) * 8;
  const unsigned kdst = lds0 + LDS_K + wid * 1024, vdst = lds0 + LDS_V + wid * 1024;
  #define DMA_K(t, slot) glds16(ksrc + (long)(t) * 64 * DM, (unsigned)__builtin_amdgcn_readfirstlane(kdst + (slot)))
  #define DMA_V(t, slot) glds16(vsrc + (long)(t) * 64 * DM, (unsigned)__builtin_amdgcn_readfirstlane(vdst + (slot)))
  const int vb0 = (int)(lds0 + LDS_V) + ((lane >> 4) & 1) * 32 + (lane & 3) * 8 + (4 * hi + ((lane & 15) >> 2)) * 64;
  const lds_cptr shm3 = (lds_cptr)shm; const lds_cptr kp0 = shm3 + LDS_K + hi * 1024 + r32 * 16;
  asm volatile("s_waitcnt vmcnt(0)" ::: "memory");
  const bool full = (g >= 2); const int nsteps = full ? 9 : NT;
  #define LOAD_TILE(i) (full ? ((i) < 6 ? (((i) & 1) ? ((i) >> 1) + 9 : ((i) >> 1)) : (i) - 3) : (i))
  #define ISSUE_LOAD(i) do { const int i_ = (i); const int tl_ = LOAD_TILE(i_); const int sb_ = (i_ % NSLOT) * SLOTB; DMA_K(tl_, sb_); DMA_V(tl_, sb_); } while (0)
  ISSUE_LOAD(0); ISSUE_LOAD(1); if (full) { ISSUE_LOAD(2); ISSUE_LOAD(3); }
  bf16x8 qr[4];
  #pragma unroll
  for (int d0 = 0; d0 < 4; ++d0) qr[d0] = *reinterpret_cast<const bf16x8*>(&Qw[(long)r32 * DM + d0 * 16 + hi * 8]);
  float m2;
  { const float mq = wmax(fabsf(gq[lane])), mk = wmax(fabsf(gk[lane])); float mb = -3.0e38f;
    for (int i = lane; i < NREL; i += 64) mb = fmaxf(mb, relb[h * NREL + i]);
    mb = wmax(mb); m2 = (8.0f * mq * mk + mb) * LOG2E; }
  for (int i = tid; i < 4 * 384; i += 512) { const int c = i / 384, j = i - c * 384, e = j + c; biasT[c * BIAS_CS + j] = (e < 384 ? relb[h * NREL + (e < 64 ? 512 : 576 - e)] : 0.f) * LOG2E - m2; }
  f32x16 o[2]; o[0] = f32x16{}; o[1] = f32x16{}; f32x16 lsum = f32x16{};
  const int qpos = 32 * (wid & 1) + r32;
  const int cch = 4 * g + (wid >> 1);
  asm volatile("s_waitcnt vmcnt(0) lgkmcnt(0)\n\ts_barrier" ::: "memory");
  for (int s = 0; s < nsteps; ++s) {
    int nis = 0;
    if (s + 2 < nsteps) { const int s2 = s + 2; if (full) { if (s2 < 3) { ISSUE_LOAD(2 * s2); ISSUE_LOAD(2 * s2 + 1); nis = 2; } else { ISSUE_LOAD(s2 + 3); nis = 1; } } else { ISSUE_LOAD(s2); nis = 1; } }
    int jrel = kc_lo + s - cch + 8, ld = full ? (s < 3 ? 2 * s : s + 3) : s;
    if (full && s < 3 && jrel < 0) { jrel += 9; ld += 1; }
    const int sl_cur = (ld % NSLOT) * SLOTB;
    if (jrel >= 0 && jrel <= 8) {
      s16x4 vlo[8], vhi[8]; { const int vb = vb0 + sl_cur;
        #pragma unroll
        for (int i_ = 0; i_ < 8; ++i_) {
          asm volatile("ds_read_b64_tr_b16 %0,%1 offset:%c2" : "=&v"(vlo[i_]) : "v"(vb), "i"((i_ >> 2) * 4096 + (i_ & 3) * 1024) : "memory");
          asm volatile("ds_read_b64_tr_b16 %0,%1 offset:%c2" : "=&v"(vhi[i_]) : "v"(vb), "i"((i_ >> 2) * 4096 + (i_ & 3) * 1024 + 512) : "memory"); } }
      f32x16 p0, p1;
      if (jrel <= 3) { const float c0 = biasT[0];
        #pragma unroll
        for (int r = 0; r < 16; ++r) { p0[r] = c0; p1[r] = c0; } }
      else { const int i0 = 64 + 4 * hi - qpos + 64 * (jrel - 4), cs = i0 & 3; const f32x4* a4 = (const f32x4*)(biasT + cs * BIAS_CS + (i0 - cs));
        #pragma unroll
        for (int q4 = 0; q4 < 4; ++q4) { const f32x4 b0 = a4[2 * q4], b1 = a4[2 * q4 + 8];
          #pragma unroll
          for (int e = 0; e < 4; ++e) { p0[4 * q4 + e] = b0[e]; p1[4 * q4 + e] = b1[e]; } } }
      bf16x8 kf[8]; kload8(kf, kp0 + sl_cur);
      #pragma unroll
      for (int d0 = 0; d0 < 4; ++d0) { p0 = __builtin_amdgcn_mfma_f32_32x32x16_bf16(kf[2 * d0], qr[d0], p0, 0, 0, 0); p1 = __builtin_amdgcn_mfma_f32_32x32x16_bf16(kf[2 * d0 + 1], qr[d0], p1, 0, 0, 0); }
      #pragma unroll
      for (int r = 0; r < 16; ++r) { p0[r] = __builtin_amdgcn_exp2f(p0[r]); p1[r] = __builtin_amdgcn_exp2f(p1[r]); }
      lsum += p0 + p1;
      u32x4 pw0, pw1, pw2, pw3;
      pw0 = (u32x4){cvtpk_s(p0[0], p0[1]), cvtpk_s(p0[2], p0[3]), cvtpk_s(p0[4], p0[5]), cvtpk_s(p0[6], p0[7])};
      pw1 = (u32x4){cvtpk_s(p0[8], p0[9]), cvtpk_s(p0[10], p0[11]), cvtpk_s(p0[12], p0[13]), cvtpk_s(p0[14], p0[15])};
      pw2 = (u32x4){cvtpk_s(p1[0], p1[1]), cvtpk_s(p1[2], p1[3]), cvtpk_s(p1[4], p1[5]), cvtpk_s(p1[6], p1[7])};
      pw3 = (u32x4){cvtpk_s(p1[8], p1[9]), cvtpk_s(p1[10], p1[11]), cvtpk_s(p1[12], p1[13]), cvtpk_s(p1[14], p1[15])};
      SBAR();
      asm volatile("s_waitcnt lgkmcnt(0)" ::: "memory"); SBAR();
      #define VF(i_) (bf16x8){vlo[i_][0], vlo[i_][1], vlo[i_][2], vlo[i_][3], vhi[i_][0], vhi[i_][1], vhi[i_][2], vhi[i_][3]}
      o[0] = __builtin_amdgcn_mfma_f32_32x32x16_bf16(__builtin_bit_cast(bf16x8, pw0), VF(0), o[0], 0, 0, 0); o[1] = __builtin_amdgcn_mfma_f32_32x32x16_bf16(__builtin_bit_cast(bf16x8, pw0), VF(4), o[1], 0, 0, 0);
      o[0] = __builtin_amdgcn_mfma_f32_32x32x16_bf16(__builtin_bit_cast(bf16x8, pw1), VF(1), o[0], 0, 0, 0); o[1] = __builtin_amdgcn_mfma_f32_32x32x16_bf16(__builtin_bit_cast(bf16x8, pw1), VF(5), o[1], 0, 0, 0);
      o[0] = __builtin_amdgcn_mfma_f32_32x32x16_bf16(__builtin_bit_cast(bf16x8, pw2), VF(2), o[0], 0, 0, 0); o[1] = __builtin_amdgcn_mfma_f32_32x32x16_bf16(__builtin_bit_cast(bf16x8, pw2), VF(6), o[1], 0, 0, 0);
      o[0] = __builtin_amdgcn_mfma_f32_32x32x16_bf16(__builtin_bit_cast(bf16x8, pw3), VF(3), o[0], 0, 0, 0); o[1] = __builtin_amdgcn_mfma_f32_32x32x16_bf16(__builtin_bit_cast(bf16x8, pw3), VF(7), o[1], 0, 0, 0);
      #undef VF
    }
    if (nis == 2)      asm volatile("s_waitcnt vmcnt(4) lgkmcnt(0)\n\ts_barrier" ::: "memory");
    else if (nis == 1) asm volatile("s_waitcnt vmcnt(2) lgkmcnt(0)\n\ts_barrier" ::: "memory");
    else               asm volatile("s_waitcnt vmcnt(0) lgkmcnt(0)\n\ts_barrier" ::: "memory");
  }
  #undef LOAD_TILE
  #undef ISSUE_LOAD
  float l_reg = 0.f;
  #pragma unroll
  for (int r = 0; r < 16; ++r) l_reg += lsum[r];
  { auto rr = __builtin_amdgcn_permlane32_swap(__float_as_uint(l_reg), __float_as_uint(l_reg), false, false); l_reg = __uint_as_float(rr[0]) + __uint_as_float(rr[1]); }
  if (hi == 0) wsf[32 + r32] = l_reg; asm volatile("s_waitcnt lgkmcnt(0)" ::: "memory");
  float rli[16];
  #pragma unroll
  for (int r = 0; r < 16; ++r) rli[r] = __builtin_amdgcn_rcpf(wsf[32 + crow(r, hi)]);
  bf16* Ow = O + (rowbase + q0 + wid * 32) * DM + h * 64;
  { bf16* stg = (bf16*)(shm + LDS_OST) + wid * 2048;
    #pragma unroll
    for (int r = 0; r < 16; ++r) { const int orow = crow(r, hi);
      #pragma unroll
      for (int d0 = 0; d0 < 2; ++d0) stg[orow * 64 + d0 * 32 + r32] = (bf16)(cvtpk_s(o[d0][r] * rli[r], 0.f) & 0xffffu); }
    asm volatile("s_waitcnt lgkmcnt(0)" ::: "memory");
    #pragma unroll
    for (int i = 0; i < 4; ++i) { const int row = i * 8 + (lane >> 3), ch = lane & 7; const u32x4 v = *(const u32x4*)(stg + row * 64 + ch * 8); pg8::st16(Ow + (long)row * DM + ch * 8, v); } }
  asm volatile("s_waitcnt lgkmcnt(0)\n\ts_barrier" ::: "memory");
  #undef DMA_K
  #undef DMA_V
}
#undef SBAR
}

#define GAS __attribute__((address_space(1)))
#define LAS __attribute__((address_space(3)))
typedef unsigned short bf16;
typedef unsigned v4u __attribute__((ext_vector_type(4)));
typedef float f32x4 __attribute__((ext_vector_type(4)));
typedef short bf16x8 __attribute__((ext_vector_type(8)));
typedef GAS unsigned gu32;
typedef GAS unsigned long long gu64;
#define RLX_AGENT __ATOMIC_RELAXED, __HIP_MEMORY_SCOPE_AGENT
#define LDS_WAIT() asm volatile("s_waitcnt lgkmcnt(0)" ::: "memory")
#define VM_WAIT() asm volatile("s_waitcnt vmcnt(0)" ::: "memory")
__device__ __forceinline__ unsigned long long rt() { return __builtin_amdgcn_s_memrealtime(); }
#define XB_TMO      128
#define XB_XCNT(j)  (256  + 64 * (j))
#define XB_XSUB(j)  (1280 + 64 * (j))
#define XB_XGEN(j)  (2304 + 64 * (j))
#define XB_TOP      3328
#define XB_TOPGEN   3392
#define XCD_BAR_WORDS 3456
#define XB_SPIN_CAP (1u << 18)

__device__ __forceinline__ unsigned xb_ld(unsigned* p)              { return __hip_atomic_load(p, __ATOMIC_RELAXED, __HIP_MEMORY_SCOPE_AGENT); }
__device__ __forceinline__ unsigned xb_add(unsigned* p, unsigned v) { return __hip_atomic_fetch_add(p, v, __ATOMIC_RELAXED, __HIP_MEMORY_SCOPE_AGENT); }
__device__ __forceinline__ unsigned xb_xcc_id() { return (unsigned)__builtin_amdgcn_s_getreg((3 << 11) | 20) & 0xFu; }
#define XB_SPIN(cond, bar) do { unsigned _sp = 0; while (cond) { __builtin_amdgcn_s_sleep(1); \
    if ((++_sp & 255u) == 0u) { if (xb_ld(&(bar)[XB_TMO])) break; if (_sp > XB_SPIN_CAP) { atomicAdd(&(bar)[XB_TMO], 1u); break; } } } } while (0)

struct XcdBarrier {
    unsigned* bar; unsigned x;
    volatile LAS unsigned* st;
};

__device__ __forceinline__ XcdBarrier xcd_barrier_post(unsigned* bar, volatile LAS unsigned* st) {
    XcdBarrier b; b.bar = bar; b.x = xb_xcc_id(); b.st = st;
    if (threadIdx.x == 0) (void)xb_add(&bar[XB_XCNT(b.x)], 1u);
    return b;
}
__device__ __forceinline__ void xcd_barrier_complete(unsigned* bar, unsigned x, unsigned& nloc, unsigned& nx) {
    const unsigned G = gridDim.x * gridDim.y * gridDim.z;
    unsigned sum, cnt, mine, sp = 0u;
    for (;;) {
        sum = 0u; cnt = 0u; mine = 0u;
#pragma unroll
        for (unsigned j = 0; j < 16; ++j) { const unsigned c = xb_ld(&bar[XB_XCNT(j)]); sum += c; cnt += (c > 0u) ? 1u : 0u; mine = (j == x) ? c : mine; }
        if (sum == G) break;
        __builtin_amdgcn_s_sleep(1);
        if ((++sp & 255u) == 0u) { if (xb_ld(&bar[XB_TMO])) break; if (sp > XB_SPIN_CAP) { atomicAdd(&bar[XB_TMO], 1u); break; } }
    }
    nloc = mine > 0u ? mine : 1u; nx = cnt > 0u ? cnt : 1u;
}

__device__ __forceinline__ void xcd_barrier(const XcdBarrier& b) {
    asm volatile("s_waitcnt vmcnt(0)" ::: "memory");
    __syncthreads();
    if (threadIdx.x == 0) {
        unsigned* bar = b.bar;
        __builtin_amdgcn_s_waitcnt(0);
        unsigned nloc = b.st[0], nx = b.st[1];
        if (nloc == 0u) { xcd_barrier_complete(bar, b.x, nloc, nx); b.st[0] = nloc; b.st[1] = nx; }
        __builtin_amdgcn_fence(__ATOMIC_RELEASE, "agent");
        asm volatile("s_waitcnt vmcnt(0)" ::: "memory");
        const unsigned old = xb_add(&bar[XB_XSUB(b.x)], 1u);
        const unsigned gen = old / nloc;
        if (old + 1u == (gen + 1u) * nloc) {
            __builtin_amdgcn_fence(__ATOMIC_RELEASE, "agent");
            asm volatile("s_waitcnt vmcnt(0)" ::: "memory");
            const unsigned og = xb_add(&bar[XB_TOP], 1u);
            const unsigned tg = og / nx;
            if (og + 1u == (tg + 1u) * nx) xb_add(&bar[XB_TOPGEN], 1u);
            else XB_SPIN(xb_ld(&bar[XB_TOPGEN]) == tg, bar);
            __builtin_amdgcn_fence(__ATOMIC_ACQUIRE, "agent");
            xb_add(&bar[XB_XGEN(b.x)], 1u);
            asm volatile("s_waitcnt vmcnt(0)" ::: "memory");
        } else {
            XB_SPIN(xb_ld(&bar[XB_XGEN(b.x)]) == gen, bar);
            __builtin_amdgcn_fence(__ATOMIC_ACQUIRE, "agent");
            asm volatile("s_waitcnt vmcnt(0)" ::: "memory");
        }
    }
    __syncthreads();
}
#include <hip/hip_cooperative_groups.h>
namespace cg = cooperative_groups;
constexpr int NWAVES = 8;
constexpr int BATCH = 4, SEQ = 4096, D = 1024, FF = 4096, M = BATCH * SEQ, NIN = 8192;
constexpr size_t MiB = 1u << 20;
constexpr size_t WS_SS = 1 * MiB;
constexpr size_t WS_W1 = 2 * MiB, WS_WC = 18 * MiB, WS_WA = 20 * MiB  , WS_WO = 22 * MiB, WS_WUP = 24 * MiB, WS_WDN = 32 * MiB;
constexpr size_t WS_V = 40 * MiB  , WS_H = 72 * MiB  , WS_Q = 104 * MiB, WS_K = 136 * MiB  , WS_BG = 168 * MiB  , WS_U1 = 200 * MiB;
constexpr size_t WS_UU = 72 * MiB;
constexpr size_t WS_END = 232 * MiB;
constexpr int LDS_BYTES = 147456;
constexpr int LDSCTL_OFF = 131072, MISC_OFF = LDSCTL_OFF + 320;
constexpr size_t WS_CTL = 0, CTL_ZERO_BYTES = 65536; constexpr int CW_BAR = 4096;
__device__ __forceinline__ unsigned f2bf(float f) { unsigned u = __builtin_bit_cast(unsigned, f); return (u + 0x7fffu + ((u >> 16) & 1u)) >> 16; }
__device__ __forceinline__ unsigned pk2(float lo, float hi) { return f2bf(lo) | (f2bf(hi) << 16); }
__device__ __forceinline__ float wave_sum(float v) {
#pragma unroll
    for (int o = 1; o < 64; o <<= 1) v += __shfl_xor(v, o);
    return v;
}
__device__ __forceinline__ void tr_item(const float* W, int ldw, int col0, int k0, bf16* WT, int Kd, int drow0, const float* kscale, LAS float* scr, int lane) {
    float tv[32];
#pragma unroll
    for (int i = 0; i < 32; ++i) { const int kk = 2 * i + (lane >> 5); tv[i] = W[(size_t)(k0 + kk) * ldw + col0 + (lane & 31)]; }
#pragma unroll
    for (int i = 0; i < 32; ++i) { const int kk = 2 * i + (lane >> 5); float v = tv[i]; if (kscale) v *= kscale[k0 + kk]; scr[kk * 33 + (lane & 31)] = v; }
    LDS_WAIT(); asm volatile("" ::: "memory");
    const int c = lane & 7;
#pragma unroll
    for (int j = 0; j < 4; ++j) { const int n = (lane >> 3) + 8 * j; const LAS float* s = scr + (8 * c) * 33 + n;
        v4u o; o.x = pk2(s[0 * 33], s[1 * 33]); o.y = pk2(s[2 * 33], s[3 * 33]); o.z = pk2(s[4 * 33], s[5 * 33]); o.w = pk2(s[6 * 33], s[7 * 33]);
        pg8::st16(WT + (size_t)(drow0 + n) * Kd + k0 + 8 * c, o); }
    LDS_WAIT(); asm volatile("" ::: "memory");
}

#ifndef PH_MASK
#define PH_MASK 127
#endif
#ifndef REP_P1
#define REP_P1 1
#endif
#ifndef REP_ATT
#define REP_ATT 1
#endif
#ifndef REP_P3
#define REP_P3 1
#endif
#ifndef REP_P4
#define REP_P4 1
#endif
#ifndef REP_P5
#define REP_P5 1
#endif
#ifndef EXTRA_SYNC
#define EXTRA_SYNC 0
#endif
__device__ unsigned g_panel_cnt[64 * 64];
__device__ unsigned g_bar_cnt = 0u, g_bar_gen = 0u, g_done_cnt = 0u;
struct Args { const float* in[16]; float* out; unsigned char* ws; };
__global__ void __launch_bounds__(NWAVES * 64, 2) fwd(Args a) {
    extern __shared__ __attribute__((aligned(16))) unsigned char lds[];
    cg::grid_group grid = cg::this_grid();
    LAS unsigned char* ldsp = (LAS unsigned char*)lds;
    const int tid = threadIdx.x, lane = tid & 63, wave = __builtin_amdgcn_readfirstlane(tid >> 6);
    const int G = gridDim.x, bx = blockIdx.x, vcu = (G % 8 == 0) ? (bx % 8) * (G / 8) + bx / 8 : bx;
    unsigned char* ws = a.ws;
    const float* x = a.in[0];
    bf16 *W1 = (bf16*)(ws + WS_W1), *WA = (bf16*)(ws + WS_WA), *WC = (bf16*)(ws + WS_WC), *WO = (bf16*)(ws + WS_WO), *WUP = (bf16*)(ws + WS_WUP), *WDN = (bf16*)(ws + WS_WDN);
    bf16 *Vb = (bf16*)(ws + WS_V), *X1B = (bf16*)(ws + WS_V), *Hb = (bf16*)(ws + WS_H), *YC = (bf16*)(ws + WS_H)  , *Qb = (bf16*)(ws + WS_Q), *AO = (bf16*)(ws + WS_Q)  , *Kb = (bf16*)(ws + WS_K), *MG = (bf16*)(ws + WS_K);
    bf16 *BG = (bf16*)(ws + WS_BG), *U1 = (bf16*)(ws + WS_U1), *UU = (bf16*)(ws + WS_UU), *Gt = (bf16*)a.out;
    float* SS = (float*)(ws + WS_SS);
    for (int u = tid; u < (LDS_BYTES - LDSCTL_OFF) / 4; u += NWAVES * 64) ((LAS unsigned*)(ldsp + LDSCTL_OFF))[u] = 0u;
    __syncthreads();
    if (a.out == nullptr) grid.sync();
#ifndef WB_AT_SEAMS
#define WB_AT_SEAMS 0
#endif
#if WB_AT_SEAMS || !WT_STORES
#define BAR_RELEASE() do { __builtin_amdgcn_fence(__ATOMIC_RELEASE, "agent"); asm volatile("s_waitcnt vmcnt(0)" ::: "memory"); } while (0)
#else
#define BAR_RELEASE() do { } while (0)
#endif
#if defined(MONO_BAR)
    const bool grouped = (G == 256);
    const unsigned NSEAMS = (grouped ? 4u : 6u) + EXTRA_SYNC;
    unsigned bar_epoch = 0u, bar_base = 0u;
#define GRID_BAR() do { asm volatile("s_waitcnt vmcnt(0)" ::: "memory"); __syncthreads(); \
    ++bar_epoch; \
    if (tid == 0) { \
        BAR_RELEASE(); \
        const unsigned old_ = xb_add(&g_bar_cnt, 1u); \
        if (bar_epoch == 1u) bar_base = old_ - old_ % (NSEAMS * (unsigned)G); \
        const unsigned tgt_ = bar_epoch * (unsigned)G; unsigned sp_ = 0u; \
        while (xb_ld(&g_bar_cnt) - bar_base < tgt_) { __builtin_amdgcn_s_sleep(1); if (++sp_ > (1u << 22)) break; } \
        __builtin_amdgcn_fence(__ATOMIC_ACQUIRE, "agent"); asm volatile("s_waitcnt vmcnt(0)" ::: "memory"); } \
    __syncthreads(); } while (0)
    unsigned grp_epoch = 0u, grp_base = 0u;
#define GROUP_BAR(pm_) do { asm volatile("s_waitcnt vmcnt(0)" ::: "memory"); __syncthreads(); \
    ++grp_epoch; \
    if (tid == 0) { unsigned* pc_ = &g_panel_cnt[64 * (pm_)]; \
        BAR_RELEASE(); \
        const unsigned old_ = xb_add(pc_, 1u); \
        if (grp_epoch == 1u) grp_base = old_ - old_ % 8u; \
        const unsigned tgt_ = grp_epoch * 4u; unsigned sp_ = 0u; \
        while (xb_ld(pc_) - grp_base < tgt_) { __builtin_amdgcn_s_sleep(1); if (++sp_ > (1u << 22)) break; } \
        __builtin_amdgcn_fence(__ATOMIC_ACQUIRE, "agent"); asm volatile("s_waitcnt vmcnt(0)" ::: "memory"); } \
    __syncthreads(); } while (0)
#elif defined(GEN_BAR)
#define GRID_BAR() do { asm volatile("s_waitcnt vmcnt(0)" ::: "memory"); __syncthreads(); \
    if (tid == 0) { \
        __builtin_amdgcn_fence(__ATOMIC_RELEASE, "agent"); asm volatile("s_waitcnt vmcnt(0)" ::: "memory"); \
        unsigned g0_ = xb_ld(&g_bar_gen); asm volatile("s_waitcnt vmcnt(0)" : "+v"(g0_) :: "memory");            \
        unsigned old_ = xb_add(&g_bar_cnt, 1u); asm volatile("s_waitcnt vmcnt(0)" : "+v"(old_) :: "memory"); \
        if (old_ == (unsigned)G - 1u) { __hip_atomic_store(&g_bar_cnt, 0u, RLX_AGENT); asm volatile("s_waitcnt vmcnt(0)" ::: "memory"); xb_add(&g_bar_gen, 1u); } \
        else { unsigned sp_ = 0u; while (xb_ld(&g_bar_gen) == g0_) { __builtin_amdgcn_s_sleep(1); if (++sp_ > (1u << 22)) break; } } \
        __builtin_amdgcn_fence(__ATOMIC_ACQUIRE, "agent"); asm volatile("s_waitcnt vmcnt(0)" ::: "memory"); } \
    __syncthreads(); } while (0)
#elif defined(CG_ALL)
#define GRID_BAR() do { asm volatile("s_waitcnt vmcnt(0)" ::: "memory"); grid.sync(); } while (0)
#elif defined(SIMPLE_BAR)
    unsigned bar_epoch = 0u;
#define GRID_BAR() do { asm volatile("s_waitcnt vmcnt(0)" ::: "memory"); __syncthreads(); \
    ++bar_epoch; \
    if (tid == 0) { unsigned* cnt_ = (unsigned*)(ws + WS_CTL) + CW_BAR + XB_TOP; \
        __builtin_amdgcn_fence(__ATOMIC_RELEASE, "agent"); asm volatile("s_waitcnt vmcnt(0)" ::: "memory"); \
        xb_add(cnt_, 1u); unsigned sp_ = 0u; \
        while (xb_ld(cnt_) < bar_epoch * (unsigned)G) { __builtin_amdgcn_s_sleep(1); if (++sp_ > (1u << 22)) break; } \
        __builtin_amdgcn_fence(__ATOMIC_ACQUIRE, "agent"); asm volatile("s_waitcnt vmcnt(0)" ::: "memory"); } \
    __syncthreads(); } while (0)
#else
#define GRID_BAR() xcd_barrier(bar)
#endif

#ifndef DUP_P0
#define DUP_P0 1
#endif
    for (int rep0 = 0; rep0 < DUP_P0; ++rep0) {
        LAS float* scr = (LAS float*)(ldsp + wave * 16384);
        const int gw = vcu * NWAVES + wave, NGW = G * NWAVES;
        constexpr int I_1 = 16 * 256, I_S = 16 * 32, I_UP = 16 * 128, I_DN = 64 * 32, NITEMS = I_1 + 3 * I_S + I_UP + I_DN;
        for (int it = gw; it < NITEMS; it += NGW) {
            int r = it;
            if (r < I_1) { const int db = r & 255, kb = r >> 8, pn = db >> 3, pb = db & 7, bj = pb >> 2, wcc = pb & 3; const float* W = a.in[2]; int ldw = 6144, col;
                if (pn < 4) col = (4 * pn + wcc) * 64 + 32 * bj;
                else if (pn < 8) col = 1024 + (4 * (pn - 4) + wcc) * 64 + 32 * bj;
                else if (pn < 12) col = 2048 + 256 * (pn - 8) + 32 * pb;
                else if (pn < 16) col = 3072 + 256 * (pn - 12) + 32 * pb;
                else if (pn < 24) col = (bj ? 5120 : 4096) + 128 * (pn - 16) + 32 * wcc;
                else { W = a.in[10]; ldw = 2048; col = 256 * (pn - 24) + 32 * pb; }
                tr_item(W, ldw, col, 64 * kb, W1, D, 32 * db, nullptr, scr, lane); continue; } r -= I_1;
            if (r < I_S) { tr_item(a.in[8], D, 32 * (r & 31), 64 * (r >> 5), WA, D, 32 * (r & 31), nullptr, scr, lane); continue; } r -= I_S;
            if (r < I_S) { tr_item(a.in[9], D, 32 * (r & 31), 64 * (r >> 5), WC, D, 32 * (r & 31), nullptr, scr, lane); continue; } r -= I_S;
            if (r < I_S) { tr_item(a.in[12], D, 32 * (r & 31), 64 * (r >> 5), WO, D, 32 * (r & 31), nullptr, scr, lane); continue; } r -= I_S;
            if (r < I_UP) { tr_item(a.in[14], FF, 32 * (r & 127), 64 * (r >> 7), WUP, D, 32 * (r & 127), a.in[13], scr, lane); continue; } r -= I_UP;
            tr_item(a.in[15], D, 32 * (r & 31), 64 * (r >> 5), WDN, FF, 32 * (r & 31), nullptr, scr, lane);
        }
        const float* g1 = a.in[1];
        f32x4 gv[4];
#pragma unroll
        for (int j = 0; j < 4; ++j) gv[j] = ((const f32x4*)g1)[lane + 64 * j];
        for (int m0 = gw; m0 < M; m0 += 2 * NGW) {
            const int m1 = m0 + NGW;
            const bool has1 = m1 < M;
            const f32x4* xr0 = (const f32x4*)(x + (size_t)m0 * D) + lane; const f32x4* xr1 = (const f32x4*)(x + (size_t)(has1 ? m1 : m0) * D) + lane;
            f32x4 v0[4], v1[4]; float s0 = 0.f, s1 = 0.f;
#pragma unroll
            for (int j = 0; j < 4; ++j) { v0[j] = xr0[64 * j]; v1[j] = xr1[64 * j]; }
#pragma unroll
            for (int j = 0; j < 4; ++j) { s0 += (v0[j].x * v0[j].x + v0[j].y * v0[j].y) + (v0[j].z * v0[j].z + v0[j].w * v0[j].w); s1 += (v1[j].x * v1[j].x + v1[j].y * v1[j].y) + (v1[j].z * v1[j].z + v1[j].w * v1[j].w); }
            const float rs0 = 1.0f / sqrtf(wave_sum(s0) * (1.0f / D) + 1e-6f), rs1 = 1.0f / sqrtf(wave_sum(s1) * (1.0f / D) + 1e-6f);
            unsigned long long* o80 = (unsigned long long*)(Hb + (size_t)m0 * D) + lane; unsigned long long* o81 = (unsigned long long*)(Hb + (size_t)m1 * D) + lane;
#pragma unroll
            for (int j = 0; j < 4; ++j) { const f32x4 y = v0[j] * rs0 * gv[j]; pg8::st8(o80 + 64 * j, (pg8::u32x2w){pk2(y.x, y.y), pk2(y.z, y.w)}); }
            if (has1) {
#pragma unroll
                for (int j = 0; j < 4; ++j) { const f32x4 y = v1[j] * rs1 * gv[j]; pg8::st8(o81 + 64 * j, (pg8::u32x2w){pk2(y.x, y.y), pk2(y.z, y.w)}); } }
        }
    }
    GRID_BAR();
#if !defined(SIMPLE_BAR) && !defined(CG_ALL) && !defined(GEN_BAR) && !defined(MONO_BAR)
    const XcdBarrier bar = xcd_barrier_post((unsigned*)(ws + WS_CTL) + CW_BAR, (volatile LAS unsigned*)(ldsp + MISC_OFF) + 8);
#endif

    if (PH_MASK & 2) {
        pg8::Gemm g{Hb, W1, M, NIN, D}; pg8::StaticOrder S; S.init(M, NIN, G, bx);
        pg8::EpiP1 E{Qb, Kb, Vb, BG, U1, Gt, a.in[3], a.in[4], a.in[11]};
        pg8::gemm_phase<pg8::EpiP1, pg8::StaticOrder, true, true>(ldsp, g, S, E);
#ifdef DUP_P1
        { pg8::Gemm g2{Hb, W1, M, NIN, D}; pg8::StaticOrder S2; S2.init(M, NIN, G, bx); pg8::gemm_phase<pg8::EpiP1, pg8::StaticOrder, true, true>(ldsp, g2, S2, E); }
#endif
    }
    GRID_BAR();

    if (PH_MASK & 4) {
        for (int L = vcu; L < 1024 * REP_ATT; L += G) { const int bh = (L & 255) >> 2, gq4 = (L & 3) + 4 * ((L >> 8) & 3);
            attn::attn_unit(bh >> 4, bh & 15, gq4, Qb, Kb, Vb, AO, a.in[5], a.in[3], a.in[4], (char*)lds); }
        const float* cw = a.in[6]; const float* cb = a.in[7];
        for (int item = vcu * 512 + tid; item < 131072; item += G * 512) {
            const int c8 = (item & 127) * 8, t0 = (item >> 7) * 16;
            float w0[8], w1[8], w2[8], b0[8], u1[8], u2[8];
#pragma unroll
            for (int e = 0; e < 8; ++e) { w0[e] = cw[c8 + e]; w1[e] = cw[1024 + c8 + e]; w2[e] = cw[2048 + c8 + e]; b0[e] = cb[c8 + e]; u1[e] = 0.f; u2[e] = 0.f; }
            if ((t0 & (SEQ - 1)) != 0) { f32x4 p, q; pg8::unpack8(*(const v4u*)(U1 + (size_t)(t0 - 2) * D + c8), p, q);
#pragma unroll
                for (int e = 0; e < 4; ++e) { u2[e] = p[e]; u2[4 + e] = q[e]; }
                pg8::unpack8(*(const v4u*)(U1 + (size_t)(t0 - 1) * D + c8), p, q);
#pragma unroll
                for (int e = 0; e < 4; ++e) { u1[e] = p[e]; u1[4 + e] = q[e]; } }
            v4u ur[16], br[16];
#pragma unroll
            for (int i = 0; i < 16; ++i) { const size_t off = (size_t)(t0 + i) * D + c8; ur[i] = *(const v4u*)(U1 + off); br[i] = *(const v4u*)(BG + off); }
#pragma unroll
            for (int i = 0; i < 16; ++i) { const size_t off = (size_t)(t0 + i) * D + c8; f32x4 p, q, bp, bq; float u0[8], bgv[8], y[8];
                pg8::unpack8(ur[i], p, q); pg8::unpack8(br[i], bp, bq);
#pragma unroll
                for (int e = 0; e < 4; ++e) { u0[e] = p[e]; u0[4 + e] = q[e]; bgv[e] = bp[e]; bgv[4 + e] = bq[e]; }
#pragma unroll
                for (int e = 0; e < 8; ++e) { y[e] = bgv[e] * (b0[e] + w0[e] * u2[e] + w1[e] * u1[e] + w2[e] * u0[e]); u2[e] = u1[e]; u1[e] = u0[e]; }
                v4u o; o.x = pk2(y[0], y[1]); o.y = pk2(y[2], y[3]); o.z = pk2(y[4], y[5]); o.w = pk2(y[6], y[7]); pg8::st16(YC + off, o); }
        }
    }
    GRID_BAR();

    if (PH_MASK & 8) {
        static_assert(WS_Q == WS_H + (size_t)M * D * 2 && WS_WA == WS_WC + (size_t)D * D * 2, "P3 reads the stacked [YC ; AO] and [Wc ; Wa]");
        pg8::PairOrder S; S.S.init(M, D, G, bx);
        pg8::Gemm g{YC, WC, 2 * M, 2 * D, D}; pg8::EpiGate2 E{Gt, MG};
        pg8::gemm_phase<pg8::EpiGate2, pg8::PairOrder, true, true>(ldsp, g, S, E);
    }
    { pg8::StaticOrder S; S.init(M, D, G, bx); pg8::Unit u0; S.next(0, u0); if (grouped) GROUP_BAR(u0.pm); else GRID_BAR(); }

    if (PH_MASK & 16) {
        pg8::Gemm g{MG, WO, M, D, D}; pg8::StaticOrder S; S.init(M, D, G, bx);
        pg8::EpiRes1 E{x, a.out, X1B, SS};
        pg8::gemm_phase<pg8::EpiRes1, pg8::StaticOrder, true, true>(ldsp, g, S, E);
#ifdef DUP_P4
        pg8::gemm_phase<pg8::EpiRes1, pg8::StaticOrder, true, true>(ldsp, g, S, E);
#endif
    }
    GRID_BAR();

    if (PH_MASK & 32) {
        pg8::Gemm g{X1B, WUP, M, FF, D}; pg8::StaticOrder S; S.init(M, FF, G, bx);
        pg8::EpiUp E{SS, UU};
        pg8::gemm_phase<pg8::EpiUp, pg8::StaticOrder, true, true>(ldsp, g, S, E);
#ifdef DUP_P5
        pg8::gemm_phase<pg8::EpiUp, pg8::StaticOrder, true, true>(ldsp, g, S, E);
#endif
    }
    { pg8::StaticOrder S; S.init(M, D, G, bx); pg8::Unit u0; S.next(0, u0); if (grouped) GROUP_BAR(u0.pm); else GRID_BAR(); }

    for (int i = 0; i < EXTRA_SYNC; ++i) GRID_BAR();
    if (PH_MASK & 64) {
        pg8::Gemm g{UU, WDN, M, D, FF}; pg8::StaticOrder S; S.init(M, D, G, bx);
        pg8::EpiRes2 E{a.out, X1B};
        pg8::gemm_phase<pg8::EpiRes2, pg8::StaticOrder, true, true>(ldsp, g, S, E);
    }
#if defined(MONO_BAR)
    if (wave == 0) { unsigned old_ = 0u; if (lane == 0) old_ = xb_add(&g_done_cnt, 1u);
        old_ = (unsigned)__builtin_amdgcn_readfirstlane((int)old_);
        if (old_ == (unsigned)G - 1u) { __hip_atomic_store(&g_panel_cnt[64 * lane], 0u, RLX_AGENT);
            if (lane == 0) { __hip_atomic_store(&g_bar_cnt, 0u, RLX_AGENT); __hip_atomic_store(&g_done_cnt, 0u, RLX_AGENT); } } }
#endif
}

extern "C" void kernel_launch(void* const* d_in, const int* in_sizes, int n_in, void* d_out, int out_size, void* d_ws, size_t ws_size, hipStream_t stream) {
    static int grid = 0;
    if (grid == 0) {
        if (n_in != 16 || out_size != M * D || ws_size < WS_END) { fprintf(stderr, "kernel_launch: unexpected shapes (n_in %d, out %d, ws %zu)\n", n_in, out_size, ws_size); grid = -1; return; }
        int dev = 0, cus = 0, per_cu = 0;
        (void)hipGetDevice(&dev); (void)hipDeviceGetAttribute(&cus, hipDeviceAttributeMultiprocessorCount, dev);
        if (hipFuncSetAttribute((const void*)fwd, hipFuncAttributeMaxDynamicSharedMemorySize, LDS_BYTES) != hipSuccess) { fprintf(stderr, "kernel_launch: hipFuncSetAttribute failed\n"); grid = -1; return; }
        if (hipOccupancyMaxActiveBlocksPerMultiprocessor(&per_cu, (const void*)fwd, NWAVES * 64, LDS_BYTES) != hipSuccess || per_cu < 1) { fprintf(stderr, "kernel_launch: occupancy query says %d\n", per_cu); per_cu = 1; }
        (void)hipGetLastError();
        grid = cus * 1;
    }
    if (grid < 0) return;
#if !defined(GEN_BAR) && !defined(MONO_BAR)
    if (hipMemsetAsync((char*)d_ws + WS_CTL, 0, CTL_ZERO_BYTES, stream) != hipSuccess) { fprintf(stderr, "kernel_launch: memset of the barrier words failed\n"); return; }
#endif
    Args a{};
    for (int i = 0; i < 16; ++i) a.in[i] = (const float*)d_in[i];
    a.out = (float*)d_out; a.ws = (unsigned char*)d_ws;
    void* args[] = {&a};
    hipError_t e = hipLaunchCooperativeKernel((const void*)fwd, dim3(grid), dim3(NWAVES * 64), args, LDS_BYTES, stream);
    if (e != hipSuccess) fprintf(stderr, "kernel_launch: cooperative launch failed: %s (grid %d)\n", hipGetErrorString(e), grid);
}
```

```cpp
#include <hip/hip_runtime.h>
#include <cstdio>
#include <cstdint>
#define MONO_BAR 1
namespace pg8 {
#define PG8_LAS __attribute__((address_space(3)))
typedef unsigned short bf16_t;
typedef short bf16x8 __attribute__((ext_vector_type(8)));
typedef float f32x4 __attribute__((ext_vector_type(4)));
typedef unsigned u32x4 __attribute__((ext_vector_type(4)));
constexpr int BM = 256, BK = 64, HALF = 128, HTB = HALF * BK * 2  , STAGE_BYTES = 8 * HTB, NXCD = 8, WGM = 8;

__host__ __device__ __forceinline__ int lds_byte(int r, int c) { const int st = (r >> 4) * 2 + (c >> 5), rr = r & 15, cc = c & 31, ob = rr * 64 + cc * 2; return st * 1024 + (ob ^ (((ob >> 9) & 1) << 5)); }
__host__ __device__ __forceinline__ void stage_rc(int b, int& R, int& C) { const int st = b / 1024, sb = b % 1024, swz = sb ^ (((sb >> 9) & 1) << 5); R = (st >> 1) * 16 + swz / 64; C = (st & 1) * 32 + (swz % 64) / 2; }
__host__ __device__ __forceinline__ int perm32(int rho) { const int n = rho >> 4, i = rho & 15; return 8 * (i >> 2) + 4 * n + (i & 3); }

struct Unit { int pm, pn; };
struct Gemm { const bf16_t* A; const bf16_t* Bt; int M, N, K; };

struct StaticOrder {
    int nM, nN, nwg, G, c;
    __host__ __device__ void init(int M, int N, int G_, int c_) { nM = M / BM; nN = N / BM; nwg = nM * nN; G = G_; c = c_; }
    __host__ __device__ bool next(int i, Unit& u) const {
        const long L = (long)i * G + c; if (L >= nwg) return false;
        int wgid = (int)L; { const int q = nwg / NXCD, r = nwg % NXCD, xcd = wgid % NXCD, off = wgid / NXCD; wgid = (xcd < r ? xcd * (q + 1) : r * (q + 1) + (xcd - r) * q) + off; }
        const int nig = WGM * nN, gid = wgid / nig, fm = gid * WGM, gsz = (nM - fm) < WGM ? (nM - fm) : WGM;
        u.pm = fm + ((wgid % nig) % gsz); u.pn = (wgid % nig) / gsz; return true;
    }
    __device__ __forceinline__ void a_ready(const Unit&) const {}
    __device__ __forceinline__ void done(const Unit&) const {}
};

__device__ __forceinline__ unsigned cvt_pk_bf16(float lo, float hi) { unsigned r; asm volatile("v_cvt_pk_bf16_f32 %0, %1, %2" : "=v"(r) : "v"(lo), "v"(hi)); return r; }
typedef float f32x2 __attribute__((ext_vector_type(2)));
#ifndef WT_STORES
#define WT_STORES 1
#endif
__device__ __forceinline__ void st16(void* p, u32x4 v) {
#if WT_STORES
    asm volatile("global_store_dwordx4 %0, %1, off sc1\n\ts_nop 1" :: "v"(p), "v"(v) : "memory");
#else
    *(u32x4*)p = v;
#endif
}
typedef unsigned u32x2w __attribute__((ext_vector_type(2)));
__device__ __forceinline__ void st8(void* p, u32x2w v) {
#if WT_STORES
    asm volatile("global_store_dwordx2 %0, %1, off sc1\n\ts_nop 1" :: "v"(p), "v"(v) : "memory");
#else
    *(u32x2w*)p = v;
#endif
}
typedef unsigned u32x2 __attribute__((ext_vector_type(2)));
__device__ __forceinline__ float bf_lo(unsigned w) { return __uint_as_float(w << 16); }
__device__ __forceinline__ float bf_hi(unsigned w) { return __uint_as_float(w & 0xffff0000u); }
__device__ __forceinline__ u32x4 pack8(f32x4 a, f32x4 b) { u32x4 w; w.x = cvt_pk_bf16(a[0], a[1]); w.y = cvt_pk_bf16(a[2], a[3]); w.z = cvt_pk_bf16(b[0], b[1]); w.w = cvt_pk_bf16(b[2], b[3]); return w; }
__device__ __forceinline__ void unpack8(u32x4 w, f32x4& a, f32x4& b) { a = (f32x4){bf_lo(w.x), bf_hi(w.x), bf_lo(w.y), bf_hi(w.y)}; b = (f32x4){bf_lo(w.z), bf_hi(w.z), bf_lo(w.w), bf_hi(w.w)}; }
constexpr float QK_C2 = 0.125f * 1.4426950408889634f;
constexpr float RMS_EPS = 1e-6f;

struct EpiP1 {
    static constexpr bool PERM = true, AFTER_DRAIN = false;
    bf16_t *Q, *Kb, *V, *BG, *U1, *G; const float *gq, *gk, *bgate;
    __device__ __forceinline__ void operator()(const f32x4 (&acc)[2][2][4][2], const Unit& u, int wr, int wc, int fr, int fq) const {
        const int pn = u.pn; const int row0 = u.pm * BM + wr * 64 + fr;
        if (pn < 8) {
            const bool isq = pn < 4; const float* g = isq ? gq : gk; bf16_t* O = isq ? Q : Kb; const float sc = isq ? QK_C2 : 1.f;
            const int head = 4 * (pn & 3) + wc;
            f32x4 gv[2][2];
#pragma unroll
            for (int bj = 0; bj < 2; ++bj)
#pragma unroll
                for (int n = 0; n < 2; ++n) gv[bj][n] = *(const f32x4*)(g + 32 * bj + 8 * fq + 4 * n) * sc;
#pragma unroll
            for (int ai = 0; ai < 2; ++ai)
#pragma unroll
                for (int m = 0; m < 4; ++m) {
                    float s = 0.f;
#pragma unroll
                    for (int bj = 0; bj < 2; ++bj)
#pragma unroll
                        for (int n = 0; n < 2; ++n) { const f32x4 x = acc[ai][bj][m][n]; s += (x[0] * x[0] + x[1] * x[1]) + (x[2] * x[2] + x[3] * x[3]); }
                    s += __shfl_xor(s, 16); s += __shfl_xor(s, 32);
                    const float rs = 1.0f / sqrtf(s * (1.0f / 64.0f) + RMS_EPS);
                    bf16_t* rowp = O + (size_t)(row0 + ai * HALF + m * 16) * 1024 + head * 64 + 8 * fq;
#pragma unroll
                    for (int bj = 0; bj < 2; ++bj) st16(rowp + 32 * bj, pack8(acc[ai][bj][m][0] * rs * gv[bj][0], acc[ai][bj][m][1] * rs * gv[bj][1]));
                }
        } else if (pn < 16) {
            bf16_t* O = (pn < 12) ? V : BG; const int col0 = 256 * (pn & 3) + wc * 32 + 8 * fq;
#pragma unroll
            for (int ai = 0; ai < 2; ++ai)
#pragma unroll
                for (int m = 0; m < 4; ++m) { bf16_t* rowp = O + (size_t)(row0 + ai * HALF + m * 16) * 1024 + col0;
#pragma unroll
                    for (int bj = 0; bj < 2; ++bj) st16(rowp + bj * HALF, pack8(acc[ai][bj][m][0], acc[ai][bj][m][1])); }
        } else if (pn < 24) {
            const int col0 = 128 * (pn - 16) + wc * 32 + 8 * fq;
#pragma unroll
            for (int ai = 0; ai < 2; ++ai)
#pragma unroll
                for (int m = 0; m < 4; ++m)
                    st16(U1 + (size_t)(row0 + ai * HALF + m * 16) * 1024 + col0, pack8(acc[ai][0][m][0] * acc[ai][1][m][0], acc[ai][0][m][1] * acc[ai][1][m][1]));
        } else {
            const int col0 = 256 * (pn - 24) + wc * 32 + 8 * fq;
            f32x4 bv[2][2];
#pragma unroll
            for (int bj = 0; bj < 2; ++bj)
#pragma unroll
                for (int n = 0; n < 2; ++n) bv[bj][n] = *(const f32x4*)(bgate + col0 + bj * HALF + 4 * n);
#pragma unroll
            for (int ai = 0; ai < 2; ++ai)
#pragma unroll
                for (int m = 0; m < 4; ++m) { bf16_t* rowp = G + (size_t)(row0 + ai * HALF + m * 16) * 2048 + col0;
#pragma unroll
                    for (int bj = 0; bj < 2; ++bj) { f32x4 v[2];
#pragma unroll
                        for (int n = 0; n < 2; ++n) { const f32x4 z = (acc[ai][bj][m][n] + bv[bj][n]) * (-1.4426950408889634f);
#pragma unroll
                            for (int e = 0; e < 4; ++e) v[n][e] = __builtin_amdgcn_rcpf(1.0f + __builtin_amdgcn_exp2f(z[e])); }
                        st16(rowp + bj * HALF, pack8(v[0], v[1])); } }
        }
    }
};
template <bool ADD> struct EpiGate {
    static constexpr bool PERM = true, AFTER_DRAIN = false;
    const bf16_t* G; bf16_t* MG; int goff;
    __device__ __forceinline__ void operator()(const f32x4 (&acc)[2][2][4][2], const Unit& u, int wr, int wc, int fr, int fq) const {
        const int row0 = u.pm * BM + wr * 64 + fr, col0 = u.pn * BM + wc * 32 + 8 * fq;
#pragma unroll
        for (int ai = 0; ai < 2; ++ai)
#pragma unroll
            for (int m = 0; m < 4; ++m) { const size_t r = (size_t)(row0 + ai * HALF + m * 16);
#pragma unroll
                for (int bj = 0; bj < 2; ++bj) { f32x4 g0, g1; unpack8(*(const u32x4*)(G + r * 2048 + goff + col0 + bj * HALF), g0, g1);
                    f32x4 v0 = acc[ai][bj][m][0] * g0, v1 = acc[ai][bj][m][1] * g1;
                    bf16_t* p = MG + r * 1024 + col0 + bj * HALF;
                    if (ADD) { f32x4 a0, a1; unpack8(*(const u32x4*)p, a0, a1); v0 += a0; v1 += a1; }
                    *(u32x4*)p = pack8(v0, v1); } }
    }
};
struct PairOrder {
    StaticOrder S;
    __device__ bool next(int i, Unit& u) const { Unit b; if (!S.next(i >> 1, b)) return false; u.pm = b.pm + ((i & 1) ? 64 : 0); u.pn = b.pn + ((i & 1) ? 4 : 0); return true; }
    __device__ __forceinline__ void a_ready(const Unit&) const {}
    __device__ __forceinline__ void done(const Unit&) const {}
};
struct EpiGate2 {
    static constexpr bool PERM = true, AFTER_DRAIN = false;
    const bf16_t* G; bf16_t* MG;
    __device__ __forceinline__ void operator()(const f32x4 (&acc)[2][2][4][2], const Unit& u, int wr, int wc, int fr, int fq) const {
        const bool second = u.pm >= 64; const int pm = second ? u.pm - 64 : u.pm, pn = second ? u.pn - 4 : u.pn, goff = second ? 0 : 1024;
        const int row0 = pm * BM + wr * 64 + fr, col0 = pn * BM + wc * 32 + 8 * fq;
#pragma unroll
        for (int ai = 0; ai < 2; ++ai) {
            u32x4 gl[4][2], ml[4][2];
#pragma unroll
            for (int m = 0; m < 4; ++m) { const size_t r = (size_t)(row0 + ai * HALF + m * 16);
#pragma unroll
                for (int bj = 0; bj < 2; ++bj) { gl[m][bj] = *(const u32x4*)(G + r * 2048 + goff + col0 + bj * HALF); if (second) ml[m][bj] = *(const u32x4*)(MG + r * 1024 + col0 + bj * HALF); } }
#pragma unroll
            for (int m = 0; m < 4; ++m) { const size_t r = (size_t)(row0 + ai * HALF + m * 16);
#pragma unroll
                for (int bj = 0; bj < 2; ++bj) { f32x4 g0, g1; unpack8(gl[m][bj], g0, g1);
                    f32x4 v0 = acc[ai][bj][m][0] * g0, v1 = acc[ai][bj][m][1] * g1;
                    bf16_t* p = MG + r * 1024 + col0 + bj * HALF;
                    if (second) { f32x4 a0, a1; unpack8(ml[m][bj], a0, a1); v0 += a0; v1 += a1; } st16(p, pack8(v0, v1)); } }
        }
    }
};
#ifndef STORE_X1_F32
#define STORE_X1_F32 0
#endif
struct EpiRes1 {
    static constexpr bool PERM = false, AFTER_DRAIN = false;
    const float* x; float* out; bf16_t* x1b; float* SS;
    __device__ __forceinline__ void operator()(const f32x4 (&acc)[2][2][4][2], const Unit& u, int wr, int wc, int fr, int fq) const {
        const int row0 = u.pm * BM + wr * 64 + fr, col0 = u.pn * BM + wc * 32 + 4 * fq;
#pragma unroll
        for (int ai = 0; ai < 2; ++ai) {
            f32x4 xv[4][2][2];
#pragma unroll
            for (int m = 0; m < 4; ++m) { const size_t off = (size_t)(row0 + ai * HALF + m * 16) * 1024 + col0;
#pragma unroll
                for (int bj = 0; bj < 2; ++bj)
#pragma unroll
                    for (int n = 0; n < 2; ++n) xv[m][bj][n] = *(const f32x4*)(x + off + bj * HALF + n * 16); }
#pragma unroll
            for (int m = 0; m < 4; ++m) { const size_t r = (size_t)(row0 + ai * HALF + m * 16); const size_t off = r * 1024 + col0; float s = 0.f;
#pragma unroll
                for (int bj = 0; bj < 2; ++bj)
#pragma unroll
                    for (int n = 0; n < 2; ++n) { const f32x4 v = xv[m][bj][n] + acc[ai][bj][m][n];
                        if (STORE_X1_F32) *(f32x4*)(out + off + bj * HALF + n * 16) = v; s += (v[0] * v[0] + v[1] * v[1]) + (v[2] * v[2] + v[3] * v[3]);
                        u32x2 w; w.x = cvt_pk_bf16(v[0], v[1]); w.y = cvt_pk_bf16(v[2], v[3]); st8(x1b + off + bj * HALF + n * 16, w); }
                s += __shfl_xor(s, 16); s += __shfl_xor(s, 32);
                if (fq == 0) __hip_atomic_store(SS + r * 16 + 4 * u.pn + wc, s, __ATOMIC_RELAXED, __HIP_MEMORY_SCOPE_AGENT); }
            asm volatile("" ::: "memory");
        }
    }
};
struct EpiUp {
    static constexpr bool PERM = true, AFTER_DRAIN = false;
    const float* SS; bf16_t* UU;
    __device__ __forceinline__ void operator()(const f32x4 (&acc)[2][2][4][2], const Unit& u, int wr, int wc, int fr, int fq) const {
        const int row0 = u.pm * BM + wr * 64 + fr, col0 = u.pn * BM + wc * 32 + 8 * fq;
#pragma unroll
        for (int ai = 0; ai < 2; ++ai)
#pragma unroll
            for (int m = 0; m < 4; ++m) { const size_t r = (size_t)(row0 + ai * HALF + m * 16);
                const f32x4* sp = (const f32x4*)(SS + r * 16); const f32x4 s4 = (sp[0] + sp[1]) + (sp[2] + sp[3]);
                const float rs = 1.0f / sqrtf(((s4[0] + s4[1]) + (s4[2] + s4[3])) * (1.0f / 1024.0f) + RMS_EPS);
#pragma unroll
                for (int bj = 0; bj < 2; ++bj) { f32x4 v[2];
#pragma unroll
                    for (int n = 0; n < 2; ++n) { const f32x4 z = acc[ai][bj][m][n] * rs;
#pragma unroll
                        for (int e = 0; e < 4; ++e) { const float t = fmaxf(z[e], 0.f); v[n][e] = t * t; } }
                    st16(UU + r * 4096 + col0 + bj * HALF, pack8(v[0], v[1])); } }
    }
};
struct EpiRes2 {
    static constexpr bool PERM = false, AFTER_DRAIN = false;
    float* out; const bf16_t* x1b;
    __device__ __forceinline__ void operator()(const f32x4 (&acc)[2][2][4][2], const Unit& u, int wr, int wc, int fr, int fq) const {
        const int row0 = u.pm * BM + wr * 64 + fr, col0 = u.pn * BM + wc * 32 + 4 * fq;
#pragma unroll
        for (int ai = 0; ai < 2; ++ai)
#pragma unroll
            for (int m = 0; m < 4; ++m) { const size_t off = (size_t)(row0 + ai * HALF + m * 16) * 1024 + col0;
#pragma unroll
                for (int bj = 0; bj < 2; ++bj)
#pragma unroll
                    for (int n = 0; n < 2; ++n) { float* p = out + off + bj * HALF + n * 16;
#if STORE_X1_F32
                        const f32x4 b = *(const f32x4*)p;
#else
                        const u32x2 w = *(const u32x2*)(x1b + off + bj * HALF + n * 16); const f32x4 b = {bf_lo(w.x), bf_hi(w.x), bf_lo(w.y), bf_hi(w.y)};
#endif
                        *(f32x4*)p = b + acc[ai][bj][m][n]; }
                if (m == 3) asm volatile("" ::: "memory"); }
    }
};

template <class Epi, class Sched, bool ALIGN_EPI = false, bool SP2 = false>
__device__ __forceinline__ void gemm_phase(PG8_LAS unsigned char* lds, const Gemm g, const Sched& S, const Epi& E) {
    int tid_ = threadIdx.x; asm volatile("" : "+v"(tid_));
    const int tid = tid_, wid = __builtin_amdgcn_readfirstlane(tid >> 6), lane = tid & 63, wr = wid >> 2, wc = wid & 3, fr = lane & 15, fq = lane >> 4;
    const int K = g.K, nt = K / BK;
    unsigned voffA[2], voffB[2];
#pragma unroll
    for (int i = 0; i < 2; ++i) { int R, C; stage_rc(tid * 16 + i * 8192, R, C); const int Rb = Epi::PERM ? ((R & ~31) + perm32(R & 31)) : R;
        voffA[i] = (unsigned)(R * K + C) * 2u; voffB[i] = (unsigned)(Rb * K + C) * 2u; }
    const size_t kstep = (size_t)(BK * 2);
    const size_t hstep = (size_t)HALF * K * 2;
    const size_t tstep = 2 * hstep;
    const unsigned ldsw = (unsigned)wid * 1024u;
    const int aoff = lds_byte(wr * 64 + fr, fq * 8), boff = lds_byte(wc * 32 + fr, fq * 8);
#define PG8_SA(b, h) (((b) * 2 + (h)) * HTB)
#define PG8_SB(b, h) ((4 + (b) * 2 + (h)) * HTB)
#define PG8_STAGE(bufoff, gbase, voff) do { _Pragma("unroll") for (int _i = 0; _i < 2; ++_i) \
        __builtin_amdgcn_global_load_lds((const unsigned*)((const char*)(gbase) + (voff)[_i]), (PG8_LAS unsigned*)(lds + (bufoff) + ldsw + _i * 8192), 16, 0, 0); } while (0)
#define PG8_LDA(dst, b, h) do { _Pragma("unroll") for (int m = 0; m < 4; ++m) _Pragma("unroll") for (int k = 0; k < 2; ++k) dst[m][k] = *(const PG8_LAS bf16x8*)(lds + PG8_SA(b, h) + aoff + m * 2048 + k * 1024); } while (0)
#define PG8_LDB(dst, b, h) do { _Pragma("unroll") for (int n = 0; n < 2; ++n) _Pragma("unroll") for (int k = 0; k < 2; ++k) dst[n][k] = *(const PG8_LAS bf16x8*)(lds + PG8_SB(b, h) + boff + n * 2048 + k * 1024); } while (0)
#define PG8_MMA(ai, bj, At, Bt) do { __builtin_amdgcn_s_setprio(1); _Pragma("unroll") for (int m = 0; m < 4; ++m) _Pragma("unroll") for (int n = 0; n < 2; ++n) _Pragma("unroll") for (int k = 0; k < 2; ++k) \
        acc[ai][bj][m][n] = __builtin_amdgcn_mfma_f32_16x16x32_bf16(Bt[n][k], At[m][k], acc[ai][bj][m][n], 0, 0, 0); __builtin_amdgcn_s_setprio(0); } while (0)
#define PG8_WAIT_V(n) asm volatile("s_waitcnt vmcnt(" #n ")" ::: "memory")
#define PG8_WAIT_L(n) asm volatile("s_waitcnt lgkmcnt(" #n ")" ::: "memory")
#define PG8_BAR __builtin_amdgcn_s_barrier()
#define PG8_SCHED __builtin_amdgcn_sched_barrier(0)
    Unit cur, nxt; int ui = 0;
    if (!S.next(0, cur)) return;
    f32x4 acc[2][2][4][2];
#pragma unroll
    for (int a = 0; a < 2; ++a)
#pragma unroll
        for (int b = 0; b < 2; ++b)
#pragma unroll
            for (int m = 0; m < 4; ++m)
#pragma unroll
                for (int n = 0; n < 2; ++n) acc[a][b][m][n] = (f32x4){0.f, 0.f, 0.f, 0.f};
    bf16x8 At[4][2], B0[2][2], B1[2][2];
    const char* cA = (const char*)g.A + (size_t)cur.pm * tstep; const char* cB = (const char*)g.Bt + (size_t)cur.pn * tstep;
    S.a_ready(cur);
    if constexpr (SP2) {
        PG8_STAGE(PG8_SB(0, 0), cB, voffB); PG8_STAGE(PG8_SB(0, 1), cB + hstep, voffB); PG8_STAGE(PG8_SA(0, 0), cA, voffA); PG8_STAGE(PG8_SA(0, 1), cA + hstep, voffA);
        if (wr == 1) PG8_BAR;
        PG8_WAIT_V(2); PG8_BAR;
        PG8_STAGE(PG8_SB(1, 0), cB + kstep, voffB); PG8_STAGE(PG8_SA(1, 0), cA + kstep, voffA); PG8_STAGE(PG8_SB(1, 1), cB + hstep + kstep, voffB);
        PG8_WAIT_V(6); PG8_BAR;
    } else {
        PG8_STAGE(PG8_SB(0, 0), cB, voffB); PG8_STAGE(PG8_SA(0, 0), cA, voffA); PG8_STAGE(PG8_SB(0, 1), cB + hstep, voffB); PG8_STAGE(PG8_SA(0, 1), cA + hstep, voffA);
        if (wr == 1) PG8_BAR;
        PG8_WAIT_V(4); PG8_BAR;
        PG8_STAGE(PG8_SB(1, 0), cB + kstep, voffB); PG8_STAGE(PG8_SA(1, 0), cA + kstep, voffA); PG8_STAGE(PG8_SB(1, 1), cB + hstep + kstep, voffB);
        PG8_WAIT_V(6); PG8_BAR;
    }
    for (;;) {
        const bool has_next = S.next(ui + 1, nxt);
        const char* nA = has_next ? (const char*)g.A + (size_t)nxt.pm * tstep : cA; const char* nB = has_next ? (const char*)g.Bt + (size_t)nxt.pn * tstep : cB;
        for (int t = 0; t < nt; t += 2) {
            const bool last = (t == nt - 2);
            const char* a1 = cA + (size_t)(t + 1) * kstep;
            const char* a2 = last ? nA : cA + (size_t)(t + 2) * kstep; const char* b2 = last ? nB : cB + (size_t)(t + 2) * kstep;
            const char* a3 = a2 + kstep; const char* b3 = b2 + kstep;
            if (last && has_next) S.a_ready(nxt);
            if constexpr (SP2) {
            PG8_LDB(B0, 0, 0); PG8_LDB(B1, 0, 1); PG8_SCHED; PG8_LDA(At, 0, 0); PG8_STAGE(PG8_SA(1, 1), a1 + hstep, voffA);
            PG8_WAIT_V(8); PG8_WAIT_L(0); PG8_BAR; PG8_MMA(0, 0, At, B0); PG8_MMA(0, 1, At, B1); PG8_BAR; PG8_SCHED;
            PG8_LDA(At, 0, 1); PG8_STAGE(PG8_SB(0, 0), b2, voffB); PG8_STAGE(PG8_SB(0, 1), b2 + hstep, voffB); PG8_STAGE(PG8_SA(0, 0), a2, voffA);
            PG8_WAIT_V(8); PG8_WAIT_L(0); PG8_BAR; PG8_MMA(1, 0, At, B0); PG8_MMA(1, 1, At, B1); PG8_BAR; PG8_SCHED;
            PG8_LDB(B0, 1, 0); PG8_LDB(B1, 1, 1); PG8_SCHED; PG8_LDA(At, 1, 0); PG8_STAGE(PG8_SA(0, 1), a2 + hstep, voffA);
            PG8_WAIT_V(8); PG8_WAIT_L(0); PG8_BAR; PG8_MMA(0, 0, At, B0); PG8_MMA(0, 1, At, B1); PG8_BAR; PG8_SCHED;
            PG8_LDA(At, 1, 1); PG8_STAGE(PG8_SB(1, 0), b3, voffB); PG8_STAGE(PG8_SB(1, 1), b3 + hstep, voffB); PG8_STAGE(PG8_SA(1, 0), a3, voffA);
            PG8_WAIT_V(8); PG8_WAIT_L(0); PG8_BAR; PG8_MMA(1, 0, At, B0); PG8_MMA(1, 1, At, B1); PG8_BAR; PG8_SCHED;
            } else {
            PG8_LDB(B0, 0, 0); PG8_SCHED; PG8_LDA(At, 0, 0); PG8_STAGE(PG8_SA(1, 1), a1 + hstep, voffA);
            PG8_WAIT_L(8); PG8_BAR; PG8_WAIT_L(0); PG8_MMA(0, 0, At, B0); PG8_BAR; PG8_SCHED;
            PG8_LDB(B1, 0, 1); PG8_STAGE(PG8_SB(0, 0), b2, voffB);
            PG8_BAR; PG8_WAIT_L(0); PG8_MMA(0, 1, At, B1); PG8_BAR;
            PG8_LDA(At, 0, 1); PG8_STAGE(PG8_SA(0, 0), a2, voffA);
            PG8_BAR; PG8_WAIT_L(0); PG8_MMA(1, 0, At, B0); PG8_BAR; PG8_SCHED;
            PG8_STAGE(PG8_SB(0, 1), b2 + hstep, voffB);
            PG8_WAIT_V(6); PG8_BAR; PG8_MMA(1, 1, At, B1); PG8_BAR;
            PG8_LDB(B0, 1, 0); PG8_SCHED; PG8_LDA(At, 1, 0); PG8_STAGE(PG8_SA(0, 1), a2 + hstep, voffA);
            PG8_WAIT_L(8); PG8_BAR; PG8_WAIT_L(0); PG8_MMA(0, 0, At, B0); PG8_BAR; PG8_SCHED;
            PG8_LDB(B1, 1, 1); PG8_STAGE(PG8_SB(1, 0), b3, voffB);
            PG8_BAR; PG8_WAIT_L(0); PG8_MMA(0, 1, At, B1); PG8_BAR;
            PG8_LDA(At, 1, 1); PG8_STAGE(PG8_SA(1, 0), a3, voffA);
            PG8_BAR; PG8_WAIT_L(0); PG8_MMA(1, 0, At, B0); PG8_BAR; PG8_SCHED;
            PG8_STAGE(PG8_SB(1, 1), b3 + hstep, voffB);
            PG8_WAIT_V(6); PG8_BAR; PG8_MMA(1, 1, At, B1); PG8_BAR;
            }
        }
        if constexpr (ALIGN_EPI) { if (wr == 0) PG8_BAR; }
        if constexpr (!Epi::AFTER_DRAIN) { E(acc, cur, wr, wc, fr, fq); S.done(cur); }
        if (!has_next) break;
#pragma unroll
        for (int a = 0; a < 2; ++a)
#pragma unroll
            for (int b = 0; b < 2; ++b)
#pragma unroll
                for (int m = 0; m < 4; ++m)
#pragma unroll
                    for (int n = 0; n < 2; ++n) acc[a][b][m][n] = (f32x4){0.f, 0.f, 0.f, 0.f};
        cur = nxt; cA = nA; cB = nB; ++ui;
        if constexpr (ALIGN_EPI) { if (wr == 1) PG8_BAR; }
    }
    PG8_WAIT_V(0);
    if constexpr (!ALIGN_EPI) { if (wr == 0) PG8_BAR; }
    PG8_BAR;
    if constexpr (Epi::AFTER_DRAIN) { E.fused(acc, cur, wr, wc, fr, fq, lds, wid, lane); S.done(cur); }
#undef PG8_SA
#undef PG8_SB
#undef PG8_STAGE
#undef PG8_LDA
#undef PG8_LDB
#undef PG8_MMA
#undef PG8_WAIT_V
#undef PG8_WAIT_L
#undef PG8_BAR
#undef PG8_SCHED
}
}

namespace attn {
using bf16 = unsigned short;
using bf16x8 = __attribute__((ext_vector_type(8))) short;
using s16x4 = __attribute__((ext_vector_type(4))) short;
using f32x16 = __attribute__((ext_vector_type(16))) float;
using u32x4 = __attribute__((ext_vector_type(4))) unsigned;
using f32x4 = __attribute__((ext_vector_type(4))) float;
constexpr int SEQ = 4096, DM = 1024, NSLOT = 6, SLOTB = 8192, NREL = 513;
constexpr int LDS_K = 0, LDS_V = NSLOT * SLOTB, LDS_WS = 2 * NSLOT * SLOTB, LDS_OST = LDS_WS + 8 * 64 * 4, LDS_BIAS = LDS_OST + 8 * 4096, BIAS_CS = 400  , LDS_BYTES = LDS_BIAS + 4 * BIAS_CS * 4;
constexpr float LOG2E = 1.4426950408889634f;
__device__ __forceinline__ int crow(int r, int hi) { return (r & 3) + 8 * (r >> 2) + 4 * hi; }
#define SBAR() __builtin_amdgcn_sched_barrier(0)
__device__ __forceinline__ void glds16(const void* gsrc, unsigned lds_dst) { unsigned keep;
  asm volatile("s_mov_b32 %0, m0\n\ts_mov_b32 m0, %2\n\ts_nop 0\n\tglobal_load_lds_dwordx4 %1, off\n\ts_mov_b32 m0, %0" : "=&s"(keep) : "v"(gsrc), "s"(lds_dst) : "memory"); }
typedef float f32x2_t __attribute__((ext_vector_type(2))); typedef __bf16 bf16x2_t __attribute__((ext_vector_type(2)));
__device__ __forceinline__ unsigned cvtpk_s(float lo, float hi) { f32x2_t v = {lo, hi}; bf16x2_t b = __builtin_convertvector(v, bf16x2_t); return __builtin_bit_cast(unsigned, b); }
typedef __attribute__((address_space(3))) const char* lds_cptr;
__device__ __forceinline__ void kload8(bf16x8* kf, lds_cptr kp) {
  kf[0] = *(const __attribute__((address_space(3))) bf16x8*)(kp);        kf[1] = *(const __attribute__((address_space(3))) bf16x8*)(kp + 512);
  kf[2] = *(const __attribute__((address_space(3))) bf16x8*)(kp + 2048); kf[3] = *(const __attribute__((address_space(3))) bf16x8*)(kp + 2560);
  kf[4] = *(const __attribute__((address_space(3))) bf16x8*)(kp + 4096); kf[5] = *(const __attribute__((address_space(3))) bf16x8*)(kp + 4608);
  kf[6] = *(const __attribute__((address_space(3))) bf16x8*)(kp + 6144); kf[7] = *(const __attribute__((address_space(3))) bf16x8*)(kp + 6656);
}
__device__ __forceinline__ void pv(f32x16* o, int vb, bf16x8 pa0, bf16x8 pa1, bf16x8 pa2, bf16x8 pa3) {
  #pragma unroll
  for (int d0 = 0; d0 < 2; ++d0) { s16x4 lo[4], hi[4];
    #pragma unroll
    for (int ks = 0; ks < 4; ++ks) {
      asm volatile("ds_read_b64_tr_b16 %0,%1 offset:%c2" : "=&v"(lo[ks]) : "v"(vb), "i"(d0 * 4096 + ks * 1024) : "memory");
      asm volatile("ds_read_b64_tr_b16 %0,%1 offset:%c2" : "=&v"(hi[ks]) : "v"(vb), "i"(d0 * 4096 + ks * 1024 + 512) : "memory"); }
    asm volatile("s_waitcnt lgkmcnt(0)" ::: "memory"); SBAR();
    #define PK(k) (bf16x8){lo[k][0], lo[k][1], lo[k][2], lo[k][3], hi[k][0], hi[k][1], hi[k][2], hi[k][3]}
    o[d0] = __builtin_amdgcn_mfma_f32_32x32x16_bf16(pa0, PK(0), o[d0], 0, 0, 0);
    o[d0] = __builtin_amdgcn_mfma_f32_32x32x16_bf16(pa1, PK(1), o[d0], 0, 0, 0);
    o[d0] = __builtin_amdgcn_mfma_f32_32x32x16_bf16(pa2, PK(2), o[d0], 0, 0, 0);
    o[d0] = __builtin_amdgcn_mfma_f32_32x32x16_bf16(pa3, PK(3), o[d0], 0, 0, 0);
    #undef PK
  }
}
__device__ __forceinline__ float wmax(float v) {
#pragma unroll
  for (int o = 1; o < 64; o <<= 1) v = fmaxf(v, __shfl_xor(v, o));
  return v;
}
__device__ __forceinline__ void attn_unit(int b, int h, int g, const bf16* Q, const bf16* __restrict__ K, const bf16* __restrict__ V, bf16* O,
                                          const float* __restrict__ relb, const float* __restrict__ gq, const float* __restrict__ gk, char* shm) {
  int tid_ = threadIdx.x; asm volatile("" : "+v"(tid_));
  const int tid = tid_, lane = tid & 63, r32 = lane & 31, hi = lane >> 5; const int wid = __builtin_amdgcn_readfirstlane(tid >> 6);
  const long rowbase = (long)b * SEQ; const int q0 = g * 256;
  const int kc_lo = (4 * g - 8) > 0 ? (4 * g - 8) : 0, NT = 4 * g + 4 - kc_lo;
  const bf16* Qw = Q + (rowbase + q0 + wid * 32) * DM + h * 64;
  const bf16* Kh = K + (rowbase + 64 * kc_lo) * DM + h * 64; const bf16* Vh = V + (rowbase + 64 * kc_lo) * DM + h * 64;
  const unsigned lds0 = (unsigned)(uintptr_t)shm;
  float* wsf = (float*)(shm + LDS_WS) + wid * 64;
  float* biasT = (float*)(shm + LDS_BIAS);
  const bf16* ksrc = Kh + (long)lane * DM + wid * 8;
  const bf16* vsrc = Vh + (long)(16 * (wid & 3) + (lane >> 2)) * DM + (wid >> 2) * 32 + (lane & 3) * 8;
  const unsigned kdst = lds0 + LDS_K + wid * 1024, vdst = lds0 + LDS_V + wid * 1024;
  #define DMA_K(t, slot) glds16(ksrc + (long)(t) * 64 * DM, (unsigned)__builtin_amdgcn_readfirstlane(kdst + (slot)))
  #define DMA_V(t, slot) glds16(vsrc + (long)(t) * 64 * DM, (unsigned)__builtin_amdgcn_readfirstlane(vdst + (slot)))
  const int vb0 = (int)(lds0 + LDS_V) + ((lane >> 4) & 1) * 32 + (lane & 3) * 8 + (4 * hi + ((lane & 15) >> 2)) * 64;
  const lds_cptr shm3 = (lds_cptr)shm; const lds_cptr kp0 = shm3 + LDS_K + hi * 1024 + r32 * 16;
  asm volatile("s_waitcnt vmcnt(0)" ::: "memory");
  const bool full = (g >= 2); const int nsteps = full ? 9 : NT;
  #define LOAD_TILE(i) (full ? ((i) < 6 ? (((i) & 1) ? ((i) >> 1) + 9 : ((i) >> 1)) : (i) - 3) : (i))
  #define ISSUE_LOAD(i) do { const int i_ = (i); const int tl_ = LOAD_TILE(i_); const int sb_ = (i_ % NSLOT) * SLOTB; DMA_K(tl_, sb_); DMA_V(tl_, sb_); } while (0)
  ISSUE_LOAD(0); ISSUE_LOAD(1); if (full) { ISSUE_LOAD(2); ISSUE_LOAD(3); }
  bf16x8 qr[4];
  #pragma unroll
  for (int d0 = 0; d0 < 4; ++d0) qr[d0] = *reinterpret_cast<const bf16x8*>(&Qw[(long)r32 * DM + d0 * 16 + hi * 8]);
  float m2;
  { const float mq = wmax(fabsf(gq[lane])), mk = wmax(fabsf(gk[lane])); float mb = -3.0e38f;
    for (int i = lane; i < NREL; i += 64) mb = fmaxf(mb, relb[h * NREL + i]);
    mb = wmax(mb); m2 = (8.0f * mq * mk + mb) * LOG2E; }
  for (int i = tid; i < 4 * 384; i += 512) { const int c = i / 384, j = i - c * 384, e = j + c; biasT[c * BIAS_CS + j] = (e < 384 ? relb[h * NREL + (e < 64 ? 512 : 576 - e)] : 0.f) * LOG2E - m2; }
  f32x16 o[2]; o[0] = f32x16{}; o[1] = f32x16{}; f32x16 lsum = f32x16{};
  const int qpos = 32 * (wid & 1) + r32;
  const int cch = 4 * g + (wid >> 1);
  asm volatile("s_waitcnt vmcnt(0) lgkmcnt(0)\n\ts_barrier" ::: "memory");
  for (int s = 0; s < nsteps; ++s) {
    int nis = 0;
    if (s + 2 < nsteps) { const int s2 = s + 2; if (full) { if (s2 < 3) { ISSUE_LOAD(2 * s2); ISSUE_LOAD(2 * s2 + 1); nis = 2; } else { ISSUE_LOAD(s2 + 3); nis = 1; } } else { ISSUE_LOAD(s2); nis = 1; } }
    int jrel = kc_lo + s - cch + 8, ld = full ? (s < 3 ? 2 * s : s + 3) : s;
    if (full && s < 3 && jrel < 0) { jrel += 9; ld += 1; }
    const int sl_cur = (ld % NSLOT) * SLOTB;
    if (jrel >= 0 && jrel <= 8) {
      s16x4 vlo[8], vhi[8]; { const int vb = vb0 + sl_cur;
        #pragma unroll
        for (int i_ = 0; i_ < 8; ++i_) {
          asm volatile("ds_read_b64_tr_b16 %0,%1 offset:%c2" : "=&v"(vlo[i_]) : "v"(vb), "i"((i_ >> 2) * 4096 + (i_ & 3) * 1024) : "memory");
          asm volatile("ds_read_b64_tr_b16 %0,%1 offset:%c2" : "=&v"(vhi[i_]) : "v"(vb), "i"((i_ >> 2) * 4096 + (i_ & 3) * 1024 + 512) : "memory"); } }
      f32x16 p0, p1;
      if (jrel <= 3) { const float c0 = biasT[0];
        #pragma unroll
        for (int r = 0; r < 16; ++r) { p0[r] = c0; p1[r] = c0; } }
      else { const int i0 = 64 + 4 * hi - qpos + 64 * (jrel - 4), cs = i0 & 3; const f32x4* a4 = (const f32x4*)(biasT + cs * BIAS_CS + (i0 - cs));
        #pragma unroll
        for (int q4 = 0; q4 < 4; ++q4) { const f32x4 b0 = a4[2 * q4], b1 = a4[2 * q4 + 8];
          #pragma unroll
          for (int e = 0; e < 4; ++e) { p0[4 * q4 + e] = b0[e]; p1[4 * q4 + e] = b1[e]; } } }
      bf16x8 kf[8]; kload8(kf, kp0 + sl_cur);
      #pragma unroll
      for (int d0 = 0; d0 < 4; ++d0) { p0 = __builtin_amdgcn_mfma_f32_32x32x16_bf16(kf[2 * d0], qr[d0], p0, 0, 0, 0); p1 = __builtin_amdgcn_mfma_f32_32x32x16_bf16(kf[2 * d0 + 1], qr[d0], p1, 0, 0, 0); }
      #pragma unroll
      for (int r = 0; r < 16; ++r) { p0[r] = __builtin_amdgcn_exp2f(p0[r]); p1[r] = __builtin_amdgcn_exp2f(p1[r]); }
      lsum += p0 + p1;
      u32x4 pw0, pw1, pw2, pw3;
      pw0 = (u32x4){cvtpk_s(p0[0], p0[1]), cvtpk_s(p0[2], p0[3]), cvtpk_s(p0[4], p0[5]), cvtpk_s(p0[6], p0[7])};
      pw1 = (u32x4){cvtpk_s(p0[8], p0[9]), cvtpk_s(p0[10], p0[11]), cvtpk_s(p0[12], p0[13]), cvtpk_s(p0[14], p0[15])};
      pw2 = (u32x4){cvtpk_s(p1[0], p1[1]), cvtpk_s(p1[2], p1[3]), cvtpk_s(p1[4], p1[5]), cvtpk_s(p1[6], p1[7])};
      pw3 = (u32x4){cvtpk_s(p1[8], p1[9]), cvtpk_s(p1[10], p1[11]), cvtpk_s(p1[12], p1[13]), cvtpk_s(p1[14], p1[15])};
      SBAR();
      asm volatile("s_waitcnt lgkmcnt(0)" ::: "memory"); SBAR();
      #define VF(i_) (bf16x8){vlo[i_][0], vlo[i_][1], vlo[i_][2], vlo[i_][3], vhi[i_][0], vhi[i_][1], vhi[i_][2], vhi[i_][3]}
      o[0] = __builtin_amdgcn_mfma_f32_32x32x16_bf16(__builtin_bit_cast(bf16x8, pw0), VF(0), o[0], 0, 0, 0); o[1] = __builtin_amdgcn_mfma_f32_32x32x16_bf16(__builtin_bit_cast(bf16x8, pw0), VF(4), o[1], 0, 0, 0);
      o[0] = __builtin_amdgcn_mfma_f32_32x32x16_bf16(__builtin_bit_cast(bf16x8, pw1), VF(1), o[0], 0, 0, 0); o[1] = __builtin_amdgcn_mfma_f32_32x32x16_bf16(__builtin_bit_cast(bf16x8, pw1), VF(5), o[1], 0, 0, 0);
      o[0] = __builtin_amdgcn_mfma_f32_32x32x16_bf16(__builtin_bit_cast(bf16x8, pw2), VF(2), o[0], 0, 0, 0); o[1] = __builtin_amdgcn_mfma_f32_32x32x16_bf16(__builtin_bit_cast(bf16x8, pw2), VF(6), o[1], 0, 0, 0);
      o[0] = __builtin_amdgcn_mfma_f32_32x32x16_bf16(__builtin_bit_cast(bf16x8, pw3), VF(3), o[0], 0, 0, 0); o[1] = __builtin_amdgcn_mfma_f32_32x32x16_bf16(__builtin_bit_cast(bf16x8, pw3), VF(7), o[1], 0, 0, 0);
      #undef VF
    }
    if (nis == 2)      asm volatile("s_waitcnt vmcnt(4) lgkmcnt(0)\n\ts_barrier" ::: "memory");
    else if (nis == 1) asm volatile("s_waitcnt vmcnt(2) lgkmcnt(0)\n\ts_barrier" ::: "memory");
    else               asm volatile("s_waitcnt vmcnt(0) lgkmcnt(0)\n\ts_barrier" ::: "memory");
  }
  #undef LOAD_TILE
  #undef ISSUE_LOAD
  float l_reg = 0.f;
  #pragma unroll
  for (int r = 0; r < 16; ++r) l_reg += lsum[r];
  { auto rr = __builtin_amdgcn_permlane32_swap(__float_as_uint(l_reg), __float_as_uint(l_reg), false, false); l_reg = __uint_as_float(rr[0]) + __uint_as_float(rr[1]); }
  if (hi == 0) wsf[32 + r32] = l_reg; asm volatile("s_waitcnt lgkmcnt(0)" ::: "memory");
  float rli[16];
  #pragma unroll
  for (int r = 0; r < 16; ++r) rli[r] = __builtin_amdgcn_rcpf(wsf[32 + crow(r, hi)]);
  bf16* Ow = O + (rowbase + q0 + wid * 32) * DM + h * 64;
  { bf16* stg = (bf16*)(shm + LDS_OST) + wid * 2048;
    #pragma unroll
    for (int r = 0; r < 16; ++r) { const int orow = crow(r, hi);
      #pragma unroll
      for (int d0 = 0; d0 < 2; ++d0) stg[orow * 64 + d0 * 32 + r32] = (bf16)(cvtpk_s(o[d0][r] * rli[r], 0.f) & 0xffffu); }
    asm volatile("s_waitcnt lgkmcnt(0)" ::: "memory");
    #pragma unroll
    for (int i = 0; i < 4; ++i) { const int row = i * 8 + (lane >> 3), ch = lane & 7; const u32x4 v = *(const u32x4*)(stg + row * 64 + ch * 8); pg8::st16(Ow + (long)row * DM + ch * 8, v); } }
  asm volatile("s_waitcnt lgkmcnt(0)\n\ts_barrier" ::: "memory");
  #undef DMA_K
  #undef DMA_V
}
#undef SBAR
}

#define GAS __attribute__((address_space(1)))
#define LAS __attribute__((address_space(3)))
typedef unsigned short bf16;
typedef unsigned v4u __attribute__((ext_vector_type(4)));
typedef float f32x4 __attribute__((ext_vector_type(4)));
typedef short bf16x8 __attribute__((ext_vector_type(8)));
typedef GAS unsigned gu32;
typedef GAS unsigned long long gu64;
#define RLX_AGENT __ATOMIC_RELAXED, __HIP_MEMORY_SCOPE_AGENT
#define LDS_WAIT() asm volatile("s_waitcnt lgkmcnt(0)" ::: "memory")
#define VM_WAIT() asm volatile("s_waitcnt vmcnt(0)" ::: "memory")
__device__ __forceinline__ unsigned long long rt() { return __builtin_amdgcn_s_memrealtime(); }
#define XB_TMO      128
#define XB_XCNT(j)  (256  + 64 * (j))
#define XB_XSUB(j)  (1280 + 64 * (j))
#define XB_XGEN(j)  (2304 + 64 * (j))
#define XB_TOP      3328
#define XB_TOPGEN   3392
#define XCD_BAR_WORDS 3456
#define XB_SPIN_CAP (1u << 18)

__device__ __forceinline__ unsigned xb_ld(unsigned* p)              { return __hip_atomic_load(p, __ATOMIC_RELAXED, __HIP_MEMORY_SCOPE_AGENT); }
__device__ __forceinline__ unsigned xb_add(unsigned* p, unsigned v) { return __hip_atomic_fetch_add(p, v, __ATOMIC_RELAXED, __HIP_MEMORY_SCOPE_AGENT); }
__device__ __forceinline__ unsigned xb_xcc_id() { return (unsigned)__builtin_amdgcn_s_getreg((3 << 11) | 20) & 0xFu; }
#define XB_SPIN(cond, bar) do { unsigned _sp = 0; while (cond) { __builtin_amdgcn_s_sleep(1); \
    if ((++_sp & 255u) == 0u) { if (xb_ld(&(bar)[XB_TMO])) break; if (_sp > XB_SPIN_CAP) { atomicAdd(&(bar)[XB_TMO], 1u); break; } } } } while (0)

struct XcdBarrier {
    unsigned* bar; unsigned x;
    volatile LAS unsigned* st;
};

__device__ __forceinline__ XcdBarrier xcd_barrier_post(unsigned* bar, volatile LAS unsigned* st) {
    XcdBarrier b; b.bar = bar; b.x = xb_xcc_id(); b.st = st;
    if (threadIdx.x == 0) (void)xb_add(&bar[XB_XCNT(b.x)], 1u);
    return b;
}
__device__ __forceinline__ void xcd_barrier_complete(unsigned* bar, unsigned x, unsigned& nloc, unsigned& nx) {
    const unsigned G = gridDim.x * gridDim.y * gridDim.z;
    unsigned sum, cnt, mine, sp = 0u;
    for (;;) {
        sum = 0u; cnt = 0u; mine = 0u;
#pragma unroll
        for (unsigned j = 0; j < 16; ++j) { const unsigned c = xb_ld(&bar[XB_XCNT(j)]); sum += c; cnt += (c > 0u) ? 1u : 0u; mine = (j == x) ? c : mine; }
        if (sum == G) break;
        __builtin_amdgcn_s_sleep(1);
        if ((++sp & 255u) == 0u) { if (xb_ld(&bar[XB_TMO])) break; if (sp > XB_SPIN_CAP) { atomicAdd(&bar[XB_TMO], 1u); break; } }
    }
    nloc = mine > 0u ? mine : 1u; nx = cnt > 0u ? cnt : 1u;
}

__device__ __forceinline__ void xcd_barrier(const XcdBarrier& b) {
    asm volatile("s_waitcnt vmcnt(0)" ::: "memory");
    __syncthreads();
    if (threadIdx.x == 0) {
        unsigned* bar = b.bar;
        __builtin_amdgcn_s_waitcnt(0);
        unsigned nloc = b.st[0], nx = b.st[1];
        if (nloc == 0u) { xcd_barrier_complete(bar, b.x, nloc, nx); b.st[0] = nloc; b.st[1] = nx; }
        __builtin_amdgcn_fence(__ATOMIC_RELEASE, "agent");
        asm volatile("s_waitcnt vmcnt(0)" ::: "memory");
        const unsigned old = xb_add(&bar[XB_XSUB(b.x)], 1u);
        const unsigned gen = old / nloc;
        if (old + 1u == (gen + 1u) * nloc) {
            __builtin_amdgcn_fence(__ATOMIC_RELEASE, "agent");
            asm volatile("s_waitcnt vmcnt(0)" ::: "memory");
            const unsigned og = xb_add(&bar[XB_TOP], 1u);
            const unsigned tg = og / nx;
            if (og + 1u == (tg + 1u) * nx) xb_add(&bar[XB_TOPGEN], 1u);
            else XB_SPIN(xb_ld(&bar[XB_TOPGEN]) == tg, bar);
            __builtin_amdgcn_fence(__ATOMIC_ACQUIRE, "agent");
            xb_add(&bar[XB_XGEN(b.x)], 1u);
            asm volatile("s_waitcnt vmcnt(0)" ::: "memory");
        } else {
            XB_SPIN(xb_ld(&bar[XB_XGEN(b.x)]) == gen, bar);
            __builtin_amdgcn_fence(__ATOMIC_ACQUIRE, "agent");
            asm volatile("s_waitcnt vmcnt(0)" ::: "memory");
        }
    }
    __syncthreads();
}
#include <hip/hip_cooperative_groups.h>
namespace cg = cooperative_groups;
constexpr int NWAVES = 8;
constexpr int BATCH = 4, SEQ = 4096, D = 1024, FF = 4096, M = BATCH * SEQ, NIN = 8192;
constexpr size_t MiB = 1u << 20;
constexpr size_t WS_SS = 1 * MiB;
constexpr size_t WS_W1 = 2 * MiB, WS_WC = 18 * MiB, WS_WA = 20 * MiB  , WS_WO = 22 * MiB, WS_WUP = 24 * MiB, WS_WDN = 32 * MiB;
constexpr size_t WS_V = 40 * MiB  , WS_H = 72 * MiB  , WS_Q = 104 * MiB, WS_K = 136 * MiB  , WS_BG = 168 * MiB  , WS_U1 = 200 * MiB;
constexpr size_t WS_UU = 72 * MiB;
constexpr size_t WS_END = 232 * MiB;
constexpr int LDS_BYTES = 147456;
constexpr int LDSCTL_OFF = 131072, MISC_OFF = LDSCTL_OFF + 320;
constexpr size_t WS_CTL = 0, CTL_ZERO_BYTES = 65536; constexpr int CW_BAR = 4096;
__device__ __forceinline__ unsigned f2bf(float f) { unsigned u = __builtin_bit_cast(unsigned, f); return (u + 0x7fffu + ((u >> 16) & 1u)) >> 16; }
__device__ __forceinline__ unsigned pk2(float lo, float hi) { return f2bf(lo) | (f2bf(hi) << 16); }
__device__ __forceinline__ float wave_sum(float v) {
#pragma unroll
    for (int o = 1; o < 64; o <<= 1) v += __shfl_xor(v, o);
    return v;
}
__device__ __forceinline__ void tr_item(const float* W, int ldw, int col0, int k0, bf16* WT, int Kd, int drow0, const float* kscale, LAS float* scr, int lane) {
    float tv[32];
#pragma unroll
    for (int i = 0; i < 32; ++i) { const int kk = 2 * i + (lane >> 5); tv[i] = W[(size_t)(k0 + kk) * ldw + col0 + (lane & 31)]; }
#pragma unroll
    for (int i = 0; i < 32; ++i) { const int kk = 2 * i + (lane >> 5); float v = tv[i]; if (kscale) v *= kscale[k0 + kk]; scr[kk * 33 + (lane & 31)] = v; }
    LDS_WAIT(); asm volatile("" ::: "memory");
    const int c = lane & 7;
#pragma unroll
    for (int j = 0; j < 4; ++j) { const int n = (lane >> 3) + 8 * j; const LAS float* s = scr + (8 * c) * 33 + n;
        v4u o; o.x = pk2(s[0 * 33], s[1 * 33]); o.y = pk2(s[2 * 33], s[3 * 33]); o.z = pk2(s[4 * 33], s[5 * 33]); o.w = pk2(s[6 * 33], s[7 * 33]);
        pg8::st16(WT + (size_t)(drow0 + n) * Kd + k0 + 8 * c, o); }
    LDS_WAIT(); asm volatile("" ::: "memory");
}

#ifndef PH_MASK
#define PH_MASK 127
#endif
#ifndef REP_P1
#define REP_P1 1
#endif
#ifndef REP_ATT
#define REP_ATT 1
#endif
#ifndef REP_P3
#define REP_P3 1
#endif
#ifndef REP_P4
#define REP_P4 1
#endif
#ifndef REP_P5
#define REP_P5 1
#endif
#ifndef EXTRA_SYNC
#define EXTRA_SYNC 0
#endif
__device__ unsigned g_panel_cnt[64 * 64];
__device__ unsigned g_bar_shard[16 * 64];
__device__ unsigned g_bar_cnt = 0u, g_bar_gen = 0u, g_done_cnt = 0u;
struct Args { const float* in[16]; float* out; unsigned char* ws; };
__global__ void __launch_bounds__(NWAVES * 64, 2) fwd(Args a) {
    extern __shared__ __attribute__((aligned(16))) unsigned char lds[];
    cg::grid_group grid = cg::this_grid();
    LAS unsigned char* ldsp = (LAS unsigned char*)lds;
    const int tid = threadIdx.x, lane = tid & 63, wave = __builtin_amdgcn_readfirstlane(tid >> 6);
    const int G = gridDim.x, bx = blockIdx.x, vcu = (G % 8 == 0) ? (bx % 8) * (G / 8) + bx / 8 : bx;
    unsigned char* ws = a.ws;
    const float* x = a.in[0];
    bf16 *W1 = (bf16*)(ws + WS_W1), *WA = (bf16*)(ws + WS_WA), *WC = (bf16*)(ws + WS_WC), *WO = (bf16*)(ws + WS_WO), *WUP = (bf16*)(ws + WS_WUP), *WDN = (bf16*)(ws + WS_WDN);
    bf16 *Vb = (bf16*)(ws + WS_V), *X1B = (bf16*)(ws + WS_V), *Hb = (bf16*)(ws + WS_H), *YC = (bf16*)(ws + WS_H)  , *Qb = (bf16*)(ws + WS_Q), *AO = (bf16*)(ws + WS_Q)  , *Kb = (bf16*)(ws + WS_K), *MG = (bf16*)(ws + WS_K);
    bf16 *BG = (bf16*)(ws + WS_BG), *U1 = (bf16*)(ws + WS_U1), *UU = (bf16*)(ws + WS_UU), *Gt = (bf16*)a.out;
    float* SS = (float*)(ws + WS_SS);
    for (int u = tid; u < (LDS_BYTES - LDSCTL_OFF) / 4; u += NWAVES * 64) ((LAS unsigned*)(ldsp + LDSCTL_OFF))[u] = 0u;
    __syncthreads();
    if (a.out == nullptr) grid.sync();
#ifndef WB_AT_SEAMS
#define WB_AT_SEAMS 0
#endif
#if WB_AT_SEAMS || !WT_STORES
#define BAR_RELEASE() do { __builtin_amdgcn_fence(__ATOMIC_RELEASE, "agent"); asm volatile("s_waitcnt vmcnt(0)" ::: "memory"); } while (0)
#else
#define BAR_RELEASE() do { } while (0)
#endif
#if defined(MONO_BAR)
    const bool grouped = (G == 256);
    const unsigned NSEAMS = (grouped ? 4u : 6u) + EXTRA_SYNC;
    unsigned bar_epoch = 0u, bar_base = 0u; const unsigned bar_xcc = xb_xcc_id();
#define GRID_BAR() do { asm volatile("s_waitcnt vmcnt(0)" ::: "memory"); __syncthreads(); \
    ++bar_epoch; \
    if (tid == 0) { \
        BAR_RELEASE(); \
        unsigned old_ = xb_add(&g_bar_shard[64u * bar_xcc], 1u);     \
        if (bar_epoch == 1u) asm volatile("s_waitcnt vmcnt(0)" : "+v"(old_) :: "memory");     \
        const unsigned tgt_ = bar_epoch * (unsigned)G; unsigned sp_ = 0u; \
        for (;;) { unsigned s_ = 0u; _Pragma("unroll") for (int j_ = 0; j_ < 16; ++j_) s_ += xb_ld(&g_bar_shard[64 * j_]); \
            if (bar_epoch == 1u && sp_ == 0u) bar_base = ((s_ - 1u) / (NSEAMS * (unsigned)G)) * (NSEAMS * (unsigned)G);     \
            if (s_ - bar_base >= tgt_) break; \
            __builtin_amdgcn_s_sleep(1); if (++sp_ > (1u << 22)) break; } \
        __builtin_amdgcn_fence(__ATOMIC_ACQUIRE, "agent"); asm volatile("s_waitcnt vmcnt(0)" ::: "memory"); } \
    __syncthreads(); } while (0)
    unsigned grp_epoch = 0u, grp_base = 0u;
#define GROUP_BAR(pm_) do { asm volatile("s_waitcnt vmcnt(0)" ::: "memory"); __syncthreads(); \
    ++grp_epoch; \
    if (tid == 0) { unsigned* pc_ = &g_panel_cnt[64 * (pm_)]; \
        BAR_RELEASE(); \
        const unsigned old_ = xb_add(pc_, 1u); \
        if (grp_epoch == 1u) grp_base = old_ - old_ % 8u; \
        const unsigned tgt_ = grp_epoch * 4u; unsigned sp_ = 0u; \
        while (xb_ld(pc_) - grp_base < tgt_) { __builtin_amdgcn_s_sleep(1); if (++sp_ > (1u << 22)) break; } \
        __builtin_amdgcn_fence(__ATOMIC_ACQUIRE, "agent"); asm volatile("s_waitcnt vmcnt(0)" ::: "memory"); } \
    __syncthreads(); } while (0)
#elif defined(GEN_BAR)
#define GRID_BAR() do { asm volatile("s_waitcnt vmcnt(0)" ::: "memory"); __syncthreads(); \
    if (tid == 0) { \
        __builtin_amdgcn_fence(__ATOMIC_RELEASE, "agent"); asm volatile("s_waitcnt vmcnt(0)" ::: "memory"); \
        unsigned g0_ = xb_ld(&g_bar_gen); asm volatile("s_waitcnt vmcnt(0)" : "+v"(g0_) :: "memory");            \
        unsigned old_ = xb_add(&g_bar_cnt, 1u); asm volatile("s_waitcnt vmcnt(0)" : "+v"(old_) :: "memory"); \
        if (old_ == (unsigned)G - 1u) { __hip_atomic_store(&g_bar_cnt, 0u, RLX_AGENT); asm volatile("s_waitcnt vmcnt(0)" ::: "memory"); xb_add(&g_bar_gen, 1u); } \
        else { unsigned sp_ = 0u; while (xb_ld(&g_bar_gen) == g0_) { __builtin_amdgcn_s_sleep(1); if (++sp_ > (1u << 22)) break; } } \
        __builtin_amdgcn_fence(__ATOMIC_ACQUIRE, "agent"); asm volatile("s_waitcnt vmcnt(0)" ::: "memory"); } \
    __syncthreads(); } while (0)
#elif defined(CG_ALL)
#define GRID_BAR() do { asm volatile("s_waitcnt vmcnt(0)" ::: "memory"); grid.sync(); } while (0)
#elif defined(SIMPLE_BAR)
    unsigned bar_epoch = 0u;
#define GRID_BAR() do { asm volatile("s_waitcnt vmcnt(0)" ::: "memory"); __syncthreads(); \
    ++bar_epoch; \
    if (tid == 0) { unsigned* cnt_ = (unsigned*)(ws + WS_CTL) + CW_BAR + XB_TOP; \
        __builtin_amdgcn_fence(__ATOMIC_RELEASE, "agent"); asm volatile("s_waitcnt vmcnt(0)" ::: "memory"); \
        xb_add(cnt_, 1u); unsigned sp_ = 0u; \
        while (xb_ld(cnt_) < bar_epoch * (unsigned)G) { __builtin_amdgcn_s_sleep(1); if (++sp_ > (1u << 22)) break; } \
        __builtin_amdgcn_fence(__ATOMIC_ACQUIRE, "agent"); asm volatile("s_waitcnt vmcnt(0)" ::: "memory"); } \
    __syncthreads(); } while (0)
#else
#define GRID_BAR() xcd_barrier(bar)
#endif

#ifndef DUP_P0
#define DUP_P0 1
#endif
    for (int rep0 = 0; rep0 < DUP_P0; ++rep0) {
        LAS float* scr = (LAS float*)(ldsp + wave * 16384);
        const int gw = vcu * NWAVES + wave, NGW = G * NWAVES;
        constexpr int I_1 = 16 * 256, I_S = 16 * 32, I_UP = 16 * 128, I_DN = 64 * 32, NITEMS = I_1 + 3 * I_S + I_UP + I_DN;
        for (int it = gw; it < NITEMS; it += NGW) {
            int r = it;
            if (r < I_1) { const int db = r & 255, kb = r >> 8, pn = db >> 3, pb = db & 7, bj = pb >> 2, wcc = pb & 3; const float* W = a.in[2]; int ldw = 6144, col;
                if (pn < 4) col = (4 * pn + wcc) * 64 + 32 * bj;
                else if (pn < 8) col = 1024 + (4 * (pn - 4) + wcc) * 64 + 32 * bj;
                else if (pn < 12) col = 2048 + 256 * (pn - 8) + 32 * pb;
                else if (pn < 16) col = 3072 + 256 * (pn - 12) + 32 * pb;
                else if (pn < 24) col = (bj ? 5120 : 4096) + 128 * (pn - 16) + 32 * wcc;
                else { W = a.in[10]; ldw = 2048; col = 256 * (pn - 24) + 32 * pb; }
                tr_item(W, ldw, col, 64 * kb, W1, D, 32 * db, nullptr, scr, lane); continue; } r -= I_1;
            if (r < I_S) { tr_item(a.in[8], D, 32 * (r & 31), 64 * (r >> 5), WA, D, 32 * (r & 31), nullptr, scr, lane); continue; } r -= I_S;
            if (r < I_S) { tr_item(a.in[9], D, 32 * (r & 31), 64 * (r >> 5), WC, D, 32 * (r & 31), nullptr, scr, lane); continue; } r -= I_S;
            if (r < I_S) { tr_item(a.in[12], D, 32 * (r & 31), 64 * (r >> 5), WO, D, 32 * (r & 31), nullptr, scr, lane); continue; } r -= I_S;
            if (r < I_UP) { tr_item(a.in[14], FF, 32 * (r & 127), 64 * (r >> 7), WUP, D, 32 * (r & 127), a.in[13], scr, lane); continue; } r -= I_UP;
            tr_item(a.in[15], D, 32 * (r & 31), 64 * (r >> 5), WDN, FF, 32 * (r & 31), nullptr, scr, lane);
        }
        const float* g1 = a.in[1];
        f32x4 gv[4];
#pragma unroll
        for (int j = 0; j < 4; ++j) gv[j] = ((const f32x4*)g1)[lane + 64 * j];
        for (int m0 = gw; m0 < M; m0 += 2 * NGW) {
            const int m1 = m0 + NGW;
            const bool has1 = m1 < M;
            const f32x4* xr0 = (const f32x4*)(x + (size_t)m0 * D) + lane; const f32x4* xr1 = (const f32x4*)(x + (size_t)(has1 ? m1 : m0) * D) + lane;
            f32x4 v0[4], v1[4]; float s0 = 0.f, s1 = 0.f;
#pragma unroll
            for (int j = 0; j < 4; ++j) { v0[j] = xr0[64 * j]; v1[j] = xr1[64 * j]; }
#pragma unroll
            for (int j = 0; j < 4; ++j) { s0 += (v0[j].x * v0[j].x + v0[j].y * v0[j].y) + (v0[j].z * v0[j].z + v0[j].w * v0[j].w); s1 += (v1[j].x * v1[j].x + v1[j].y * v1[j].y) + (v1[j].z * v1[j].z + v1[j].w * v1[j].w); }
            const float rs0 = 1.0f / sqrtf(wave_sum(s0) * (1.0f / D) + 1e-6f), rs1 = 1.0f / sqrtf(wave_sum(s1) * (1.0f / D) + 1e-6f);
            unsigned long long* o80 = (unsigned long long*)(Hb + (size_t)m0 * D) + lane; unsigned long long* o81 = (unsigned long long*)(Hb + (size_t)m1 * D) + lane;
#pragma unroll
            for (int j = 0; j < 4; ++j) { const f32x4 y = v0[j] * rs0 * gv[j]; pg8::st8(o80 + 64 * j, (pg8::u32x2w){pk2(y.x, y.y), pk2(y.z, y.w)}); }
            if (has1) {
#pragma unroll
                for (int j = 0; j < 4; ++j) { const f32x4 y = v1[j] * rs1 * gv[j]; pg8::st8(o81 + 64 * j, (pg8::u32x2w){pk2(y.x, y.y), pk2(y.z, y.w)}); } }
        }
    }
    GRID_BAR();
#if !defined(SIMPLE_BAR) && !defined(CG_ALL) && !defined(GEN_BAR) && !defined(MONO_BAR)
    const XcdBarrier bar = xcd_barrier_post((unsigned*)(ws + WS_CTL) + CW_BAR, (volatile LAS unsigned*)(ldsp + MISC_OFF) + 8);
#endif

    if (PH_MASK & 2) {
        pg8::Gemm g{Hb, W1, M, NIN, D}; pg8::StaticOrder S; S.init(M, NIN, G, bx);
        pg8::EpiP1 E{Qb, Kb, Vb, BG, U1, Gt, a.in[3], a.in[4], a.in[11]};
        pg8::gemm_phase<pg8::EpiP1, pg8::StaticOrder, true, true>(ldsp, g, S, E);
#ifdef DUP_P1
        { pg8::Gemm g2{Hb, W1, M, NIN, D}; pg8::StaticOrder S2; S2.init(M, NIN, G, bx); pg8::gemm_phase<pg8::EpiP1, pg8::StaticOrder, true, true>(ldsp, g2, S2, E); }
#endif
    }
    GRID_BAR();

    if (PH_MASK & 4) {
        for (int L = vcu; L < 1024 * REP_ATT; L += G) { const int bh = (L & 255) >> 2, gq4 = (L & 3) + 4 * ((L >> 8) & 3);
            attn::attn_unit(bh >> 4, bh & 15, gq4, Qb, Kb, Vb, AO, a.in[5], a.in[3], a.in[4], (char*)lds); }
        const float* cw = a.in[6]; const float* cb = a.in[7];
        for (int item = vcu * 512 + tid; item < 131072; item += G * 512) {
            const int c8 = (item & 127) * 8, t0 = (item >> 7) * 16;
            float w0[8], w1[8], w2[8], b0[8], u1[8], u2[8];
#pragma unroll
            for (int e = 0; e < 8; ++e) { w0[e] = cw[c8 + e]; w1[e] = cw[1024 + c8 + e]; w2[e] = cw[2048 + c8 + e]; b0[e] = cb[c8 + e]; u1[e] = 0.f; u2[e] = 0.f; }
            if ((t0 & (SEQ - 1)) != 0) { f32x4 p, q; pg8::unpack8(*(const v4u*)(U1 + (size_t)(t0 - 2) * D + c8), p, q);
#pragma unroll
                for (int e = 0; e < 4; ++e) { u2[e] = p[e]; u2[4 + e] = q[e]; }
                pg8::unpack8(*(const v4u*)(U1 + (size_t)(t0 - 1) * D + c8), p, q);
#pragma unroll
                for (int e = 0; e < 4; ++e) { u1[e] = p[e]; u1[4 + e] = q[e]; } }
            v4u ur[16], br[16];
#pragma unroll
            for (int i = 0; i < 16; ++i) { const size_t off = (size_t)(t0 + i) * D + c8; ur[i] = *(const v4u*)(U1 + off); br[i] = *(const v4u*)(BG + off); }
#pragma unroll
            for (int i = 0; i < 16; ++i) { const size_t off = (size_t)(t0 + i) * D + c8; f32x4 p, q, bp, bq; float u0[8], bgv[8], y[8];
                pg8::unpack8(ur[i], p, q); pg8::unpack8(br[i], bp, bq);
#pragma unroll
                for (int e = 0; e < 4; ++e) { u0[e] = p[e]; u0[4 + e] = q[e]; bgv[e] = bp[e]; bgv[4 + e] = bq[e]; }
#pragma unroll
                for (int e = 0; e < 8; ++e) { y[e] = bgv[e] * (b0[e] + w0[e] * u2[e] + w1[e] * u1[e] + w2[e] * u0[e]); u2[e] = u1[e]; u1[e] = u0[e]; }
                v4u o; o.x = pk2(y[0], y[1]); o.y = pk2(y[2], y[3]); o.z = pk2(y[4], y[5]); o.w = pk2(y[6], y[7]); pg8::st16(YC + off, o); }
        }
    }
    GRID_BAR();

    if (PH_MASK & 8) {
        static_assert(WS_Q == WS_H + (size_t)M * D * 2 && WS_WA == WS_WC + (size_t)D * D * 2, "P3 reads the stacked [YC ; AO] and [Wc ; Wa]");
        pg8::PairOrder S; S.S.init(M, D, G, bx);
        pg8::Gemm g{YC, WC, 2 * M, 2 * D, D}; pg8::EpiGate2 E{Gt, MG};
        pg8::gemm_phase<pg8::EpiGate2, pg8::PairOrder, true, true>(ldsp, g, S, E);
    }
    { pg8::StaticOrder S; S.init(M, D, G, bx); pg8::Unit u0; S.next(0, u0); if (grouped) GROUP_BAR(u0.pm); else GRID_BAR(); }

    if (PH_MASK & 16) {
        pg8::Gemm g{MG, WO, M, D, D}; pg8::StaticOrder S; S.init(M, D, G, bx);
        pg8::EpiRes1 E{x, a.out, X1B, SS};
        pg8::gemm_phase<pg8::EpiRes1, pg8::StaticOrder, true, true>(ldsp, g, S, E);
#ifdef DUP_P4
        pg8::gemm_phase<pg8::EpiRes1, pg8::StaticOrder, true, true>(ldsp, g, S, E);
#endif
    }
    GRID_BAR();

    if (PH_MASK & 32) {
        pg8::Gemm g{X1B, WUP, M, FF, D}; pg8::StaticOrder S; S.init(M, FF, G, bx);
        pg8::EpiUp E{SS, UU};
        pg8::gemm_phase<pg8::EpiUp, pg8::StaticOrder, true, true>(ldsp, g, S, E);
#ifdef DUP_P5
        pg8::gemm_phase<pg8::EpiUp, pg8::StaticOrder, true, true>(ldsp, g, S, E);
#endif
    }
    { pg8::StaticOrder S; S.init(M, D, G, bx); pg8::Unit u0; S.next(0, u0); if (grouped) GROUP_BAR(u0.pm); else GRID_BAR(); }

    for (int i = 0; i < EXTRA_SYNC; ++i) GRID_BAR();
    if (PH_MASK & 64) {
        pg8::Gemm g{UU, WDN, M, D, FF}; pg8::StaticOrder S; S.init(M, D, G, bx);
        pg8::EpiRes2 E{a.out, X1B};
        pg8::gemm_phase<pg8::EpiRes2, pg8::StaticOrder, true, true>(ldsp, g, S, E);
    }
#if defined(MONO_BAR)
    if (wave == 0) { unsigned old_ = 0u; if (lane == 0) old_ = xb_add(&g_done_cnt, 1u);
        old_ = (unsigned)__builtin_amdgcn_readfirstlane((int)old_);
        if (old_ == (unsigned)G - 1u) { __hip_atomic_store(&g_panel_cnt[64 * lane], 0u, RLX_AGENT);
            if (lane < 16) __hip_atomic_store(&g_bar_shard[64 * lane], 0u, RLX_AGENT);
            if (lane == 0) { __hip_atomic_store(&g_bar_cnt, 0u, RLX_AGENT); __hip_atomic_store(&g_done_cnt, 0u, RLX_AGENT); } } }
#endif
}

extern "C" void kernel_launch(void* const* d_in, const int* in_sizes, int n_in, void* d_out, int out_size, void* d_ws, size_t ws_size, hipStream_t stream) {
    static int grid = 0;
    if (grid == 0) {
        if (n_in != 16 || out_size != M * D || ws_size < WS_END) { fprintf(stderr, "kernel_launch: unexpected shapes (n_in %d, out %d, ws %zu)\n", n_in, out_size, ws_size); grid = -1; return; }
        int dev = 0, cus = 0, per_cu = 0;
        (void)hipGetDevice(&dev); (void)hipDeviceGetAttribute(&cus, hipDeviceAttributeMultiprocessorCount, dev);
        if (hipFuncSetAttribute((const void*)fwd, hipFuncAttributeMaxDynamicSharedMemorySize, LDS_BYTES) != hipSuccess) { fprintf(stderr, "kernel_launch: hipFuncSetAttribute failed\n"); grid = -1; return; }
        if (hipOccupancyMaxActiveBlocksPerMultiprocessor(&per_cu, (const void*)fwd, NWAVES * 64, LDS_BYTES) != hipSuccess || per_cu < 1) { fprintf(stderr, "kernel_launch: occupancy query says %d\n", per_cu); per_cu = 1; }
        (void)hipGetLastError();
        grid = cus * 1;
    }
    if (grid < 0) return;
#if !defined(GEN_BAR) && !defined(MONO_BAR)
    if (hipMemsetAsync((char*)d_ws + WS_CTL, 0, CTL_ZERO_BYTES, stream) != hipSuccess) { fprintf(stderr, "kernel_launch: memset of the barrier words failed\n"); return; }
#endif
    Args a{};
    for (int i = 0; i < 16; ++i) a.in[i] = (const float*)d_in[i];
    a.out = (float*)d_out; a.ws = (unsigned char*)d_ws;
    void* args[] = {&a};
    hipError_t e = hipLaunchCooperativeKernel((const void*)fwd, dim3(grid), dim3(NWAVES * 64), args, LDS_BYTES, stream);
    if (e != hipSuccess) fprintf(stderr, "kernel_launch: cooperative launch failed: %s (grid %d)\n", hipGetErrorString(e), grid);
}
```

```cpp
#include <hip/hip_runtime.h>
#include <cstdio>
#include <cstdint>
#define MONO_BAR 1
namespace pg8 {
#define PG8_LAS __attribute__((address_space(3)))
typedef unsigned short bf16_t;
typedef short bf16x8 __attribute__((ext_vector_type(8)));
typedef float f32x4 __attribute__((ext_vector_type(4)));
typedef unsigned u32x4 __attribute__((ext_vector_type(4)));
constexpr int BM = 256, BK = 64, HALF = 128, HTB = HALF * BK * 2  , STAGE_BYTES = 8 * HTB, NXCD = 8, WGM = 8;

__host__ __device__ __forceinline__ int lds_byte(int r, int c) { const int st = (r >> 4) * 2 + (c >> 5), rr = r & 15, cc = c & 31, ob = rr * 64 + cc * 2; return st * 1024 + (ob ^ (((ob >> 9) & 1) << 5)); }
__host__ __device__ __forceinline__ void stage_rc(int b, int& R, int& C) { const int st = b / 1024, sb = b % 1024, swz = sb ^ (((sb >> 9) & 1) << 5); R = (st >> 1) * 16 + swz / 64; C = (st & 1) * 32 + (swz % 64) / 2; }
__host__ __device__ __forceinline__ int perm32(int rho) { const int n = rho >> 4, i = rho & 15; return 8 * (i >> 2) + 4 * n + (i & 3); }

struct Unit { int pm, pn; };
struct Gemm { const bf16_t* A; const bf16_t* Bt; int M, N, K; };

struct StaticOrder {
    int nM, nN, nwg, G, c;
    __host__ __device__ void init(int M, int N, int G_, int c_) { nM = M / BM; nN = N / BM; nwg = nM * nN; G = G_; c = c_; }
    __host__ __device__ bool next(int i, Unit& u) const {
        const long L = (long)i * G + c; if (L >= nwg) return false;
        int wgid = (int)L; { const int q = nwg / NXCD, r = nwg % NXCD, xcd = wgid % NXCD, off = wgid / NXCD; wgid = (xcd < r ? xcd * (q + 1) : r * (q + 1) + (xcd - r) * q) + off; }
        const int nig = WGM * nN, gid = wgid / nig, fm = gid * WGM, gsz = (nM - fm) < WGM ? (nM - fm) : WGM;
        u.pm = fm + ((wgid % nig) % gsz); u.pn = (wgid % nig) / gsz; return true;
    }
    __device__ __forceinline__ void a_ready(const Unit&) const {}
    __device__ __forceinline__ void done(const Unit&) const {}
};

__device__ __forceinline__ unsigned cvt_pk_bf16(float lo, float hi) { unsigned r; asm volatile("v_cvt_pk_bf16_f32 %0, %1, %2" : "=v"(r) : "v"(lo), "v"(hi)); return r; }
typedef float f32x2 __attribute__((ext_vector_type(2)));
#ifndef WT_STORES
#define WT_STORES 1
#endif
__device__ __forceinline__ void st16(void* p, u32x4 v) {
#if WT_STORES
    asm volatile("global_store_dwordx4 %0, %1, off sc1\n\ts_nop 1" :: "v"(p), "v"(v) : "memory");
#else
    *(u32x4*)p = v;
#endif
}
typedef unsigned u32x2w __attribute__((ext_vector_type(2)));
__device__ __forceinline__ void st8(void* p, u32x2w v) {
#if WT_STORES
    asm volatile("global_store_dwordx2 %0, %1, off sc1\n\ts_nop 1" :: "v"(p), "v"(v) : "memory");
#else
    *(u32x2w*)p = v;
#endif
}
typedef unsigned u32x2 __attribute__((ext_vector_type(2)));
__device__ __forceinline__ float bf_lo(unsigned w) { return __uint_as_float(w << 16); }
__device__ __forceinline__ float bf_hi(unsigned w) { return __uint_as_float(w & 0xffff0000u); }
__device__ __forceinline__ u32x4 pack8(f32x4 a, f32x4 b) { u32x4 w; w.x = cvt_pk_bf16(a[0], a[1]); w.y = cvt_pk_bf16(a[2], a[3]); w.z = cvt_pk_bf16(b[0], b[1]); w.w = cvt_pk_bf16(b[2], b[3]); return w; }
__device__ __forceinline__ void unpack8(u32x4 w, f32x4& a, f32x4& b) { a = (f32x4){bf_lo(w.x), bf_hi(w.x), bf_lo(w.y), bf_hi(w.y)}; b = (f32x4){bf_lo(w.z), bf_hi(w.z), bf_lo(w.w), bf_hi(w.w)}; }
constexpr float QK_C2 = 0.125f * 1.4426950408889634f;
constexpr float RMS_EPS = 1e-6f;

struct EpiP1 {
    static constexpr bool PERM = true, AFTER_DRAIN = false;
    bf16_t *Q, *Kb, *V, *BG, *U1, *G; const float *gq, *gk, *bgate;
    __device__ __forceinline__ void operator()(const f32x4 (&acc)[2][2][4][2], const Unit& u, int wr, int wc, int fr, int fq) const {
        const int pn = u.pn; const int row0 = u.pm * BM + wr * 64 + fr;
        if (pn < 8) {
            const bool isq = pn < 4; const float* g = isq ? gq : gk; bf16_t* O = isq ? Q : Kb; const float sc = isq ? QK_C2 : 1.f;
            const int head = 4 * (pn & 3) + wc;
            f32x4 gv[2][2];
#pragma unroll
            for (int bj = 0; bj < 2; ++bj)
#pragma unroll
                for (int n = 0; n < 2; ++n) gv[bj][n] = *(const f32x4*)(g + 32 * bj + 8 * fq + 4 * n) * sc;
#pragma unroll
            for (int ai = 0; ai < 2; ++ai)
#pragma unroll
                for (int m = 0; m < 4; ++m) {
                    float s = 0.f;
#pragma unroll
                    for (int bj = 0; bj < 2; ++bj)
#pragma unroll
                        for (int n = 0; n < 2; ++n) { const f32x4 x = acc[ai][bj][m][n]; s += (x[0] * x[0] + x[1] * x[1]) + (x[2] * x[2] + x[3] * x[3]); }
                    s += __shfl_xor(s, 16); s += __shfl_xor(s, 32);
                    const float rs = 1.0f / sqrtf(s * (1.0f / 64.0f) + RMS_EPS);
                    bf16_t* rowp = O + (size_t)(row0 + ai * HALF + m * 16) * 1024 + head * 64 + 8 * fq;
#pragma unroll
                    for (int bj = 0; bj < 2; ++bj) st16(rowp + 32 * bj, pack8(acc[ai][bj][m][0] * rs * gv[bj][0], acc[ai][bj][m][1] * rs * gv[bj][1]));
                }
        } else if (pn < 16) {
            bf16_t* O = (pn < 12) ? V : BG; const int col0 = 256 * (pn & 3) + wc * 32 + 8 * fq;
#pragma unroll
            for (int ai = 0; ai < 2; ++ai)
#pragma unroll
                for (int m = 0; m < 4; ++m) { bf16_t* rowp = O + (size_t)(row0 + ai * HALF + m * 16) * 1024 + col0;
#pragma unroll
                    for (int bj = 0; bj < 2; ++bj) st16(rowp + bj * HALF, pack8(acc[ai][bj][m][0], acc[ai][bj][m][1])); }
        } else if (pn < 24) {
            const int col0 = 128 * (pn - 16) + wc * 32 + 8 * fq;
#pragma unroll
            for (int ai = 0; ai < 2; ++ai)
#pragma unroll
                for (int m = 0; m < 4; ++m)
                    st16(U1 + (size_t)(row0 + ai * HALF + m * 16) * 1024 + col0, pack8(acc[ai][0][m][0] * acc[ai][1][m][0], acc[ai][0][m][1] * acc[ai][1][m][1]));
        } else {
            const int col0 = 256 * (pn - 24) + wc * 32 + 8 * fq;
            f32x4 bv[2][2];
#pragma unroll
            for (int bj = 0; bj < 2; ++bj)
#pragma unroll
                for (int n = 0; n < 2; ++n) bv[bj][n] = *(const f32x4*)(bgate + col0 + bj * HALF + 4 * n);
#pragma unroll
            for (int ai = 0; ai < 2; ++ai)
#pragma unroll
                for (int m = 0; m < 4; ++m) { bf16_t* rowp = G + (size_t)(row0 + ai * HALF + m * 16) * 2048 + col0;
#pragma unroll
                    for (int bj = 0; bj < 2; ++bj) { f32x4 v[2];
#pragma unroll
                        for (int n = 0; n < 2; ++n) { const f32x4 z = (acc[ai][bj][m][n] + bv[bj][n]) * (-1.4426950408889634f);
#pragma unroll
                            for (int e = 0; e < 4; ++e) v[n][e] = __builtin_amdgcn_rcpf(1.0f + __builtin_amdgcn_exp2f(z[e])); }
                        st16(rowp + bj * HALF, pack8(v[0], v[1])); } }
        }
    }
};
template <bool ADD> struct EpiGate {
    static constexpr bool PERM = true, AFTER_DRAIN = false;
    const bf16_t* G; bf16_t* MG; int goff;
    __device__ __forceinline__ void operator()(const f32x4 (&acc)[2][2][4][2], const Unit& u, int wr, int wc, int fr, int fq) const {
        const int row0 = u.pm * BM + wr * 64 + fr, col0 = u.pn * BM + wc * 32 + 8 * fq;
#pragma unroll
        for (int ai = 0; ai < 2; ++ai)
#pragma unroll
            for (int m = 0; m < 4; ++m) { const size_t r = (size_t)(row0 + ai * HALF + m * 16);
#pragma unroll
                for (int bj = 0; bj < 2; ++bj) { f32x4 g0, g1; unpack8(*(const u32x4*)(G + r * 2048 + goff + col0 + bj * HALF), g0, g1);
                    f32x4 v0 = acc[ai][bj][m][0] * g0, v1 = acc[ai][bj][m][1] * g1;
                    bf16_t* p = MG + r * 1024 + col0 + bj * HALF;
                    if (ADD) { f32x4 a0, a1; unpack8(*(const u32x4*)p, a0, a1); v0 += a0; v1 += a1; }
                    *(u32x4*)p = pack8(v0, v1); } }
    }
};
struct PairOrder {
    StaticOrder S;
    __device__ bool next(int i, Unit& u) const { Unit b; if (!S.next(i >> 1, b)) return false; u.pm = b.pm + ((i & 1) ? 64 : 0); u.pn = b.pn + ((i & 1) ? 4 : 0); return true; }
    __device__ __forceinline__ void a_ready(const Unit&) const {}
    __device__ __forceinline__ void done(const Unit&) const {}
};
struct EpiGate2 {
    static constexpr bool PERM = true, AFTER_DRAIN = false;
    const bf16_t* G; bf16_t* MG;
    __device__ __forceinline__ void operator()(const f32x4 (&acc)[2][2][4][2], const Unit& u, int wr, int wc, int fr, int fq) const {
        const bool second = u.pm >= 64; const int pm = second ? u.pm - 64 : u.pm, pn = second ? u.pn - 4 : u.pn, goff = second ? 0 : 1024;
        const int row0 = pm * BM + wr * 64 + fr, col0 = pn * BM + wc * 32 + 8 * fq;
#pragma unroll
        for (int ai = 0; ai < 2; ++ai) {
            u32x4 gl[4][2], ml[4][2];
#pragma unroll
            for (int m = 0; m < 4; ++m) { const size_t r = (size_t)(row0 + ai * HALF + m * 16);
#pragma unroll
                for (int bj = 0; bj < 2; ++bj) { gl[m][bj] = *(const u32x4*)(G + r * 2048 + goff + col0 + bj * HALF); if (second) ml[m][bj] = *(const u32x4*)(MG + r * 1024 + col0 + bj * HALF); } }
#pragma unroll
            for (int m = 0; m < 4; ++m) { const size_t r = (size_t)(row0 + ai * HALF + m * 16);
#pragma unroll
                for (int bj = 0; bj < 2; ++bj) { f32x4 g0, g1; unpack8(gl[m][bj], g0, g1);
                    f32x4 v0 = acc[ai][bj][m][0] * g0, v1 = acc[ai][bj][m][1] * g1;
                    bf16_t* p = MG + r * 1024 + col0 + bj * HALF;
                    if (second) { f32x4 a0, a1; unpack8(ml[m][bj], a0, a1); v0 += a0; v1 += a1; } st16(p, pack8(v0, v1)); } }
        }
    }
};
#ifndef STORE_X1_F32
#define STORE_X1_F32 0
#endif
struct EpiRes1 {
    static constexpr bool PERM = false, AFTER_DRAIN = false;
    const float* x; float* out; bf16_t* x1b; float* SS;
    __device__ __forceinline__ void operator()(const f32x4 (&acc)[2][2][4][2], const Unit& u, int wr, int wc, int fr, int fq) const {
        const int row0 = u.pm * BM + wr * 64 + fr, col0 = u.pn * BM + wc * 32 + 4 * fq;
#pragma unroll
        for (int ai = 0; ai < 2; ++ai) {
            f32x4 xv[4][2][2];
#pragma unroll
            for (int m = 0; m < 4; ++m) { const size_t off = (size_t)(row0 + ai * HALF + m * 16) * 1024 + col0;
#pragma unroll
                for (int bj = 0; bj < 2; ++bj)
#pragma unroll
                    for (int n = 0; n < 2; ++n) xv[m][bj][n] = *(const f32x4*)(x + off + bj * HALF + n * 16); }
#pragma unroll
            for (int m = 0; m < 4; ++m) { const size_t r = (size_t)(row0 + ai * HALF + m * 16); const size_t off = r * 1024 + col0; float s = 0.f;
#pragma unroll
                for (int bj = 0; bj < 2; ++bj)
#pragma unroll
                    for (int n = 0; n < 2; ++n) { const f32x4 v = xv[m][bj][n] + acc[ai][bj][m][n];
                        if (STORE_X1_F32) *(f32x4*)(out + off + bj * HALF + n * 16) = v; s += (v[0] * v[0] + v[1] * v[1]) + (v[2] * v[2] + v[3] * v[3]);
                        u32x2 w; w.x = cvt_pk_bf16(v[0], v[1]); w.y = cvt_pk_bf16(v[2], v[3]); st8(x1b + off + bj * HALF + n * 16, w); }
                s += __shfl_xor(s, 16); s += __shfl_xor(s, 32);
                if (fq == 0) __hip_atomic_store(SS + r * 16 + 4 * u.pn + wc, s, __ATOMIC_RELAXED, __HIP_MEMORY_SCOPE_AGENT); }
            asm volatile("" ::: "memory");
        }
    }
};
struct EpiUp {
    static constexpr bool PERM = true, AFTER_DRAIN = false;
    const float* SS; bf16_t* UU;
    __device__ __forceinline__ void operator()(const f32x4 (&acc)[2][2][4][2], const Unit& u, int wr, int wc, int fr, int fq) const {
        const int row0 = u.pm * BM + wr * 64 + fr, col0 = u.pn * BM + wc * 32 + 8 * fq;
#pragma unroll
        for (int ai = 0; ai < 2; ++ai)
#pragma unroll
            for (int m = 0; m < 4; ++m) { const size_t r = (size_t)(row0 + ai * HALF + m * 16);
                const f32x4* sp = (const f32x4*)(SS + r * 16); const f32x4 s4 = (sp[0] + sp[1]) + (sp[2] + sp[3]);
                const float rs = 1.0f / sqrtf(((s4[0] + s4[1]) + (s4[2] + s4[3])) * (1.0f / 1024.0f) + RMS_EPS);
#pragma unroll
                for (int bj = 0; bj < 2; ++bj) { f32x4 v[2];
#pragma unroll
                    for (int n = 0; n < 2; ++n) { const f32x4 z = acc[ai][bj][m][n] * rs;
#pragma unroll
                        for (int e = 0; e < 4; ++e) { const float t = fmaxf(z[e], 0.f); v[n][e] = t * t; } }
                    st16(UU + r * 4096 + col0 + bj * HALF, pack8(v[0], v[1])); } }
    }
};
struct EpiRes2 {
    static constexpr bool PERM = false, AFTER_DRAIN = false;
    float* out; const bf16_t* x1b;
    __device__ __forceinline__ void operator()(const f32x4 (&acc)[2][2][4][2], const Unit& u, int wr, int wc, int fr, int fq) const {
        const int row0 = u.pm * BM + wr * 64 + fr, col0 = u.pn * BM + wc * 32 + 4 * fq;
#pragma unroll
        for (int ai = 0; ai < 2; ++ai)
#pragma unroll
            for (int m = 0; m < 4; ++m) { const size_t off = (size_t)(row0 + ai * HALF + m * 16) * 1024 + col0;
#pragma unroll
                for (int bj = 0; bj < 2; ++bj)
#pragma unroll
                    for (int n = 0; n < 2; ++n) { float* p = out + off + bj * HALF + n * 16;
#if STORE_X1_F32
                        const f32x4 b = *(const f32x4*)p;
#else
                        const u32x2 w = *(const u32x2*)(x1b + off + bj * HALF + n * 16); const f32x4 b = {bf_lo(w.x), bf_hi(w.x), bf_lo(w.y), bf_hi(w.y)};
#endif
                        *(f32x4*)p = b + acc[ai][bj][m][n]; }
                if (m == 3) asm volatile("" ::: "memory"); }
    }
};

template <class Epi, class Sched, bool ALIGN_EPI = false, bool SP2 = false>
__device__ __forceinline__ void gemm_phase(PG8_LAS unsigned char* lds, const Gemm g, const Sched& S, const Epi& E) {
    int tid_ = threadIdx.x; asm volatile("" : "+v"(tid_));
    const int tid = tid_, wid = __builtin_amdgcn_readfirstlane(tid >> 6), lane = tid & 63, wr = wid >> 2, wc = wid & 3, fr = lane & 15, fq = lane >> 4;
    const int K = g.K, nt = K / BK;
    unsigned voffA[2], voffB[2];
#pragma unroll
    for (int i = 0; i < 2; ++i) { int R, C; stage_rc(tid * 16 + i * 8192, R, C); const int Rb = Epi::PERM ? ((R & ~31) + perm32(R & 31)) : R;
        voffA[i] = (unsigned)(R * K + C) * 2u; voffB[i] = (unsigned)(Rb * K + C) * 2u; }
    const size_t kstep = (size_t)(BK * 2);
    const size_t hstep = (size_t)HALF * K * 2;
    const size_t tstep = 2 * hstep;
    const unsigned ldsw = (unsigned)wid * 1024u;
    const int aoff = lds_byte(wr * 64 + fr, fq * 8), boff = lds_byte(wc * 32 + fr, fq * 8);
#define PG8_SA(b, h) (((b) * 2 + (h)) * HTB)
#define PG8_SB(b, h) ((4 + (b) * 2 + (h)) * HTB)
#define PG8_STAGE(bufoff, gbase, voff) do { _Pragma("unroll") for (int _i = 0; _i < 2; ++_i) \
        __builtin_amdgcn_global_load_lds((const unsigned*)((const char*)(gbase) + (voff)[_i]), (PG8_LAS unsigned*)(lds + (bufoff) + ldsw + _i * 8192), 16, 0, 0); } while (0)
#define PG8_LDA(dst, b, h) do { _Pragma("unroll") for (int m = 0; m < 4; ++m) _Pragma("unroll") for (int k = 0; k < 2; ++k) dst[m][k] = *(const PG8_LAS bf16x8*)(lds + PG8_SA(b, h) + aoff + m * 2048 + k * 1024); } while (0)
#define PG8_LDB(dst, b, h) do { _Pragma("unroll") for (int n = 0; n < 2; ++n) _Pragma("unroll") for (int k = 0; k < 2; ++k) dst[n][k] = *(const PG8_LAS bf16x8*)(lds + PG8_SB(b, h) + boff + n * 2048 + k * 1024); } while (0)
#define PG8_MMA(ai, bj, At, Bt) do { __builtin_amdgcn_s_setprio(1); _Pragma("unroll") for (int m = 0; m < 4; ++m) _Pragma("unroll") for (int n = 0; n < 2; ++n) _Pragma("unroll") for (int k = 0; k < 2; ++k) \
        acc[ai][bj][m][n] = __builtin_amdgcn_mfma_f32_16x16x32_bf16(Bt[n][k], At[m][k], acc[ai][bj][m][n], 0, 0, 0); __builtin_amdgcn_s_setprio(0); } while (0)
#define PG8_WAIT_V(n) asm volatile("s_waitcnt vmcnt(" #n ")" ::: "memory")
#define PG8_WAIT_L(n) asm volatile("s_waitcnt lgkmcnt(" #n ")" ::: "memory")
#define PG8_BAR __builtin_amdgcn_s_barrier()
#define PG8_SCHED __builtin_amdgcn_sched_barrier(0)
    Unit cur, nxt; int ui = 0;
    if (!S.next(0, cur)) return;
    f32x4 acc[2][2][4][2];
#pragma unroll
    for (int a = 0; a < 2; ++a)
#pragma unroll
        for (int b = 0; b < 2; ++b)
#pragma unroll
            for (int m = 0; m < 4; ++m)
#pragma unroll
                for (int n = 0; n < 2; ++n) acc[a][b][m][n] = (f32x4){0.f, 0.f, 0.f, 0.f};
    bf16x8 At[4][2], B0[2][2], B1[2][2];
    const char* cA = (const char*)g.A + (size_t)cur.pm * tstep; const char* cB = (const char*)g.Bt + (size_t)cur.pn * tstep;
    S.a_ready(cur);
    if constexpr (SP2) {
        PG8_STAGE(PG8_SB(0, 0), cB, voffB); PG8_STAGE(PG8_SB(0, 1), cB + hstep, voffB); PG8_STAGE(PG8_SA(0, 0), cA, voffA); PG8_STAGE(PG8_SA(0, 1), cA + hstep, voffA);
        if (wr == 1) PG8_BAR;
        PG8_WAIT_V(2); PG8_BAR;
        PG8_STAGE(PG8_SB(1, 0), cB + kstep, voffB); PG8_STAGE(PG8_SA(1, 0), cA + kstep, voffA); PG8_STAGE(PG8_SB(1, 1), cB + hstep + kstep, voffB);
        PG8_WAIT_V(6); PG8_BAR;
    } else {
        PG8_STAGE(PG8_SB(0, 0), cB, voffB); PG8_STAGE(PG8_SA(0, 0), cA, voffA); PG8_STAGE(PG8_SB(0, 1), cB + hstep, voffB); PG8_STAGE(PG8_SA(0, 1), cA + hstep, voffA);
        if (wr == 1) PG8_BAR;
        PG8_WAIT_V(4); PG8_BAR;
        PG8_STAGE(PG8_SB(1, 0), cB + kstep, voffB); PG8_STAGE(PG8_SA(1, 0), cA + kstep, voffA); PG8_STAGE(PG8_SB(1, 1), cB + hstep + kstep, voffB);
        PG8_WAIT_V(6); PG8_BAR;
    }
    for (;;) {
        const bool has_next = S.next(ui + 1, nxt);
        const char* nA = has_next ? (const char*)g.A + (size_t)nxt.pm * tstep : cA; const char* nB = has_next ? (const char*)g.Bt + (size_t)nxt.pn * tstep : cB;
        for (int t = 0; t < nt; t += 2) {
            const bool last = (t == nt - 2);
            const char* a1 = cA + (size_t)(t + 1) * kstep;
            const char* a2 = last ? nA : cA + (size_t)(t + 2) * kstep; const char* b2 = last ? nB : cB + (size_t)(t + 2) * kstep;
            const char* a3 = a2 + kstep; const char* b3 = b2 + kstep;
            if (last && has_next) S.a_ready(nxt);
            if constexpr (SP2) {
            PG8_LDB(B0, 0, 0); PG8_LDB(B1, 0, 1); PG8_SCHED; PG8_LDA(At, 0, 0); PG8_STAGE(PG8_SA(1, 1), a1 + hstep, voffA);
            PG8_WAIT_V(8); PG8_WAIT_L(0); PG8_BAR; PG8_MMA(0, 0, At, B0); PG8_MMA(0, 1, At, B1); PG8_BAR; PG8_SCHED;
            PG8_LDA(At, 0, 1); PG8_STAGE(PG8_SB(0, 0), b2, voffB); PG8_STAGE(PG8_SB(0, 1), b2 + hstep, voffB); PG8_STAGE(PG8_SA(0, 0), a2, voffA);
            PG8_WAIT_V(8); PG8_WAIT_L(0); PG8_BAR; PG8_MMA(1, 0, At, B0); PG8_MMA(1, 1, At, B1); PG8_BAR; PG8_SCHED;
            PG8_LDB(B0, 1, 0); PG8_LDB(B1, 1, 1); PG8_SCHED; PG8_LDA(At, 1, 0); PG8_STAGE(PG8_SA(0, 1), a2 + hstep, voffA);
            PG8_WAIT_V(8); PG8_WAIT_L(0); PG8_BAR; PG8_MMA(0, 0, At, B0); PG8_MMA(0, 1, At, B1); PG8_BAR; PG8_SCHED;
            PG8_LDA(At, 1, 1); PG8_STAGE(PG8_SB(1, 0), b3, voffB); PG8_STAGE(PG8_SB(1, 1), b3 + hstep, voffB); PG8_STAGE(PG8_SA(1, 0), a3, voffA);
            PG8_WAIT_V(8); PG8_WAIT_L(0); PG8_BAR; PG8_MMA(1, 0, At, B0); PG8_MMA(1, 1, At, B1); PG8_BAR; PG8_SCHED;
            } else {
            PG8_LDB(B0, 0, 0); PG8_SCHED; PG8_LDA(At, 0, 0); PG8_STAGE(PG8_SA(1, 1), a1 + hstep, voffA);
            PG8_WAIT_L(8); PG8_BAR; PG8_WAIT_L(0); PG8_MMA(0, 0, At, B0); PG8_BAR; PG8_SCHED;
            PG8_LDB(B1, 0, 1); PG8_STAGE(PG8_SB(0, 0), b2, voffB);
            PG8_BAR; PG8_WAIT_L(0); PG8_MMA(0, 1, At, B1); PG8_BAR;
            PG8_LDA(At, 0, 1); PG8_STAGE(PG8_SA(0, 0), a2, voffA);
            PG8_BAR; PG8_WAIT_L(0); PG8_MMA(1, 0, At, B0); PG8_BAR; PG8_SCHED;
            PG8_STAGE(PG8_SB(0, 1), b2 + hstep, voffB);
            PG8_WAIT_V(6); PG8_BAR; PG8_MMA(1, 1, At, B1); PG8_BAR;
            PG8_LDB(B0, 1, 0); PG8_SCHED; PG8_LDA(At, 1, 0); PG8_STAGE(PG8_SA(0, 1), a2 + hstep, voffA);
            PG8_WAIT_L(8); PG8_BAR; PG8_WAIT_L(0); PG8_MMA(0, 0, At, B0); PG8_BAR; PG8_SCHED;
            PG8_LDB(B1, 1, 1); PG8_STAGE(PG8_SB(1, 0), b3, voffB);
            PG8_BAR; PG8_WAIT_L(0); PG8_MMA(0, 1, At, B1); PG8_BAR;
            PG8_LDA(At, 1, 1); PG8_STAGE(PG8_SA(1, 0), a3, voffA);
            PG8_BAR; PG8_WAIT_L(0); PG8_MMA(1, 0, At, B0); PG8_BAR; PG8_SCHED;
            PG8_STAGE(PG8_SB(1, 1), b3 + hstep, voffB);
            PG8_WAIT_V(6); PG8_BAR; PG8_MMA(1, 1, At, B1); PG8_BAR;
            }
        }
        if constexpr (ALIGN_EPI) { if (wr == 0) PG8_BAR; }
        if constexpr (!Epi::AFTER_DRAIN) { E(acc, cur, wr, wc, fr, fq); S.done(cur); }
        if (!has_next) break;
#pragma unroll
        for (int a = 0; a < 2; ++a)
#pragma unroll
            for (int b = 0; b < 2; ++b)
#pragma unroll
                for (int m = 0; m < 4; ++m)
#pragma unroll
                    for (int n = 0; n < 2; ++n) acc[a][b][m][n] = (f32x4){0.f, 0.f, 0.f, 0.f};
        cur = nxt; cA = nA; cB = nB; ++ui;
        if constexpr (ALIGN_EPI) { if (wr == 1) PG8_BAR; }
    }
    PG8_WAIT_V(0);
    if constexpr (!ALIGN_EPI) { if (wr == 0) PG8_BAR; }
    PG8_BAR;
    if constexpr (Epi::AFTER_DRAIN) { E.fused(acc, cur, wr, wc, fr, fq, lds, wid, lane); S.done(cur); }
#undef PG8_SA
#undef PG8_SB
#undef PG8_STAGE
#undef PG8_LDA
#undef PG8_LDB
#undef PG8_MMA
#undef PG8_WAIT_V
#undef PG8_WAIT_L
#undef PG8_BAR
#undef PG8_SCHED
}
}

namespace attn {
using bf16 = unsigned short;
using bf16x8 = __attribute__((ext_vector_type(8))) short;
using s16x4 = __attribute__((ext_vector_type(4))) short;
using f32x16 = __attribute__((ext_vector_type(16))) float;
using u32x4 = __attribute__((ext_vector_type(4))) unsigned;
using f32x4 = __attribute__((ext_vector_type(4))) float;
constexpr int SEQ = 4096, DM = 1024, NSLOT = 6, SLOTB = 8192, NREL = 513;
constexpr int LDS_K = 0, LDS_V = NSLOT * SLOTB, LDS_WS = 2 * NSLOT * SLOTB, LDS_OST = LDS_WS + 8 * 64 * 4, LDS_BIAS = LDS_OST + 8 * 4096, BIAS_CS = 400  , LDS_BYTES = LDS_BIAS + 4 * BIAS_CS * 4;
constexpr float LOG2E = 1.4426950408889634f;
__device__ __forceinline__ int crow(int r, int hi) { return (r & 3) + 8 * (r >> 2) + 4 * hi; }
#define SBAR() __builtin_amdgcn_sched_barrier(0)
__device__ __forceinline__ void glds16(const void* gsrc, unsigned lds_dst) { unsigned keep;
  asm volatile("s_mov_b32 %0, m0\n\ts_mov_b32 m0, %2\n\ts_nop 0\n\tglobal_load_lds_dwordx4 %1, off\n\ts_mov_b32 m0, %0" : "=&s"(keep) : "v"(gsrc), "s"(lds_dst) : "memory"); }
typedef float f32x2_t __attribute__((ext_vector_type(2))); typedef __bf16 bf16x2_t __attribute__((ext_vector_type(2)));
__device__ __forceinline__ unsigned cvtpk_s(float lo, float hi) { f32x2_t v = {lo, hi}; bf16x2_t b = __builtin_convertvector(v, bf16x2_t); return __builtin_bit_cast(unsigned, b); }
typedef __attribute__((address_space(3))) const char* lds_cptr;
__device__ __forceinline__ void kload8(bf16x8* kf, lds_cptr kp) {
  kf[0] = *(const __attribute__((address_space(3))) bf16x8*)(kp);        kf[1] = *(const __attribute__((address_space(3))) bf16x8*)(kp + 512);
  kf[2] = *(const __attribute__((address_space(3))) bf16x8*)(kp + 2048); kf[3] = *(const __attribute__((address_space(3))) bf16x8*)(kp + 2560);
  kf[4] = *(const __attribute__((address_space(3))) bf16x8*)(kp + 4096); kf[5] = *(const __attribute__((address_space(3))) bf16x8*)(kp + 4608);
  kf[6] = *(const __attribute__((address_space(3))) bf16x8*)(kp + 6144); kf[7] = *(const __attribute__((address_space(3))) bf16x8*)(kp + 6656);
}
__device__ __forceinline__ void pv(f32x16* o, int vb, bf16x8 pa0, bf16x8 pa1, bf16x8 pa2, bf16x8 pa3) {
  #pragma unroll
  for (int d0 = 0; d0 < 2; ++d0) { s16x4 lo[4], hi[4];
    #pragma unroll
    for (int ks = 0; ks < 4; ++ks) {
      asm volatile("ds_read_b64_tr_b16 %0,%1 offset:%c2" : "=&v"(lo[ks]) : "v"(vb), "i"(d0 * 4096 + ks * 1024) : "memory");
      asm volatile("ds_read_b64_tr_b16 %0,%1 offset:%c2" : "=&v"(hi[ks]) : "v"(vb), "i"(d0 * 4096 + ks * 1024 + 512) : "memory"); }
    asm volatile("s_waitcnt lgkmcnt(0)" ::: "memory"); SBAR();
    #define PK(k) (bf16x8){lo[k][0], lo[k][1], lo[k][2], lo[k][3], hi[k][0], hi[k][1], hi[k][2], hi[k][3]}
    o[d0] = __builtin_amdgcn_mfma_f32_32x32x16_bf16(pa0, PK(0), o[d0], 0, 0, 0);
    o[d0] = __builtin_amdgcn_mfma_f32_32x32x16_bf16(pa1, PK(1), o[d0], 0, 0, 0);
    o[d0] = __builtin_amdgcn_mfma_f32_32x32x16_bf16(pa2, PK(2), o[d0], 0, 0, 0);
    o[d0] = __builtin_amdgcn_mfma_f32_32x32x16_bf16(pa3, PK(3), o[d0], 0, 0, 0);
    #undef PK
  }
}
__device__ __forceinline__ float wmax(float v) {
#pragma unroll
  for (int o = 1; o < 64; o <<= 1) v = fmaxf(v, __shfl_xor(v, o));
  return v;
}
__device__ __forceinline__ void attn_unit(int b, int h, int g, const bf16* Q, const bf16* __restrict__ K, const bf16* __restrict__ V, bf16* O,
                                          const float* __restrict__ relb, const float* __restrict__ gq, const float* __restrict__ gk, char* shm) {
  int tid_ = threadIdx.x; asm volatile("" : "+v"(tid_));
  const int tid = tid_, lane = tid & 63, r32 = lane & 31, hi = lane >> 5; const int wid = __builtin_amdgcn_readfirstlane(tid >> 6);
  const long rowbase = (long)b * SEQ; const int q0 = g * 256;
  const int kc_lo = (4 * g - 8) > 0 ? (4 * g - 8) : 0, NT = 4 * g + 4 - kc_lo;
  const bf16* Qw = Q + (rowbase + q0 + wid * 32) * DM + h * 64;
  const bf16* Kh = K + (rowbase + 64 * kc_lo) * DM + h * 64; const bf16* Vh = V + (rowbase + 64 * kc_lo) * DM + h * 64;
  const unsigned lds0 = (unsigned)(uintptr_t)shm;
  float* wsf = (float*)(shm + LDS_WS) + wid * 64;
  float* biasT = (float*)(shm + LDS_BIAS);
  const bf16* ksrc = Kh + (long)lane * DM + wid * 8;
  const bf16* vsrc = Vh + (long)(16 * (wid & 3) + (lane >> 2)) * DM + (wid >> 2) * 32 + (lane & 3) * 8;
  const unsigned kdst = lds0 + LDS_K + wid * 1024, vdst = lds0 + LDS_V + wid * 1024;
  #define DMA_K(t, slot) glds16(ksrc + (long)(t) * 64 * DM, (unsigned)__builtin_amdgcn_readfirstlane(kdst + (slot)))
  #define DMA_V(t, slot) glds16(vsrc + (long)(t) * 64 * DM, (unsigned)__builtin_amdgcn_readfirstlane(vdst + (slot)))
  const int vb0 = (int)(lds0 + LDS_V) + ((lane >> 4) & 1) * 32 + (lane & 3) * 8 + (4 * hi + ((lane & 15) >> 2)) * 64;
  const lds_cptr shm3 = (lds_cptr)shm; const lds_cptr kp0 = shm3 + LDS_K + hi * 1024 + r32 * 16;
  const bool full = (g >= 2); const int nsteps = full ? 9 : NT;
  #define LOAD_TILE(i) (full ? ((i) < 6 ? (((i) & 1) ? ((i) >> 1) + 9 : ((i) >> 1)) : (i) - 3) : (i))
  #define ISSUE_LOAD(i) do { const int i_ = (i); const int tl_ = LOAD_TILE(i_); const int sb_ = (i_ % NSLOT) * SLOTB; DMA_K(tl_, sb_); DMA_V(tl_, sb_); } while (0)
  ISSUE_LOAD(0); ISSUE_LOAD(1); if (full) { ISSUE_LOAD(2); ISSUE_LOAD(3); }
  bf16x8 qr[4];
  #pragma unroll
  for (int d0 = 0; d0 < 4; ++d0) qr[d0] = *reinterpret_cast<const bf16x8*>(&Qw[(long)r32 * DM + d0 * 16 + hi * 8]);
  float m2;
  { const float mq = wmax(fabsf(gq[lane])), mk = wmax(fabsf(gk[lane])); float mb = -3.0e38f;
    for (int i = lane; i < NREL; i += 64) mb = fmaxf(mb, relb[h * NREL + i]);
    mb = wmax(mb); m2 = (8.0f * mq * mk + mb) * LOG2E; }
  for (int i = tid; i < 4 * 384; i += 512) { const int c = i / 384, j = i - c * 384, e = j + c; biasT[c * BIAS_CS + j] = (e < 384 ? relb[h * NREL + (e < 64 ? 512 : 576 - e)] : 0.f) * LOG2E - m2; }
  f32x16 o[2]; o[0] = f32x16{}; o[1] = f32x16{}; f32x16 lsum = f32x16{};
  const int qpos = 32 * (wid & 1) + r32;
  const int cch = 4 * g + (wid >> 1);
  asm volatile("s_waitcnt vmcnt(0) lgkmcnt(0)\n\ts_barrier" ::: "memory");
  for (int s = 0; s < nsteps; ++s) {
    int nis = 0;
    if (s + 2 < nsteps) { const int s2 = s + 2; if (full) { if (s2 < 3) { ISSUE_LOAD(2 * s2); ISSUE_LOAD(2 * s2 + 1); nis = 2; } else { ISSUE_LOAD(s2 + 3); nis = 1; } } else { ISSUE_LOAD(s2); nis = 1; } }
    int jrel = kc_lo + s - cch + 8, ld = full ? (s < 3 ? 2 * s : s + 3) : s;
    if (full && s < 3 && jrel < 0) { jrel += 9; ld += 1; }
    const int sl_cur = (ld % NSLOT) * SLOTB;
    if (jrel >= 0 && jrel <= 8) {
      s16x4 vlo[8], vhi[8]; { const int vb = vb0 + sl_cur;
        #pragma unroll
        for (int i_ = 0; i_ < 8; ++i_) {
          asm volatile("ds_read_b64_tr_b16 %0,%1 offset:%c2" : "=&v"(vlo[i_]) : "v"(vb), "i"((i_ >> 2) * 4096 + (i_ & 3) * 1024) : "memory");
          asm volatile("ds_read_b64_tr_b16 %0,%1 offset:%c2" : "=&v"(vhi[i_]) : "v"(vb), "i"((i_ >> 2) * 4096 + (i_ & 3) * 1024 + 512) : "memory"); } }
      f32x16 p0, p1;
      if (jrel <= 3) { const float c0 = biasT[0];
        #pragma unroll
        for (int r = 0; r < 16; ++r) { p0[r] = c0; p1[r] = c0; } }
      else { const int i0 = 64 + 4 * hi - qpos + 64 * (jrel - 4), cs = i0 & 3; const f32x4* a4 = (const f32x4*)(biasT + cs * BIAS_CS + (i0 - cs));
        #pragma unroll
        for (int q4 = 0; q4 < 4; ++q4) { const f32x4 b0 = a4[2 * q4], b1 = a4[2 * q4 + 8];
          #pragma unroll
          for (int e = 0; e < 4; ++e) { p0[4 * q4 + e] = b0[e]; p1[4 * q4 + e] = b1[e]; } } }
      bf16x8 kf[8]; kload8(kf, kp0 + sl_cur);
      #pragma unroll
      for (int d0 = 0; d0 < 4; ++d0) { p0 = __builtin_amdgcn_mfma_f32_32x32x16_bf16(kf[2 * d0], qr[d0], p0, 0, 0, 0); p1 = __builtin_amdgcn_mfma_f32_32x32x16_bf16(kf[2 * d0 + 1], qr[d0], p1, 0, 0, 0); }
      #pragma unroll
      for (int r = 0; r < 16; ++r) { p0[r] = __builtin_amdgcn_exp2f(p0[r]); p1[r] = __builtin_amdgcn_exp2f(p1[r]); }
      lsum += p0 + p1;
      u32x4 pw0, pw1, pw2, pw3;
      pw0 = (u32x4){cvtpk_s(p0[0], p0[1]), cvtpk_s(p0[2], p0[3]), cvtpk_s(p0[4], p0[5]), cvtpk_s(p0[6], p0[7])};
      pw1 = (u32x4){cvtpk_s(p0[8], p0[9]), cvtpk_s(p0[10], p0[11]), cvtpk_s(p0[12], p0[13]), cvtpk_s(p0[14], p0[15])};
      pw2 = (u32x4){cvtpk_s(p1[0], p1[1]), cvtpk_s(p1[2], p1[3]), cvtpk_s(p1[4], p1[5]), cvtpk_s(p1[6], p1[7])};
      pw3 = (u32x4){cvtpk_s(p1[8], p1[9]), cvtpk_s(p1[10], p1[11]), cvtpk_s(p1[12], p1[13]), cvtpk_s(p1[14], p1[15])};
      SBAR();
      asm volatile("s_waitcnt lgkmcnt(0)" ::: "memory"); SBAR();
      #define VF(i_) (bf16x8){vlo[i_][0], vlo[i_][1], vlo[i_][2], vlo[i_][3], vhi[i_][0], vhi[i_][1], vhi[i_][2], vhi[i_][3]}
      o[0] = __builtin_amdgcn_mfma_f32_32x32x16_bf16(__builtin_bit_cast(bf16x8, pw0), VF(0), o[0], 0, 0, 0); o[1] = __builtin_amdgcn_mfma_f32_32x32x16_bf16(__builtin_bit_cast(bf16x8, pw0), VF(4), o[1], 0, 0, 0);
      o[0] = __builtin_amdgcn_mfma_f32_32x32x16_bf16(__builtin_bit_cast(bf16x8, pw1), VF(1), o[0], 0, 0, 0); o[1] = __builtin_amdgcn_mfma_f32_32x32x16_bf16(__builtin_bit_cast(bf16x8, pw1), VF(5), o[1], 0, 0, 0);
      o[0] = __builtin_amdgcn_mfma_f32_32x32x16_bf16(__builtin_bit_cast(bf16x8, pw2), VF(2), o[0], 0, 0, 0); o[1] = __builtin_amdgcn_mfma_f32_32x32x16_bf16(__builtin_bit_cast(bf16x8, pw2), VF(6), o[1], 0, 0, 0);
      o[0] = __builtin_amdgcn_mfma_f32_32x32x16_bf16(__builtin_bit_cast(bf16x8, pw3), VF(3), o[0], 0, 0, 0); o[1] = __builtin_amdgcn_mfma_f32_32x32x16_bf16(__builtin_bit_cast(bf16x8, pw3), VF(7), o[1], 0, 0, 0);
      #undef VF
    }
    if (nis == 2)      asm volatile("s_waitcnt vmcnt(4) lgkmcnt(0)\n\ts_barrier" ::: "memory");
    else if (nis == 1) asm volatile("s_waitcnt vmcnt(2) lgkmcnt(0)\n\ts_barrier" ::: "memory");
    else               asm volatile("s_waitcnt vmcnt(0) lgkmcnt(0)\n\ts_barrier" ::: "memory");
  }
  #undef LOAD_TILE
  #undef ISSUE_LOAD
  float l_reg = 0.f;
  #pragma unroll
  for (int r = 0; r < 16; ++r) l_reg += lsum[r];
  { auto rr = __builtin_amdgcn_permlane32_swap(__float_as_uint(l_reg), __float_as_uint(l_reg), false, false); l_reg = __uint_as_float(rr[0]) + __uint_as_float(rr[1]); }
  if (hi == 0) wsf[32 + r32] = l_reg; asm volatile("s_waitcnt lgkmcnt(0)" ::: "memory");
  float rli[16];
  #pragma unroll
  for (int r = 0; r < 16; ++r) rli[r] = __builtin_amdgcn_rcpf(wsf[32 + crow(r, hi)]);
  bf16* Ow = O + (rowbase + q0 + wid * 32) * DM + h * 64;
  { bf16* stg = (bf16*)(shm + LDS_OST) + wid * 2048;
    #pragma unroll
    for (int r = 0; r < 16; ++r) { const int orow = crow(r, hi);
      #pragma unroll
      for (int d0 = 0; d0 < 2; ++d0) stg[orow * 64 + d0 * 32 + r32] = (bf16)(cvtpk_s(o[d0][r] * rli[r], 0.f) & 0xffffu); }
    asm volatile("s_waitcnt lgkmcnt(0)" ::: "memory");
    #pragma unroll
    for (int i = 0; i < 4; ++i) { const int row = i * 8 + (lane >> 3), ch = lane & 7; const u32x4 v = *(const u32x4*)(stg + row * 64 + ch * 8); pg8::st16(Ow + (long)row * DM + ch * 8, v); } }
  asm volatile("s_waitcnt lgkmcnt(0)\n\ts_barrier" ::: "memory");
  #undef DMA_K
  #undef DMA_V
}
#undef SBAR
}

#define GAS __attribute__((address_space(1)))
#define LAS __attribute__((address_space(3)))
typedef unsigned short bf16;
typedef unsigned v4u __attribute__((ext_vector_type(4)));
typedef float f32x4 __attribute__((ext_vector_type(4)));
typedef short bf16x8 __attribute__((ext_vector_type(8)));
typedef GAS unsigned gu32;
typedef GAS unsigned long long gu64;
#define RLX_AGENT __ATOMIC_RELAXED, __HIP_MEMORY_SCOPE_AGENT
#define LDS_WAIT() asm volatile("s_waitcnt lgkmcnt(0)" ::: "memory")
#define VM_WAIT() asm volatile("s_waitcnt vmcnt(0)" ::: "memory")
__device__ __forceinline__ unsigned long long rt() { return __builtin_amdgcn_s_memrealtime(); }
#define XB_TMO      128
#define XB_XCNT(j)  (256  + 64 * (j))
#define XB_XSUB(j)  (1280 + 64 * (j))
#define XB_XGEN(j)  (2304 + 64 * (j))
#define XB_TOP      3328
#define XB_TOPGEN   3392
#define XCD_BAR_WORDS 3456
#define XB_SPIN_CAP (1u << 18)

__device__ __forceinline__ unsigned xb_ld(unsigned* p)              { return __hip_atomic_load(p, __ATOMIC_RELAXED, __HIP_MEMORY_SCOPE_AGENT); }
__device__ __forceinline__ unsigned xb_add(unsigned* p, unsigned v) { return __hip_atomic_fetch_add(p, v, __ATOMIC_RELAXED, __HIP_MEMORY_SCOPE_AGENT); }
__device__ __forceinline__ unsigned xb_xcc_id() { return (unsigned)__builtin_amdgcn_s_getreg((3 << 11) | 20) & 0xFu; }
#define XB_SPIN(cond, bar) do { unsigned _sp = 0; while (cond) { __builtin_amdgcn_s_sleep(1); \
    if ((++_sp & 255u) == 0u) { if (xb_ld(&(bar)[XB_TMO])) break; if (_sp > XB_SPIN_CAP) { atomicAdd(&(bar)[XB_TMO], 1u); break; } } } } while (0)

struct XcdBarrier {
    unsigned* bar; unsigned x;
    volatile LAS unsigned* st;
};

__device__ __forceinline__ XcdBarrier xcd_barrier_post(unsigned* bar, volatile LAS unsigned* st) {
    XcdBarrier b; b.bar = bar; b.x = xb_xcc_id(); b.st = st;
    if (threadIdx.x == 0) (void)xb_add(&bar[XB_XCNT(b.x)], 1u);
    return b;
}
__device__ __forceinline__ void xcd_barrier_complete(unsigned* bar, unsigned x, unsigned& nloc, unsigned& nx) {
    const unsigned G = gridDim.x * gridDim.y * gridDim.z;
    unsigned sum, cnt, mine, sp = 0u;
    for (;;) {
        sum = 0u; cnt = 0u; mine = 0u;
#pragma unroll
        for (unsigned j = 0; j < 16; ++j) { const unsigned c = xb_ld(&bar[XB_XCNT(j)]); sum += c; cnt += (c > 0u) ? 1u : 0u; mine = (j == x) ? c : mine; }
        if (sum == G) break;
        __builtin_amdgcn_s_sleep(1);
        if ((++sp & 255u) == 0u) { if (xb_ld(&bar[XB_TMO])) break; if (sp > XB_SPIN_CAP) { atomicAdd(&bar[XB_TMO], 1u); break; } }
    }
    nloc = mine > 0u ? mine : 1u; nx = cnt > 0u ? cnt : 1u;
}

__device__ __forceinline__ void xcd_barrier(const XcdBarrier& b) {
    asm volatile("s_waitcnt vmcnt(0)" ::: "memory");
    __syncthreads();
    if (threadIdx.x == 0) {
        unsigned* bar = b.bar;
        __builtin_amdgcn_s_waitcnt(0);
        unsigned nloc = b.st[0], nx = b.st[1];
        if (nloc == 0u) { xcd_barrier_complete(bar, b.x, nloc, nx); b.st[0] = nloc; b.st[1] = nx; }
        __builtin_amdgcn_fence(__ATOMIC_RELEASE, "agent");
        asm volatile("s_waitcnt vmcnt(0)" ::: "memory");
        const unsigned old = xb_add(&bar[XB_XSUB(b.x)], 1u);
        const unsigned gen = old / nloc;
        if (old + 1u == (gen + 1u) * nloc) {
            __builtin_amdgcn_fence(__ATOMIC_RELEASE, "agent");
            asm volatile("s_waitcnt vmcnt(0)" ::: "memory");
            const unsigned og = xb_add(&bar[XB_TOP], 1u);
            const unsigned tg = og / nx;
            if (og + 1u == (tg + 1u) * nx) xb_add(&bar[XB_TOPGEN], 1u);
            else XB_SPIN(xb_ld(&bar[XB_TOPGEN]) == tg, bar);
            __builtin_amdgcn_fence(__ATOMIC_ACQUIRE, "agent");
            xb_add(&bar[XB_XGEN(b.x)], 1u);
            asm volatile("s_waitcnt vmcnt(0)" ::: "memory");
        } else {
            XB_SPIN(xb_ld(&bar[XB_XGEN(b.x)]) == gen, bar);
            __builtin_amdgcn_fence(__ATOMIC_ACQUIRE, "agent");
            asm volatile("s_waitcnt vmcnt(0)" ::: "memory");
        }
    }
    __syncthreads();
}
#include <hip/hip_cooperative_groups.h>
namespace cg = cooperative_groups;
constexpr int NWAVES = 8;
constexpr int BATCH = 4, SEQ = 4096, D = 1024, FF = 4096, M = BATCH * SEQ, NIN = 8192;
constexpr size_t MiB = 1u << 20;
constexpr size_t WS_SS = 1 * MiB;
constexpr size_t WS_W1 = 2 * MiB, WS_WC = 18 * MiB, WS_WA = 20 * MiB  , WS_WO = 22 * MiB, WS_WUP = 24 * MiB, WS_WDN = 32 * MiB;
constexpr size_t WS_V = 40 * MiB  , WS_H = 72 * MiB  , WS_Q = 104 * MiB, WS_K = 136 * MiB  , WS_BG = 168 * MiB  , WS_U1 = 200 * MiB;
constexpr size_t WS_UU = 72 * MiB;
constexpr size_t WS_END = 232 * MiB;
constexpr int LDS_BYTES = 147456;
constexpr int LDSCTL_OFF = 131072, MISC_OFF = LDSCTL_OFF + 320;
constexpr size_t WS_CTL = 0, CTL_ZERO_BYTES = 65536; constexpr int CW_BAR = 4096;
__device__ __forceinline__ unsigned f2bf(float f) { unsigned u = __builtin_bit_cast(unsigned, f); return (u + 0x7fffu + ((u >> 16) & 1u)) >> 16; }
__device__ __forceinline__ unsigned pk2(float lo, float hi) { return f2bf(lo) | (f2bf(hi) << 16); }
__device__ __forceinline__ float wave_sum(float v) {
#pragma unroll
    for (int o = 1; o < 64; o <<= 1) v += __shfl_xor(v, o);
    return v;
}
__device__ __forceinline__ void tr_item(const float* W, int ldw, int col0, int k0, bf16* WT, int Kd, int drow0, const float* kscale, LAS float* scr, int lane) {
    float tv[32];
#pragma unroll
    for (int i = 0; i < 32; ++i) { const int kk = 2 * i + (lane >> 5); tv[i] = W[(size_t)(k0 + kk) * ldw + col0 + (lane & 31)]; }
#pragma unroll
    for (int i = 0; i < 32; ++i) { const int kk = 2 * i + (lane >> 5); float v = tv[i]; if (kscale) v *= kscale[k0 + kk]; scr[kk * 33 + (lane & 31)] = v; }
    LDS_WAIT(); asm volatile("" ::: "memory");
    const int c = lane & 7;
#pragma unroll
    for (int j = 0; j < 4; ++j) { const int n = (lane >> 3) + 8 * j; const LAS float* s = scr + (8 * c) * 33 + n;
        v4u o; o.x = pk2(s[0 * 33], s[1 * 33]); o.y = pk2(s[2 * 33], s[3 * 33]); o.z = pk2(s[4 * 33], s[5 * 33]); o.w = pk2(s[6 * 33], s[7 * 33]);
        pg8::st16(WT + (size_t)(drow0 + n) * Kd + k0 + 8 * c, o); }
    LDS_WAIT(); asm volatile("" ::: "memory");
}

#ifndef PH_MASK
#define PH_MASK 127
#endif
#ifndef REP_P1
#define REP_P1 1
#endif
#ifndef REP_ATT
#define REP_ATT 1
#endif
#ifndef REP_P3
#define REP_P3 1
#endif
#ifndef REP_P4
#define REP_P4 1
#endif
#ifndef REP_P5
#define REP_P5 1
#endif
#ifndef EXTRA_SYNC
#define EXTRA_SYNC 0
#endif
__device__ unsigned g_panel_cnt[64 * 64];
__device__ unsigned g_bar_shard[16 * 64];
__device__ unsigned g_bar_cnt = 0u, g_bar_gen = 0u, g_done_cnt = 0u;
struct Args { const float* in[16]; float* out; unsigned char* ws; };
__global__ void __launch_bounds__(NWAVES * 64, 2) fwd(Args a) {
    extern __shared__ __attribute__((aligned(16))) unsigned char lds[];
    cg::grid_group grid = cg::this_grid();
    LAS unsigned char* ldsp = (LAS unsigned char*)lds;
    const int tid = threadIdx.x, lane = tid & 63, wave = __builtin_amdgcn_readfirstlane(tid >> 6);
    const int G = gridDim.x, bx = blockIdx.x, vcu = (G % 8 == 0) ? (bx % 8) * (G / 8) + bx / 8 : bx;
    unsigned char* ws = a.ws;
    const float* x = a.in[0];
    bf16 *W1 = (bf16*)(ws + WS_W1), *WA = (bf16*)(ws + WS_WA), *WC = (bf16*)(ws + WS_WC), *WO = (bf16*)(ws + WS_WO), *WUP = (bf16*)(ws + WS_WUP), *WDN = (bf16*)(ws + WS_WDN);
    bf16 *Vb = (bf16*)(ws + WS_V), *X1B = (bf16*)(ws + WS_V), *Hb = (bf16*)(ws + WS_H), *YC = (bf16*)(ws + WS_H)  , *Qb = (bf16*)(ws + WS_Q), *AO = (bf16*)(ws + WS_Q)  , *Kb = (bf16*)(ws + WS_K), *MG = (bf16*)(ws + WS_K);
    bf16 *BG = (bf16*)(ws + WS_BG), *U1 = (bf16*)(ws + WS_U1), *UU = (bf16*)(ws + WS_UU), *Gt = (bf16*)a.out;
    float* SS = (float*)(ws + WS_SS);
    for (int u = tid; u < (LDS_BYTES - LDSCTL_OFF) / 4; u += NWAVES * 64) ((LAS unsigned*)(ldsp + LDSCTL_OFF))[u] = 0u;
    __syncthreads();
    if (a.out == nullptr) grid.sync();
#ifndef WB_AT_SEAMS
#define WB_AT_SEAMS 0
#endif
#if WB_AT_SEAMS || !WT_STORES
#define BAR_RELEASE() do { __builtin_amdgcn_fence(__ATOMIC_RELEASE, "agent"); asm volatile("s_waitcnt vmcnt(0)" ::: "memory"); } while (0)
#else
#define BAR_RELEASE() do { } while (0)
#endif
#if defined(MONO_BAR)
    const bool grouped = (G == 256);
    const unsigned NSEAMS = (grouped ? 4u : 6u) + EXTRA_SYNC;
    unsigned bar_epoch = 0u, bar_base = 0u; const unsigned bar_xcc = xb_xcc_id();
#define GRID_BAR() do { asm volatile("s_waitcnt vmcnt(0)" ::: "memory"); __syncthreads(); \
    ++bar_epoch; \
    if (tid == 0) { \
        BAR_RELEASE(); \
        unsigned old_ = xb_add(&g_bar_shard[64u * bar_xcc], 1u);     \
        if (bar_epoch == 1u) asm volatile("s_waitcnt vmcnt(0)" : "+v"(old_) :: "memory");     \
        const unsigned tgt_ = bar_epoch * (unsigned)G; unsigned sp_ = 0u; \
        for (;;) { unsigned s_ = 0u; _Pragma("unroll") for (int j_ = 0; j_ < 16; ++j_) s_ += xb_ld(&g_bar_shard[64 * j_]); \
            if (bar_epoch == 1u && sp_ == 0u) bar_base = ((s_ - 1u) / (NSEAMS * (unsigned)G)) * (NSEAMS * (unsigned)G);     \
            if (s_ - bar_base >= tgt_) break; \
            __builtin_amdgcn_s_sleep(8); if (++sp_ > (1u << 22)) break; } \
        __builtin_amdgcn_fence(__ATOMIC_ACQUIRE, "agent"); asm volatile("s_waitcnt vmcnt(0)" ::: "memory"); } \
    __syncthreads(); } while (0)
    unsigned grp_epoch = 0u, grp_base = 0u;
#define GROUP_BAR(pm_) do { asm volatile("s_waitcnt vmcnt(0)" ::: "memory"); __syncthreads(); \
    ++grp_epoch; \
    if (tid == 0) { unsigned* pc_ = &g_panel_cnt[64 * (pm_)]; \
        BAR_RELEASE(); \
        const unsigned old_ = xb_add(pc_, 1u); \
        if (grp_epoch == 1u) grp_base = old_ - old_ % 8u; \
        const unsigned tgt_ = grp_epoch * 4u; unsigned sp_ = 0u; \
        while (xb_ld(pc_) - grp_base < tgt_) { __builtin_amdgcn_s_sleep(1); if (++sp_ > (1u << 22)) break; } \
        __builtin_amdgcn_fence(__ATOMIC_ACQUIRE, "agent"); asm volatile("s_waitcnt vmcnt(0)" ::: "memory"); } \
    __syncthreads(); } while (0)
#elif defined(GEN_BAR)
#define GRID_BAR() do { asm volatile("s_waitcnt vmcnt(0)" ::: "memory"); __syncthreads(); \
    if (tid == 0) { \
        __builtin_amdgcn_fence(__ATOMIC_RELEASE, "agent"); asm volatile("s_waitcnt vmcnt(0)" ::: "memory"); \
        unsigned g0_ = xb_ld(&g_bar_gen); asm volatile("s_waitcnt vmcnt(0)" : "+v"(g0_) :: "memory");            \
        unsigned old_ = xb_add(&g_bar_cnt, 1u); asm volatile("s_waitcnt vmcnt(0)" : "+v"(old_) :: "memory"); \
        if (old_ == (unsigned)G - 1u) { __hip_atomic_store(&g_bar_cnt, 0u, RLX_AGENT); asm volatile("s_waitcnt vmcnt(0)" ::: "memory"); xb_add(&g_bar_gen, 1u); } \
        else { unsigned sp_ = 0u; while (xb_ld(&g_bar_gen) == g0_) { __builtin_amdgcn_s_sleep(1); if (++sp_ > (1u << 22)) break; } } \
        __builtin_amdgcn_fence(__ATOMIC_ACQUIRE, "agent"); asm volatile("s_waitcnt vmcnt(0)" ::: "memory"); } \
    __syncthreads(); } while (0)
#elif defined(CG_ALL)
#define GRID_BAR() do { asm volatile("s_waitcnt vmcnt(0)" ::: "memory"); grid.sync(); } while (0)
#elif defined(SIMPLE_BAR)
    unsigned bar_epoch = 0u;
#define GRID_BAR() do { asm volatile("s_waitcnt vmcnt(0)" ::: "memory"); __syncthreads(); \
    ++bar_epoch; \
    if (tid == 0) { unsigned* cnt_ = (unsigned*)(ws + WS_CTL) + CW_BAR + XB_TOP; \
        __builtin_amdgcn_fence(__ATOMIC_RELEASE, "agent"); asm volatile("s_waitcnt vmcnt(0)" ::: "memory"); \
        xb_add(cnt_, 1u); unsigned sp_ = 0u; \
        while (xb_ld(cnt_) < bar_epoch * (unsigned)G) { __builtin_amdgcn_s_sleep(1); if (++sp_ > (1u << 22)) break; } \
        __builtin_amdgcn_fence(__ATOMIC_ACQUIRE, "agent"); asm volatile("s_waitcnt vmcnt(0)" ::: "memory"); } \
    __syncthreads(); } while (0)
#else
#define GRID_BAR() xcd_barrier(bar)
#endif

#ifndef DUP_P0
#define DUP_P0 1
#endif
    for (int rep0 = 0; rep0 < DUP_P0; ++rep0) {
        LAS float* scr = (LAS float*)(ldsp + wave * 16384);
        const int gw = vcu * NWAVES + wave, NGW = G * NWAVES;
        constexpr int I_1 = 16 * 256, I_S = 16 * 32, I_UP = 16 * 128, I_DN = 64 * 32, NITEMS = I_1 + 3 * I_S + I_UP + I_DN;
        for (int it = gw; it < NITEMS; it += NGW) {
            int r = it;
            if (r < I_1) { const int db = r & 255, kb = r >> 8, pn = db >> 3, pb = db & 7, bj = pb >> 2, wcc = pb & 3; const float* W = a.in[2]; int ldw = 6144, col;
                if (pn < 4) col = (4 * pn + wcc) * 64 + 32 * bj;
                else if (pn < 8) col = 1024 + (4 * (pn - 4) + wcc) * 64 + 32 * bj;
                else if (pn < 12) col = 2048 + 256 * (pn - 8) + 32 * pb;
                else if (pn < 16) col = 3072 + 256 * (pn - 12) + 32 * pb;
                else if (pn < 24) col = (bj ? 5120 : 4096) + 128 * (pn - 16) + 32 * wcc;
                else { W = a.in[10]; ldw = 2048; col = 256 * (pn - 24) + 32 * pb; }
                tr_item(W, ldw, col, 64 * kb, W1, D, 32 * db, nullptr, scr, lane); continue; } r -= I_1;
            if (r < I_S) { tr_item(a.in[8], D, 32 * (r & 31), 64 * (r >> 5), WA, D, 32 * (r & 31), nullptr, scr, lane); continue; } r -= I_S;
            if (r < I_S) { tr_item(a.in[9], D, 32 * (r & 31), 64 * (r >> 5), WC, D, 32 * (r & 31), nullptr, scr, lane); continue; } r -= I_S;
            if (r < I_S) { tr_item(a.in[12], D, 32 * (r & 31), 64 * (r >> 5), WO, D, 32 * (r & 31), nullptr, scr, lane); continue; } r -= I_S;
            if (r < I_UP) { tr_item(a.in[14], FF, 32 * (r & 127), 64 * (r >> 7), WUP, D, 32 * (r & 127), a.in[13], scr, lane); continue; } r -= I_UP;
            tr_item(a.in[15], D, 32 * (r & 31), 64 * (r >> 5), WDN, FF, 32 * (r & 31), nullptr, scr, lane);
        }
        const float* g1 = a.in[1];
        f32x4 gv[4];
#pragma unroll
        for (int j = 0; j < 4; ++j) gv[j] = ((const f32x4*)g1)[lane + 64 * j];
        for (int m0 = gw; m0 < M; m0 += 2 * NGW) {
            const int m1 = m0 + NGW;
            const bool has1 = m1 < M;
            const f32x4* xr0 = (const f32x4*)(x + (size_t)m0 * D) + lane; const f32x4* xr1 = (const f32x4*)(x + (size_t)(has1 ? m1 : m0) * D) + lane;
            f32x4 v0[4], v1[4]; float s0 = 0.f, s1 = 0.f;
#pragma unroll
            for (int j = 0; j < 4; ++j) { v0[j] = xr0[64 * j]; v1[j] = xr1[64 * j]; }
#pragma unroll
            for (int j = 0; j < 4; ++j) { s0 += (v0[j].x * v0[j].x + v0[j].y * v0[j].y) + (v0[j].z * v0[j].z + v0[j].w * v0[j].w); s1 += (v1[j].x * v1[j].x + v1[j].y * v1[j].y) + (v1[j].z * v1[j].z + v1[j].w * v1[j].w); }
            const float rs0 = 1.0f / sqrtf(wave_sum(s0) * (1.0f / D) + 1e-6f), rs1 = 1.0f / sqrtf(wave_sum(s1) * (1.0f / D) + 1e-6f);
            unsigned long long* o80 = (unsigned long long*)(Hb + (size_t)m0 * D) + lane; unsigned long long* o81 = (unsigned long long*)(Hb + (size_t)m1 * D) + lane;
#pragma unroll
            for (int j = 0; j < 4; ++j) { const f32x4 y = v0[j] * rs0 * gv[j]; pg8::st8(o80 + 64 * j, (pg8::u32x2w){pk2(y.x, y.y), pk2(y.z, y.w)}); }
            if (has1) {
#pragma unroll
                for (int j = 0; j < 4; ++j) { const f32x4 y = v1[j] * rs1 * gv[j]; pg8::st8(o81 + 64 * j, (pg8::u32x2w){pk2(y.x, y.y), pk2(y.z, y.w)}); } }
        }
    }
    GRID_BAR();
#if !defined(SIMPLE_BAR) && !defined(CG_ALL) && !defined(GEN_BAR) && !defined(MONO_BAR)
    const XcdBarrier bar = xcd_barrier_post((unsigned*)(ws + WS_CTL) + CW_BAR, (volatile LAS unsigned*)(ldsp + MISC_OFF) + 8);
#endif

    if (PH_MASK & 2) {
        pg8::Gemm g{Hb, W1, M, NIN, D}; pg8::StaticOrder S; S.init(M, NIN, G, bx);
        pg8::EpiP1 E{Qb, Kb, Vb, BG, U1, Gt, a.in[3], a.in[4], a.in[11]};
        pg8::gemm_phase<pg8::EpiP1, pg8::StaticOrder, true, true>(ldsp, g, S, E);
#ifdef DUP_P1
        { pg8::Gemm g2{Hb, W1, M, NIN, D}; pg8::StaticOrder S2; S2.init(M, NIN, G, bx); pg8::gemm_phase<pg8::EpiP1, pg8::StaticOrder, true, true>(ldsp, g2, S2, E); }
#endif
    }
    GRID_BAR();

    if (PH_MASK & 4) {
        for (int L = vcu; L < 1024 * REP_ATT; L += G) { const int bh = (L & 255) >> 2, gq4 = (L & 3) + 4 * ((L >> 8) & 3);
            attn::attn_unit(bh >> 4, bh & 15, gq4, Qb, Kb, Vb, AO, a.in[5], a.in[3], a.in[4], (char*)lds); }
        const float* cw = a.in[6]; const float* cb = a.in[7];
        for (int item = vcu * 512 + tid; item < 131072; item += G * 512) {
            const int c8 = (item & 127) * 8, t0 = (item >> 7) * 16;
            float w0[8], w1[8], w2[8], b0[8], u1[8], u2[8];
#pragma unroll
            for (int e = 0; e < 8; ++e) { w0[e] = cw[c8 + e]; w1[e] = cw[1024 + c8 + e]; w2[e] = cw[2048 + c8 + e]; b0[e] = cb[c8 + e]; u1[e] = 0.f; u2[e] = 0.f; }
            if ((t0 & (SEQ - 1)) != 0) { f32x4 p, q; pg8::unpack8(*(const v4u*)(U1 + (size_t)(t0 - 2) * D + c8), p, q);
#pragma unroll
                for (int e = 0; e < 4; ++e) { u2[e] = p[e]; u2[4 + e] = q[e]; }
                pg8::unpack8(*(const v4u*)(U1 + (size_t)(t0 - 1) * D + c8), p, q);
#pragma unroll
                for (int e = 0; e < 4; ++e) { u1[e] = p[e]; u1[4 + e] = q[e]; } }
            v4u ur[16], br[16];
#pragma unroll
            for (int i = 0; i < 16; ++i) { const size_t off = (size_t)(t0 + i) * D + c8; ur[i] = *(const v4u*)(U1 + off); br[i] = *(const v4u*)(BG + off); }
#pragma unroll
            for (int i = 0; i < 16; ++i) { const size_t off = (size_t)(t0 + i) * D + c8; f32x4 p, q, bp, bq; float u0[8], bgv[8], y[8];
                pg8::unpack8(ur[i], p, q); pg8::unpack8(br[i], bp, bq);
#pragma unroll
                for (int e = 0; e < 4; ++e) { u0[e] = p[e]; u0[4 + e] = q[e]; bgv[e] = bp[e]; bgv[4 + e] = bq[e]; }
#pragma unroll
                for (int e = 0; e < 8; ++e) { y[e] = bgv[e] * (b0[e] + w0[e] * u2[e] + w1[e] * u1[e] + w2[e] * u0[e]); u2[e] = u1[e]; u1[e] = u0[e]; }
                v4u o; o.x = pk2(y[0], y[1]); o.y = pk2(y[2], y[3]); o.z = pk2(y[4], y[5]); o.w = pk2(y[6], y[7]); pg8::st16(YC + off, o); }
        }
    }
    GRID_BAR();

    if (PH_MASK & 8) {
        static_assert(WS_Q == WS_H + (size_t)M * D * 2 && WS_WA == WS_WC + (size_t)D * D * 2, "P3 reads the stacked [YC ; AO] and [Wc ; Wa]");
        pg8::PairOrder S; S.S.init(M, D, G, bx);
        pg8::Gemm g{YC, WC, 2 * M, 2 * D, D}; pg8::EpiGate2 E{Gt, MG};
        pg8::gemm_phase<pg8::EpiGate2, pg8::PairOrder, true, true>(ldsp, g, S, E);
    }
    { pg8::StaticOrder S; S.init(M, D, G, bx); pg8::Unit u0; S.next(0, u0); if (grouped) GROUP_BAR(u0.pm); else GRID_BAR(); }

    if (PH_MASK & 16) {
        pg8::Gemm g{MG, WO, M, D, D}; pg8::StaticOrder S; S.init(M, D, G, bx);
        pg8::EpiRes1 E{x, a.out, X1B, SS};
        pg8::gemm_phase<pg8::EpiRes1, pg8::StaticOrder, true, true>(ldsp, g, S, E);
#ifdef DUP_P4
        pg8::gemm_phase<pg8::EpiRes1, pg8::StaticOrder, true, true>(ldsp, g, S, E);
#endif
    }
    GRID_BAR();

    if (PH_MASK & 32) {
        pg8::Gemm g{X1B, WUP, M, FF, D}; pg8::StaticOrder S; S.init(M, FF, G, bx);
        pg8::EpiUp E{SS, UU};
        pg8::gemm_phase<pg8::EpiUp, pg8::StaticOrder, true, true>(ldsp, g, S, E);
#ifdef DUP_P5
        pg8::gemm_phase<pg8::EpiUp, pg8::StaticOrder, true, true>(ldsp, g, S, E);
#endif
    }
    { pg8::StaticOrder S; S.init(M, D, G, bx); pg8::Unit u0; S.next(0, u0); if (grouped) GROUP_BAR(u0.pm); else GRID_BAR(); }

    for (int i = 0; i < EXTRA_SYNC; ++i) GRID_BAR();
    if (PH_MASK & 64) {
        pg8::Gemm g{UU, WDN, M, D, FF}; pg8::StaticOrder S; S.init(M, D, G, bx);
        pg8::EpiRes2 E{a.out, X1B};
        pg8::gemm_phase<pg8::EpiRes2, pg8::StaticOrder, true, true>(ldsp, g, S, E);
    }
#if defined(MONO_BAR)
    if (wave == 0) { unsigned old_ = 0u; if (lane == 0) old_ = xb_add(&g_done_cnt, 1u);
        old_ = (unsigned)__builtin_amdgcn_readfirstlane((int)old_);
        if (old_ == (unsigned)G - 1u) { __hip_atomic_store(&g_panel_cnt[64 * lane], 0u, RLX_AGENT);
            if (lane < 16) __hip_atomic_store(&g_bar_shard[64 * lane], 0u, RLX_AGENT);
            if (lane == 0) { __hip_atomic_store(&g_bar_cnt, 0u, RLX_AGENT); __hip_atomic_store(&g_done_cnt, 0u, RLX_AGENT); } } }
#endif
}

extern "C" void kernel_launch(void* const* d_in, const int* in_sizes, int n_in, void* d_out, int out_size, void* d_ws, size_t ws_size, hipStream_t stream) {
    static int grid = 0;
    if (grid == 0) {
        if (n_in != 16 || out_size != M * D || ws_size < WS_END) { fprintf(stderr, "kernel_launch: unexpected shapes (n_in %d, out %d, ws %zu)\n", n_in, out_size, ws_size); grid = -1; return; }
        int dev = 0, cus = 0, per_cu = 0;
        (void)hipGetDevice(&dev); (void)hipDeviceGetAttribute(&cus, hipDeviceAttributeMultiprocessorCount, dev);
        if (hipFuncSetAttribute((const void*)fwd, hipFuncAttributeMaxDynamicSharedMemorySize, LDS_BYTES) != hipSuccess) { fprintf(stderr, "kernel_launch: hipFuncSetAttribute failed\n"); grid = -1; return; }
        if (hipOccupancyMaxActiveBlocksPerMultiprocessor(&per_cu, (const void*)fwd, NWAVES * 64, LDS_BYTES) != hipSuccess || per_cu < 1) { fprintf(stderr, "kernel_launch: occupancy query says %d\n", per_cu); per_cu = 1; }
        (void)hipGetLastError();
        grid = cus * 1;
    }
    if (grid < 0) return;
#if !defined(GEN_BAR) && !defined(MONO_BAR)
    if (hipMemsetAsync((char*)d_ws + WS_CTL, 0, CTL_ZERO_BYTES, stream) != hipSuccess) { fprintf(stderr, "kernel_launch: memset of the barrier words failed\n"); return; }
#endif
    Args a{};
    for (int i = 0; i < 16; ++i) a.in[i] = (const float*)d_in[i];
    a.out = (float*)d_out; a.ws = (unsigned char*)d_ws;
    void* args[] = {&a};
    hipError_t e = hipLaunchCooperativeKernel((const void*)fwd, dim3(grid), dim3(NWAVES * 64), args, LDS_BYTES, stream);
    if (e != hipSuccess) fprintf(stderr, "kernel_launch: cooperative launch failed: %s (grid %d)\n", hipGetErrorString(e), grid);
}
```

```cpp
#include <hip/hip_runtime.h>
#include <cstdio>
#include <cstdint>
#define MONO_BAR 1
namespace pg8 {
#define PG8_LAS __attribute__((address_space(3)))
typedef unsigned short bf16_t;
typedef short bf16x8 __attribute__((ext_vector_type(8)));
typedef float f32x4 __attribute__((ext_vector_type(4)));
typedef unsigned u32x4 __attribute__((ext_vector_type(4)));
constexpr int BM = 256, BK = 64, HALF = 128, HTB = HALF * BK * 2  , STAGE_BYTES = 8 * HTB, NXCD = 8, WGM = 8;

__host__ __device__ __forceinline__ int lds_byte(int r, int c) { const int st = (r >> 4) * 2 + (c >> 5), rr = r & 15, cc = c & 31, ob = rr * 64 + cc * 2; return st * 1024 + (ob ^ (((ob >> 9) & 1) << 5)); }
__host__ __device__ __forceinline__ void stage_rc(int b, int& R, int& C) { const int st = b / 1024, sb = b % 1024, swz = sb ^ (((sb >> 9) & 1) << 5); R = (st >> 1) * 16 + swz / 64; C = (st & 1) * 32 + (swz % 64) / 2; }
__host__ __device__ __forceinline__ int perm32(int rho) { const int n = rho >> 4, i = rho & 15; return 8 * (i >> 2) + 4 * n + (i & 3); }

struct Unit { int pm, pn; };
struct Gemm { const bf16_t* A; const bf16_t* Bt; int M, N, K; int lda; int segsh; size_t segstride; };

struct StaticOrder {
    int nM, nN, nwg, G, c;
    __host__ __device__ void init(int M, int N, int G_, int c_) { nM = M / BM; nN = N / BM; nwg = nM * nN; G = G_; c = c_; }
    __host__ __device__ bool next(int i, Unit& u) const {
        const long L = (long)i * G + c; if (L >= nwg) return false;
        int wgid = (int)L; { const int q = nwg / NXCD, r = nwg % NXCD, xcd = wgid % NXCD, off = wgid / NXCD; wgid = (xcd < r ? xcd * (q + 1) : r * (q + 1) + (xcd - r) * q) + off; }
        const int nig = WGM * nN, gid = wgid / nig, fm = gid * WGM, gsz = (nM - fm) < WGM ? (nM - fm) : WGM;
        u.pm = fm + ((wgid % nig) % gsz); u.pn = (wgid % nig) / gsz; return true;
    }
    __device__ __forceinline__ void a_ready(const Unit&) const {}
    __device__ __forceinline__ void done(const Unit&) const {}
};

__device__ __forceinline__ unsigned cvt_pk_bf16(float lo, float hi) { unsigned r; asm volatile("v_cvt_pk_bf16_f32 %0, %1, %2" : "=v"(r) : "v"(lo), "v"(hi)); return r; }
typedef float f32x2 __attribute__((ext_vector_type(2)));
#ifndef WT_STORES
#define WT_STORES 1
#endif
__device__ __forceinline__ void st16(void* p, u32x4 v) {
#if WT_STORES
    asm volatile("global_store_dwordx4 %0, %1, off sc1\n\ts_nop 1" :: "v"(p), "v"(v) : "memory");
#else
    *(u32x4*)p = v;
#endif
}
typedef unsigned u32x2w __attribute__((ext_vector_type(2)));
__device__ __forceinline__ void st8(void* p, u32x2w v) {
#if WT_STORES
    asm volatile("global_store_dwordx2 %0, %1, off sc1\n\ts_nop 1" :: "v"(p), "v"(v) : "memory");
#else
    *(u32x2w*)p = v;
#endif
}
typedef unsigned u32x2 __attribute__((ext_vector_type(2)));
__device__ __forceinline__ float bf_lo(unsigned w) { return __uint_as_float(w << 16); }
__device__ __forceinline__ float bf_hi(unsigned w) { return __uint_as_float(w & 0xffff0000u); }
__device__ __forceinline__ u32x4 pack8(f32x4 a, f32x4 b) { u32x4 w; w.x = cvt_pk_bf16(a[0], a[1]); w.y = cvt_pk_bf16(a[2], a[3]); w.z = cvt_pk_bf16(b[0], b[1]); w.w = cvt_pk_bf16(b[2], b[3]); return w; }
__device__ __forceinline__ void unpack8(u32x4 w, f32x4& a, f32x4& b) { a = (f32x4){bf_lo(w.x), bf_hi(w.x), bf_lo(w.y), bf_hi(w.y)}; b = (f32x4){bf_lo(w.z), bf_hi(w.z), bf_lo(w.w), bf_hi(w.w)}; }
constexpr float QK_C2 = 0.125f * 1.4426950408889634f;
constexpr float RMS_EPS = 1e-6f;

struct EpiP1 {
    static constexpr bool PERM = true, AFTER_DRAIN = false;
    bf16_t *Q, *Kb, *V, *BG, *U1, *G; const float *gq, *gk, *bgate;
    __device__ __forceinline__ void operator()(const f32x4 (&acc)[2][2][4][2], const Unit& u, int wr, int wc, int fr, int fq) const {
        const int pn = u.pn; const int row0 = u.pm * BM + wr * 64 + fr;
        if (pn < 8) {
            const bool isq = pn < 4; const float* g = isq ? gq : gk; bf16_t* O = isq ? Q : Kb; const float sc = isq ? QK_C2 : 1.f;
            const int head = 4 * (pn & 3) + wc;
            f32x4 gv[2][2];
#pragma unroll
            for (int bj = 0; bj < 2; ++bj)
#pragma unroll
                for (int n = 0; n < 2; ++n) gv[bj][n] = *(const f32x4*)(g + 32 * bj + 8 * fq + 4 * n) * sc;
#pragma unroll
            for (int ai = 0; ai < 2; ++ai)
#pragma unroll
                for (int m = 0; m < 4; ++m) {
                    float s = 0.f;
#pragma unroll
                    for (int bj = 0; bj < 2; ++bj)
#pragma unroll
                        for (int n = 0; n < 2; ++n) { const f32x4 x = acc[ai][bj][m][n]; s += (x[0] * x[0] + x[1] * x[1]) + (x[2] * x[2] + x[3] * x[3]); }
                    s += __shfl_xor(s, 16); s += __shfl_xor(s, 32);
                    const float rs = 1.0f / sqrtf(s * (1.0f / 64.0f) + RMS_EPS);
                    bf16_t* rowp = O + (size_t)(row0 + ai * HALF + m * 16) * 1024 + head * 64 + 8 * fq;
#pragma unroll
                    for (int bj = 0; bj < 2; ++bj) st16(rowp + 32 * bj, pack8(acc[ai][bj][m][0] * rs * gv[bj][0], acc[ai][bj][m][1] * rs * gv[bj][1]));
                }
        } else if (pn < 16) {
            bf16_t* O = (pn < 12) ? V : BG; const int col0 = 256 * (pn & 3) + wc * 32 + 8 * fq;
#pragma unroll
            for (int ai = 0; ai < 2; ++ai)
#pragma unroll
                for (int m = 0; m < 4; ++m) { bf16_t* rowp = O + (size_t)(row0 + ai * HALF + m * 16) * 1024 + col0;
#pragma unroll
                    for (int bj = 0; bj < 2; ++bj) st16(rowp + bj * HALF, pack8(acc[ai][bj][m][0], acc[ai][bj][m][1])); }
        } else if (pn < 24) {
            const int col0 = 128 * (pn - 16) + wc * 32 + 8 * fq;
#pragma unroll
            for (int ai = 0; ai < 2; ++ai)
#pragma unroll
                for (int m = 0; m < 4; ++m)
                    st16(U1 + (size_t)(row0 + ai * HALF + m * 16) * 1024 + col0, pack8(acc[ai][0][m][0] * acc[ai][1][m][0], acc[ai][0][m][1] * acc[ai][1][m][1]));
        } else {
            const int col0 = 256 * (pn - 24) + wc * 32 + 8 * fq;
            f32x4 bv[2][2];
#pragma unroll
            for (int bj = 0; bj < 2; ++bj)
#pragma unroll
                for (int n = 0; n < 2; ++n) bv[bj][n] = *(const f32x4*)(bgate + col0 + bj * HALF + 4 * n);
#pragma unroll
            for (int ai = 0; ai < 2; ++ai)
#pragma unroll
                for (int m = 0; m < 4; ++m) { bf16_t* rowp = G + (size_t)(row0 + ai * HALF + m * 16) * 2048 + col0;
#pragma unroll
                    for (int bj = 0; bj < 2; ++bj) { f32x4 v[2];
#pragma unroll
                        for (int n = 0; n < 2; ++n) { const f32x4 z = (acc[ai][bj][m][n] + bv[bj][n]) * (-1.4426950408889634f);
#pragma unroll
                            for (int e = 0; e < 4; ++e) v[n][e] = __builtin_amdgcn_rcpf(1.0f + __builtin_amdgcn_exp2f(z[e])); }
                        st16(rowp + bj * HALF, pack8(v[0], v[1])); } }
        }
    }
};
template <bool ADD> struct EpiGate {
    static constexpr bool PERM = true, AFTER_DRAIN = false;
    const bf16_t* G; bf16_t* MG; int goff;
    __device__ __forceinline__ void operator()(const f32x4 (&acc)[2][2][4][2], const Unit& u, int wr, int wc, int fr, int fq) const {
        const int row0 = u.pm * BM + wr * 64 + fr, col0 = u.pn * BM + wc * 32 + 8 * fq;
#pragma unroll
        for (int ai = 0; ai < 2; ++ai)
#pragma unroll
            for (int m = 0; m < 4; ++m) { const size_t r = (size_t)(row0 + ai * HALF + m * 16);
#pragma unroll
                for (int bj = 0; bj < 2; ++bj) { f32x4 g0, g1; unpack8(*(const u32x4*)(G + r * 2048 + goff + col0 + bj * HALF), g0, g1);
                    f32x4 v0 = acc[ai][bj][m][0] * g0, v1 = acc[ai][bj][m][1] * g1;
                    bf16_t* p = MG + r * 1024 + col0 + bj * HALF;
                    if (ADD) { f32x4 a0, a1; unpack8(*(const u32x4*)p, a0, a1); v0 += a0; v1 += a1; }
                    *(u32x4*)p = pack8(v0, v1); } }
    }
};
struct PairOrder {
    StaticOrder S;
    __device__ bool next(int i, Unit& u) const { Unit b; if (!S.next(i >> 1, b)) return false; u.pm = b.pm + ((i & 1) ? 64 : 0); u.pn = b.pn + ((i & 1) ? 4 : 0); return true; }
    __device__ __forceinline__ void a_ready(const Unit&) const {}
    __device__ __forceinline__ void done(const Unit&) const {}
};
struct EpiGate2 {
    static constexpr bool PERM = true, AFTER_DRAIN = false;
    const bf16_t* G; bf16_t* MG;
    __device__ __forceinline__ void operator()(const f32x4 (&acc)[2][2][4][2], const Unit& u, int wr, int wc, int fr, int fq) const {
        const bool second = u.pm >= 64; const int pm = second ? u.pm - 64 : u.pm, pn = second ? u.pn - 4 : u.pn, goff = second ? 0 : 1024;
        const int row0 = pm * BM + wr * 64 + fr, col0 = pn * BM + wc * 32 + 8 * fq;
#pragma unroll
        for (int ai = 0; ai < 2; ++ai) {
            u32x4 gl[4][2], ml[4][2];
#pragma unroll
            for (int m = 0; m < 4; ++m) { const size_t r = (size_t)(row0 + ai * HALF + m * 16);
#pragma unroll
                for (int bj = 0; bj < 2; ++bj) { gl[m][bj] = *(const u32x4*)(G + r * 2048 + goff + col0 + bj * HALF); if (second) ml[m][bj] = *(const u32x4*)(MG + r * 1024 + col0 + bj * HALF); } }
#pragma unroll
            for (int m = 0; m < 4; ++m) { const size_t r = (size_t)(row0 + ai * HALF + m * 16);
#pragma unroll
                for (int bj = 0; bj < 2; ++bj) { f32x4 g0, g1; unpack8(gl[m][bj], g0, g1);
                    f32x4 v0 = acc[ai][bj][m][0] * g0, v1 = acc[ai][bj][m][1] * g1;
                    bf16_t* p = MG + r * 1024 + col0 + bj * HALF;
                    if (second) { f32x4 a0, a1; unpack8(ml[m][bj], a0, a1); v0 += a0; v1 += a1; } st16(p, pack8(v0, v1)); } }
        }
    }
};
#ifndef STORE_X1_F32
#define STORE_X1_F32 0
#endif
struct EpiRes1 {
    static constexpr bool PERM = false, AFTER_DRAIN = false;
    const float* x; float* out; bf16_t* x1b; float* SS;
    __device__ __forceinline__ void operator()(const f32x4 (&acc)[2][2][4][2], const Unit& u, int wr, int wc, int fr, int fq) const {
        const int row0 = u.pm * BM + wr * 64 + fr, col0 = u.pn * BM + wc * 32 + 4 * fq;
#pragma unroll
        for (int ai = 0; ai < 2; ++ai) {
            f32x4 xv[4][2][2];
#pragma unroll
            for (int m = 0; m < 4; ++m) { const size_t off = (size_t)(row0 + ai * HALF + m * 16) * 1024 + col0;
#pragma unroll
                for (int bj = 0; bj < 2; ++bj)
#pragma unroll
                    for (int n = 0; n < 2; ++n) xv[m][bj][n] = *(const f32x4*)(x + off + bj * HALF + n * 16); }
#pragma unroll
            for (int m = 0; m < 4; ++m) { const size_t r = (size_t)(row0 + ai * HALF + m * 16); const size_t off = r * 1024 + col0; float s = 0.f;
#pragma unroll
                for (int bj = 0; bj < 2; ++bj)
#pragma unroll
                    for (int n = 0; n < 2; ++n) { const f32x4 v = xv[m][bj][n] + acc[ai][bj][m][n];
                        if (STORE_X1_F32) *(f32x4*)(out + off + bj * HALF + n * 16) = v; s += (v[0] * v[0] + v[1] * v[1]) + (v[2] * v[2] + v[3] * v[3]);
                        u32x2 w; w.x = cvt_pk_bf16(v[0], v[1]); w.y = cvt_pk_bf16(v[2], v[3]); st8(x1b + off + bj * HALF + n * 16, w); }
                s += __shfl_xor(s, 16); s += __shfl_xor(s, 32);
                if (fq == 0) __hip_atomic_store(SS + r * 16 + 4 * u.pn + wc, s, __ATOMIC_RELAXED, __HIP_MEMORY_SCOPE_AGENT); }
            asm volatile("" ::: "memory");
        }
    }
};
struct EpiUp {
    static constexpr bool PERM = true, AFTER_DRAIN = false;
    const float* SS; bf16_t* UU; size_t piece;
    __device__ __forceinline__ void operator()(const f32x4 (&acc)[2][2][4][2], const Unit& u, int wr, int wc, int fr, int fq) const {
        const int row0 = u.pm * BM + wr * 64 + fr;
        bf16_t* UUp = UU + (size_t)(u.pn >> 2) * piece + (u.pn & 3) * BM + wc * 32 + 8 * fq;
#pragma unroll
        for (int ai = 0; ai < 2; ++ai)
#pragma unroll
            for (int m = 0; m < 4; ++m) { const size_t r = (size_t)(row0 + ai * HALF + m * 16);
                const f32x4* sp = (const f32x4*)(SS + r * 16); const f32x4 s4 = (sp[0] + sp[1]) + (sp[2] + sp[3]);
                const float rs = 1.0f / sqrtf(((s4[0] + s4[1]) + (s4[2] + s4[3])) * (1.0f / 1024.0f) + RMS_EPS);
#pragma unroll
                for (int bj = 0; bj < 2; ++bj) { f32x4 v[2];
#pragma unroll
                    for (int n = 0; n < 2; ++n) { const f32x4 z = acc[ai][bj][m][n] * rs;
#pragma unroll
                        for (int e = 0; e < 4; ++e) { const float t = fmaxf(z[e], 0.f); v[n][e] = t * t; } }
                    st16(UUp + r * 1024 + bj * HALF, pack8(v[0], v[1])); } }
    }
};
struct EpiRes2 {
    static constexpr bool PERM = false, AFTER_DRAIN = false;
    float* out; const bf16_t* x1b;
    __device__ __forceinline__ void operator()(const f32x4 (&acc)[2][2][4][2], const Unit& u, int wr, int wc, int fr, int fq) const {
        const int row0 = u.pm * BM + wr * 64 + fr, col0 = u.pn * BM + wc * 32 + 4 * fq;
#pragma unroll
        for (int ai = 0; ai < 2; ++ai)
#pragma unroll
            for (int m = 0; m < 4; ++m) { const size_t off = (size_t)(row0 + ai * HALF + m * 16) * 1024 + col0;
#pragma unroll
                for (int bj = 0; bj < 2; ++bj)
#pragma unroll
                    for (int n = 0; n < 2; ++n) { float* p = out + off + bj * HALF + n * 16;
#if STORE_X1_F32
                        const f32x4 b = *(const f32x4*)p;
#else
                        const u32x2 w = *(const u32x2*)(x1b + off + bj * HALF + n * 16); const f32x4 b = {bf_lo(w.x), bf_hi(w.x), bf_lo(w.y), bf_hi(w.y)};
#endif
                        *(f32x4*)p = b + acc[ai][bj][m][n]; }
                if (m == 3) asm volatile("" ::: "memory"); }
    }
};

template <class Epi, class Sched, bool ALIGN_EPI = false, bool SP2 = false>
__device__ __forceinline__ void gemm_phase(PG8_LAS unsigned char* lds, const Gemm g, const Sched& S, const Epi& E) {
    int tid_ = threadIdx.x; asm volatile("" : "+v"(tid_));
    const int tid = tid_, wid = __builtin_amdgcn_readfirstlane(tid >> 6), lane = tid & 63, wr = wid >> 2, wc = wid & 3, fr = lane & 15, fq = lane >> 4;
    const int K = g.K, nt = K / BK;
    const int lda = g.lda ? g.lda : K, segsh = g.segsh ? g.segsh : 30;
    unsigned voffA[2], voffB[2];
#pragma unroll
    for (int i = 0; i < 2; ++i) { int R, C; stage_rc(tid * 16 + i * 8192, R, C); const int Rb = Epi::PERM ? ((R & ~31) + perm32(R & 31)) : R;
        voffA[i] = (unsigned)(R * lda + C) * 2u; voffB[i] = (unsigned)(Rb * K + C) * 2u; }
    const size_t kstep = (size_t)(BK * 2);
    const size_t hstep = (size_t)HALF * K * 2;
    const size_t tstep = 2 * hstep;
    const size_t hstepA = (size_t)HALF * lda * 2, tstepA = 2 * hstepA;
#define PG8_AOFF(t_) ((size_t)((t_) >> segsh) * g.segstride + (size_t)((t_) & ((1 << segsh) - 1)) * kstep)
    const unsigned ldsw = (unsigned)wid * 1024u;
    const int aoff = lds_byte(wr * 64 + fr, fq * 8), boff = lds_byte(wc * 32 + fr, fq * 8);
#define PG8_SA(b, h) (((b) * 2 + (h)) * HTB)
#define PG8_SB(b, h) ((4 + (b) * 2 + (h)) * HTB)
#define PG8_STAGE(bufoff, gbase, voff) do { _Pragma("unroll") for (int _i = 0; _i < 2; ++_i) \
        __builtin_amdgcn_global_load_lds((const unsigned*)((const char*)(gbase) + (voff)[_i]), (PG8_LAS unsigned*)(lds + (bufoff) + ldsw + _i * 8192), 16, 0, 0); } while (0)
#define PG8_LDA(dst, b, h) do { _Pragma("unroll") for (int m = 0; m < 4; ++m) _Pragma("unroll") for (int k = 0; k < 2; ++k) dst[m][k] = *(const PG8_LAS bf16x8*)(lds + PG8_SA(b, h) + aoff + m * 2048 + k * 1024); } while (0)
#define PG8_LDB(dst, b, h) do { _Pragma("unroll") for (int n = 0; n < 2; ++n) _Pragma("unroll") for (int k = 0; k < 2; ++k) dst[n][k] = *(const PG8_LAS bf16x8*)(lds + PG8_SB(b, h) + boff + n * 2048 + k * 1024); } while (0)
#define PG8_MMA(ai, bj, At, Bt) do { __builtin_amdgcn_s_setprio(1); _Pragma("unroll") for (int m = 0; m < 4; ++m) _Pragma("unroll") for (int n = 0; n < 2; ++n) _Pragma("unroll") for (int k = 0; k < 2; ++k) \
        acc[ai][bj][m][n] = __builtin_amdgcn_mfma_f32_16x16x32_bf16(Bt[n][k], At[m][k], acc[ai][bj][m][n], 0, 0, 0); __builtin_amdgcn_s_setprio(0); } while (0)
#define PG8_WAIT_V(n) asm volatile("s_waitcnt vmcnt(" #n ")" ::: "memory")
#define PG8_WAIT_L(n) asm volatile("s_waitcnt lgkmcnt(" #n ")" ::: "memory")
#define PG8_BAR __builtin_amdgcn_s_barrier()
#define PG8_SCHED __builtin_amdgcn_sched_barrier(0)
    Unit cur, nxt; int ui = 0;
    if (!S.next(0, cur)) return;
    f32x4 acc[2][2][4][2];
#pragma unroll
    for (int a = 0; a < 2; ++a)
#pragma unroll
        for (int b = 0; b < 2; ++b)
#pragma unroll
            for (int m = 0; m < 4; ++m)
#pragma unroll
                for (int n = 0; n < 2; ++n) acc[a][b][m][n] = (f32x4){0.f, 0.f, 0.f, 0.f};
    bf16x8 At[4][2], B0[2][2], B1[2][2];
    const char* cA = (const char*)g.A + (size_t)cur.pm * tstepA; const char* cB = (const char*)g.Bt + (size_t)cur.pn * tstep;
    S.a_ready(cur);
    if constexpr (SP2) {
        PG8_STAGE(PG8_SB(0, 0), cB, voffB); PG8_STAGE(PG8_SB(0, 1), cB + hstep, voffB); PG8_STAGE(PG8_SA(0, 0), cA, voffA); PG8_STAGE(PG8_SA(0, 1), cA + hstepA, voffA);
        if (wr == 1) PG8_BAR;
        PG8_WAIT_V(2); PG8_BAR;
        PG8_STAGE(PG8_SB(1, 0), cB + kstep, voffB); PG8_STAGE(PG8_SA(1, 0), cA + kstep, voffA); PG8_STAGE(PG8_SB(1, 1), cB + hstep + kstep, voffB);
        PG8_WAIT_V(6); PG8_BAR;
    } else {
        PG8_STAGE(PG8_SB(0, 0), cB, voffB); PG8_STAGE(PG8_SA(0, 0), cA, voffA); PG8_STAGE(PG8_SB(0, 1), cB + hstep, voffB); PG8_STAGE(PG8_SA(0, 1), cA + hstepA, voffA);
        if (wr == 1) PG8_BAR;
        PG8_WAIT_V(4); PG8_BAR;
        PG8_STAGE(PG8_SB(1, 0), cB + kstep, voffB); PG8_STAGE(PG8_SA(1, 0), cA + kstep, voffA); PG8_STAGE(PG8_SB(1, 1), cB + hstep + kstep, voffB);
        PG8_WAIT_V(6); PG8_BAR;
    }
    for (;;) {
        const bool has_next = S.next(ui + 1, nxt);
        const char* nA = has_next ? (const char*)g.A + (size_t)nxt.pm * tstepA : cA; const char* nB = has_next ? (const char*)g.Bt + (size_t)nxt.pn * tstep : cB;
        for (int t = 0; t < nt; t += 2) {
            const bool last = (t == nt - 2);
            const char* a1 = cA + PG8_AOFF(t) + kstep;
            const char* a2 = last ? nA : cA + PG8_AOFF(t + 2); const char* b2 = last ? nB : cB + (size_t)(t + 2) * kstep;
            const char* a3 = a2 + kstep; const char* b3 = b2 + kstep;
            if (last && has_next) S.a_ready(nxt);
            if constexpr (SP2) {
            PG8_LDB(B0, 0, 0); PG8_LDB(B1, 0, 1); PG8_SCHED; PG8_LDA(At, 0, 0); PG8_STAGE(PG8_SA(1, 1), a1 + hstepA, voffA);
            PG8_WAIT_V(8); PG8_WAIT_L(0); PG8_BAR; PG8_MMA(0, 0, At, B0); PG8_MMA(0, 1, At, B1); PG8_BAR; PG8_SCHED;
            PG8_LDA(At, 0, 1); PG8_STAGE(PG8_SB(0, 0), b2, voffB); PG8_STAGE(PG8_SB(0, 1), b2 + hstep, voffB); PG8_STAGE(PG8_SA(0, 0), a2, voffA);
            PG8_WAIT_V(8); PG8_WAIT_L(0); PG8_BAR; PG8_MMA(1, 0, At, B0); PG8_MMA(1, 1, At, B1); PG8_BAR; PG8_SCHED;
            PG8_LDB(B0, 1, 0); PG8_LDB(B1, 1, 1); PG8_SCHED; PG8_LDA(At, 1, 0); PG8_STAGE(PG8_SA(0, 1), a2 + hstepA, voffA);
            PG8_WAIT_V(8); PG8_WAIT_L(0); PG8_BAR; PG8_MMA(0, 0, At, B0); PG8_MMA(0, 1, At, B1); PG8_BAR; PG8_SCHED;
            PG8_LDA(At, 1, 1); PG8_STAGE(PG8_SB(1, 0), b3, voffB); PG8_STAGE(PG8_SB(1, 1), b3 + hstep, voffB); PG8_STAGE(PG8_SA(1, 0), a3, voffA);
            PG8_WAIT_V(8); PG8_WAIT_L(0); PG8_BAR; PG8_MMA(1, 0, At, B0); PG8_MMA(1, 1, At, B1); PG8_BAR; PG8_SCHED;
            } else {
            PG8_LDB(B0, 0, 0); PG8_SCHED; PG8_LDA(At, 0, 0); PG8_STAGE(PG8_SA(1, 1), a1 + hstepA, voffA);
            PG8_WAIT_L(8); PG8_BAR; PG8_WAIT_L(0); PG8_MMA(0, 0, At, B0); PG8_BAR; PG8_SCHED;
            PG8_LDB(B1, 0, 1); PG8_STAGE(PG8_SB(0, 0), b2, voffB);
            PG8_BAR; PG8_WAIT_L(0); PG8_MMA(0, 1, At, B1); PG8_BAR;
            PG8_LDA(At, 0, 1); PG8_STAGE(PG8_SA(0, 0), a2, voffA);
            PG8_BAR; PG8_WAIT_L(0); PG8_MMA(1, 0, At, B0); PG8_BAR; PG8_SCHED;
            PG8_STAGE(PG8_SB(0, 1), b2 + hstep, voffB);
            PG8_WAIT_V(6); PG8_BAR; PG8_MMA(1, 1, At, B1); PG8_BAR;
            PG8_LDB(B0, 1, 0); PG8_SCHED; PG8_LDA(At, 1, 0); PG8_STAGE(PG8_SA(0, 1), a2 + hstepA, voffA);
            PG8_WAIT_L(8); PG8_BAR; PG8_WAIT_L(0); PG8_MMA(0, 0, At, B0); PG8_BAR; PG8_SCHED;
            PG8_LDB(B1, 1, 1); PG8_STAGE(PG8_SB(1, 0), b3, voffB);
            PG8_BAR; PG8_WAIT_L(0); PG8_MMA(0, 1, At, B1); PG8_BAR;
            PG8_LDA(At, 1, 1); PG8_STAGE(PG8_SA(1, 0), a3, voffA);
            PG8_BAR; PG8_WAIT_L(0); PG8_MMA(1, 0, At, B0); PG8_BAR; PG8_SCHED;
            PG8_STAGE(PG8_SB(1, 1), b3 + hstep, voffB);
            PG8_WAIT_V(6); PG8_BAR; PG8_MMA(1, 1, At, B1); PG8_BAR;
            }
        }
        if constexpr (ALIGN_EPI) { if (wr == 0) PG8_BAR; }
        if constexpr (!Epi::AFTER_DRAIN) { E(acc, cur, wr, wc, fr, fq); S.done(cur); }
        if (!has_next) break;
#pragma unroll
        for (int a = 0; a < 2; ++a)
#pragma unroll
            for (int b = 0; b < 2; ++b)
#pragma unroll
                for (int m = 0; m < 4; ++m)
#pragma unroll
                    for (int n = 0; n < 2; ++n) acc[a][b][m][n] = (f32x4){0.f, 0.f, 0.f, 0.f};
        cur = nxt; cA = nA; cB = nB; ++ui;
        if constexpr (ALIGN_EPI) { if (wr == 1) PG8_BAR; }
    }
    PG8_WAIT_V(0);
    if constexpr (!ALIGN_EPI) { if (wr == 0) PG8_BAR; }
    PG8_BAR;
    if constexpr (Epi::AFTER_DRAIN) { E.fused(acc, cur, wr, wc, fr, fq, lds, wid, lane); S.done(cur); }
#undef PG8_AOFF
#undef PG8_SA
#undef PG8_SB
#undef PG8_STAGE
#undef PG8_LDA
#undef PG8_LDB
#undef PG8_MMA
#undef PG8_WAIT_V
#undef PG8_WAIT_L
#undef PG8_BAR
#undef PG8_SCHED
}
}

namespace attn {
using bf16 = unsigned short;
using bf16x8 = __attribute__((ext_vector_type(8))) short;
using s16x4 = __attribute__((ext_vector_type(4))) short;
using f32x16 = __attribute__((ext_vector_type(16))) float;
using u32x4 = __attribute__((ext_vector_type(4))) unsigned;
using f32x4 = __attribute__((ext_vector_type(4))) float;
constexpr int SEQ = 4096, DM = 1024, NSLOT = 6, SLOTB = 8192, NREL = 513;
constexpr int LDS_K = 0, LDS_V = NSLOT * SLOTB, LDS_WS = 2 * NSLOT * SLOTB, LDS_OST = LDS_WS + 8 * 64 * 4, LDS_BIAS = LDS_OST + 8 * 4096, BIAS_CS = 400  , LDS_BYTES = LDS_BIAS + 4 * BIAS_CS * 4;
constexpr float LOG2E = 1.4426950408889634f;
__device__ __forceinline__ int crow(int r, int hi) { return (r & 3) + 8 * (r >> 2) + 4 * hi; }
#define SBAR() __builtin_amdgcn_sched_barrier(0)
__device__ __forceinline__ void glds16(const void* gsrc, unsigned lds_dst) { unsigned keep;
  asm volatile("s_mov_b32 %0, m0\n\ts_mov_b32 m0, %2\n\ts_nop 0\n\tglobal_load_lds_dwordx4 %1, off\n\ts_mov_b32 m0, %0" : "=&s"(keep) : "v"(gsrc), "s"(lds_dst) : "memory"); }
typedef float f32x2_t __attribute__((ext_vector_type(2))); typedef __bf16 bf16x2_t __attribute__((ext_vector_type(2)));
__device__ __forceinline__ unsigned cvtpk_s(float lo, float hi) { f32x2_t v = {lo, hi}; bf16x2_t b = __builtin_convertvector(v, bf16x2_t); return __builtin_bit_cast(unsigned, b); }
typedef __attribute__((address_space(3))) const char* lds_cptr;
__device__ __forceinline__ void kload8(bf16x8* kf, lds_cptr kp) {
  kf[0] = *(const __attribute__((address_space(3))) bf16x8*)(kp);        kf[1] = *(const __attribute__((address_space(3))) bf16x8*)(kp + 512);
  kf[2] = *(const __attribute__((address_space(3))) bf16x8*)(kp + 2048); kf[3] = *(const __attribute__((address_space(3))) bf16x8*)(kp + 2560);
  kf[4] = *(const __attribute__((address_space(3))) bf16x8*)(kp + 4096); kf[5] = *(const __attribute__((address_space(3))) bf16x8*)(kp + 4608);
  kf[6] = *(const __attribute__((address_space(3))) bf16x8*)(kp + 6144); kf[7] = *(const __attribute__((address_space(3))) bf16x8*)(kp + 6656);
}
__device__ __forceinline__ void pv(f32x16* o, int vb, bf16x8 pa0, bf16x8 pa1, bf16x8 pa2, bf16x8 pa3) {
  #pragma unroll
  for (int d0 = 0; d0 < 2; ++d0) { s16x4 lo[4], hi[4];
    #pragma unroll
    for (int ks = 0; ks < 4; ++ks) {
      asm volatile("ds_read_b64_tr_b16 %0,%1 offset:%c2" : "=&v"(lo[ks]) : "v"(vb), "i"(d0 * 4096 + ks * 1024) : "memory");
      asm volatile("ds_read_b64_tr_b16 %0,%1 offset:%c2" : "=&v"(hi[ks]) : "v"(vb), "i"(d0 * 4096 + ks * 1024 + 512) : "memory"); }
    asm volatile("s_waitcnt lgkmcnt(0)" ::: "memory"); SBAR();
    #define PK(k) (bf16x8){lo[k][0], lo[k][1], lo[k][2], lo[k][3], hi[k][0], hi[k][1], hi[k][2], hi[k][3]}
    o[d0] = __builtin_amdgcn_mfma_f32_32x32x16_bf16(pa0, PK(0), o[d0], 0, 0, 0);
    o[d0] = __builtin_amdgcn_mfma_f32_32x32x16_bf16(pa1, PK(1), o[d0], 0, 0, 0);
    o[d0] = __builtin_amdgcn_mfma_f32_32x32x16_bf16(pa2, PK(2), o[d0], 0, 0, 0);
    o[d0] = __builtin_amdgcn_mfma_f32_32x32x16_bf16(pa3, PK(3), o[d0], 0, 0, 0);
    #undef PK
  }
}
__device__ __forceinline__ float wmax(float v) {
#pragma unroll
  for (int o = 1; o < 64; o <<= 1) v = fmaxf(v, __shfl_xor(v, o));
  return v;
}
__device__ __forceinline__ void attn_unit(int b, int h, int g, const bf16* Q, const bf16* __restrict__ K, const bf16* __restrict__ V, bf16* O,
                                          const float* __restrict__ relb, const float* __restrict__ gq, const float* __restrict__ gk, char* shm) {
  int tid_ = threadIdx.x; asm volatile("" : "+v"(tid_));
  const int tid = tid_, lane = tid & 63, r32 = lane & 31, hi = lane >> 5; const int wid = __builtin_amdgcn_readfirstlane(tid >> 6);
  const long rowbase = (long)b * SEQ; const int q0 = g * 256;
  const int kc_lo = (4 * g - 8) > 0 ? (4 * g - 8) : 0, NT = 4 * g + 4 - kc_lo;
  const bf16* Qw = Q + (rowbase + q0 + wid * 32) * DM + h * 64;
  const bf16* Kh = K + (rowbase + 64 * kc_lo) * DM + h * 64; const bf16* Vh = V + (rowbase + 64 * kc_lo) * DM + h * 64;
  const unsigned lds0 = (unsigned)(uintptr_t)shm;
  float* wsf = (float*)(shm + LDS_WS) + wid * 64;
  float* biasT = (float*)(shm + LDS_BIAS);
  const bf16* ksrc = Kh + (long)lane * DM + wid * 8;
  const bf16* vsrc = Vh + (long)(16 * (wid & 3) + (lane >> 2)) * DM + (wid >> 2) * 32 + (lane & 3) * 8;
  const unsigned kdst = lds0 + LDS_K + wid * 1024, vdst = lds0 + LDS_V + wid * 1024;
  #define DMA_K(t, slot) glds16(ksrc + (long)(t) * 64 * DM, (unsigned)__builtin_amdgcn_readfirstlane(kdst + (slot)))
  #define DMA_V(t, slot) glds16(vsrc + (long)(t) * 64 * DM, (unsigned)__builtin_amdgcn_readfirstlane(vdst + (slot)))
  const int vb0 = (int)(lds0 + LDS_V) + ((lane >> 4) & 1) * 32 + (lane & 3) * 8 + (4 * hi + ((lane & 15) >> 2)) * 64;
  const lds_cptr shm3 = (lds_cptr)shm; const lds_cptr kp0 = shm3 + LDS_K + hi * 1024 + r32 * 16;
  const bool full = (g >= 2); const int nsteps = full ? 9 : NT;
  #define LOAD_TILE(i) (full ? ((i) < 6 ? (((i) & 1) ? ((i) >> 1) + 9 : ((i) >> 1)) : (i) - 3) : (i))
  #define ISSUE_LOAD(i) do { const int i_ = (i); const int tl_ = LOAD_TILE(i_); const int sb_ = (i_ % NSLOT) * SLOTB; DMA_K(tl_, sb_); DMA_V(tl_, sb_); } while (0)
  ISSUE_LOAD(0); ISSUE_LOAD(1); if (full) { ISSUE_LOAD(2); ISSUE_LOAD(3); }
  bf16x8 qr[4];
  #pragma unroll
  for (int d0 = 0; d0 < 4; ++d0) qr[d0] = *reinterpret_cast<const bf16x8*>(&Qw[(long)r32 * DM + d0 * 16 + hi * 8]);
  float m2;
  { const float mq = wmax(fabsf(gq[lane])), mk = wmax(fabsf(gk[lane])); float mb = -3.0e38f;
    for (int i = lane; i < NREL; i += 64) mb = fmaxf(mb, relb[h * NREL + i]);
    mb = wmax(mb); m2 = (8.0f * mq * mk + mb) * LOG2E; }
  for (int i = tid; i < 4 * 384; i += 512) { const int c = i / 384, j = i - c * 384, e = j + c; biasT[c * BIAS_CS + j] = (e < 384 ? relb[h * NREL + (e < 64 ? 512 : 576 - e)] : 0.f) * LOG2E - m2; }
  f32x16 o[2]; o[0] = f32x16{}; o[1] = f32x16{}; f32x16 lsum = f32x16{};
  const int qpos = 32 * (wid & 1) + r32;
  const int cch = 4 * g + (wid >> 1);
  asm volatile("s_waitcnt vmcnt(0) lgkmcnt(0)\n\ts_barrier" ::: "memory");
  for (int s = 0; s < nsteps; ++s) {
    int nis = 0;
    if (s + 2 < nsteps) { const int s2 = s + 2; if (full) { if (s2 < 3) { ISSUE_LOAD(2 * s2); ISSUE_LOAD(2 * s2 + 1); nis = 2; } else { ISSUE_LOAD(s2 + 3); nis = 1; } } else { ISSUE_LOAD(s2); nis = 1; } }
    int jrel = kc_lo + s - cch + 8, ld = full ? (s < 3 ? 2 * s : s + 3) : s;
    if (full && s < 3 && jrel < 0) { jrel += 9; ld += 1; }
    const int sl_cur = (ld % NSLOT) * SLOTB;
    if (jrel >= 0 && jrel <= 8) {
      s16x4 vlo[8], vhi[8]; { const int vb = vb0 + sl_cur;
        #pragma unroll
        for (int i_ = 0; i_ < 8; ++i_) {
          asm volatile("ds_read_b64_tr_b16 %0,%1 offset:%c2" : "=&v"(vlo[i_]) : "v"(vb), "i"((i_ >> 2) * 4096 + (i_ & 3) * 1024) : "memory");
          asm volatile("ds_read_b64_tr_b16 %0,%1 offset:%c2" : "=&v"(vhi[i_]) : "v"(vb), "i"((i_ >> 2) * 4096 + (i_ & 3) * 1024 + 512) : "memory"); } }
      f32x16 p0, p1;
      if (jrel <= 3) { const float c0 = biasT[0];
        #pragma unroll
        for (int r = 0; r < 16; ++r) { p0[r] = c0; p1[r] = c0; } }
      else { const int i0 = 64 + 4 * hi - qpos + 64 * (jrel - 4), cs = i0 & 3; const f32x4* a4 = (const f32x4*)(biasT + cs * BIAS_CS + (i0 - cs));
        #pragma unroll
        for (int q4 = 0; q4 < 4; ++q4) { const f32x4 b0 = a4[2 * q4], b1 = a4[2 * q4 + 8];
          #pragma unroll
          for (int e = 0; e < 4; ++e) { p0[4 * q4 + e] = b0[e]; p1[4 * q4 + e] = b1[e]; } } }
      bf16x8 kf[8]; kload8(kf, kp0 + sl_cur);
      #pragma unroll
      for (int d0 = 0; d0 < 4; ++d0) { p0 = __builtin_amdgcn_mfma_f32_32x32x16_bf16(kf[2 * d0], qr[d0], p0, 0, 0, 0); p1 = __builtin_amdgcn_mfma_f32_32x32x16_bf16(kf[2 * d0 + 1], qr[d0], p1, 0, 0, 0); }
      #pragma unroll
      for (int r = 0; r < 16; ++r) { p0[r] = __builtin_amdgcn_exp2f(p0[r]); p1[r] = __builtin_amdgcn_exp2f(p1[r]); }
      lsum += p0 + p1;
      u32x4 pw0, pw1, pw2, pw3;
      pw0 = (u32x4){cvtpk_s(p0[0], p0[1]), cvtpk_s(p0[2], p0[3]), cvtpk_s(p0[4], p0[5]), cvtpk_s(p0[6], p0[7])};
      pw1 = (u32x4){cvtpk_s(p0[8], p0[9]), cvtpk_s(p0[10], p0[11]), cvtpk_s(p0[12], p0[13]), cvtpk_s(p0[14], p0[15])};
      pw2 = (u32x4){cvtpk_s(p1[0], p1[1]), cvtpk_s(p1[2], p1[3]), cvtpk_s(p1[4], p1[5]), cvtpk_s(p1[6], p1[7])};
      pw3 = (u32x4){cvtpk_s(p1[8], p1[9]), cvtpk_s(p1[10], p1[11]), cvtpk_s(p1[12], p1[13]), cvtpk_s(p1[14], p1[15])};
      SBAR();
      asm volatile("s_waitcnt lgkmcnt(0)" ::: "memory"); SBAR();
      #define VF(i_) (bf16x8){vlo[i_][0], vlo[i_][1], vlo[i_][2], vlo[i_][3], vhi[i_][0], vhi[i_][1], vhi[i_][2], vhi[i_][3]}
      o[0] = __builtin_amdgcn_mfma_f32_32x32x16_bf16(__builtin_bit_cast(bf16x8, pw0), VF(0), o[0], 0, 0, 0); o[1] = __builtin_amdgcn_mfma_f32_32x32x16_bf16(__builtin_bit_cast(bf16x8, pw0), VF(4), o[1], 0, 0, 0);
      o[0] = __builtin_amdgcn_mfma_f32_32x32x16_bf16(__builtin_bit_cast(bf16x8, pw1), VF(1), o[0], 0, 0, 0); o[1] = __builtin_amdgcn_mfma_f32_32x32x16_bf16(__builtin_bit_cast(bf16x8, pw1), VF(5), o[1], 0, 0, 0);
      o[0] = __builtin_amdgcn_mfma_f32_32x32x16_bf16(__builtin_bit_cast(bf16x8, pw2), VF(2), o[0], 0, 0, 0); o[1] = __builtin_amdgcn_mfma_f32_32x32x16_bf16(__builtin_bit_cast(bf16x8, pw2), VF(6), o[1], 0, 0, 0);
      o[0] = __builtin_amdgcn_mfma_f32_32x32x16_bf16(__builtin_bit_cast(bf16x8, pw3), VF(3), o[0], 0, 0, 0); o[1] = __builtin_amdgcn_mfma_f32_32x32x16_bf16(__builtin_bit_cast(bf16x8, pw3), VF(7), o[1], 0, 0, 0);
      #undef VF
    }
    if (nis == 2)      asm volatile("s_waitcnt vmcnt(4) lgkmcnt(0)\n\ts_barrier" ::: "memory");
    else if (nis == 1) asm volatile("s_waitcnt vmcnt(2) lgkmcnt(0)\n\ts_barrier" ::: "memory");
    else               asm volatile("s_waitcnt vmcnt(0) lgkmcnt(0)\n\ts_barrier" ::: "memory");
  }
  #undef LOAD_TILE
  #undef ISSUE_LOAD
  float l_reg = 0.f;
  #pragma unroll
  for (int r = 0; r < 16; ++r) l_reg += lsum[r];
  { auto rr = __builtin_amdgcn_permlane32_swap(__float_as_uint(l_reg), __float_as_uint(l_reg), false, false); l_reg = __uint_as_float(rr[0]) + __uint_as_float(rr[1]); }
  if (hi == 0) wsf[32 + r32] = l_reg; asm volatile("s_waitcnt lgkmcnt(0)" ::: "memory");
  float rli[16];
  #pragma unroll
  for (int r = 0; r < 16; ++r) rli[r] = __builtin_amdgcn_rcpf(wsf[32 + crow(r, hi)]);
  bf16* Ow = O + (rowbase + q0 + wid * 32) * DM + h * 64;
  { bf16* stg = (bf16*)(shm + LDS_OST) + wid * 2048;
    #pragma unroll
    for (int r = 0; r < 16; ++r) { const int orow = crow(r, hi);
      #pragma unroll
      for (int d0 = 0; d0 < 2; ++d0) stg[orow * 64 + d0 * 32 + r32] = (bf16)(cvtpk_s(o[d0][r] * rli[r], 0.f) & 0xffffu); }
    asm volatile("s_waitcnt lgkmcnt(0)" ::: "memory");
    #pragma unroll
    for (int i = 0; i < 4; ++i) { const int row = i * 8 + (lane >> 3), ch = lane & 7; const u32x4 v = *(const u32x4*)(stg + row * 64 + ch * 8); pg8::st16(Ow + (long)row * DM + ch * 8, v); } }
  asm volatile("s_waitcnt lgkmcnt(0)\n\ts_barrier" ::: "memory");
  #undef DMA_K
  #undef DMA_V
}
#undef SBAR
}

#define GAS __attribute__((address_space(1)))
#define LAS __attribute__((address_space(3)))
typedef unsigned short bf16;
typedef unsigned v4u __attribute__((ext_vector_type(4)));
typedef float f32x4 __attribute__((ext_vector_type(4)));
typedef short bf16x8 __attribute__((ext_vector_type(8)));
typedef GAS unsigned gu32;
typedef GAS unsigned long long gu64;
#define RLX_AGENT __ATOMIC_RELAXED, __HIP_MEMORY_SCOPE_AGENT
#define LDS_WAIT() asm volatile("s_waitcnt lgkmcnt(0)" ::: "memory")
#define VM_WAIT() asm volatile("s_waitcnt vmcnt(0)" ::: "memory")
__device__ __forceinline__ unsigned long long rt() { return __builtin_amdgcn_s_memrealtime(); }
#define XB_TMO      128
#define XB_XCNT(j)  (256  + 64 * (j))
#define XB_XSUB(j)  (1280 + 64 * (j))
#define XB_XGEN(j)  (2304 + 64 * (j))
#define XB_TOP      3328
#define XB_TOPGEN   3392
#define XCD_BAR_WORDS 3456
#define XB_SPIN_CAP (1u << 18)

__device__ __forceinline__ unsigned xb_ld(unsigned* p)              { return __hip_atomic_load(p, __ATOMIC_RELAXED, __HIP_MEMORY_SCOPE_AGENT); }
__device__ __forceinline__ unsigned xb_add(unsigned* p, unsigned v) { return __hip_atomic_fetch_add(p, v, __ATOMIC_RELAXED, __HIP_MEMORY_SCOPE_AGENT); }
__device__ __forceinline__ unsigned xb_xcc_id() { return (unsigned)__builtin_amdgcn_s_getreg((3 << 11) | 20) & 0xFu; }
#define XB_SPIN(cond, bar) do { unsigned _sp = 0; while (cond) { __builtin_amdgcn_s_sleep(1); \
    if ((++_sp & 255u) == 0u) { if (xb_ld(&(bar)[XB_TMO])) break; if (_sp > XB_SPIN_CAP) { atomicAdd(&(bar)[XB_TMO], 1u); break; } } } } while (0)

struct XcdBarrier {
    unsigned* bar; unsigned x;
    volatile LAS unsigned* st;
};

__device__ __forceinline__ XcdBarrier xcd_barrier_post(unsigned* bar, volatile LAS unsigned* st) {
    XcdBarrier b; b.bar = bar; b.x = xb_xcc_id(); b.st = st;
    if (threadIdx.x == 0) (void)xb_add(&bar[XB_XCNT(b.x)], 1u);
    return b;
}
__device__ __forceinline__ void xcd_barrier_complete(unsigned* bar, unsigned x, unsigned& nloc, unsigned& nx) {
    const unsigned G = gridDim.x * gridDim.y * gridDim.z;
    unsigned sum, cnt, mine, sp = 0u;
    for (;;) {
        sum = 0u; cnt = 0u; mine = 0u;
#pragma unroll
        for (unsigned j = 0; j < 16; ++j) { const unsigned c = xb_ld(&bar[XB_XCNT(j)]); sum += c; cnt += (c > 0u) ? 1u : 0u; mine = (j == x) ? c : mine; }
        if (sum == G) break;
        __builtin_amdgcn_s_sleep(1);
        if ((++sp & 255u) == 0u) { if (xb_ld(&bar[XB_TMO])) break; if (sp > XB_SPIN_CAP) { atomicAdd(&bar[XB_TMO], 1u); break; } }
    }
    nloc = mine > 0u ? mine : 1u; nx = cnt > 0u ? cnt : 1u;
}

__device__ __forceinline__ void xcd_barrier(const XcdBarrier& b) {
    asm volatile("s_waitcnt vmcnt(0)" ::: "memory");
    __syncthreads();
    if (threadIdx.x == 0) {
        unsigned* bar = b.bar;
        __builtin_amdgcn_s_waitcnt(0);
        unsigned nloc = b.st[0], nx = b.st[1];
        if (nloc == 0u) { xcd_barrier_complete(bar, b.x, nloc, nx); b.st[0] = nloc; b.st[1] = nx; }
        __builtin_amdgcn_fence(__ATOMIC_RELEASE, "agent");
        asm volatile("s_waitcnt vmcnt(0)" ::: "memory");
        const unsigned old = xb_add(&bar[XB_XSUB(b.x)], 1u);
        const unsigned gen = old / nloc;
        if (old + 1u == (gen + 1u) * nloc) {
            __builtin_amdgcn_fence(__ATOMIC_RELEASE, "agent");
            asm volatile("s_waitcnt vmcnt(0)" ::: "memory");
            const unsigned og = xb_add(&bar[XB_TOP], 1u);
            const unsigned tg = og / nx;
            if (og + 1u == (tg + 1u) * nx) xb_add(&bar[XB_TOPGEN], 1u);
            else XB_SPIN(xb_ld(&bar[XB_TOPGEN]) == tg, bar);
            __builtin_amdgcn_fence(__ATOMIC_ACQUIRE, "agent");
            xb_add(&bar[XB_XGEN(b.x)], 1u);
            asm volatile("s_waitcnt vmcnt(0)" ::: "memory");
        } else {
            XB_SPIN(xb_ld(&bar[XB_XGEN(b.x)]) == gen, bar);
            __builtin_amdgcn_fence(__ATOMIC_ACQUIRE, "agent");
            asm volatile("s_waitcnt vmcnt(0)" ::: "memory");
        }
    }
    __syncthreads();
}
#include <hip/hip_cooperative_groups.h>
namespace cg = cooperative_groups;
constexpr int NWAVES = 8;
constexpr int BATCH = 4, SEQ = 4096, D = 1024, FF = 4096, M = BATCH * SEQ, NIN = 8192;
constexpr size_t MiB = 1u << 20;
constexpr size_t WS_SS = 1 * MiB;
constexpr size_t WS_W1 = 2 * MiB, WS_WC = 18 * MiB, WS_WA = 20 * MiB  , WS_WO = 22 * MiB, WS_WUP = 24 * MiB, WS_WDN = 32 * MiB;
constexpr size_t WS_V = 40 * MiB  , WS_H = 72 * MiB  , WS_Q = 104 * MiB, WS_K = 136 * MiB  , WS_BG = 168 * MiB  , WS_U1 = 200 * MiB;
constexpr size_t WS_UU = 72 * MiB;
constexpr size_t WS_END = 232 * MiB;
constexpr int LDS_BYTES = 147456;
constexpr int LDSCTL_OFF = 131072, MISC_OFF = LDSCTL_OFF + 320;
constexpr size_t WS_CTL = 0, CTL_ZERO_BYTES = 65536; constexpr int CW_BAR = 4096;
__device__ __forceinline__ unsigned f2bf(float f) { unsigned u = __builtin_bit_cast(unsigned, f); return (u + 0x7fffu + ((u >> 16) & 1u)) >> 16; }
__device__ __forceinline__ unsigned pk2(float lo, float hi) { return f2bf(lo) | (f2bf(hi) << 16); }
__device__ __forceinline__ float wave_sum(float v) {
#pragma unroll
    for (int o = 1; o < 64; o <<= 1) v += __shfl_xor(v, o);
    return v;
}
__device__ __forceinline__ void tr_item(const float* W, int ldw, int col0, int k0, bf16* WT, int Kd, int drow0, const float* kscale, LAS float* scr, int lane) {
    float tv[32];
#pragma unroll
    for (int i = 0; i < 32; ++i) { const int kk = 2 * i + (lane >> 5); tv[i] = W[(size_t)(k0 + kk) * ldw + col0 + (lane & 31)]; }
#pragma unroll
    for (int i = 0; i < 32; ++i) { const int kk = 2 * i + (lane >> 5); float v = tv[i]; if (kscale) v *= kscale[k0 + kk]; scr[kk * 33 + (lane & 31)] = v; }
    LDS_WAIT(); asm volatile("" ::: "memory");
    const int c = lane & 7;
#pragma unroll
    for (int j = 0; j < 4; ++j) { const int n = (lane >> 3) + 8 * j; const LAS float* s = scr + (8 * c) * 33 + n;
        v4u o; o.x = pk2(s[0 * 33], s[1 * 33]); o.y = pk2(s[2 * 33], s[3 * 33]); o.z = pk2(s[4 * 33], s[5 * 33]); o.w = pk2(s[6 * 33], s[7 * 33]);
        pg8::st16(WT + (size_t)(drow0 + n) * Kd + k0 + 8 * c, o); }
    LDS_WAIT(); asm volatile("" ::: "memory");
}

#ifndef PH_MASK
#define PH_MASK 127
#endif
#ifndef REP_P1
#define REP_P1 1
#endif
#ifndef REP_ATT
#define REP_ATT 1
#endif
#ifndef REP_P3
#define REP_P3 1
#endif
#ifndef REP_P4
#define REP_P4 1
#endif
#ifndef REP_P5
#define REP_P5 1
#endif
#ifndef EXTRA_SYNC
#define EXTRA_SYNC 0
#endif
__device__ unsigned g_panel_cnt[64 * 64];
__device__ unsigned g_bar_shard[16 * 64];
__device__ unsigned g_bar_cnt = 0u, g_bar_gen = 0u, g_done_cnt = 0u;
struct Args { const float* in[16]; float* out; unsigned char* ws; };
__global__ void __launch_bounds__(NWAVES * 64, 2) fwd(Args a) {
    extern __shared__ __attribute__((aligned(16))) unsigned char lds[];
    cg::grid_group grid = cg::this_grid();
    LAS unsigned char* ldsp = (LAS unsigned char*)lds;
    const int tid = threadIdx.x, lane = tid & 63, wave = __builtin_amdgcn_readfirstlane(tid >> 6);
    const int G = gridDim.x, bx = blockIdx.x, vcu = (G % 8 == 0) ? (bx % 8) * (G / 8) + bx / 8 : bx;
    unsigned char* ws = a.ws;
    const float* x = a.in[0];
    bf16 *W1 = (bf16*)(ws + WS_W1), *WA = (bf16*)(ws + WS_WA), *WC = (bf16*)(ws + WS_WC), *WO = (bf16*)(ws + WS_WO), *WUP = (bf16*)(ws + WS_WUP), *WDN = (bf16*)(ws + WS_WDN);
    bf16 *Vb = (bf16*)(ws + WS_V), *X1B = (bf16*)(ws + WS_V), *Hb = (bf16*)(ws + WS_H), *YC = (bf16*)(ws + WS_H)  , *Qb = (bf16*)(ws + WS_Q), *AO = (bf16*)(ws + WS_Q)  , *Kb = (bf16*)(ws + WS_K), *MG = (bf16*)(ws + WS_K);
    bf16 *BG = (bf16*)(ws + WS_BG), *U1 = (bf16*)(ws + WS_U1), *UU = (bf16*)(ws + WS_UU), *Gt = (bf16*)a.out;
    float* SS = (float*)(ws + WS_SS);
    for (int u = tid; u < (LDS_BYTES - LDSCTL_OFF) / 4; u += NWAVES * 64) ((LAS unsigned*)(ldsp + LDSCTL_OFF))[u] = 0u;
    __syncthreads();
    if (a.out == nullptr) grid.sync();
#ifndef WB_AT_SEAMS
#define WB_AT_SEAMS 0
#endif
#if WB_AT_SEAMS || !WT_STORES
#define BAR_RELEASE() do { __builtin_amdgcn_fence(__ATOMIC_RELEASE, "agent"); asm volatile("s_waitcnt vmcnt(0)" ::: "memory"); } while (0)
#else
#define BAR_RELEASE() do { } while (0)
#endif
#if defined(MONO_BAR)
    const bool grouped = (G == 256);
    const unsigned NSEAMS = (grouped ? 3u : 6u) + EXTRA_SYNC;
    unsigned bar_epoch = 0u, bar_base = 0u; const unsigned bar_xcc = xb_xcc_id();
#define GRID_BAR() do { asm volatile("s_waitcnt vmcnt(0)" ::: "memory"); __syncthreads(); \
    ++bar_epoch; \
    if (tid == 0) { \
        BAR_RELEASE(); \
        unsigned old_ = xb_add(&g_bar_shard[64u * bar_xcc], 1u);     \
        if (bar_epoch == 1u) asm volatile("s_waitcnt vmcnt(0)" : "+v"(old_) :: "memory");     \
        const unsigned tgt_ = bar_epoch * (unsigned)G; unsigned sp_ = 0u; \
        for (;;) { unsigned s_ = 0u; _Pragma("unroll") for (int j_ = 0; j_ < 16; ++j_) s_ += xb_ld(&g_bar_shard[64 * j_]); \
            if (bar_epoch == 1u && sp_ == 0u) bar_base = ((s_ - 1u) / (NSEAMS * (unsigned)G)) * (NSEAMS * (unsigned)G);     \
            if (s_ - bar_base >= tgt_) break; \
            __builtin_amdgcn_s_sleep(8); if (++sp_ > (1u << 22)) break; } \
        __builtin_amdgcn_fence(__ATOMIC_ACQUIRE, "agent"); asm volatile("s_waitcnt vmcnt(0)" ::: "memory"); } \
    __syncthreads(); } while (0)
    unsigned grp_epoch = 0u, grp_base = 0u;
#define GROUP_BAR(pm_) do { asm volatile("s_waitcnt vmcnt(0)" ::: "memory"); __syncthreads(); \
    ++grp_epoch; \
    if (tid == 0) { unsigned* pc_ = &g_panel_cnt[64 * (pm_)]; \
        BAR_RELEASE(); \
        const unsigned old_ = xb_add(pc_, 1u); \
        if (grp_epoch == 1u) grp_base = old_ - old_ % 12u; \
        const unsigned tgt_ = grp_epoch * 4u; unsigned sp_ = 0u; \
        while (xb_ld(pc_) - grp_base < tgt_) { __builtin_amdgcn_s_sleep(1); if (++sp_ > (1u << 22)) break; } \
        __builtin_amdgcn_fence(__ATOMIC_ACQUIRE, "agent"); asm volatile("s_waitcnt vmcnt(0)" ::: "memory"); } \
    __syncthreads(); } while (0)
#elif defined(GEN_BAR)
#define GRID_BAR() do { asm volatile("s_waitcnt vmcnt(0)" ::: "memory"); __syncthreads(); \
    if (tid == 0) { \
        __builtin_amdgcn_fence(__ATOMIC_RELEASE, "agent"); asm volatile("s_waitcnt vmcnt(0)" ::: "memory"); \
        unsigned g0_ = xb_ld(&g_bar_gen); asm volatile("s_waitcnt vmcnt(0)" : "+v"(g0_) :: "memory");            \
        unsigned old_ = xb_add(&g_bar_cnt, 1u); asm volatile("s_waitcnt vmcnt(0)" : "+v"(old_) :: "memory"); \
        if (old_ == (unsigned)G - 1u) { __hip_atomic_store(&g_bar_cnt, 0u, RLX_AGENT); asm volatile("s_waitcnt vmcnt(0)" ::: "memory"); xb_add(&g_bar_gen, 1u); } \
        else { unsigned sp_ = 0u; while (xb_ld(&g_bar_gen) == g0_) { __builtin_amdgcn_s_sleep(1); if (++sp_ > (1u << 22)) break; } } \
        __builtin_amdgcn_fence(__ATOMIC_ACQUIRE, "agent"); asm volatile("s_waitcnt vmcnt(0)" ::: "memory"); } \
    __syncthreads(); } while (0)
#elif defined(CG_ALL)
#define GRID_BAR() do { asm volatile("s_waitcnt vmcnt(0)" ::: "memory"); grid.sync(); } while (0)
#elif defined(SIMPLE_BAR)
    unsigned bar_epoch = 0u;
#define GRID_BAR() do { asm volatile("s_waitcnt vmcnt(0)" ::: "memory"); __syncthreads(); \
    ++bar_epoch; \
    if (tid == 0) { unsigned* cnt_ = (unsigned*)(ws + WS_CTL) + CW_BAR + XB_TOP; \
        __builtin_amdgcn_fence(__ATOMIC_RELEASE, "agent"); asm volatile("s_waitcnt vmcnt(0)" ::: "memory"); \
        xb_add(cnt_, 1u); unsigned sp_ = 0u; \
        while (xb_ld(cnt_) < bar_epoch * (unsigned)G) { __builtin_amdgcn_s_sleep(1); if (++sp_ > (1u << 22)) break; } \
        __builtin_amdgcn_fence(__ATOMIC_ACQUIRE, "agent"); asm volatile("s_waitcnt vmcnt(0)" ::: "memory"); } \
    __syncthreads(); } while (0)
#else
#define GRID_BAR() xcd_barrier(bar)
#endif

#ifndef DUP_P0
#define DUP_P0 1
#endif
    for (int rep0 = 0; rep0 < DUP_P0; ++rep0) {
        LAS float* scr = (LAS float*)(ldsp + wave * 16384);
        const int gw = vcu * NWAVES + wave, NGW = G * NWAVES;
        constexpr int I_1 = 16 * 256, I_S = 16 * 32, I_UP = 16 * 128, I_DN = 64 * 32, NITEMS = I_1 + 3 * I_S + I_UP + I_DN;
        for (int it = gw; it < NITEMS; it += NGW) {
            int r = it;
            if (r < I_1) { const int db = r & 255, kb = r >> 8, pn = db >> 3, pb = db & 7, bj = pb >> 2, wcc = pb & 3; const float* W = a.in[2]; int ldw = 6144, col;
                if (pn < 4) col = (4 * pn + wcc) * 64 + 32 * bj;
                else if (pn < 8) col = 1024 + (4 * (pn - 4) + wcc) * 64 + 32 * bj;
                else if (pn < 12) col = 2048 + 256 * (pn - 8) + 32 * pb;
                else if (pn < 16) col = 3072 + 256 * (pn - 12) + 32 * pb;
                else if (pn < 24) col = (bj ? 5120 : 4096) + 128 * (pn - 16) + 32 * wcc;
                else { W = a.in[10]; ldw = 2048; col = 256 * (pn - 24) + 32 * pb; }
                tr_item(W, ldw, col, 64 * kb, W1, D, 32 * db, nullptr, scr, lane); continue; } r -= I_1;
            if (r < I_S) { tr_item(a.in[8], D, 32 * (r & 31), 64 * (r >> 5), WA, D, 32 * (r & 31), nullptr, scr, lane); continue; } r -= I_S;
            if (r < I_S) { tr_item(a.in[9], D, 32 * (r & 31), 64 * (r >> 5), WC, D, 32 * (r & 31), nullptr, scr, lane); continue; } r -= I_S;
            if (r < I_S) { tr_item(a.in[12], D, 32 * (r & 31), 64 * (r >> 5), WO, D, 32 * (r & 31), nullptr, scr, lane); continue; } r -= I_S;
            if (r < I_UP) { tr_item(a.in[14], FF, 32 * (r & 127), 64 * (r >> 7), WUP, D, 32 * (r & 127), a.in[13], scr, lane); continue; } r -= I_UP;
            tr_item(a.in[15], D, 32 * (r & 31), 64 * (r >> 5), WDN, FF, 32 * (r & 31), nullptr, scr, lane);
        }
        const float* g1 = a.in[1];
        f32x4 gv[4];
#pragma unroll
        for (int j = 0; j < 4; ++j) gv[j] = ((const f32x4*)g1)[lane + 64 * j];
        for (int m0 = gw; m0 < M; m0 += 2 * NGW) {
            const int m1 = m0 + NGW;
            const bool has1 = m1 < M;
            const f32x4* xr0 = (const f32x4*)(x + (size_t)m0 * D) + lane; const f32x4* xr1 = (const f32x4*)(x + (size_t)(has1 ? m1 : m0) * D) + lane;
            f32x4 v0[4], v1[4]; float s0 = 0.f, s1 = 0.f;
#pragma unroll
            for (int j = 0; j < 4; ++j) { v0[j] = xr0[64 * j]; v1[j] = xr1[64 * j]; }
#pragma unroll
            for (int j = 0; j < 4; ++j) { s0 += (v0[j].x * v0[j].x + v0[j].y * v0[j].y) + (v0[j].z * v0[j].z + v0[j].w * v0[j].w); s1 += (v1[j].x * v1[j].x + v1[j].y * v1[j].y) + (v1[j].z * v1[j].z + v1[j].w * v1[j].w); }
            const float rs0 = 1.0f / sqrtf(wave_sum(s0) * (1.0f / D) + 1e-6f), rs1 = 1.0f / sqrtf(wave_sum(s1) * (1.0f / D) + 1e-6f);
            unsigned long long* o80 = (unsigned long long*)(Hb + (size_t)m0 * D) + lane; unsigned long long* o81 = (unsigned long long*)(Hb + (size_t)m1 * D) + lane;
#pragma unroll
            for (int j = 0; j < 4; ++j) { const f32x4 y = v0[j] * rs0 * gv[j]; pg8::st8(o80 + 64 * j, (pg8::u32x2w){pk2(y.x, y.y), pk2(y.z, y.w)}); }
            if (has1) {
#pragma unroll
                for (int j = 0; j < 4; ++j) { const f32x4 y = v1[j] * rs1 * gv[j]; pg8::st8(o81 + 64 * j, (pg8::u32x2w){pk2(y.x, y.y), pk2(y.z, y.w)}); } }
        }
    }
    GRID_BAR();
#if !defined(SIMPLE_BAR) && !defined(CG_ALL) && !defined(GEN_BAR) && !defined(MONO_BAR)
    const XcdBarrier bar = xcd_barrier_post((unsigned*)(ws + WS_CTL) + CW_BAR, (volatile LAS unsigned*)(ldsp + MISC_OFF) + 8);
#endif

    if (PH_MASK & 2) {
        pg8::Gemm g{Hb, W1, M, NIN, D}; pg8::StaticOrder S; S.init(M, NIN, G, bx);
        pg8::EpiP1 E{Qb, Kb, Vb, BG, U1, Gt, a.in[3], a.in[4], a.in[11]};
        pg8::gemm_phase<pg8::EpiP1, pg8::StaticOrder, true, true>(ldsp, g, S, E);
#ifdef DUP_P1
        { pg8::Gemm g2{Hb, W1, M, NIN, D}; pg8::StaticOrder S2; S2.init(M, NIN, G, bx); pg8::gemm_phase<pg8::EpiP1, pg8::StaticOrder, true, true>(ldsp, g2, S2, E); }
#endif
    }
    GRID_BAR();

    if (PH_MASK & 4) {
        for (int L = vcu; L < 1024 * REP_ATT; L += G) { const int bh = (L & 255) >> 2, gq4 = (L & 3) + 4 * ((L >> 8) & 3);
            attn::attn_unit(bh >> 4, bh & 15, gq4, Qb, Kb, Vb, AO, a.in[5], a.in[3], a.in[4], (char*)lds); }
        const float* cw = a.in[6]; const float* cb = a.in[7];
        for (int item = vcu * 512 + tid; item < 131072; item += G * 512) {
            const int c8 = (item & 127) * 8, t0 = (item >> 7) * 16;
            float w0[8], w1[8], w2[8], b0[8], u1[8], u2[8];
#pragma unroll
            for (int e = 0; e < 8; ++e) { w0[e] = cw[c8 + e]; w1[e] = cw[1024 + c8 + e]; w2[e] = cw[2048 + c8 + e]; b0[e] = cb[c8 + e]; u1[e] = 0.f; u2[e] = 0.f; }
            if ((t0 & (SEQ - 1)) != 0) { f32x4 p, q; pg8::unpack8(*(const v4u*)(U1 + (size_t)(t0 - 2) * D + c8), p, q);
#pragma unroll
                for (int e = 0; e < 4; ++e) { u2[e] = p[e]; u2[4 + e] = q[e]; }
                pg8::unpack8(*(const v4u*)(U1 + (size_t)(t0 - 1) * D + c8), p, q);
#pragma unroll
                for (int e = 0; e < 4; ++e) { u1[e] = p[e]; u1[4 + e] = q[e]; } }
            v4u ur[16], br[16];
#pragma unroll
            for (int i = 0; i < 16; ++i) { const size_t off = (size_t)(t0 + i) * D + c8; ur[i] = *(const v4u*)(U1 + off); br[i] = *(const v4u*)(BG + off); }
#pragma unroll
            for (int i = 0; i < 16; ++i) { const size_t off = (size_t)(t0 + i) * D + c8; f32x4 p, q, bp, bq; float u0[8], bgv[8], y[8];
                pg8::unpack8(ur[i], p, q); pg8::unpack8(br[i], bp, bq);
#pragma unroll
                for (int e = 0; e < 4; ++e) { u0[e] = p[e]; u0[4 + e] = q[e]; bgv[e] = bp[e]; bgv[4 + e] = bq[e]; }
#pragma unroll
                for (int e = 0; e < 8; ++e) { y[e] = bgv[e] * (b0[e] + w0[e] * u2[e] + w1[e] * u1[e] + w2[e] * u0[e]); u2[e] = u1[e]; u1[e] = u0[e]; }
                v4u o; o.x = pk2(y[0], y[1]); o.y = pk2(y[2], y[3]); o.z = pk2(y[4], y[5]); o.w = pk2(y[6], y[7]); pg8::st16(YC + off, o); }
        }
    }
    GRID_BAR();

    if (PH_MASK & 8) {
        static_assert(WS_Q == WS_H + (size_t)M * D * 2 && WS_WA == WS_WC + (size_t)D * D * 2, "P3 reads the stacked [YC ; AO] and [Wc ; Wa]");
        pg8::PairOrder S; S.S.init(M, D, G, bx);
        pg8::Gemm g{YC, WC, 2 * M, 2 * D, D}; pg8::EpiGate2 E{Gt, MG};
        pg8::gemm_phase<pg8::EpiGate2, pg8::PairOrder, true, true>(ldsp, g, S, E);
    }
    { pg8::StaticOrder S; S.init(M, D, G, bx); pg8::Unit u0; S.next(0, u0); if (grouped) GROUP_BAR(u0.pm); else GRID_BAR(); }

    if (PH_MASK & 16) {
        pg8::Gemm g{MG, WO, M, D, D}; pg8::StaticOrder S; S.init(M, D, G, bx);
        pg8::EpiRes1 E{x, a.out, X1B, SS};
        pg8::gemm_phase<pg8::EpiRes1, pg8::StaticOrder, true, true>(ldsp, g, S, E);
#ifdef DUP_P4
        pg8::gemm_phase<pg8::EpiRes1, pg8::StaticOrder, true, true>(ldsp, g, S, E);
#endif
    }
    { pg8::StaticOrder S; S.init(M, D, G, bx); pg8::Unit u0; S.next(0, u0); if (grouped) GROUP_BAR(u0.pm); else GRID_BAR(); }

    if (PH_MASK & 32) {
        pg8::Gemm g{X1B, WUP, M, FF, D}; pg8::StaticOrder S; S.init(M, FF, G, bx);
        pg8::EpiUp E{SS, UU, (size_t)M * D};
        pg8::gemm_phase<pg8::EpiUp, pg8::StaticOrder, true, true>(ldsp, g, S, E);
#ifdef DUP_P5
        pg8::gemm_phase<pg8::EpiUp, pg8::StaticOrder, true, true>(ldsp, g, S, E);
#endif
    }
    { pg8::StaticOrder S; S.init(M, D, G, bx); pg8::Unit u0; S.next(0, u0); if (grouped) GROUP_BAR(u0.pm); else GRID_BAR(); }

    for (int i = 0; i < EXTRA_SYNC; ++i) GRID_BAR();
    if (PH_MASK & 64) {
        pg8::Gemm g{UU, WDN, M, D, FF, D, 4, (size_t)M * D * 2}; pg8::StaticOrder S; S.init(M, D, G, bx);
        pg8::EpiRes2 E{a.out, X1B};
        pg8::gemm_phase<pg8::EpiRes2, pg8::StaticOrder, true, true>(ldsp, g, S, E);
    }
#if defined(MONO_BAR)
    if (wave == 0) { unsigned old_ = 0u; if (lane == 0) old_ = xb_add(&g_done_cnt, 1u);
        old_ = (unsigned)__builtin_amdgcn_readfirstlane((int)old_);
        if (old_ == (unsigned)G - 1u) { __hip_atomic_store(&g_panel_cnt[64 * lane], 0u, RLX_AGENT);
            if (lane < 16) __hip_atomic_store(&g_bar_shard[64 * lane], 0u, RLX_AGENT);
            if (lane == 0) { __hip_atomic_store(&g_bar_cnt, 0u, RLX_AGENT); __hip_atomic_store(&g_done_cnt, 0u, RLX_AGENT); } } }
#endif
}

extern "C" void kernel_launch(void* const* d_in, const int* in_sizes, int n_in, void* d_out, int out_size, void* d_ws, size_t ws_size, hipStream_t stream) {
    static int grid = 0;
    if (grid == 0) {
        if (n_in != 16 || out_size != M * D || ws_size < WS_END) { fprintf(stderr, "kernel_launch: unexpected shapes (n_in %d, out %d, ws %zu)\n", n_in, out_size, ws_size); grid = -1; return; }
        int dev = 0, cus = 0, per_cu = 0;
        (void)hipGetDevice(&dev); (void)hipDeviceGetAttribute(&cus, hipDeviceAttributeMultiprocessorCount, dev);
        if (hipFuncSetAttribute((const void*)fwd, hipFuncAttributeMaxDynamicSharedMemorySize, LDS_BYTES) != hipSuccess) { fprintf(stderr, "kernel_launch: hipFuncSetAttribute failed\n"); grid = -1; return; }
        if (hipOccupancyMaxActiveBlocksPerMultiprocessor(&per_cu, (const void*)fwd, NWAVES * 64, LDS_BYTES) != hipSuccess || per_cu < 1) { fprintf(stderr, "kernel_launch: occupancy query says %d\n", per_cu); per_cu = 1; }
        (void)hipGetLastError();
        grid = cus * 1;
    }
    if (grid < 0) return;
#if !defined(GEN_BAR) && !defined(MONO_BAR)
    if (hipMemsetAsync((char*)d_ws + WS_CTL, 0, CTL_ZERO_BYTES, stream) != hipSuccess) { fprintf(stderr, "kernel_launch: memset of the barrier words failed\n"); return; }
#endif
    Args a{};
    for (int i = 0; i < 16; ++i) a.in[i] = (const float*)d_in[i];
    a.out = (float*)d_out; a.ws = (unsigned char*)d_ws;
    void* args[] = {&a};
    hipError_t e = hipLaunchCooperativeKernel((const void*)fwd, dim3(grid), dim3(NWAVES * 64), args, LDS_BYTES, stream);
    if (e != hipSuccess) fprintf(stderr, "kernel_launch: cooperative launch failed: %s (grid %d)\n", hipGetErrorString(e), grid);
}
```

```cpp
#include <hip/hip_runtime.h>
#include <cstdio>
#include <cstdint>
#define MONO_BAR 1
namespace pg8 {
#define PG8_LAS __attribute__((address_space(3)))
typedef unsigned short bf16_t;
typedef short bf16x8 __attribute__((ext_vector_type(8)));
typedef float f32x4 __attribute__((ext_vector_type(4)));
typedef unsigned u32x4 __attribute__((ext_vector_type(4)));
constexpr int BM = 256, BK = 64, HALF = 128, HTB = HALF * BK * 2  , STAGE_BYTES = 8 * HTB, NXCD = 8, WGM = 8;

__host__ __device__ __forceinline__ int lds_byte(int r, int c) { const int st = (r >> 4) * 2 + (c >> 5), rr = r & 15, cc = c & 31, ob = rr * 64 + cc * 2; return st * 1024 + (ob ^ (((ob >> 9) & 1) << 5)); }
__host__ __device__ __forceinline__ void stage_rc(int b, int& R, int& C) { const int st = b / 1024, sb = b % 1024, swz = sb ^ (((sb >> 9) & 1) << 5); R = (st >> 1) * 16 + swz / 64; C = (st & 1) * 32 + (swz % 64) / 2; }
__host__ __device__ __forceinline__ int perm32(int rho) { const int n = rho >> 4, i = rho & 15; return 8 * (i >> 2) + 4 * n + (i & 3); }

struct Unit { int pm, pn; };
struct Gemm { const bf16_t* A; const bf16_t* Bt; int M, N, K; int lda; int segsh; size_t segstride; };

struct StaticOrder {
    int nM, nN, nwg, G, c;
    __host__ __device__ void init(int M, int N, int G_, int c_) { nM = M / BM; nN = N / BM; nwg = nM * nN; G = G_; c = c_; }
    __host__ __device__ bool next(int i, Unit& u) const {
        const long L = (long)i * G + c; if (L >= nwg) return false;
        int wgid = (int)L; { const int q = nwg / NXCD, r = nwg % NXCD, xcd = wgid % NXCD, off = wgid / NXCD; wgid = (xcd < r ? xcd * (q + 1) : r * (q + 1) + (xcd - r) * q) + off; }
        const int nig = WGM * nN, gid = wgid / nig, fm = gid * WGM, gsz = (nM - fm) < WGM ? (nM - fm) : WGM;
        u.pm = fm + ((wgid % nig) % gsz); u.pn = (wgid % nig) / gsz; return true;
    }
    __device__ __forceinline__ void a_ready(const Unit&) const {}
    __device__ __forceinline__ void done(const Unit&) const {}
};

__device__ __forceinline__ unsigned cvt_pk_bf16(float lo, float hi) { unsigned r; asm volatile("v_cvt_pk_bf16_f32 %0, %1, %2" : "=v"(r) : "v"(lo), "v"(hi)); return r; }
typedef float f32x2 __attribute__((ext_vector_type(2)));
#ifndef WT_STORES
#define WT_STORES 1
#endif
__device__ __forceinline__ void st16(void* p, u32x4 v) {
#if WT_STORES
    asm volatile("global_store_dwordx4 %0, %1, off sc1\n\ts_nop 1" :: "v"(p), "v"(v) : "memory");
#else
    *(u32x4*)p = v;
#endif
}
typedef unsigned u32x2w __attribute__((ext_vector_type(2)));
__device__ __forceinline__ void st8(void* p, u32x2w v) {
#if WT_STORES
    asm volatile("global_store_dwordx2 %0, %1, off sc1\n\ts_nop 1" :: "v"(p), "v"(v) : "memory");
#else
    *(u32x2w*)p = v;
#endif
}
typedef unsigned u32x2 __attribute__((ext_vector_type(2)));
__device__ __forceinline__ float bf_lo(unsigned w) { return __uint_as_float(w << 16); }
__device__ __forceinline__ float bf_hi(unsigned w) { return __uint_as_float(w & 0xffff0000u); }
__device__ __forceinline__ u32x4 pack8(f32x4 a, f32x4 b) { u32x4 w; w.x = cvt_pk_bf16(a[0], a[1]); w.y = cvt_pk_bf16(a[2], a[3]); w.z = cvt_pk_bf16(b[0], b[1]); w.w = cvt_pk_bf16(b[2], b[3]); return w; }
__device__ __forceinline__ void unpack8(u32x4 w, f32x4& a, f32x4& b) { a = (f32x4){bf_lo(w.x), bf_hi(w.x), bf_lo(w.y), bf_hi(w.y)}; b = (f32x4){bf_lo(w.z), bf_hi(w.z), bf_lo(w.w), bf_hi(w.w)}; }
constexpr float QK_C2 = 0.125f * 1.4426950408889634f;
constexpr float RMS_EPS = 1e-6f;

struct EpiP1 {
    static constexpr bool PERM = true, AFTER_DRAIN = false;
    bf16_t *Q, *Kb, *V, *BG, *U1, *G; const float *gq, *gk, *bgate;
    __device__ __forceinline__ void operator()(const f32x4 (&acc)[2][2][4][2], const Unit& u, int wr, int wc, int fr, int fq) const {
        const int pn = u.pn; const int row0 = u.pm * BM + wr * 64 + fr;
        if (pn < 8) {
            const bool isq = pn < 4; const float* g = isq ? gq : gk; bf16_t* O = isq ? Q : Kb; const float sc = isq ? QK_C2 : 1.f;
            const int head = 4 * (pn & 3) + wc;
            f32x4 gv[2][2];
#pragma unroll
            for (int bj = 0; bj < 2; ++bj)
#pragma unroll
                for (int n = 0; n < 2; ++n) gv[bj][n] = *(const f32x4*)(g + 32 * bj + 8 * fq + 4 * n) * sc;
#pragma unroll
            for (int ai = 0; ai < 2; ++ai)
#pragma unroll
                for (int m = 0; m < 4; ++m) {
                    float s = 0.f;
#pragma unroll
                    for (int bj = 0; bj < 2; ++bj)
#pragma unroll
                        for (int n = 0; n < 2; ++n) { const f32x4 x = acc[ai][bj][m][n]; s += (x[0] * x[0] + x[1] * x[1]) + (x[2] * x[2] + x[3] * x[3]); }
                    s += __shfl_xor(s, 16); s += __shfl_xor(s, 32);
                    const float rs = 1.0f / sqrtf(s * (1.0f / 64.0f) + RMS_EPS);
                    bf16_t* rowp = O + (size_t)(row0 + ai * HALF + m * 16) * 1024 + head * 64 + 8 * fq;
#pragma unroll
                    for (int bj = 0; bj < 2; ++bj) st16(rowp + 32 * bj, pack8(acc[ai][bj][m][0] * rs * gv[bj][0], acc[ai][bj][m][1] * rs * gv[bj][1]));
                }
        } else if (pn < 16) {
            bf16_t* O = (pn < 12) ? V : BG; const int col0 = 256 * (pn & 3) + wc * 32 + 8 * fq;
#pragma unroll
            for (int ai = 0; ai < 2; ++ai)
#pragma unroll
                for (int m = 0; m < 4; ++m) { bf16_t* rowp = O + (size_t)(row0 + ai * HALF + m * 16) * 1024 + col0;
#pragma unroll
                    for (int bj = 0; bj < 2; ++bj) st16(rowp + bj * HALF, pack8(acc[ai][bj][m][0], acc[ai][bj][m][1])); }
        } else if (pn < 24) {
            const int col0 = 128 * (pn - 16) + wc * 32 + 8 * fq;
#pragma unroll
            for (int ai = 0; ai < 2; ++ai)
#pragma unroll
                for (int m = 0; m < 4; ++m)
                    st16(U1 + (size_t)(row0 + ai * HALF + m * 16) * 1024 + col0, pack8(acc[ai][0][m][0] * acc[ai][1][m][0], acc[ai][0][m][1] * acc[ai][1][m][1]));
        } else {
            const int col0 = 256 * (pn - 24) + wc * 32 + 8 * fq;
            f32x4 bv[2][2];
#pragma unroll
            for (int bj = 0; bj < 2; ++bj)
#pragma unroll
                for (int n = 0; n < 2; ++n) bv[bj][n] = *(const f32x4*)(bgate + col0 + bj * HALF + 4 * n);
#pragma unroll
            for (int ai = 0; ai < 2; ++ai)
#pragma unroll
                for (int m = 0; m < 4; ++m) { bf16_t* rowp = G + (size_t)(row0 + ai * HALF + m * 16) * 2048 + col0;
#pragma unroll
                    for (int bj = 0; bj < 2; ++bj) { f32x4 v[2];
#pragma unroll
                        for (int n = 0; n < 2; ++n) { const f32x4 z = (acc[ai][bj][m][n] + bv[bj][n]) * (-1.4426950408889634f);
#pragma unroll
                            for (int e = 0; e < 4; ++e) v[n][e] = __builtin_amdgcn_rcpf(1.0f + __builtin_amdgcn_exp2f(z[e])); }
                        st16(rowp + bj * HALF, pack8(v[0], v[1])); } }
        }
    }
};
template <bool ADD> struct EpiGate {
    static constexpr bool PERM = true, AFTER_DRAIN = false;
    const bf16_t* G; bf16_t* MG; int goff;
    __device__ __forceinline__ void operator()(const f32x4 (&acc)[2][2][4][2], const Unit& u, int wr, int wc, int fr, int fq) const {
        const int row0 = u.pm * BM + wr * 64 + fr, col0 = u.pn * BM + wc * 32 + 8 * fq;
#pragma unroll
        for (int ai = 0; ai < 2; ++ai)
#pragma unroll
            for (int m = 0; m < 4; ++m) { const size_t r = (size_t)(row0 + ai * HALF + m * 16);
#pragma unroll
                for (int bj = 0; bj < 2; ++bj) { f32x4 g0, g1; unpack8(*(const u32x4*)(G + r * 2048 + goff + col0 + bj * HALF), g0, g1);
                    f32x4 v0 = acc[ai][bj][m][0] * g0, v1 = acc[ai][bj][m][1] * g1;
                    bf16_t* p = MG + r * 1024 + col0 + bj * HALF;
                    if (ADD) { f32x4 a0, a1; unpack8(*(const u32x4*)p, a0, a1); v0 += a0; v1 += a1; }
                    *(u32x4*)p = pack8(v0, v1); } }
    }
};
struct PairOrder {
    StaticOrder S;
    __device__ bool next(int i, Unit& u) const { Unit b; if (!S.next(i >> 1, b)) return false; u.pm = b.pm + ((i & 1) ? 64 : 0); u.pn = b.pn + ((i & 1) ? 4 : 0); return true; }
    __device__ __forceinline__ void a_ready(const Unit&) const {}
    __device__ __forceinline__ void done(const Unit&) const {}
};
struct EpiGate2 {
    static constexpr bool PERM = true, AFTER_DRAIN = false;
    const bf16_t* G; bf16_t* MG;
    __device__ __forceinline__ void operator()(const f32x4 (&acc)[2][2][4][2], const Unit& u, int wr, int wc, int fr, int fq) const {
        const bool second = u.pm >= 64; const int pm = second ? u.pm - 64 : u.pm, pn = second ? u.pn - 4 : u.pn, goff = second ? 0 : 1024;
        const int row0 = pm * BM + wr * 64 + fr, col0 = pn * BM + wc * 32 + 8 * fq;
#pragma unroll
        for (int ai = 0; ai < 2; ++ai) {
            u32x4 gl[4][2], ml[4][2];
#pragma unroll
            for (int m = 0; m < 4; ++m) { const size_t r = (size_t)(row0 + ai * HALF + m * 16);
#pragma unroll
                for (int bj = 0; bj < 2; ++bj) { gl[m][bj] = *(const u32x4*)(G + r * 2048 + goff + col0 + bj * HALF); if (second) ml[m][bj] = *(const u32x4*)(MG + r * 1024 + col0 + bj * HALF); } }
#pragma unroll
            for (int m = 0; m < 4; ++m) { const size_t r = (size_t)(row0 + ai * HALF + m * 16);
#pragma unroll
                for (int bj = 0; bj < 2; ++bj) { f32x4 g0, g1; unpack8(gl[m][bj], g0, g1);
                    f32x4 v0 = acc[ai][bj][m][0] * g0, v1 = acc[ai][bj][m][1] * g1;
                    bf16_t* p = MG + r * 1024 + col0 + bj * HALF;
                    if (second) { f32x4 a0, a1; unpack8(ml[m][bj], a0, a1); v0 += a0; v1 += a1; } st16(p, pack8(v0, v1)); } }
        }
    }
};
#ifndef STORE_X1_F32
#define STORE_X1_F32 0
#endif
struct EpiRes1 {
    static constexpr bool PERM = false, AFTER_DRAIN = false;
    const float* x; float* out; bf16_t* x1b; float* SS;
    __device__ __forceinline__ void operator()(const f32x4 (&acc)[2][2][4][2], const Unit& u, int wr, int wc, int fr, int fq) const {
        const int row0 = u.pm * BM + wr * 64 + fr, col0 = u.pn * BM + wc * 32 + 4 * fq;
#pragma unroll
        for (int ai = 0; ai < 2; ++ai) {
            f32x4 xv[4][2][2];
#pragma unroll
            for (int m = 0; m < 4; ++m) { const size_t off = (size_t)(row0 + ai * HALF + m * 16) * 1024 + col0;
#pragma unroll
                for (int bj = 0; bj < 2; ++bj)
#pragma unroll
                    for (int n = 0; n < 2; ++n) xv[m][bj][n] = *(const f32x4*)(x + off + bj * HALF + n * 16); }
#pragma unroll
            for (int m = 0; m < 4; ++m) { const size_t r = (size_t)(row0 + ai * HALF + m * 16); const size_t off = r * 1024 + col0; float s = 0.f;
#pragma unroll
                for (int bj = 0; bj < 2; ++bj)
#pragma unroll
                    for (int n = 0; n < 2; ++n) { const f32x4 v = xv[m][bj][n] + acc[ai][bj][m][n];
                        if (STORE_X1_F32) *(f32x4*)(out + off + bj * HALF + n * 16) = v; s += (v[0] * v[0] + v[1] * v[1]) + (v[2] * v[2] + v[3] * v[3]);
                        u32x2 w; w.x = cvt_pk_bf16(v[0], v[1]); w.y = cvt_pk_bf16(v[2], v[3]); st8(x1b + off + bj * HALF + n * 16, w); }
                s += __shfl_xor(s, 16); s += __shfl_xor(s, 32);
                if (fq == 0) __hip_atomic_store(SS + r * 16 + 4 * u.pn + wc, s, __ATOMIC_RELAXED, __HIP_MEMORY_SCOPE_AGENT); }
            asm volatile("" ::: "memory");
        }
    }
};
struct EpiUp {
    static constexpr bool PERM = true, AFTER_DRAIN = false;
    const float* SS; bf16_t* UU; size_t piece;
    __device__ __forceinline__ void operator()(const f32x4 (&acc)[2][2][4][2], const Unit& u, int wr, int wc, int fr, int fq) const {
        const int row0 = u.pm * BM + wr * 64 + fr;
        bf16_t* UUp = UU + (size_t)(u.pn >> 2) * piece + (u.pn & 3) * BM + wc * 32 + 8 * fq;
#pragma unroll
        for (int ai = 0; ai < 2; ++ai)
#pragma unroll
            for (int m = 0; m < 4; ++m) { const size_t r = (size_t)(row0 + ai * HALF + m * 16);
                const f32x4* sp = (const f32x4*)(SS + r * 16); const f32x4 s4 = (sp[0] + sp[1]) + (sp[2] + sp[3]);
                const float rs = 1.0f / sqrtf(((s4[0] + s4[1]) + (s4[2] + s4[3])) * (1.0f / 1024.0f) + RMS_EPS);
#pragma unroll
                for (int bj = 0; bj < 2; ++bj) { f32x4 v[2];
#pragma unroll
                    for (int n = 0; n < 2; ++n) { const f32x4 z = acc[ai][bj][m][n] * rs;
#pragma unroll
                        for (int e = 0; e < 4; ++e) { const float t = fmaxf(z[e], 0.f); v[n][e] = t * t; } }
                    st16(UUp + r * 1024 + bj * HALF, pack8(v[0], v[1])); } }
    }
};
struct EpiRes2 {
    static constexpr bool PERM = false, AFTER_DRAIN = false;
    float* out; const bf16_t* x1b;
    __device__ __forceinline__ void operator()(const f32x4 (&acc)[2][2][4][2], const Unit& u, int wr, int wc, int fr, int fq) const {
        const int row0 = u.pm * BM + wr * 64 + fr, col0 = u.pn * BM + wc * 32 + 4 * fq;
#pragma unroll
        for (int ai = 0; ai < 2; ++ai)
#pragma unroll
            for (int m = 0; m < 4; ++m) { const size_t off = (size_t)(row0 + ai * HALF + m * 16) * 1024 + col0;
#pragma unroll
                for (int bj = 0; bj < 2; ++bj)
#pragma unroll
                    for (int n = 0; n < 2; ++n) { float* p = out + off + bj * HALF + n * 16;
#if STORE_X1_F32
                        const f32x4 b = *(const f32x4*)p;
#else
                        const u32x2 w = *(const u32x2*)(x1b + off + bj * HALF + n * 16); const f32x4 b = {bf_lo(w.x), bf_hi(w.x), bf_lo(w.y), bf_hi(w.y)};
#endif
                        *(f32x4*)p = b + acc[ai][bj][m][n]; }
                if (m == 3) asm volatile("" ::: "memory"); }
    }
};

template <class Epi, class Sched, bool ALIGN_EPI = false, bool SP2 = false>
__device__ __forceinline__ void gemm_phase(PG8_LAS unsigned char* lds, const Gemm g, const Sched& S, const Epi& E) {
    int tid_ = threadIdx.x; asm volatile("" : "+v"(tid_));
    const int tid = tid_, wid = __builtin_amdgcn_readfirstlane(tid >> 6), lane = tid & 63, wr = wid >> 2, wc = wid & 3, fr = lane & 15, fq = lane >> 4;
    const int K = g.K, nt = K / BK;
    const int lda = g.lda ? g.lda : K, segsh = g.segsh ? g.segsh : 30;
    unsigned voffA[2], voffB[2];
#pragma unroll
    for (int i = 0; i < 2; ++i) { int R, C; stage_rc(tid * 16 + i * 8192, R, C); const int Rb = Epi::PERM ? ((R & ~31) + perm32(R & 31)) : R;
        voffA[i] = (unsigned)(R * lda + C) * 2u; voffB[i] = (unsigned)(Rb * K + C) * 2u; }
    const size_t kstep = (size_t)(BK * 2);
    const size_t hstep = (size_t)HALF * K * 2;
    const size_t tstep = 2 * hstep;
    const size_t hstepA = (size_t)HALF * lda * 2, tstepA = 2 * hstepA;
#define PG8_AOFF(t_) ((size_t)((t_) >> segsh) * g.segstride + (size_t)((t_) & ((1 << segsh) - 1)) * kstep)
    const unsigned ldsw = (unsigned)wid * 1024u;
    const int aoff = lds_byte(wr * 64 + fr, fq * 8), boff = lds_byte(wc * 32 + fr, fq * 8);
#define PG8_SA(b, h) (((b) * 2 + (h)) * HTB)
#define PG8_SB(b, h) ((4 + (b) * 2 + (h)) * HTB)
#define PG8_STAGE(bufoff, gbase, voff) do { _Pragma("unroll") for (int _i = 0; _i < 2; ++_i) \
        __builtin_amdgcn_global_load_lds((const unsigned*)((const char*)(gbase) + (voff)[_i]), (PG8_LAS unsigned*)(lds + (bufoff) + ldsw + _i * 8192), 16, 0, 0); } while (0)
#define PG8_LDA(dst, b, h) do { _Pragma("unroll") for (int m = 0; m < 4; ++m) _Pragma("unroll") for (int k = 0; k < 2; ++k) dst[m][k] = *(const PG8_LAS bf16x8*)(lds + PG8_SA(b, h) + aoff + m * 2048 + k * 1024); } while (0)
#define PG8_LDB(dst, b, h) do { _Pragma("unroll") for (int n = 0; n < 2; ++n) _Pragma("unroll") for (int k = 0; k < 2; ++k) dst[n][k] = *(const PG8_LAS bf16x8*)(lds + PG8_SB(b, h) + boff + n * 2048 + k * 1024); } while (0)
#define PG8_MMA(ai, bj, At, Bt) do { __builtin_amdgcn_s_setprio(1); _Pragma("unroll") for (int m = 0; m < 4; ++m) _Pragma("unroll") for (int n = 0; n < 2; ++n) _Pragma("unroll") for (int k = 0; k < 2; ++k) \
        acc[ai][bj][m][n] = __builtin_amdgcn_mfma_f32_16x16x32_bf16(Bt[n][k], At[m][k], acc[ai][bj][m][n], 0, 0, 0); __builtin_amdgcn_s_setprio(0); } while (0)
#define PG8_WAIT_V(n) asm volatile("s_waitcnt vmcnt(" #n ")" ::: "memory")
#define PG8_WAIT_L(n) asm volatile("s_waitcnt lgkmcnt(" #n ")" ::: "memory")
#define PG8_BAR __builtin_amdgcn_s_barrier()
#define PG8_SCHED __builtin_amdgcn_sched_barrier(0)
    Unit cur, nxt; int ui = 0;
    if (!S.next(0, cur)) return;
    f32x4 acc[2][2][4][2];
#pragma unroll
    for (int a = 0; a < 2; ++a)
#pragma unroll
        for (int b = 0; b < 2; ++b)
#pragma unroll
            for (int m = 0; m < 4; ++m)
#pragma unroll
                for (int n = 0; n < 2; ++n) acc[a][b][m][n] = (f32x4){0.f, 0.f, 0.f, 0.f};
    bf16x8 At[4][2], B0[2][2], B1[2][2];
    const char* cA = (const char*)g.A + (size_t)cur.pm * tstepA; const char* cB = (const char*)g.Bt + (size_t)cur.pn * tstep;
    S.a_ready(cur);
    if constexpr (SP2) {
        PG8_STAGE(PG8_SB(0, 0), cB, voffB); PG8_STAGE(PG8_SB(0, 1), cB + hstep, voffB); PG8_STAGE(PG8_SA(0, 0), cA, voffA); PG8_STAGE(PG8_SA(0, 1), cA + hstepA, voffA);
        if (wr == 1) PG8_BAR;
        PG8_WAIT_V(2); PG8_BAR;
        PG8_STAGE(PG8_SB(1, 0), cB + kstep, voffB); PG8_STAGE(PG8_SA(1, 0), cA + kstep, voffA); PG8_STAGE(PG8_SB(1, 1), cB + hstep + kstep, voffB);
        PG8_WAIT_V(6); PG8_BAR;
    } else {
        PG8_STAGE(PG8_SB(0, 0), cB, voffB); PG8_STAGE(PG8_SA(0, 0), cA, voffA); PG8_STAGE(PG8_SB(0, 1), cB + hstep, voffB); PG8_STAGE(PG8_SA(0, 1), cA + hstepA, voffA);
        if (wr == 1) PG8_BAR;
        PG8_WAIT_V(4); PG8_BAR;
        PG8_STAGE(PG8_SB(1, 0), cB + kstep, voffB); PG8_STAGE(PG8_SA(1, 0), cA + kstep, voffA); PG8_STAGE(PG8_SB(1, 1), cB + hstep + kstep, voffB);
        PG8_WAIT_V(6); PG8_BAR;
    }
    for (;;) {
        const bool has_next = S.next(ui + 1, nxt);
        const char* nA = has_next ? (const char*)g.A + (size_t)nxt.pm * tstepA : cA; const char* nB = has_next ? (const char*)g.Bt + (size_t)nxt.pn * tstep : cB;
        for (int t = 0; t < nt; t += 2) {
            const bool last = (t == nt - 2);
            const char* a1 = cA + PG8_AOFF(t) + kstep;
            const char* a2 = last ? nA : cA + PG8_AOFF(t + 2); const char* b2 = last ? nB : cB + (size_t)(t + 2) * kstep;
            const char* a3 = a2 + kstep; const char* b3 = b2 + kstep;
            if (last && has_next) S.a_ready(nxt);
            if constexpr (SP2) {
            PG8_LDB(B0, 0, 0); PG8_LDB(B1, 0, 1); PG8_SCHED; PG8_LDA(At, 0, 0); PG8_STAGE(PG8_SA(1, 1), a1 + hstepA, voffA);
            PG8_WAIT_V(8); PG8_WAIT_L(0); PG8_BAR; PG8_MMA(0, 0, At, B0); PG8_MMA(0, 1, At, B1); PG8_BAR; PG8_SCHED;
            PG8_LDA(At, 0, 1); PG8_STAGE(PG8_SB(0, 0), b2, voffB); PG8_STAGE(PG8_SB(0, 1), b2 + hstep, voffB); PG8_STAGE(PG8_SA(0, 0), a2, voffA);
            PG8_WAIT_V(8); PG8_WAIT_L(0); PG8_BAR; PG8_MMA(1, 0, At, B0); PG8_MMA(1, 1, At, B1); PG8_BAR; PG8_SCHED;
            PG8_LDB(B0, 1, 0); PG8_LDB(B1, 1, 1); PG8_SCHED; PG8_LDA(At, 1, 0); PG8_STAGE(PG8_SA(0, 1), a2 + hstepA, voffA);
            PG8_WAIT_V(8); PG8_WAIT_L(0); PG8_BAR; PG8_MMA(0, 0, At, B0); PG8_MMA(0, 1, At, B1); PG8_BAR; PG8_SCHED;
            PG8_LDA(At, 1, 1); PG8_STAGE(PG8_SB(1, 0), b3, voffB); PG8_STAGE(PG8_SB(1, 1), b3 + hstep, voffB); PG8_STAGE(PG8_SA(1, 0), a3, voffA);
            PG8_WAIT_V(8); PG8_WAIT_L(0); PG8_BAR; PG8_MMA(1, 0, At, B0); PG8_MMA(1, 1, At, B1); PG8_BAR; PG8_SCHED;
            } else {
            PG8_LDB(B0, 0, 0); PG8_SCHED; PG8_LDA(At, 0, 0); PG8_STAGE(PG8_SA(1, 1), a1 + hstepA, voffA);
            PG8_WAIT_L(8); PG8_BAR; PG8_WAIT_L(0); PG8_MMA(0, 0, At, B0); PG8_BAR; PG8_SCHED;
            PG8_LDB(B1, 0, 1); PG8_STAGE(PG8_SB(0, 0), b2, voffB);
            PG8_BAR; PG8_WAIT_L(0); PG8_MMA(0, 1, At, B1); PG8_BAR;
            PG8_LDA(At, 0, 1); PG8_STAGE(PG8_SA(0, 0), a2, voffA);
            PG8_BAR; PG8_WAIT_L(0); PG8_MMA(1, 0, At, B0); PG8_BAR; PG8_SCHED;
            PG8_STAGE(PG8_SB(0, 1), b2 + hstep, voffB);
            PG8_WAIT_V(6); PG8_BAR; PG8_MMA(1, 1, At, B1); PG8_BAR;
            PG8_LDB(B0, 1, 0); PG8_SCHED; PG8_LDA(At, 1, 0); PG8_STAGE(PG8_SA(0, 1), a2 + hstepA, voffA);
            PG8_WAIT_L(8); PG8_BAR; PG8_WAIT_L(0); PG8_MMA(0, 0, At, B0); PG8_BAR; PG8_SCHED;
            PG8_LDB(B1, 1, 1); PG8_STAGE(PG8_SB(1, 0), b3, voffB);
            PG8_BAR; PG8_WAIT_L(0); PG8_MMA(0, 1, At, B1); PG8_BAR;
            PG8_LDA(At, 1, 1); PG8_STAGE(PG8_SA(1, 0), a3, voffA);
            PG8_BAR; PG8_WAIT_L(0); PG8_MMA(1, 0, At, B0); PG8_BAR; PG8_SCHED;
            PG8_STAGE(PG8_SB(1, 1), b3 + hstep, voffB);
            PG8_WAIT_V(6); PG8_BAR; PG8_MMA(1, 1, At, B1); PG8_BAR;
            }
        }
        if constexpr (ALIGN_EPI) { if (wr == 0) PG8_BAR; }
        if constexpr (!Epi::AFTER_DRAIN) { E(acc, cur, wr, wc, fr, fq); S.done(cur); }
        if (!has_next) break;
#pragma unroll
        for (int a = 0; a < 2; ++a)
#pragma unroll
            for (int b = 0; b < 2; ++b)
#pragma unroll
                for (int m = 0; m < 4; ++m)
#pragma unroll
                    for (int n = 0; n < 2; ++n) acc[a][b][m][n] = (f32x4){0.f, 0.f, 0.f, 0.f};
        cur = nxt; cA = nA; cB = nB; ++ui;
        if constexpr (ALIGN_EPI) { if (wr == 1) PG8_BAR; }
    }
    PG8_WAIT_V(0);
    if constexpr (!ALIGN_EPI) { if (wr == 0) PG8_BAR; }
    PG8_BAR;
    if constexpr (Epi::AFTER_DRAIN) { E.fused(acc, cur, wr, wc, fr, fq, lds, wid, lane); S.done(cur); }
#undef PG8_AOFF
#undef PG8_SA
#undef PG8_SB
#undef PG8_STAGE
#undef PG8_LDA
#undef PG8_LDB
#undef PG8_MMA
#undef PG8_WAIT_V
#undef PG8_WAIT_L
#undef PG8_BAR
#undef PG8_SCHED
}
}

namespace attn {
using bf16 = unsigned short;
using bf16x8 = __attribute__((ext_vector_type(8))) short;
using s16x4 = __attribute__((ext_vector_type(4))) short;
using f32x16 = __attribute__((ext_vector_type(16))) float;
using u32x4 = __attribute__((ext_vector_type(4))) unsigned;
using f32x4 = __attribute__((ext_vector_type(4))) float;
constexpr int SEQ = 4096, DM = 1024, NSLOT = 6, SLOTB = 8192, NREL = 513;
constexpr int LDS_K = 0, LDS_V = NSLOT * SLOTB, LDS_WS = 2 * NSLOT * SLOTB, LDS_OST = LDS_WS + 8 * 64 * 4, LDS_BIAS = LDS_OST + 8 * 4096, BIAS_CS = 400  , LDS_BYTES = LDS_BIAS + 4 * BIAS_CS * 4;
constexpr float LOG2E = 1.4426950408889634f;
__device__ __forceinline__ int crow(int r, int hi) { return (r & 3) + 8 * (r >> 2) + 4 * hi; }
#define SBAR() __builtin_amdgcn_sched_barrier(0)
__device__ __forceinline__ void glds16(const void* gsrc, unsigned lds_dst) { unsigned keep;
  asm volatile("s_mov_b32 %0, m0\n\ts_mov_b32 m0, %2\n\ts_nop 0\n\tglobal_load_lds_dwordx4 %1, off\n\ts_mov_b32 m0, %0" : "=&s"(keep) : "v"(gsrc), "s"(lds_dst) : "memory"); }
typedef float f32x2_t __attribute__((ext_vector_type(2))); typedef __bf16 bf16x2_t __attribute__((ext_vector_type(2)));
__device__ __forceinline__ unsigned cvtpk_s(float lo, float hi) { f32x2_t v = {lo, hi}; bf16x2_t b = __builtin_convertvector(v, bf16x2_t); return __builtin_bit_cast(unsigned, b); }
typedef __attribute__((address_space(3))) const char* lds_cptr;
__device__ __forceinline__ void kload8(bf16x8* kf, lds_cptr kp) {
  kf[0] = *(const __attribute__((address_space(3))) bf16x8*)(kp);        kf[1] = *(const __attribute__((address_space(3))) bf16x8*)(kp + 512);
  kf[2] = *(const __attribute__((address_space(3))) bf16x8*)(kp + 2048); kf[3] = *(const __attribute__((address_space(3))) bf16x8*)(kp + 2560);
  kf[4] = *(const __attribute__((address_space(3))) bf16x8*)(kp + 4096); kf[5] = *(const __attribute__((address_space(3))) bf16x8*)(kp + 4608);
  kf[6] = *(const __attribute__((address_space(3))) bf16x8*)(kp + 6144); kf[7] = *(const __attribute__((address_space(3))) bf16x8*)(kp + 6656);
}
__device__ __forceinline__ void pv(f32x16* o, int vb, bf16x8 pa0, bf16x8 pa1, bf16x8 pa2, bf16x8 pa3) {
  #pragma unroll
  for (int d0 = 0; d0 < 2; ++d0) { s16x4 lo[4], hi[4];
    #pragma unroll
    for (int ks = 0; ks < 4; ++ks) {
      asm volatile("ds_read_b64_tr_b16 %0,%1 offset:%c2" : "=&v"(lo[ks]) : "v"(vb), "i"(d0 * 4096 + ks * 1024) : "memory");
      asm volatile("ds_read_b64_tr_b16 %0,%1 offset:%c2" : "=&v"(hi[ks]) : "v"(vb), "i"(d0 * 4096 + ks * 1024 + 512) : "memory"); }
    asm volatile("s_waitcnt lgkmcnt(0)" ::: "memory"); SBAR();
    #define PK(k) (bf16x8){lo[k][0], lo[k][1], lo[k][2], lo[k][3], hi[k][0], hi[k][1], hi[k][2], hi[k][3]}
    o[d0] = __builtin_amdgcn_mfma_f32_32x32x16_bf16(pa0, PK(0), o[d0], 0, 0, 0);
    o[d0] = __builtin_amdgcn_mfma_f32_32x32x16_bf16(pa1, PK(1), o[d0], 0, 0, 0);
    o[d0] = __builtin_amdgcn_mfma_f32_32x32x16_bf16(pa2, PK(2), o[d0], 0, 0, 0);
    o[d0] = __builtin_amdgcn_mfma_f32_32x32x16_bf16(pa3, PK(3), o[d0], 0, 0, 0);
    #undef PK
  }
}
__device__ __forceinline__ float wmax(float v) {
#pragma unroll
  for (int o = 1; o < 64; o <<= 1) v = fmaxf(v, __shfl_xor(v, o));
  return v;
}
__device__ __forceinline__ void attn_unit(int b, int h, int g, const bf16* Q, const bf16* __restrict__ K, const bf16* __restrict__ V, bf16* O,
                                          const float* __restrict__ relb, const float* __restrict__ gq, const float* __restrict__ gk, char* shm) {
  int tid_ = threadIdx.x; asm volatile("" : "+v"(tid_));
  const int tid = tid_, lane = tid & 63, r32 = lane & 31, hi = lane >> 5; const int wid = __builtin_amdgcn_readfirstlane(tid >> 6);
  const long rowbase = (long)b * SEQ; const int q0 = g * 256;
  const int kc_lo = (4 * g - 8) > 0 ? (4 * g - 8) : 0, NT = 4 * g + 4 - kc_lo;
  const bf16* Qw = Q + (rowbase + q0 + wid * 32) * DM + h * 64;
  const bf16* Kh = K + (rowbase + 64 * kc_lo) * DM + h * 64; const bf16* Vh = V + (rowbase + 64 * kc_lo) * DM + h * 64;
  const unsigned lds0 = (unsigned)(uintptr_t)shm;
  float* wsf = (float*)(shm + LDS_WS) + wid * 64;
  float* biasT = (float*)(shm + LDS_BIAS);
  const bf16* ksrc = Kh + (long)lane * DM + wid * 8;
  const bf16* vsrc = Vh + (long)(16 * (wid & 3) + (lane >> 2)) * DM + (wid >> 2) * 32 + (lane & 3) * 8;
  const unsigned kdst = lds0 + LDS_K + wid * 1024, vdst = lds0 + LDS_V + wid * 1024;
  #define DMA_K(t, slot) glds16(ksrc + (long)(t) * 64 * DM, (unsigned)__builtin_amdgcn_readfirstlane(kdst + (slot)))
  #define DMA_V(t, slot) glds16(vsrc + (long)(t) * 64 * DM, (unsigned)__builtin_amdgcn_readfirstlane(vdst + (slot)))
  const int vb0 = (int)(lds0 + LDS_V) + ((lane >> 4) & 1) * 32 + (lane & 3) * 8 + (4 * hi + ((lane & 15) >> 2)) * 64;
  const lds_cptr shm3 = (lds_cptr)shm; const lds_cptr kp0 = shm3 + LDS_K + hi * 1024 + r32 * 16;
  const bool full = (g >= 2); const int nsteps = full ? 9 : NT;
  #define LOAD_TILE(i) (full ? ((i) < 6 ? (((i) & 1) ? ((i) >> 1) + 9 : ((i) >> 1)) : (i) - 3) : (i))
  #define ISSUE_LOAD(i) do { const int i_ = (i); const int tl_ = LOAD_TILE(i_); const int sb_ = (i_ % NSLOT) * SLOTB; DMA_K(tl_, sb_); DMA_V(tl_, sb_); } while (0)
  bf16x8 qr[4];
  #pragma unroll
  for (int d0 = 0; d0 < 4; ++d0) qr[d0] = *reinterpret_cast<const bf16x8*>(&Qw[(long)r32 * DM + d0 * 16 + hi * 8]);
  const float gqv = gq[lane], gkv = gk[lane]; float rbv[9], tbv[3];
  #pragma unroll
  for (int k = 0; k < 9; ++k) { const int i = lane + 64 * k; rbv[k] = (i < NREL) ? relb[h * NREL + i] : -3.0e38f; }
  #pragma unroll
  for (int k = 0; k < 3; ++k) { const int i = tid + 512 * k, c = i / 384, jj = i - c * 384, e = jj + c; tbv[k] = (e < 384) ? relb[h * NREL + (e < 64 ? 512 : 576 - e)] : 0.f; }
  asm volatile("" ::: "memory");
  ISSUE_LOAD(0); ISSUE_LOAD(1); if (full) { ISSUE_LOAD(2); ISSUE_LOAD(3); }
  float m2;
  { const float mq = wmax(fabsf(gqv)), mk = wmax(fabsf(gkv)); float mb = -3.0e38f;
    #pragma unroll
    for (int k = 0; k < 9; ++k) mb = fmaxf(mb, rbv[k]);
    mb = wmax(mb); m2 = (8.0f * mq * mk + mb) * LOG2E; }
  #pragma unroll
  for (int k = 0; k < 3; ++k) { const int i = tid + 512 * k, c = i / 384, jj = i - c * 384; biasT[c * BIAS_CS + jj] = tbv[k] * LOG2E - m2; }
  f32x16 o[2]; o[0] = f32x16{}; o[1] = f32x16{}; f32x16 lsum = f32x16{};
  const int qpos = 32 * (wid & 1) + r32;
  const int cch = 4 * g + (wid >> 1);
  if (full) asm volatile("s_waitcnt vmcnt(4) lgkmcnt(0)\n\ts_barrier" ::: "memory");
  else      asm volatile("s_waitcnt vmcnt(2) lgkmcnt(0)\n\ts_barrier" ::: "memory");
  for (int s = 0; s < nsteps; ++s) {
    int nis = 0;
    if (s + 2 < nsteps) { const int s2 = s + 2; if (full) { if (s2 < 3) { ISSUE_LOAD(2 * s2); ISSUE_LOAD(2 * s2 + 1); nis = 2; } else { ISSUE_LOAD(s2 + 3); nis = 1; } } else { ISSUE_LOAD(s2); nis = 1; } }
    int jrel = kc_lo + s - cch + 8, ld = full ? (s < 3 ? 2 * s : s + 3) : s;
    if (full && s < 3 && jrel < 0) { jrel += 9; ld += 1; }
    const int sl_cur = (ld % NSLOT) * SLOTB;
    if (jrel >= 0 && jrel <= 8) {
      s16x4 vlo[8], vhi[8]; { const int vb = vb0 + sl_cur;
        #pragma unroll
        for (int i_ = 0; i_ < 8; ++i_) {
          asm volatile("ds_read_b64_tr_b16 %0,%1 offset:%c2" : "=&v"(vlo[i_]) : "v"(vb), "i"((i_ >> 2) * 4096 + (i_ & 3) * 1024) : "memory");
          asm volatile("ds_read_b64_tr_b16 %0,%1 offset:%c2" : "=&v"(vhi[i_]) : "v"(vb), "i"((i_ >> 2) * 4096 + (i_ & 3) * 1024 + 512) : "memory"); } }
      f32x16 p0, p1;
      if (jrel <= 3) { const float c0 = biasT[0];
        #pragma unroll
        for (int r = 0; r < 16; ++r) { p0[r] = c0; p1[r] = c0; } }
      else { const int i0 = 64 + 4 * hi - qpos + 64 * (jrel - 4), cs = i0 & 3; const f32x4* a4 = (const f32x4*)(biasT + cs * BIAS_CS + (i0 - cs));
        #pragma unroll
        for (int q4 = 0; q4 < 4; ++q4) { const f32x4 b0 = a4[2 * q4], b1 = a4[2 * q4 + 8];
          #pragma unroll
          for (int e = 0; e < 4; ++e) { p0[4 * q4 + e] = b0[e]; p1[4 * q4 + e] = b1[e]; } } }
      bf16x8 kf[8]; kload8(kf, kp0 + sl_cur);
      #pragma unroll
      for (int d0 = 0; d0 < 4; ++d0) { p0 = __builtin_amdgcn_mfma_f32_32x32x16_bf16(kf[2 * d0], qr[d0], p0, 0, 0, 0); p1 = __builtin_amdgcn_mfma_f32_32x32x16_bf16(kf[2 * d0 + 1], qr[d0], p1, 0, 0, 0); }
      #pragma unroll
      for (int r = 0; r < 16; ++r) { p0[r] = __builtin_amdgcn_exp2f(p0[r]); p1[r] = __builtin_amdgcn_exp2f(p1[r]); }
      lsum += p0 + p1;
      u32x4 pw0, pw1, pw2, pw3;
      pw0 = (u32x4){cvtpk_s(p0[0], p0[1]), cvtpk_s(p0[2], p0[3]), cvtpk_s(p0[4], p0[5]), cvtpk_s(p0[6], p0[7])};
      pw1 = (u32x4){cvtpk_s(p0[8], p0[9]), cvtpk_s(p0[10], p0[11]), cvtpk_s(p0[12], p0[13]), cvtpk_s(p0[14], p0[15])};
      pw2 = (u32x4){cvtpk_s(p1[0], p1[1]), cvtpk_s(p1[2], p1[3]), cvtpk_s(p1[4], p1[5]), cvtpk_s(p1[6], p1[7])};
      pw3 = (u32x4){cvtpk_s(p1[8], p1[9]), cvtpk_s(p1[10], p1[11]), cvtpk_s(p1[12], p1[13]), cvtpk_s(p1[14], p1[15])};
      SBAR();
      asm volatile("s_waitcnt lgkmcnt(0)" ::: "memory"); SBAR();
      #define VF(i_) (bf16x8){vlo[i_][0], vlo[i_][1], vlo[i_][2], vlo[i_][3], vhi[i_][0], vhi[i_][1], vhi[i_][2], vhi[i_][3]}
      o[0] = __builtin_amdgcn_mfma_f32_32x32x16_bf16(__builtin_bit_cast(bf16x8, pw0), VF(0), o[0], 0, 0, 0); o[1] = __builtin_amdgcn_mfma_f32_32x32x16_bf16(__builtin_bit_cast(bf16x8, pw0), VF(4), o[1], 0, 0, 0);
      o[0] = __builtin_amdgcn_mfma_f32_32x32x16_bf16(__builtin_bit_cast(bf16x8, pw1), VF(1), o[0], 0, 0, 0); o[1] = __builtin_amdgcn_mfma_f32_32x32x16_bf16(__builtin_bit_cast(bf16x8, pw1), VF(5), o[1], 0, 0, 0);
      o[0] = __builtin_amdgcn_mfma_f32_32x32x16_bf16(__builtin_bit_cast(bf16x8, pw2), VF(2), o[0], 0, 0, 0); o[1] = __builtin_amdgcn_mfma_f32_32x32x16_bf16(__builtin_bit_cast(bf16x8, pw2), VF(6), o[1], 0, 0, 0);
      o[0] = __builtin_amdgcn_mfma_f32_32x32x16_bf16(__builtin_bit_cast(bf16x8, pw3), VF(3), o[0], 0, 0, 0); o[1] = __builtin_amdgcn_mfma_f32_32x32x16_bf16(__builtin_bit_cast(bf16x8, pw3), VF(7), o[1], 0, 0, 0);
      #undef VF
    }
    if (nis == 2)      asm volatile("s_waitcnt vmcnt(4) lgkmcnt(0)\n\ts_barrier" ::: "memory");
    else if (nis == 1) asm volatile("s_waitcnt vmcnt(2) lgkmcnt(0)\n\ts_barrier" ::: "memory");
    else               asm volatile("s_waitcnt vmcnt(0) lgkmcnt(0)\n\ts_barrier" ::: "memory");
  }
  #undef LOAD_TILE
  #undef ISSUE_LOAD
  float l_reg = 0.f;
  #pragma unroll
  for (int r = 0; r < 16; ++r) l_reg += lsum[r];
  { auto rr = __builtin_amdgcn_permlane32_swap(__float_as_uint(l_reg), __float_as_uint(l_reg), false, false); l_reg = __uint_as_float(rr[0]) + __uint_as_float(rr[1]); }
  if (hi == 0) wsf[32 + r32] = l_reg; asm volatile("s_waitcnt lgkmcnt(0)" ::: "memory");
  float rli[16];
  #pragma unroll
  for (int r = 0; r < 16; ++r) rli[r] = __builtin_amdgcn_rcpf(wsf[32 + crow(r, hi)]);
  bf16* Ow = O + (rowbase + q0 + wid * 32) * DM + h * 64;
  { bf16* stg = (bf16*)(shm + LDS_OST) + wid * 2048;
    #pragma unroll
    for (int r = 0; r < 16; ++r) { const int orow = crow(r, hi);
      #pragma unroll
      for (int d0 = 0; d0 < 2; ++d0) stg[orow * 64 + d0 * 32 + r32] = (bf16)(cvtpk_s(o[d0][r] * rli[r], 0.f) & 0xffffu); }
    asm volatile("s_waitcnt lgkmcnt(0)" ::: "memory");
    #pragma unroll
    for (int i = 0; i < 4; ++i) { const int row = i * 8 + (lane >> 3), ch = lane & 7; const u32x4 v = *(const u32x4*)(stg + row * 64 + ch * 8); pg8::st16(Ow + (long)row * DM + ch * 8, v); } }
  asm volatile("s_waitcnt lgkmcnt(0)\n\ts_barrier" ::: "memory");
  #undef DMA_K
  #undef DMA_V
}
#undef SBAR
}

#define GAS __attribute__((address_space(1)))
#define LAS __attribute__((address_space(3)))
typedef unsigned short bf16;
typedef unsigned v4u __attribute__((ext_vector_type(4)));
typedef float f32x4 __attribute__((ext_vector_type(4)));
typedef short bf16x8 __attribute__((ext_vector_type(8)));
typedef GAS unsigned gu32;
typedef GAS unsigned long long gu64;
#define RLX_AGENT __ATOMIC_RELAXED, __HIP_MEMORY_SCOPE_AGENT
#define LDS_WAIT() asm volatile("s_waitcnt lgkmcnt(0)" ::: "memory")
#define VM_WAIT() asm volatile("s_waitcnt vmcnt(0)" ::: "memory")
__device__ __forceinline__ unsigned long long rt() { return __builtin_amdgcn_s_memrealtime(); }
#define XB_TMO      128
#define XB_XCNT(j)  (256  + 64 * (j))
#define XB_XSUB(j)  (1280 + 64 * (j))
#define XB_XGEN(j)  (2304 + 64 * (j))
#define XB_TOP      3328
#define XB_TOPGEN   3392
#define XCD_BAR_WORDS 3456
#define XB_SPIN_CAP (1u << 18)

__device__ __forceinline__ unsigned xb_ld(unsigned* p)              { return __hip_atomic_load(p, __ATOMIC_RELAXED, __HIP_MEMORY_SCOPE_AGENT); }
__device__ __forceinline__ unsigned xb_add(unsigned* p, unsigned v) { return __hip_atomic_fetch_add(p, v, __ATOMIC_RELAXED, __HIP_MEMORY_SCOPE_AGENT); }
__device__ __forceinline__ unsigned xb_xcc_id() { return (unsigned)__builtin_amdgcn_s_getreg((3 << 11) | 20) & 0xFu; }
#define XB_SPIN(cond, bar) do { unsigned _sp = 0; while (cond) { __builtin_amdgcn_s_sleep(1); \
    if ((++_sp & 255u) == 0u) { if (xb_ld(&(bar)[XB_TMO])) break; if (_sp > XB_SPIN_CAP) { atomicAdd(&(bar)[XB_TMO], 1u); break; } } } } while (0)

struct XcdBarrier {
    unsigned* bar; unsigned x;
    volatile LAS unsigned* st;
};

__device__ __forceinline__ XcdBarrier xcd_barrier_post(unsigned* bar, volatile LAS unsigned* st) {
    XcdBarrier b; b.bar = bar; b.x = xb_xcc_id(); b.st = st;
    if (threadIdx.x == 0) (void)xb_add(&bar[XB_XCNT(b.x)], 1u);
    return b;
}
__device__ __forceinline__ void xcd_barrier_complete(unsigned* bar, unsigned x, unsigned& nloc, unsigned& nx) {
    const unsigned G = gridDim.x * gridDim.y * gridDim.z;
    unsigned sum, cnt, mine, sp = 0u;
    for (;;) {
        sum = 0u; cnt = 0u; mine = 0u;
#pragma unroll
        for (unsigned j = 0; j < 16; ++j) { const unsigned c = xb_ld(&bar[XB_XCNT(j)]); sum += c; cnt += (c > 0u) ? 1u : 0u; mine = (j == x) ? c : mine; }
        if (sum == G) break;
        __builtin_amdgcn_s_sleep(1);
        if ((++sp & 255u) == 0u) { if (xb_ld(&bar[XB_TMO])) break; if (sp > XB_SPIN_CAP) { atomicAdd(&bar[XB_TMO], 1u); break; } }
    }
    nloc = mine > 0u ? mine : 1u; nx = cnt > 0u ? cnt : 1u;
}

__device__ __forceinline__ void xcd_barrier(const XcdBarrier& b) {
    asm volatile("s_waitcnt vmcnt(0)" ::: "memory");
    __syncthreads();
    if (threadIdx.x == 0) {
        unsigned* bar = b.bar;
        __builtin_amdgcn_s_waitcnt(0);
        unsigned nloc = b.st[0], nx = b.st[1];
        if (nloc == 0u) { xcd_barrier_complete(bar, b.x, nloc, nx); b.st[0] = nloc; b.st[1] = nx; }
        __builtin_amdgcn_fence(__ATOMIC_RELEASE, "agent");
        asm volatile("s_waitcnt vmcnt(0)" ::: "memory");
        const unsigned old = xb_add(&bar[XB_XSUB(b.x)], 1u);
        const unsigned gen = old / nloc;
        if (old + 1u == (gen + 1u) * nloc) {
            __builtin_amdgcn_fence(__ATOMIC_RELEASE, "agent");
            asm volatile("s_waitcnt vmcnt(0)" ::: "memory");
            const unsigned og = xb_add(&bar[XB_TOP], 1u);
            const unsigned tg = og / nx;
            if (og + 1u == (tg + 1u) * nx) xb_add(&bar[XB_TOPGEN], 1u);
            else XB_SPIN(xb_ld(&bar[XB_TOPGEN]) == tg, bar);
            __builtin_amdgcn_fence(__ATOMIC_ACQUIRE, "agent");
            xb_add(&bar[XB_XGEN(b.x)], 1u);
            asm volatile("s_waitcnt vmcnt(0)" ::: "memory");
        } else {
            XB_SPIN(xb_ld(&bar[XB_XGEN(b.x)]) == gen, bar);
            __builtin_amdgcn_fence(__ATOMIC_ACQUIRE, "agent");
            asm volatile("s_waitcnt vmcnt(0)" ::: "memory");
        }
    }
    __syncthreads();
}
#include <hip/hip_cooperative_groups.h>
namespace cg = cooperative_groups;
constexpr int NWAVES = 8;
constexpr int BATCH = 4, SEQ = 4096, D = 1024, FF = 4096, M = BATCH * SEQ, NIN = 8192;
constexpr size_t MiB = 1u << 20;
constexpr size_t WS_SS = 1 * MiB;
constexpr size_t WS_W1 = 2 * MiB, WS_WC = 18 * MiB, WS_WA = 20 * MiB  , WS_WO = 22 * MiB, WS_WUP = 24 * MiB, WS_WDN = 32 * MiB;
constexpr size_t WS_V = 40 * MiB  , WS_H = 72 * MiB  , WS_Q = 104 * MiB, WS_K = 136 * MiB  , WS_BG = 168 * MiB  , WS_U1 = 200 * MiB;
constexpr size_t WS_UU = 72 * MiB;
constexpr size_t WS_END = 232 * MiB;
constexpr int LDS_BYTES = 147456;
constexpr int LDSCTL_OFF = 131072, MISC_OFF = LDSCTL_OFF + 320;
constexpr size_t WS_CTL = 0, CTL_ZERO_BYTES = 65536; constexpr int CW_BAR = 4096;
__device__ __forceinline__ unsigned f2bf(float f) { unsigned u = __builtin_bit_cast(unsigned, f); return (u + 0x7fffu + ((u >> 16) & 1u)) >> 16; }
__device__ __forceinline__ unsigned pk2(float lo, float hi) { return f2bf(lo) | (f2bf(hi) << 16); }
__device__ __forceinline__ float wave_sum(float v) {
#pragma unroll
    for (int o = 1; o < 64; o <<= 1) v += __shfl_xor(v, o);
    return v;
}
__device__ __forceinline__ void tr_item(const float* W, int ldw, int col0, int k0, bf16* WT, int Kd, int drow0, const float* kscale, LAS float* scr, int lane) {
    float tv[32];
#pragma unroll
    for (int i = 0; i < 32; ++i) { const int kk = 2 * i + (lane >> 5); tv[i] = W[(size_t)(k0 + kk) * ldw + col0 + (lane & 31)]; }
#pragma unroll
    for (int i = 0; i < 32; ++i) { const int kk = 2 * i + (lane >> 5); float v = tv[i]; if (kscale) v *= kscale[k0 + kk]; scr[kk * 33 + (lane & 31)] = v; }
    LDS_WAIT(); asm volatile("" ::: "memory");
    const int c = lane & 7;
#pragma unroll
    for (int j = 0; j < 4; ++j) { const int n = (lane >> 3) + 8 * j; const LAS float* s = scr + (8 * c) * 33 + n;
        v4u o; o.x = pk2(s[0 * 33], s[1 * 33]); o.y = pk2(s[2 * 33], s[3 * 33]); o.z = pk2(s[4 * 33], s[5 * 33]); o.w = pk2(s[6 * 33], s[7 * 33]);
        pg8::st16(WT + (size_t)(drow0 + n) * Kd + k0 + 8 * c, o); }
    LDS_WAIT(); asm volatile("" ::: "memory");
}

#ifndef PH_MASK
#define PH_MASK 127
#endif
#ifndef REP_P1
#define REP_P1 1
#endif
#ifndef REP_ATT
#define REP_ATT 1
#endif
#ifndef REP_P3
#define REP_P3 1
#endif
#ifndef REP_P4
#define REP_P4 1
#endif
#ifndef REP_P5
#define REP_P5 1
#endif
#ifndef EXTRA_SYNC
#define EXTRA_SYNC 0
#endif
__device__ unsigned g_panel_cnt[64 * 64];
__device__ unsigned g_bar_shard[16 * 64];
__device__ unsigned g_bar_cnt = 0u, g_bar_gen = 0u, g_done_cnt = 0u;
struct Args { const float* in[16]; float* out; unsigned char* ws; };
__global__ void __launch_bounds__(NWAVES * 64, 2) fwd(Args a) {
    extern __shared__ __attribute__((aligned(16))) unsigned char lds[];
    cg::grid_group grid = cg::this_grid();
    LAS unsigned char* ldsp = (LAS unsigned char*)lds;
    const int tid = threadIdx.x, lane = tid & 63, wave = __builtin_amdgcn_readfirstlane(tid >> 6);
    const int G = gridDim.x, bx = blockIdx.x, vcu = (G % 8 == 0) ? (bx % 8) * (G / 8) + bx / 8 : bx;
    unsigned char* ws = a.ws;
    const float* x = a.in[0];
    bf16 *W1 = (bf16*)(ws + WS_W1), *WA = (bf16*)(ws + WS_WA), *WC = (bf16*)(ws + WS_WC), *WO = (bf16*)(ws + WS_WO), *WUP = (bf16*)(ws + WS_WUP), *WDN = (bf16*)(ws + WS_WDN);
    bf16 *Vb = (bf16*)(ws + WS_V), *X1B = (bf16*)(ws + WS_V), *Hb = (bf16*)(ws + WS_H), *YC = (bf16*)(ws + WS_H)  , *Qb = (bf16*)(ws + WS_Q), *AO = (bf16*)(ws + WS_Q)  , *Kb = (bf16*)(ws + WS_K), *MG = (bf16*)(ws + WS_K);
    bf16 *BG = (bf16*)(ws + WS_BG), *U1 = (bf16*)(ws + WS_U1), *UU = (bf16*)(ws + WS_UU), *Gt = (bf16*)a.out;
    float* SS = (float*)(ws + WS_SS);
    for (int u = tid; u < (LDS_BYTES - LDSCTL_OFF) / 4; u += NWAVES * 64) ((LAS unsigned*)(ldsp + LDSCTL_OFF))[u] = 0u;
    __syncthreads();
    if (a.out == nullptr) grid.sync();
#ifndef WB_AT_SEAMS
#define WB_AT_SEAMS 0
#endif
#if WB_AT_SEAMS || !WT_STORES
#define BAR_RELEASE() do { __builtin_amdgcn_fence(__ATOMIC_RELEASE, "agent"); asm volatile("s_waitcnt vmcnt(0)" ::: "memory"); } while (0)
#else
#define BAR_RELEASE() do { } while (0)
#endif
#if defined(MONO_BAR)
    const bool grouped = (G == 256);
    const unsigned NSEAMS = (grouped ? 3u : 6u) + EXTRA_SYNC;
    unsigned bar_epoch = 0u, bar_base = 0u; const unsigned bar_xcc = xb_xcc_id();
#define GRID_BAR() do { asm volatile("s_waitcnt vmcnt(0)" ::: "memory"); __syncthreads(); \
    ++bar_epoch; \
    if (tid == 0) { \
        BAR_RELEASE(); \
        unsigned old_ = xb_add(&g_bar_shard[64u * bar_xcc], 1u);     \
        if (bar_epoch == 1u) asm volatile("s_waitcnt vmcnt(0)" : "+v"(old_) :: "memory");     \
        const unsigned tgt_ = bar_epoch * (unsigned)G; unsigned sp_ = 0u; \
        for (;;) { unsigned s_ = 0u; _Pragma("unroll") for (int j_ = 0; j_ < 16; ++j_) s_ += xb_ld(&g_bar_shard[64 * j_]); \
            if (bar_epoch == 1u && sp_ == 0u) bar_base = ((s_ - 1u) / (NSEAMS * (unsigned)G)) * (NSEAMS * (unsigned)G);     \
            if (s_ - bar_base >= tgt_) break; \
            __builtin_amdgcn_s_sleep(8); if (++sp_ > (1u << 22)) break; } \
        __builtin_amdgcn_fence(__ATOMIC_ACQUIRE, "agent"); asm volatile("s_waitcnt vmcnt(0)" ::: "memory"); } \
    __syncthreads(); } while (0)
    unsigned grp_epoch = 0u, grp_base = 0u;
#define GROUP_BAR(pm_) do { asm volatile("s_waitcnt vmcnt(0)" ::: "memory"); __syncthreads(); \
    ++grp_epoch; \
    if (tid == 0) { unsigned* pc_ = &g_panel_cnt[64 * (pm_)]; \
        BAR_RELEASE(); \
        const unsigned old_ = xb_add(pc_, 1u); \
        if (grp_epoch == 1u) grp_base = old_ - old_ % 12u; \
        const unsigned tgt_ = grp_epoch * 4u; unsigned sp_ = 0u; \
        while (xb_ld(pc_) - grp_base < tgt_) { __builtin_amdgcn_s_sleep(1); if (++sp_ > (1u << 22)) break; } \
        __builtin_amdgcn_fence(__ATOMIC_ACQUIRE, "agent"); asm volatile("s_waitcnt vmcnt(0)" ::: "memory"); } \
    __syncthreads(); } while (0)
#elif defined(GEN_BAR)
#define GRID_BAR() do { asm volatile("s_waitcnt vmcnt(0)" ::: "memory"); __syncthreads(); \
    if (tid == 0) { \
        __builtin_amdgcn_fence(__ATOMIC_RELEASE, "agent"); asm volatile("s_waitcnt vmcnt(0)" ::: "memory"); \
        unsigned g0_ = xb_ld(&g_bar_gen); asm volatile("s_waitcnt vmcnt(0)" : "+v"(g0_) :: "memory");            \
        unsigned old_ = xb_add(&g_bar_cnt, 1u); asm volatile("s_waitcnt vmcnt(0)" : "+v"(old_) :: "memory"); \
        if (old_ == (unsigned)G - 1u) { __hip_atomic_store(&g_bar_cnt, 0u, RLX_AGENT); asm volatile("s_waitcnt vmcnt(0)" ::: "memory"); xb_add(&g_bar_gen, 1u); } \
        else { unsigned sp_ = 0u; while (xb_ld(&g_bar_gen) == g0_) { __builtin_amdgcn_s_sleep(1); if (++sp_ > (1u << 22)) break; } } \
        __builtin_amdgcn_fence(__ATOMIC_ACQUIRE, "agent"); asm volatile("s_waitcnt vmcnt(0)" ::: "memory"); } \
    __syncthreads(); } while (0)
#elif defined(CG_ALL)
#define GRID_BAR() do { asm volatile("s_waitcnt vmcnt(0)" ::: "memory"); grid.sync(); } while (0)
#elif defined(SIMPLE_BAR)
    unsigned bar_epoch = 0u;
#define GRID_BAR() do { asm volatile("s_waitcnt vmcnt(0)" ::: "memory"); __syncthreads(); \
    ++bar_epoch; \
    if (tid == 0) { unsigned* cnt_ = (unsigned*)(ws + WS_CTL) + CW_BAR + XB_TOP; \
        __builtin_amdgcn_fence(__ATOMIC_RELEASE, "agent"); asm volatile("s_waitcnt vmcnt(0)" ::: "memory"); \
        xb_add(cnt_, 1u); unsigned sp_ = 0u; \
        while (xb_ld(cnt_) < bar_epoch * (unsigned)G) { __builtin_amdgcn_s_sleep(1); if (++sp_ > (1u << 22)) break; } \
        __builtin_amdgcn_fence(__ATOMIC_ACQUIRE, "agent"); asm volatile("s_waitcnt vmcnt(0)" ::: "memory"); } \
    __syncthreads(); } while (0)
#else
#define GRID_BAR() xcd_barrier(bar)
#endif

#ifndef DUP_P0
#define DUP_P0 1
#endif
    for (int rep0 = 0; rep0 < DUP_P0; ++rep0) {
        LAS float* scr = (LAS float*)(ldsp + wave * 16384);
        const int gw = vcu * NWAVES + wave, NGW = G * NWAVES;
        constexpr int I_1 = 16 * 256, I_S = 16 * 32, I_UP = 16 * 128, I_DN = 64 * 32, NITEMS = I_1 + 3 * I_S + I_UP + I_DN;
        for (int it = gw; it < NITEMS; it += NGW) {
            int r = it;
            if (r < I_1) { const int db = r & 255, kb = r >> 8, pn = db >> 3, pb = db & 7, bj = pb >> 2, wcc = pb & 3; const float* W = a.in[2]; int ldw = 6144, col;
                if (pn < 4) col = (4 * pn + wcc) * 64 + 32 * bj;
                else if (pn < 8) col = 1024 + (4 * (pn - 4) + wcc) * 64 + 32 * bj;
                else if (pn < 12) col = 2048 + 256 * (pn - 8) + 32 * pb;
                else if (pn < 16) col = 3072 + 256 * (pn - 12) + 32 * pb;
                else if (pn < 24) col = (bj ? 5120 : 4096) + 128 * (pn - 16) + 32 * wcc;
                else { W = a.in[10]; ldw = 2048; col = 256 * (pn - 24) + 32 * pb; }
                tr_item(W, ldw, col, 64 * kb, W1, D, 32 * db, nullptr, scr, lane); continue; } r -= I_1;
            if (r < I_S) { tr_item(a.in[8], D, 32 * (r & 31), 64 * (r >> 5), WA, D, 32 * (r & 31), nullptr, scr, lane); continue; } r -= I_S;
            if (r < I_S) { tr_item(a.in[9], D, 32 * (r & 31), 64 * (r >> 5), WC, D, 32 * (r & 31), nullptr, scr, lane); continue; } r -= I_S;
            if (r < I_S) { tr_item(a.in[12], D, 32 * (r & 31), 64 * (r >> 5), WO, D, 32 * (r & 31), nullptr, scr, lane); continue; } r -= I_S;
            if (r < I_UP) { tr_item(a.in[14], FF, 32 * (r & 127), 64 * (r >> 7), WUP, D, 32 * (r & 127), a.in[13], scr, lane); continue; } r -= I_UP;
            tr_item(a.in[15], D, 32 * (r & 31), 64 * (r >> 5), WDN, FF, 32 * (r & 31), nullptr, scr, lane);
        }
        const float* g1 = a.in[1];
        f32x4 gv[4];
#pragma unroll
        for (int j = 0; j < 4; ++j) gv[j] = ((const f32x4*)g1)[lane + 64 * j];
        for (int m0 = gw; m0 < M; m0 += 2 * NGW) {
            const int m1 = m0 + NGW;
            const bool has1 = m1 < M;
            const f32x4* xr0 = (const f32x4*)(x + (size_t)m0 * D) + lane; const f32x4* xr1 = (const f32x4*)(x + (size_t)(has1 ? m1 : m0) * D) + lane;
            f32x4 v0[4], v1[4]; float s0 = 0.f, s1 = 0.f;
#pragma unroll
            for (int j = 0; j < 4; ++j) { v0[j] = xr0[64 * j]; v1[j] = xr1[64 * j]; }
#pragma unroll
            for (int j = 0; j < 4; ++j) { s0 += (v0[j].x * v0[j].x + v0[j].y * v0[j].y) + (v0[j].z * v0[j].z + v0[j].w * v0[j].w); s1 += (v1[j].x * v1[j].x + v1[j].y * v1[j].y) + (v1[j].z * v1[j].z + v1[j].w * v1[j].w); }
            const float rs0 = 1.0f / sqrtf(wave_sum(s0) * (1.0f / D) + 1e-6f), rs1 = 1.0f / sqrtf(wave_sum(s1) * (1.0f / D) + 1e-6f);
            unsigned long long* o80 = (unsigned long long*)(Hb + (size_t)m0 * D) + lane; unsigned long long* o81 = (unsigned long long*)(Hb + (size_t)m1 * D) + lane;
#pragma unroll
            for (int j = 0; j < 4; ++j) { const f32x4 y = v0[j] * rs0 * gv[j]; pg8::st8(o80 + 64 * j, (pg8::u32x2w){pk2(y.x, y.y), pk2(y.z, y.w)}); }
            if (has1) {
#pragma unroll
                for (int j = 0; j < 4; ++j) { const f32x4 y = v1[j] * rs1 * gv[j]; pg8::st8(o81 + 64 * j, (pg8::u32x2w){pk2(y.x, y.y), pk2(y.z, y.w)}); } }
        }
    }
    GRID_BAR();
#if !defined(SIMPLE_BAR) && !defined(CG_ALL) && !defined(GEN_BAR) && !defined(MONO_BAR)
    const XcdBarrier bar = xcd_barrier_post((unsigned*)(ws + WS_CTL) + CW_BAR, (volatile LAS unsigned*)(ldsp + MISC_OFF) + 8);
#endif

    if (PH_MASK & 2) {
        pg8::Gemm g{Hb, W1, M, NIN, D}; pg8::StaticOrder S; S.init(M, NIN, G, bx);
        pg8::EpiP1 E{Qb, Kb, Vb, BG, U1, Gt, a.in[3], a.in[4], a.in[11]};
        pg8::gemm_phase<pg8::EpiP1, pg8::StaticOrder, true, true>(ldsp, g, S, E);
#ifdef DUP_P1
        { pg8::Gemm g2{Hb, W1, M, NIN, D}; pg8::StaticOrder S2; S2.init(M, NIN, G, bx); pg8::gemm_phase<pg8::EpiP1, pg8::StaticOrder, true, true>(ldsp, g2, S2, E); }
#endif
    }
    GRID_BAR();

    if (PH_MASK & 4) {
        for (int L = vcu; L < 1024 * REP_ATT; L += G) { const int bh = (L & 255) >> 2, gq4 = (L & 3) + 4 * ((L >> 8) & 3);
            attn::attn_unit(bh >> 4, bh & 15, gq4, Qb, Kb, Vb, AO, a.in[5], a.in[3], a.in[4], (char*)lds); }
        const float* cw = a.in[6]; const float* cb = a.in[7];
        for (int item = vcu * 512 + tid; item < 131072; item += G * 512) {
            const int c8 = (item & 127) * 8, t0 = (item >> 7) * 16;
            float w0[8], w1[8], w2[8], b0[8], u1[8], u2[8];
#pragma unroll
            for (int e = 0; e < 8; ++e) { w0[e] = cw[c8 + e]; w1[e] = cw[1024 + c8 + e]; w2[e] = cw[2048 + c8 + e]; b0[e] = cb[c8 + e]; u1[e] = 0.f; u2[e] = 0.f; }
            if ((t0 & (SEQ - 1)) != 0) { f32x4 p, q; pg8::unpack8(*(const v4u*)(U1 + (size_t)(t0 - 2) * D + c8), p, q);
#pragma unroll
                for (int e = 0; e < 4; ++e) { u2[e] = p[e]; u2[4 + e] = q[e]; }
                pg8::unpack8(*(const v4u*)(U1 + (size_t)(t0 - 1) * D + c8), p, q);
#pragma unroll
                for (int e = 0; e < 4; ++e) { u1[e] = p[e]; u1[4 + e] = q[e]; } }
            v4u ur[16], br[16];
#pragma unroll
            for (int i = 0; i < 16; ++i) { const size_t off = (size_t)(t0 + i) * D + c8; ur[i] = *(const v4u*)(U1 + off); br[i] = *(const v4u*)(BG + off); }
#pragma unroll
            for (int i = 0; i < 16; ++i) { const size_t off = (size_t)(t0 + i) * D + c8; f32x4 p, q, bp, bq; float u0[8], bgv[8], y[8];
                pg8::unpack8(ur[i], p, q); pg8::unpack8(br[i], bp, bq);
#pragma unroll
                for (int e = 0; e < 4; ++e) { u0[e] = p[e]; u0[4 + e] = q[e]; bgv[e] = bp[e]; bgv[4 + e] = bq[e]; }
#pragma unroll
                for (int e = 0; e < 8; ++e) { y[e] = bgv[e] * (b0[e] + w0[e] * u2[e] + w1[e] * u1[e] + w2[e] * u0[e]); u2[e] = u1[e]; u1[e] = u0[e]; }
                v4u o; o.x = pk2(y[0], y[1]); o.y = pk2(y[2], y[3]); o.z = pk2(y[4], y[5]); o.w = pk2(y[6], y[7]); pg8::st16(YC + off, o); }
        }
    }
    GRID_BAR();

    if (PH_MASK & 8) {
        static_assert(WS_Q == WS_H + (size_t)M * D * 2 && WS_WA == WS_WC + (size_t)D * D * 2, "P3 reads the stacked [YC ; AO] and [Wc ; Wa]");
        pg8::PairOrder S; S.S.init(M, D, G, bx);
        pg8::Gemm g{YC, WC, 2 * M, 2 * D, D}; pg8::EpiGate2 E{Gt, MG};
        pg8::gemm_phase<pg8::EpiGate2, pg8::PairOrder, true, true>(ldsp, g, S, E);
    }
    { pg8::StaticOrder S; S.init(M, D, G, bx); pg8::Unit u0; S.next(0, u0); if (grouped) GROUP_BAR(u0.pm); else GRID_BAR(); }

    if (PH_MASK & 16) {
        pg8::Gemm g{MG, WO, M, D, D}; pg8::StaticOrder S; S.init(M, D, G, bx);
        pg8::EpiRes1 E{x, a.out, X1B, SS};
        pg8::gemm_phase<pg8::EpiRes1, pg8::StaticOrder, true, true>(ldsp, g, S, E);
#ifdef DUP_P4
        pg8::gemm_phase<pg8::EpiRes1, pg8::StaticOrder, true, true>(ldsp, g, S, E);
#endif
    }
    { pg8::StaticOrder S; S.init(M, D, G, bx); pg8::Unit u0; S.next(0, u0); if (grouped) GROUP_BAR(u0.pm); else GRID_BAR(); }

    if (PH_MASK & 32) {
        pg8::Gemm g{X1B, WUP, M, FF, D}; pg8::StaticOrder S; S.init(M, FF, G, bx);
        pg8::EpiUp E{SS, UU, (size_t)M * D};
        pg8::gemm_phase<pg8::EpiUp, pg8::StaticOrder, true, true>(ldsp, g, S, E);
#ifdef DUP_P5
        pg8::gemm_phase<pg8::EpiUp, pg8::StaticOrder, true, true>(ldsp, g, S, E);
#endif
    }
    { pg8::StaticOrder S; S.init(M, D, G, bx); pg8::Unit u0; S.next(0, u0); if (grouped) GROUP_BAR(u0.pm); else GRID_BAR(); }

    for (int i = 0; i < EXTRA_SYNC; ++i) GRID_BAR();
    if (PH_MASK & 64) {
        pg8::Gemm g{UU, WDN, M, D, FF, D, 4, (size_t)M * D * 2}; pg8::StaticOrder S; S.init(M, D, G, bx);
        pg8::EpiRes2 E{a.out, X1B};
        pg8::gemm_phase<pg8::EpiRes2, pg8::StaticOrder, true, true>(ldsp, g, S, E);
    }
#if defined(MONO_BAR)
    if (wave == 0) { unsigned old_ = 0u; if (lane == 0) old_ = xb_add(&g_done_cnt, 1u);
        old_ = (unsigned)__builtin_amdgcn_readfirstlane((int)old_);
        if (old_ == (unsigned)G - 1u) { __hip_atomic_store(&g_panel_cnt[64 * lane], 0u, RLX_AGENT);
            if (lane < 16) __hip_atomic_store(&g_bar_shard[64 * lane], 0u, RLX_AGENT);
            if (lane == 0) { __hip_atomic_store(&g_bar_cnt, 0u, RLX_AGENT); __hip_atomic_store(&g_done_cnt, 0u, RLX_AGENT); } } }
#endif
}

extern "C" void kernel_launch(void* const* d_in, const int* in_sizes, int n_in, void* d_out, int out_size, void* d_ws, size_t ws_size, hipStream_t stream) {
    static int grid = 0;
    if (grid == 0) {
        if (n_in != 16 || out_size != M * D || ws_size < WS_END) { fprintf(stderr, "kernel_launch: unexpected shapes (n_in %d, out %d, ws %zu)\n", n_in, out_size, ws_size); grid = -1; return; }
        int dev = 0, cus = 0, per_cu = 0;
        (void)hipGetDevice(&dev); (void)hipDeviceGetAttribute(&cus, hipDeviceAttributeMultiprocessorCount, dev);
        if (hipFuncSetAttribute((const void*)fwd, hipFuncAttributeMaxDynamicSharedMemorySize, LDS_BYTES) != hipSuccess) { fprintf(stderr, "kernel_launch: hipFuncSetAttribute failed\n"); grid = -1; return; }
        if (hipOccupancyMaxActiveBlocksPerMultiprocessor(&per_cu, (const void*)fwd, NWAVES * 64, LDS_BYTES) != hipSuccess || per_cu < 1) { fprintf(stderr, "kernel_launch: occupancy query says %d\n", per_cu); per_cu = 1; }
        (void)hipGetLastError();
        grid = cus * 1;
    }
    if (grid < 0) return;
#if !defined(GEN_BAR) && !defined(MONO_BAR)
    if (hipMemsetAsync((char*)d_ws + WS_CTL, 0, CTL_ZERO_BYTES, stream) != hipSuccess) { fprintf(stderr, "kernel_launch: memset of the barrier words failed\n"); return; }
#endif
    Args a{};
    for (int i = 0; i < 16; ++i) a.in[i] = (const float*)d_in[i];
    a.out = (float*)d_out; a.ws = (unsigned char*)d_ws;
    void* args[] = {&a};
    hipError_t e = hipLaunchCooperativeKernel((const void*)fwd, dim3(grid), dim3(NWAVES * 64), args, LDS_BYTES, stream);
    if (e != hipSuccess) fprintf(stderr, "kernel_launch: cooperative launch failed: %s (grid %d)\n", hipGetErrorString(e), grid);
}
```

```cpp
#include <hip/hip_runtime.h>
#include <cstdio>
#include <cstdint>
#define MONO_BAR 1
namespace pg8 {
#define PG8_LAS __attribute__((address_space(3)))
typedef unsigned short bf16_t;
typedef short bf16x8 __attribute__((ext_vector_type(8)));
typedef float f32x4 __attribute__((ext_vector_type(4)));
typedef unsigned u32x4 __attribute__((ext_vector_type(4)));
constexpr int BM = 256, BK = 64, HALF = 128, HTB = HALF * BK * 2  , STAGE_BYTES = 8 * HTB, NXCD = 8, WGM = 8;

__host__ __device__ __forceinline__ int lds_byte(int r, int c) { const int st = (r >> 4) * 2 + (c >> 5), rr = r & 15, cc = c & 31, ob = rr * 64 + cc * 2; return st * 1024 + (ob ^ (((ob >> 9) & 1) << 5)); }
__host__ __device__ __forceinline__ void stage_rc(int b, int& R, int& C) { const int st = b / 1024, sb = b % 1024, swz = sb ^ (((sb >> 9) & 1) << 5); R = (st >> 1) * 16 + swz / 64; C = (st & 1) * 32 + (swz % 64) / 2; }
__host__ __device__ __forceinline__ int perm32(int rho) { const int n = rho >> 4, i = rho & 15; return 8 * (i >> 2) + 4 * n + (i & 3); }

struct Unit { int pm, pn; };
struct Gemm { const bf16_t* A; const bf16_t* Bt; int M, N, K; int lda; int segsh; size_t segstride; };

struct StaticOrder {
    int nM, nN, nwg, G, c;
    __host__ __device__ void init(int M, int N, int G_, int c_) { nM = M / BM; nN = N / BM; nwg = nM * nN; G = G_; c = c_; }
    __host__ __device__ bool next(int i, Unit& u) const {
        const long L = (long)i * G + c; if (L >= nwg) return false;
        int wgid = (int)L; { const int q = nwg / NXCD, r = nwg % NXCD, xcd = wgid % NXCD, off = wgid / NXCD; wgid = (xcd < r ? xcd * (q + 1) : r * (q + 1) + (xcd - r) * q) + off; }
        const int nig = WGM * nN, gid = wgid / nig, fm = gid * WGM, gsz = (nM - fm) < WGM ? (nM - fm) : WGM;
        u.pm = fm + ((wgid % nig) % gsz); u.pn = (wgid % nig) / gsz; return true;
    }
    __device__ __forceinline__ void a_ready(const Unit&) const {}
    __device__ __forceinline__ void done(const Unit&) const {}
};

__device__ __forceinline__ unsigned cvt_pk_bf16(float lo, float hi) { unsigned r; asm volatile("v_cvt_pk_bf16_f32 %0, %1, %2" : "=v"(r) : "v"(lo), "v"(hi)); return r; }
typedef float f32x2 __attribute__((ext_vector_type(2)));
#ifndef WT_STORES
#define WT_STORES 1
#endif
__device__ __forceinline__ void st16(void* p, u32x4 v) {
#if WT_STORES
    asm volatile("global_store_dwordx4 %0, %1, off sc1\n\ts_nop 1" :: "v"(p), "v"(v) : "memory");
#else
    *(u32x4*)p = v;
#endif
}
typedef unsigned u32x2w __attribute__((ext_vector_type(2)));
__device__ __forceinline__ void st8(void* p, u32x2w v) {
#if WT_STORES
    asm volatile("global_store_dwordx2 %0, %1, off sc1\n\ts_nop 1" :: "v"(p), "v"(v) : "memory");
#else
    *(u32x2w*)p = v;
#endif
}
typedef unsigned u32x2 __attribute__((ext_vector_type(2)));
__device__ __forceinline__ float bf_lo(unsigned w) { return __uint_as_float(w << 16); }
__device__ __forceinline__ float bf_hi(unsigned w) { return __uint_as_float(w & 0xffff0000u); }
__device__ __forceinline__ u32x4 pack8(f32x4 a, f32x4 b) { u32x4 w; w.x = cvt_pk_bf16(a[0], a[1]); w.y = cvt_pk_bf16(a[2], a[3]); w.z = cvt_pk_bf16(b[0], b[1]); w.w = cvt_pk_bf16(b[2], b[3]); return w; }
__device__ __forceinline__ void unpack8(u32x4 w, f32x4& a, f32x4& b) { a = (f32x4){bf_lo(w.x), bf_hi(w.x), bf_lo(w.y), bf_hi(w.y)}; b = (f32x4){bf_lo(w.z), bf_hi(w.z), bf_lo(w.w), bf_hi(w.w)}; }
constexpr float QK_C2 = 0.125f * 1.4426950408889634f;
constexpr float RMS_EPS = 1e-6f;

struct EpiP1 {
    static constexpr bool PERM = true, AFTER_DRAIN = false;
    bf16_t *Q, *Kb, *V, *BG, *U1, *G; const float *gq, *gk, *bgate;
    __device__ __forceinline__ void operator()(const f32x4 (&acc)[2][2][4][2], const Unit& u, int wr, int wc, int fr, int fq) const {
        const int pn = u.pn; const int row0 = u.pm * BM + wr * 64 + fr;
        if (pn < 8) {
            const bool isq = pn < 4; const float* g = isq ? gq : gk; bf16_t* O = isq ? Q : Kb; const float sc = isq ? QK_C2 : 1.f;
            const int head = 4 * (pn & 3) + wc;
            f32x4 gv[2][2];
#pragma unroll
            for (int bj = 0; bj < 2; ++bj)
#pragma unroll
                for (int n = 0; n < 2; ++n) gv[bj][n] = *(const f32x4*)(g + 32 * bj + 8 * fq + 4 * n) * sc;
#pragma unroll
            for (int ai = 0; ai < 2; ++ai)
#pragma unroll
                for (int m = 0; m < 4; ++m) {
                    float s = 0.f;
#pragma unroll
                    for (int bj = 0; bj < 2; ++bj)
#pragma unroll
                        for (int n = 0; n < 2; ++n) { const f32x4 x = acc[ai][bj][m][n]; s += (x[0] * x[0] + x[1] * x[1]) + (x[2] * x[2] + x[3] * x[3]); }
                    s += __shfl_xor(s, 16); s += __shfl_xor(s, 32);
                    const float rs = 1.0f / sqrtf(s * (1.0f / 64.0f) + RMS_EPS);
                    bf16_t* rowp = O + (size_t)(row0 + ai * HALF + m * 16) * 1024 + head * 64 + 8 * fq;
#pragma unroll
                    for (int bj = 0; bj < 2; ++bj) st16(rowp + 32 * bj, pack8(acc[ai][bj][m][0] * rs * gv[bj][0], acc[ai][bj][m][1] * rs * gv[bj][1]));
                }
        } else if (pn < 16) {
            bf16_t* O = (pn < 12) ? V : BG; const int col0 = 256 * (pn & 3) + wc * 32 + 8 * fq;
#pragma unroll
            for (int ai = 0; ai < 2; ++ai)
#pragma unroll
                for (int m = 0; m < 4; ++m) { bf16_t* rowp = O + (size_t)(row0 + ai * HALF + m * 16) * 1024 + col0;
#pragma unroll
                    for (int bj = 0; bj < 2; ++bj) st16(rowp + bj * HALF, pack8(acc[ai][bj][m][0], acc[ai][bj][m][1])); }
        } else if (pn < 24) {
            const int col0 = 128 * (pn - 16) + wc * 32 + 8 * fq;
#pragma unroll
            for (int ai = 0; ai < 2; ++ai)
#pragma unroll
                for (int m = 0; m < 4; ++m)
                    st16(U1 + (size_t)(row0 + ai * HALF + m * 16) * 1024 + col0, pack8(acc[ai][0][m][0] * acc[ai][1][m][0], acc[ai][0][m][1] * acc[ai][1][m][1]));
        } else {
            const int col0 = 256 * (pn - 24) + wc * 32 + 8 * fq;
            f32x4 bv[2][2];
#pragma unroll
            for (int bj = 0; bj < 2; ++bj)
#pragma unroll
                for (int n = 0; n < 2; ++n) bv[bj][n] = *(const f32x4*)(bgate + col0 + bj * HALF + 4 * n);
#pragma unroll
            for (int ai = 0; ai < 2; ++ai)
#pragma unroll
                for (int m = 0; m < 4; ++m) { bf16_t* rowp = G + (size_t)(row0 + ai * HALF + m * 16) * 2048 + col0;
#pragma unroll
                    for (int bj = 0; bj < 2; ++bj) { f32x4 v[2];
#pragma unroll
                        for (int n = 0; n < 2; ++n) { const f32x4 z = (acc[ai][bj][m][n] + bv[bj][n]) * (-1.4426950408889634f);
#pragma unroll
                            for (int e = 0; e < 4; ++e) v[n][e] = __builtin_amdgcn_rcpf(1.0f + __builtin_amdgcn_exp2f(z[e])); }
                        st16(rowp + bj * HALF, pack8(v[0], v[1])); } }
        }
    }
};
template <bool ADD> struct EpiGate {
    static constexpr bool PERM = true, AFTER_DRAIN = false;
    const bf16_t* G; bf16_t* MG; int goff;
    __device__ __forceinline__ void operator()(const f32x4 (&acc)[2][2][4][2], const Unit& u, int wr, int wc, int fr, int fq) const {
        const int row0 = u.pm * BM + wr * 64 + fr, col0 = u.pn * BM + wc * 32 + 8 * fq;
#pragma unroll
        for (int ai = 0; ai < 2; ++ai)
#pragma unroll
            for (int m = 0; m < 4; ++m) { const size_t r = (size_t)(row0 + ai * HALF + m * 16);
#pragma unroll
                for (int bj = 0; bj < 2; ++bj) { f32x4 g0, g1; unpack8(*(const u32x4*)(G + r * 2048 + goff + col0 + bj * HALF), g0, g1);
                    f32x4 v0 = acc[ai][bj][m][0] * g0, v1 = acc[ai][bj][m][1] * g1;
                    bf16_t* p = MG + r * 1024 + col0 + bj * HALF;
                    if (ADD) { f32x4 a0, a1; unpack8(*(const u32x4*)p, a0, a1); v0 += a0; v1 += a1; }
                    *(u32x4*)p = pack8(v0, v1); } }
    }
};
struct PairOrder {
    StaticOrder S;
    __device__ bool next(int i, Unit& u) const { Unit b; if (!S.next(i >> 1, b)) return false; u.pm = b.pm + ((i & 1) ? 64 : 0); u.pn = b.pn + ((i & 1) ? 4 : 0); return true; }
    __device__ __forceinline__ void a_ready(const Unit&) const {}
    __device__ __forceinline__ void done(const Unit&) const {}
};
struct EpiGate2 {
    static constexpr bool PERM = true, AFTER_DRAIN = false;
    const bf16_t* G; bf16_t* MG;
    __device__ __forceinline__ void operator()(const f32x4 (&acc)[2][2][4][2], const Unit& u, int wr, int wc, int fr, int fq) const {
        const bool second = u.pm >= 64; const int pm = second ? u.pm - 64 : u.pm, pn = second ? u.pn - 4 : u.pn, goff = second ? 0 : 1024;
        const int row0 = pm * BM + wr * 64 + fr, col0 = pn * BM + wc * 32 + 8 * fq;
#pragma unroll
        for (int ai = 0; ai < 2; ++ai) {
            u32x4 gl[4][2], ml[4][2];
#pragma unroll
            for (int m = 0; m < 4; ++m) { const size_t r = (size_t)(row0 + ai * HALF + m * 16);
#pragma unroll
                for (int bj = 0; bj < 2; ++bj) { gl[m][bj] = *(const u32x4*)(G + r * 2048 + goff + col0 + bj * HALF); if (second) ml[m][bj] = *(const u32x4*)(MG + r * 1024 + col0 + bj * HALF); } }
#pragma unroll
            for (int m = 0; m < 4; ++m) { const size_t r = (size_t)(row0 + ai * HALF + m * 16);
#pragma unroll
                for (int bj = 0; bj < 2; ++bj) { f32x4 g0, g1; unpack8(gl[m][bj], g0, g1);
                    f32x4 v0 = acc[ai][bj][m][0] * g0, v1 = acc[ai][bj][m][1] * g1;
                    bf16_t* p = MG + r * 1024 + col0 + bj * HALF;
                    if (second) { f32x4 a0, a1; unpack8(ml[m][bj], a0, a1); v0 += a0; v1 += a1; } st16(p, pack8(v0, v1)); } }
        }
    }
};
#ifndef STORE_X1_F32
#define STORE_X1_F32 0
#endif
struct EpiRes1 {
    static constexpr bool PERM = true, AFTER_DRAIN = false;
    const float* x; float* out; bf16_t* x1b; float* SS;
    __device__ __forceinline__ void operator()(const f32x4 (&acc)[2][2][4][2], const Unit& u, int wr, int wc, int fr, int fq) const {
        const int row0 = u.pm * BM + wr * 64 + fr, col0 = u.pn * BM + wc * 32 + 8 * fq;
#pragma unroll
        for (int ai = 0; ai < 2; ++ai) {
            f32x4 xv[4][2][2];
#pragma unroll
            for (int m = 0; m < 4; ++m) { const size_t off = (size_t)(row0 + ai * HALF + m * 16) * 1024 + col0;
#pragma unroll
                for (int bj = 0; bj < 2; ++bj)
#pragma unroll
                    for (int n = 0; n < 2; ++n) xv[m][bj][n] = *(const f32x4*)(x + off + bj * HALF + n * 4); }
#pragma unroll
            for (int m = 0; m < 4; ++m) { const size_t r = (size_t)(row0 + ai * HALF + m * 16); const size_t off = r * 1024 + col0; float s = 0.f;
#pragma unroll
                for (int bj = 0; bj < 2; ++bj) { const f32x4 v0 = xv[m][bj][0] + acc[ai][bj][m][0], v1 = xv[m][bj][1] + acc[ai][bj][m][1];
                    if (STORE_X1_F32) { *(f32x4*)(out + off + bj * HALF) = v0; *(f32x4*)(out + off + bj * HALF + 4) = v1; }
                    s += ((v0[0] * v0[0] + v0[1] * v0[1]) + (v0[2] * v0[2] + v0[3] * v0[3])) + ((v1[0] * v1[0] + v1[1] * v1[1]) + (v1[2] * v1[2] + v1[3] * v1[3]));
                    st16(x1b + off + bj * HALF, pack8(v0, v1)); }
                s += __shfl_xor(s, 16); s += __shfl_xor(s, 32);
                if (fq == 0) __hip_atomic_store(SS + r * 16 + 4 * u.pn + wc, s, __ATOMIC_RELAXED, __HIP_MEMORY_SCOPE_AGENT); }
            asm volatile("" ::: "memory");
        }
    }
};
struct EpiUp {
    static constexpr bool PERM = true, AFTER_DRAIN = false;
    const float* SS; bf16_t* UU; size_t piece;
    __device__ __forceinline__ void operator()(const f32x4 (&acc)[2][2][4][2], const Unit& u, int wr, int wc, int fr, int fq) const {
        const int row0 = u.pm * BM + wr * 64 + fr;
        bf16_t* UUp = UU + (size_t)(u.pn >> 2) * piece + (u.pn & 3) * BM + wc * 32 + 8 * fq;
#pragma unroll
        for (int ai = 0; ai < 2; ++ai)
#pragma unroll
            for (int m = 0; m < 4; ++m) { const size_t r = (size_t)(row0 + ai * HALF + m * 16);
                const f32x4* sp = (const f32x4*)(SS + r * 16); const f32x4 s4 = (sp[0] + sp[1]) + (sp[2] + sp[3]);
                const float rs = 1.0f / sqrtf(((s4[0] + s4[1]) + (s4[2] + s4[3])) * (1.0f / 1024.0f) + RMS_EPS);
#pragma unroll
                for (int bj = 0; bj < 2; ++bj) { f32x4 v[2];
#pragma unroll
                    for (int n = 0; n < 2; ++n) { const f32x4 z = acc[ai][bj][m][n] * rs;
#pragma unroll
                        for (int e = 0; e < 4; ++e) { const float t = fmaxf(z[e], 0.f); v[n][e] = t * t; } }
                    st16(UUp + r * 1024 + bj * HALF, pack8(v[0], v[1])); } }
    }
};
struct EpiRes2 {
    static constexpr bool PERM = true, AFTER_DRAIN = false;
    float* out; const bf16_t* x1b;
    __device__ __forceinline__ void operator()(const f32x4 (&acc)[2][2][4][2], const Unit& u, int wr, int wc, int fr, int fq) const {
        const int row0 = u.pm * BM + wr * 64 + fr, col0 = u.pn * BM + wc * 32 + 8 * fq;
#pragma unroll
        for (int ai = 0; ai < 2; ++ai) {
            u32x4 bw[4][2];
#pragma unroll
            for (int m = 0; m < 4; ++m) { const size_t off = (size_t)(row0 + ai * HALF + m * 16) * 1024 + col0;
#pragma unroll
                for (int bj = 0; bj < 2; ++bj) bw[m][bj] = *(const u32x4*)(x1b + off + bj * HALF); }
#pragma unroll
            for (int m = 0; m < 4; ++m) { const size_t off = (size_t)(row0 + ai * HALF + m * 16) * 1024 + col0;
#pragma unroll
                for (int bj = 0; bj < 2; ++bj) { f32x4 b0, b1; unpack8(bw[m][bj], b0, b1); float* p = out + off + bj * HALF;
                    *(f32x4*)p = b0 + acc[ai][bj][m][0]; *(f32x4*)(p + 4) = b1 + acc[ai][bj][m][1]; } }
            asm volatile("" ::: "memory");
        }
    }
};

template <class Epi, class Sched, bool ALIGN_EPI = false, bool SP2 = false>
__device__ __forceinline__ void gemm_phase(PG8_LAS unsigned char* lds, const Gemm g, const Sched& S, const Epi& E) {
    int tid_ = threadIdx.x; asm volatile("" : "+v"(tid_));
    const int tid = tid_, wid = __builtin_amdgcn_readfirstlane(tid >> 6), lane = tid & 63, wr = wid >> 2, wc = wid & 3, fr = lane & 15, fq = lane >> 4;
    const int K = g.K, nt = K / BK;
    const int lda = g.lda ? g.lda : K, segsh = g.segsh ? g.segsh : 30;
    unsigned voffA[2], voffB[2];
#pragma unroll
    for (int i = 0; i < 2; ++i) { int R, C; stage_rc(tid * 16 + i * 8192, R, C); const int Rb = Epi::PERM ? ((R & ~31) + perm32(R & 31)) : R;
        voffA[i] = (unsigned)(R * lda + C) * 2u; voffB[i] = (unsigned)(Rb * K + C) * 2u; }
    const size_t kstep = (size_t)(BK * 2);
    const size_t hstep = (size_t)HALF * K * 2;
    const size_t tstep = 2 * hstep;
    const size_t hstepA = (size_t)HALF * lda * 2, tstepA = 2 * hstepA;
#define PG8_AOFF(t_) ((size_t)((t_) >> segsh) * g.segstride + (size_t)((t_) & ((1 << segsh) - 1)) * kstep)
    const unsigned ldsw = (unsigned)wid * 1024u;
    const int aoff = lds_byte(wr * 64 + fr, fq * 8), boff = lds_byte(wc * 32 + fr, fq * 8);
#define PG8_SA(b, h) (((b) * 2 + (h)) * HTB)
#define PG8_SB(b, h) ((4 + (b) * 2 + (h)) * HTB)
#define PG8_STAGE(bufoff, gbase, voff) do { _Pragma("unroll") for (int _i = 0; _i < 2; ++_i) \
        __builtin_amdgcn_global_load_lds((const unsigned*)((const char*)(gbase) + (voff)[_i]), (PG8_LAS unsigned*)(lds + (bufoff) + ldsw + _i * 8192), 16, 0, 0); } while (0)
#define PG8_LDA(dst, b, h) do { _Pragma("unroll") for (int m = 0; m < 4; ++m) _Pragma("unroll") for (int k = 0; k < 2; ++k) dst[m][k] = *(const PG8_LAS bf16x8*)(lds + PG8_SA(b, h) + aoff + m * 2048 + k * 1024); } while (0)
#define PG8_LDB(dst, b, h) do { _Pragma("unroll") for (int n = 0; n < 2; ++n) _Pragma("unroll") for (int k = 0; k < 2; ++k) dst[n][k] = *(const PG8_LAS bf16x8*)(lds + PG8_SB(b, h) + boff + n * 2048 + k * 1024); } while (0)
#define PG8_MMA(ai, bj, At, Bt) do { __builtin_amdgcn_s_setprio(1); _Pragma("unroll") for (int m = 0; m < 4; ++m) _Pragma("unroll") for (int n = 0; n < 2; ++n) _Pragma("unroll") for (int k = 0; k < 2; ++k) \
        acc[ai][bj][m][n] = __builtin_amdgcn_mfma_f32_16x16x32_bf16(Bt[n][k], At[m][k], acc[ai][bj][m][n], 0, 0, 0); __builtin_amdgcn_s_setprio(0); } while (0)
#define PG8_WAIT_V(n) asm volatile("s_waitcnt vmcnt(" #n ")" ::: "memory")
#define PG8_WAIT_L(n) asm volatile("s_waitcnt lgkmcnt(" #n ")" ::: "memory")
#define PG8_BAR __builtin_amdgcn_s_barrier()
#define PG8_SCHED __builtin_amdgcn_sched_barrier(0)
    Unit cur, nxt; int ui = 0;
    if (!S.next(0, cur)) return;
    f32x4 acc[2][2][4][2];
#pragma unroll
    for (int a = 0; a < 2; ++a)
#pragma unroll
        for (int b = 0; b < 2; ++b)
#pragma unroll
            for (int m = 0; m < 4; ++m)
#pragma unroll
                for (int n = 0; n < 2; ++n) acc[a][b][m][n] = (f32x4){0.f, 0.f, 0.f, 0.f};
    bf16x8 At[4][2], B0[2][2], B1[2][2];
    const char* cA = (const char*)g.A + (size_t)cur.pm * tstepA; const char* cB = (const char*)g.Bt + (size_t)cur.pn * tstep;
    S.a_ready(cur);
    if constexpr (SP2) {
        PG8_STAGE(PG8_SB(0, 0), cB, voffB); PG8_STAGE(PG8_SB(0, 1), cB + hstep, voffB); PG8_STAGE(PG8_SA(0, 0), cA, voffA); PG8_STAGE(PG8_SA(0, 1), cA + hstepA, voffA);
        if (wr == 1) PG8_BAR;
        PG8_WAIT_V(2); PG8_BAR;
        PG8_STAGE(PG8_SB(1, 0), cB + kstep, voffB); PG8_STAGE(PG8_SA(1, 0), cA + kstep, voffA); PG8_STAGE(PG8_SB(1, 1), cB + hstep + kstep, voffB);
        PG8_WAIT_V(6); PG8_BAR;
    } else {
        PG8_STAGE(PG8_SB(0, 0), cB, voffB); PG8_STAGE(PG8_SA(0, 0), cA, voffA); PG8_STAGE(PG8_SB(0, 1), cB + hstep, voffB); PG8_STAGE(PG8_SA(0, 1), cA + hstepA, voffA);
        if (wr == 1) PG8_BAR;
        PG8_WAIT_V(4); PG8_BAR;
        PG8_STAGE(PG8_SB(1, 0), cB + kstep, voffB); PG8_STAGE(PG8_SA(1, 0), cA + kstep, voffA); PG8_STAGE(PG8_SB(1, 1), cB + hstep + kstep, voffB);
        PG8_WAIT_V(6); PG8_BAR;
    }
    for (;;) {
        const bool has_next = S.next(ui + 1, nxt);
        const char* nA = has_next ? (const char*)g.A + (size_t)nxt.pm * tstepA : cA; const char* nB = has_next ? (const char*)g.Bt + (size_t)nxt.pn * tstep : cB;
        for (int t = 0; t < nt; t += 2) {
            const bool last = (t == nt - 2);
            const char* a1 = cA + PG8_AOFF(t) + kstep;
            const char* a2 = last ? nA : cA + PG8_AOFF(t + 2); const char* b2 = last ? nB : cB + (size_t)(t + 2) * kstep;
            const char* a3 = a2 + kstep; const char* b3 = b2 + kstep;
            if (last && has_next) S.a_ready(nxt);
            if constexpr (SP2) {
            PG8_LDB(B0, 0, 0); PG8_LDB(B1, 0, 1); PG8_SCHED; PG8_LDA(At, 0, 0); PG8_STAGE(PG8_SA(1, 1), a1 + hstepA, voffA);
            PG8_WAIT_V(8); PG8_WAIT_L(0); PG8_BAR; PG8_MMA(0, 0, At, B0); PG8_MMA(0, 1, At, B1); PG8_BAR; PG8_SCHED;
            PG8_LDA(At, 0, 1); PG8_STAGE(PG8_SB(0, 0), b2, voffB); PG8_STAGE(PG8_SB(0, 1), b2 + hstep, voffB); PG8_STAGE(PG8_SA(0, 0), a2, voffA);
            PG8_WAIT_V(8); PG8_WAIT_L(0); PG8_BAR; PG8_MMA(1, 0, At, B0); PG8_MMA(1, 1, At, B1); PG8_BAR; PG8_SCHED;
            PG8_LDB(B0, 1, 0); PG8_LDB(B1, 1, 1); PG8_SCHED; PG8_LDA(At, 1, 0); PG8_STAGE(PG8_SA(0, 1), a2 + hstepA, voffA);
            PG8_WAIT_V(8); PG8_WAIT_L(0); PG8_BAR; PG8_MMA(0, 0, At, B0); PG8_MMA(0, 1, At, B1); PG8_BAR; PG8_SCHED;
            PG8_LDA(At, 1, 1); PG8_STAGE(PG8_SB(1, 0), b3, voffB); PG8_STAGE(PG8_SB(1, 1), b3 + hstep, voffB); PG8_STAGE(PG8_SA(1, 0), a3, voffA);
            PG8_WAIT_V(8); PG8_WAIT_L(0); PG8_BAR; PG8_MMA(1, 0, At, B0); PG8_MMA(1, 1, At, B1); PG8_BAR; PG8_SCHED;
            } else {
            PG8_LDB(B0, 0, 0); PG8_SCHED; PG8_LDA(At, 0, 0); PG8_STAGE(PG8_SA(1, 1), a1 + hstepA, voffA);
            PG8_WAIT_L(8); PG8_BAR; PG8_WAIT_L(0); PG8_MMA(0, 0, At, B0); PG8_BAR; PG8_SCHED;
            PG8_LDB(B1, 0, 1); PG8_STAGE(PG8_SB(0, 0), b2, voffB);
            PG8_BAR; PG8_WAIT_L(0); PG8_MMA(0, 1, At, B1); PG8_BAR;
            PG8_LDA(At, 0, 1); PG8_STAGE(PG8_SA(0, 0), a2, voffA);
            PG8_BAR; PG8_WAIT_L(0); PG8_MMA(1, 0, At, B0); PG8_BAR; PG8_SCHED;
            PG8_STAGE(PG8_SB(0, 1), b2 + hstep, voffB);
            PG8_WAIT_V(6); PG8_BAR; PG8_MMA(1, 1, At, B1); PG8_BAR;
            PG8_LDB(B0, 1, 0); PG8_SCHED; PG8_LDA(At, 1, 0); PG8_STAGE(PG8_SA(0, 1), a2 + hstepA, voffA);
            PG8_WAIT_L(8); PG8_BAR; PG8_WAIT_L(0); PG8_MMA(0, 0, At, B0); PG8_BAR; PG8_SCHED;
            PG8_LDB(B1, 1, 1); PG8_STAGE(PG8_SB(1, 0), b3, voffB);
            PG8_BAR; PG8_WAIT_L(0); PG8_MMA(0, 1, At, B1); PG8_BAR;
            PG8_LDA(At, 1, 1); PG8_STAGE(PG8_SA(1, 0), a3, voffA);
            PG8_BAR; PG8_WAIT_L(0); PG8_MMA(1, 0, At, B0); PG8_BAR; PG8_SCHED;
            PG8_STAGE(PG8_SB(1, 1), b3 + hstep, voffB);
            PG8_WAIT_V(6); PG8_BAR; PG8_MMA(1, 1, At, B1); PG8_BAR;
            }
        }
        if constexpr (ALIGN_EPI) { if (wr == 0) PG8_BAR; }
        if constexpr (!Epi::AFTER_DRAIN) { E(acc, cur, wr, wc, fr, fq); S.done(cur); }
        if (!has_next) break;
#pragma unroll
        for (int a = 0; a < 2; ++a)
#pragma unroll
            for (int b = 0; b < 2; ++b)
#pragma unroll
                for (int m = 0; m < 4; ++m)
#pragma unroll
                    for (int n = 0; n < 2; ++n) acc[a][b][m][n] = (f32x4){0.f, 0.f, 0.f, 0.f};
        cur = nxt; cA = nA; cB = nB; ++ui;
        if constexpr (ALIGN_EPI) { if (wr == 1) PG8_BAR; }
    }
    PG8_WAIT_V(0);
    if constexpr (!ALIGN_EPI) { if (wr == 0) PG8_BAR; }
    PG8_BAR;
    if constexpr (Epi::AFTER_DRAIN) { E.fused(acc, cur, wr, wc, fr, fq, lds, wid, lane); S.done(cur); }
#undef PG8_AOFF
#undef PG8_SA
#undef PG8_SB
#undef PG8_STAGE
#undef PG8_LDA
#undef PG8_LDB
#undef PG8_MMA
#undef PG8_WAIT_V
#undef PG8_WAIT_L
#undef PG8_BAR
#undef PG8_SCHED
}
}

namespace attn {
using bf16 = unsigned short;
using bf16x8 = __attribute__((ext_vector_type(8))) short;
using s16x4 = __attribute__((ext_vector_type(4))) short;
using f32x16 = __attribute__((ext_vector_type(16))) float;
using u32x4 = __attribute__((ext_vector_type(4))) unsigned;
using f32x4 = __attribute__((ext_vector_type(4))) float;
constexpr int SEQ = 4096, DM = 1024, NSLOT = 6, SLOTB = 8192, NREL = 513;
constexpr int LDS_K = 0, LDS_V = NSLOT * SLOTB, LDS_WS = 2 * NSLOT * SLOTB, LDS_OST = LDS_WS + 8 * 64 * 4, LDS_BIAS = LDS_OST + 8 * 4096, BIAS_CS = 400  , LDS_BYTES = LDS_BIAS + 4 * BIAS_CS * 4;
constexpr float LOG2E = 1.4426950408889634f;
__device__ __forceinline__ int crow(int r, int hi) { return (r & 3) + 8 * (r >> 2) + 4 * hi; }
#define SBAR() __builtin_amdgcn_sched_barrier(0)
__device__ __forceinline__ void glds16(const void* gsrc, unsigned lds_dst) { unsigned keep;
  asm volatile("s_mov_b32 %0, m0\n\ts_mov_b32 m0, %2\n\ts_nop 0\n\tglobal_load_lds_dwordx4 %1, off\n\ts_mov_b32 m0, %0" : "=&s"(keep) : "v"(gsrc), "s"(lds_dst) : "memory"); }
typedef float f32x2_t __attribute__((ext_vector_type(2))); typedef __bf16 bf16x2_t __attribute__((ext_vector_type(2)));
__device__ __forceinline__ unsigned cvtpk_s(float lo, float hi) { f32x2_t v = {lo, hi}; bf16x2_t b = __builtin_convertvector(v, bf16x2_t); return __builtin_bit_cast(unsigned, b); }
typedef __attribute__((address_space(3))) const char* lds_cptr;
__device__ __forceinline__ void kload8(bf16x8* kf, lds_cptr kp) {
  kf[0] = *(const __attribute__((address_space(3))) bf16x8*)(kp);        kf[1] = *(const __attribute__((address_space(3))) bf16x8*)(kp + 512);
  kf[2] = *(const __attribute__((address_space(3))) bf16x8*)(kp + 2048); kf[3] = *(const __attribute__((address_space(3))) bf16x8*)(kp + 2560);
  kf[4] = *(const __attribute__((address_space(3))) bf16x8*)(kp + 4096); kf[5] = *(const __attribute__((address_space(3))) bf16x8*)(kp + 4608);
  kf[6] = *(const __attribute__((address_space(3))) bf16x8*)(kp + 6144); kf[7] = *(const __attribute__((address_space(3))) bf16x8*)(kp + 6656);
}
__device__ __forceinline__ void pv(f32x16* o, int vb, bf16x8 pa0, bf16x8 pa1, bf16x8 pa2, bf16x8 pa3) {
  #pragma unroll
  for (int d0 = 0; d0 < 2; ++d0) { s16x4 lo[4], hi[4];
    #pragma unroll
    for (int ks = 0; ks < 4; ++ks) {
      asm volatile("ds_read_b64_tr_b16 %0,%1 offset:%c2" : "=&v"(lo[ks]) : "v"(vb), "i"(d0 * 4096 + ks * 1024) : "memory");
      asm volatile("ds_read_b64_tr_b16 %0,%1 offset:%c2" : "=&v"(hi[ks]) : "v"(vb), "i"(d0 * 4096 + ks * 1024 + 512) : "memory"); }
    asm volatile("s_waitcnt lgkmcnt(0)" ::: "memory"); SBAR();
    #define PK(k) (bf16x8){lo[k][0], lo[k][1], lo[k][2], lo[k][3], hi[k][0], hi[k][1], hi[k][2], hi[k][3]}
    o[d0] = __builtin_amdgcn_mfma_f32_32x32x16_bf16(pa0, PK(0), o[d0], 0, 0, 0);
    o[d0] = __builtin_amdgcn_mfma_f32_32x32x16_bf16(pa1, PK(1), o[d0], 0, 0, 0);
    o[d0] = __builtin_amdgcn_mfma_f32_32x32x16_bf16(pa2, PK(2), o[d0], 0, 0, 0);
    o[d0] = __builtin_amdgcn_mfma_f32_32x32x16_bf16(pa3, PK(3), o[d0], 0, 0, 0);
    #undef PK
  }
}
__device__ __forceinline__ float wmax(float v) {
#pragma unroll
  for (int o = 1; o < 64; o <<= 1) v = fmaxf(v, __shfl_xor(v, o));
  return v;
}
__device__ __forceinline__ void attn_unit(int b, int h, int g, const bf16* Q, const bf16* __restrict__ K, const bf16* __restrict__ V, bf16* O,
                                          const float* __restrict__ relb, const float* __restrict__ gq, const float* __restrict__ gk, char* shm) {
  int tid_ = threadIdx.x; asm volatile("" : "+v"(tid_));
  const int tid = tid_, lane = tid & 63, r32 = lane & 31, hi = lane >> 5; const int wid = __builtin_amdgcn_readfirstlane(tid >> 6);
  const long rowbase = (long)b * SEQ; const int q0 = g * 256;
  const int kc_lo = (4 * g - 8) > 0 ? (4 * g - 8) : 0, NT = 4 * g + 4 - kc_lo;
  const bf16* Qw = Q + (rowbase + q0 + wid * 32) * DM + h * 64;
  const bf16* Kh = K + (rowbase + 64 * kc_lo) * DM + h * 64; const bf16* Vh = V + (rowbase + 64 * kc_lo) * DM + h * 64;
  const unsigned lds0 = (unsigned)(uintptr_t)shm;
  float* wsf = (float*)(shm + LDS_WS) + wid * 64;
  float* biasT = (float*)(shm + LDS_BIAS);
  const bf16* ksrc = Kh + (long)lane * DM + wid * 8;
  const bf16* vsrc = Vh + (long)(16 * (wid & 3) + (lane >> 2)) * DM + (wid >> 2) * 32 + (lane & 3) * 8;
  const unsigned kdst = lds0 + LDS_K + wid * 1024, vdst = lds0 + LDS_V + wid * 1024;
  #define DMA_K(t, slot) glds16(ksrc + (long)(t) * 64 * DM, (unsigned)__builtin_amdgcn_readfirstlane(kdst + (slot)))
  #define DMA_V(t, slot) glds16(vsrc + (long)(t) * 64 * DM, (unsigned)__builtin_amdgcn_readfirstlane(vdst + (slot)))
  const int vb0 = (int)(lds0 + LDS_V) + ((lane >> 4) & 1) * 32 + (lane & 3) * 8 + (4 * hi + ((lane & 15) >> 2)) * 64;
  const lds_cptr shm3 = (lds_cptr)shm; const lds_cptr kp0 = shm3 + LDS_K + hi * 1024 + r32 * 16;
  const bool full = (g >= 2); const int nsteps = full ? 9 : NT;
  #define LOAD_TILE(i) (full ? ((i) < 6 ? (((i) & 1) ? ((i) >> 1) + 9 : ((i) >> 1)) : (i) - 3) : (i))
  #define ISSUE_LOAD(i) do { const int i_ = (i); const int tl_ = LOAD_TILE(i_); const int sb_ = (i_ % NSLOT) * SLOTB; DMA_K(tl_, sb_); DMA_V(tl_, sb_); } while (0)
  bf16x8 qr[4];
  #pragma unroll
  for (int d0 = 0; d0 < 4; ++d0) qr[d0] = *reinterpret_cast<const bf16x8*>(&Qw[(long)r32 * DM + d0 * 16 + hi * 8]);
  const float gqv = gq[lane], gkv = gk[lane]; float rbv[9], tbv[3];
  #pragma unroll
  for (int k = 0; k < 9; ++k) { const int i = lane + 64 * k; rbv[k] = (i < NREL) ? relb[h * NREL + i] : -3.0e38f; }
  #pragma unroll
  for (int k = 0; k < 3; ++k) { const int i = tid + 512 * k, c = i / 384, jj = i - c * 384, e = jj + c; tbv[k] = (e < 384) ? relb[h * NREL + (e < 64 ? 512 : 576 - e)] : 0.f; }
  asm volatile("" ::: "memory");
  ISSUE_LOAD(0); ISSUE_LOAD(1); if (full) { ISSUE_LOAD(2); ISSUE_LOAD(3); }
  float m2;
  { const float mq = wmax(fabsf(gqv)), mk = wmax(fabsf(gkv)); float mb = -3.0e38f;
    #pragma unroll
    for (int k = 0; k < 9; ++k) mb = fmaxf(mb, rbv[k]);
    mb = wmax(mb); m2 = (8.0f * mq * mk + mb) * LOG2E; }
  #pragma unroll
  for (int k = 0; k < 3; ++k) { const int i = tid + 512 * k, c = i / 384, jj = i - c * 384; biasT[c * BIAS_CS + jj] = tbv[k] * LOG2E - m2; }
  f32x16 o[2]; o[0] = f32x16{}; o[1] = f32x16{}; f32x16 lsum = f32x16{};
  const int qpos = 32 * (wid & 1) + r32;
  const int cch = 4 * g + (wid >> 1);
  if (full) asm volatile("s_waitcnt vmcnt(4) lgkmcnt(0)\n\ts_barrier" ::: "memory");
  else      asm volatile("s_waitcnt vmcnt(2) lgkmcnt(0)\n\ts_barrier" ::: "memory");
  for (int s = 0; s < nsteps; ++s) {
    int nis = 0;
    if (s + 2 < nsteps) { const int s2 = s + 2; if (full) { if (s2 < 3) { ISSUE_LOAD(2 * s2); ISSUE_LOAD(2 * s2 + 1); nis = 2; } else { ISSUE_LOAD(s2 + 3); nis = 1; } } else { ISSUE_LOAD(s2); nis = 1; } }
    int jrel = kc_lo + s - cch + 8, ld = full ? (s < 3 ? 2 * s : s + 3) : s;
    if (full && s < 3 && jrel < 0) { jrel += 9; ld += 1; }
    const int sl_cur = (ld % NSLOT) * SLOTB;
    if (jrel >= 0 && jrel <= 8) {
      s16x4 vlo[8], vhi[8]; { const int vb = vb0 + sl_cur;
        #pragma unroll
        for (int i_ = 0; i_ < 8; ++i_) {
          asm volatile("ds_read_b64_tr_b16 %0,%1 offset:%c2" : "=&v"(vlo[i_]) : "v"(vb), "i"((i_ >> 2) * 4096 + (i_ & 3) * 1024) : "memory");
          asm volatile("ds_read_b64_tr_b16 %0,%1 offset:%c2" : "=&v"(vhi[i_]) : "v"(vb), "i"((i_ >> 2) * 4096 + (i_ & 3) * 1024 + 512) : "memory"); } }
      f32x16 p0, p1;
      if (jrel <= 3) { const float c0 = biasT[0];
        #pragma unroll
        for (int r = 0; r < 16; ++r) { p0[r] = c0; p1[r] = c0; } }
      else { const int i0 = 64 + 4 * hi - qpos + 64 * (jrel - 4), cs = i0 & 3; const f32x4* a4 = (const f32x4*)(biasT + cs * BIAS_CS + (i0 - cs));
        #pragma unroll
        for (int q4 = 0; q4 < 4; ++q4) { const f32x4 b0 = a4[2 * q4], b1 = a4[2 * q4 + 8];
          #pragma unroll
          for (int e = 0; e < 4; ++e) { p0[4 * q4 + e] = b0[e]; p1[4 * q4 + e] = b1[e]; } } }
      bf16x8 kf[8]; kload8(kf, kp0 + sl_cur);
      #pragma unroll
      for (int d0 = 0; d0 < 4; ++d0) { p0 = __builtin_amdgcn_mfma_f32_32x32x16_bf16(kf[2 * d0], qr[d0], p0, 0, 0, 0); p1 = __builtin_amdgcn_mfma_f32_32x32x16_bf16(kf[2 * d0 + 1], qr[d0], p1, 0, 0, 0); }
      #pragma unroll
      for (int r = 0; r < 16; ++r) { p0[r] = __builtin_amdgcn_exp2f(p0[r]); p1[r] = __builtin_amdgcn_exp2f(p1[r]); }
      lsum += p0 + p1;
      u32x4 pw0, pw1, pw2, pw3;
      pw0 = (u32x4){cvtpk_s(p0[0], p0[1]), cvtpk_s(p0[2], p0[3]), cvtpk_s(p0[4], p0[5]), cvtpk_s(p0[6], p0[7])};
      pw1 = (u32x4){cvtpk_s(p0[8], p0[9]), cvtpk_s(p0[10], p0[11]), cvtpk_s(p0[12], p0[13]), cvtpk_s(p0[14], p0[15])};
      pw2 = (u32x4){cvtpk_s(p1[0], p1[1]), cvtpk_s(p1[2], p1[3]), cvtpk_s(p1[4], p1[5]), cvtpk_s(p1[6], p1[7])};
      pw3 = (u32x4){cvtpk_s(p1[8], p1[9]), cvtpk_s(p1[10], p1[11]), cvtpk_s(p1[12], p1[13]), cvtpk_s(p1[14], p1[15])};
      SBAR();
      asm volatile("s_waitcnt lgkmcnt(0)" ::: "memory"); SBAR();
      #define VF(i_) (bf16x8){vlo[i_][0], vlo[i_][1], vlo[i_][2], vlo[i_][3], vhi[i_][0], vhi[i_][1], vhi[i_][2], vhi[i_][3]}
      o[0] = __builtin_amdgcn_mfma_f32_32x32x16_bf16(__builtin_bit_cast(bf16x8, pw0), VF(0), o[0], 0, 0, 0); o[1] = __builtin_amdgcn_mfma_f32_32x32x16_bf16(__builtin_bit_cast(bf16x8, pw0), VF(4), o[1], 0, 0, 0);
      o[0] = __builtin_amdgcn_mfma_f32_32x32x16_bf16(__builtin_bit_cast(bf16x8, pw1), VF(1), o[0], 0, 0, 0); o[1] = __builtin_amdgcn_mfma_f32_32x32x16_bf16(__builtin_bit_cast(bf16x8, pw1), VF(5), o[1], 0, 0, 0);
      o[0] = __builtin_amdgcn_mfma_f32_32x32x16_bf16(__builtin_bit_cast(bf16x8, pw2), VF(2), o[0], 0, 0, 0); o[1] = __builtin_amdgcn_mfma_f32_32x32x16_bf16(__builtin_bit_cast(bf16x8, pw2), VF(6), o[1], 0, 0, 0);
      o[0] = __builtin_amdgcn_mfma_f32_32x32x16_bf16(__builtin_bit_cast(bf16x8, pw3), VF(3), o[0], 0, 0, 0); o[1] = __builtin_amdgcn_mfma_f32_32x32x16_bf16(__builtin_bit_cast(bf16x8, pw3), VF(7), o[1], 0, 0, 0);
      #undef VF
    }
    if (nis == 2)      asm volatile("s_waitcnt vmcnt(4) lgkmcnt(0)\n\ts_barrier" ::: "memory");
    else if (nis == 1) asm volatile("s_waitcnt vmcnt(2) lgkmcnt(0)\n\ts_barrier" ::: "memory");
    else               asm volatile("s_waitcnt vmcnt(0) lgkmcnt(0)\n\ts_barrier" ::: "memory");
  }
  #undef LOAD_TILE
  #undef ISSUE_LOAD
  float l_reg = 0.f;
  #pragma unroll
  for (int r = 0; r < 16; ++r) l_reg += lsum[r];
  { auto rr = __builtin_amdgcn_permlane32_swap(__float_as_uint(l_reg), __float_as_uint(l_reg), false, false); l_reg = __uint_as_float(rr[0]) + __uint_as_float(rr[1]); }
  if (hi == 0) wsf[32 + r32] = l_reg; asm volatile("s_waitcnt lgkmcnt(0)" ::: "memory");
  float rli[16];
  #pragma unroll
  for (int r = 0; r < 16; ++r) rli[r] = __builtin_amdgcn_rcpf(wsf[32 + crow(r, hi)]);
  bf16* Ow = O + (rowbase + q0 + wid * 32) * DM + h * 64;
  { bf16* stg = (bf16*)(shm + LDS_OST) + wid * 2048;
    #pragma unroll
    for (int r = 0; r < 16; ++r) { const int orow = crow(r, hi);
      #pragma unroll
      for (int d0 = 0; d0 < 2; ++d0) stg[orow * 64 + d0 * 32 + r32] = (bf16)(cvtpk_s(o[d0][r] * rli[r], 0.f) & 0xffffu); }
    asm volatile("s_waitcnt lgkmcnt(0)" ::: "memory");
    #pragma unroll
    for (int i = 0; i < 4; ++i) { const int row = i * 8 + (lane >> 3), ch = lane & 7; const u32x4 v = *(const u32x4*)(stg + row * 64 + ch * 8); pg8::st16(Ow + (long)row * DM + ch * 8, v); } }
  asm volatile("s_waitcnt lgkmcnt(0)\n\ts_barrier" ::: "memory");
  #undef DMA_K
  #undef DMA_V
}
#undef SBAR
}

#define GAS __attribute__((address_space(1)))
#define LAS __attribute__((address_space(3)))
typedef unsigned short bf16;
typedef unsigned v4u __attribute__((ext_vector_type(4)));
typedef float f32x4 __attribute__((ext_vector_type(4)));
typedef short bf16x8 __attribute__((ext_vector_type(8)));
typedef GAS unsigned gu32;
typedef GAS unsigned long long gu64;
#define RLX_AGENT __ATOMIC_RELAXED, __HIP_MEMORY_SCOPE_AGENT
#define LDS_WAIT() asm volatile("s_waitcnt lgkmcnt(0)" ::: "memory")
#define VM_WAIT() asm volatile("s_waitcnt vmcnt(0)" ::: "memory")
__device__ __forceinline__ unsigned long long rt() { return __builtin_amdgcn_s_memrealtime(); }
#define XB_TMO      128
#define XB_XCNT(j)  (256  + 64 * (j))
#define XB_XSUB(j)  (1280 + 64 * (j))
#define XB_XGEN(j)  (2304 + 64 * (j))
#define XB_TOP      3328
#define XB_TOPGEN   3392
#define XCD_BAR_WORDS 3456
#define XB_SPIN_CAP (1u << 18)

__device__ __forceinline__ unsigned xb_ld(unsigned* p)              { return __hip_atomic_load(p, __ATOMIC_RELAXED, __HIP_MEMORY_SCOPE_AGENT); }
__device__ __forceinline__ unsigned xb_add(unsigned* p, unsigned v) { return __hip_atomic_fetch_add(p, v, __ATOMIC_RELAXED, __HIP_MEMORY_SCOPE_AGENT); }
__device__ __forceinline__ unsigned xb_xcc_id() { return (unsigned)__builtin_amdgcn_s_getreg((3 << 11) | 20) & 0xFu; }
#define XB_SPIN(cond, bar) do { unsigned _sp = 0; while (cond) { __builtin_amdgcn_s_sleep(1); \
    if ((++_sp & 255u) == 0u) { if (xb_ld(&(bar)[XB_TMO])) break; if (_sp > XB_SPIN_CAP) { atomicAdd(&(bar)[XB_TMO], 1u); break; } } } } while (0)

struct XcdBarrier {
    unsigned* bar; unsigned x;
    volatile LAS unsigned* st;
};

__device__ __forceinline__ XcdBarrier xcd_barrier_post(unsigned* bar, volatile LAS unsigned* st) {
    XcdBarrier b; b.bar = bar; b.x = xb_xcc_id(); b.st = st;
    if (threadIdx.x == 0) (void)xb_add(&bar[XB_XCNT(b.x)], 1u);
    return b;
}
__device__ __forceinline__ void xcd_barrier_complete(unsigned* bar, unsigned x, unsigned& nloc, unsigned& nx) {
    const unsigned G = gridDim.x * gridDim.y * gridDim.z;
    unsigned sum, cnt, mine, sp = 0u;
    for (;;) {
        sum = 0u; cnt = 0u; mine = 0u;
#pragma unroll
        for (unsigned j = 0; j < 16; ++j) { const unsigned c = xb_ld(&bar[XB_XCNT(j)]); sum += c; cnt += (c > 0u) ? 1u : 0u; mine = (j == x) ? c : mine; }
        if (sum == G) break;
        __builtin_amdgcn_s_sleep(1);
        if ((++sp & 255u) == 0u) { if (xb_ld(&bar[XB_TMO])) break; if (sp > XB_SPIN_CAP) { atomicAdd(&bar[XB_TMO], 1u); break; } }
    }
    nloc = mine > 0u ? mine : 1u; nx = cnt > 0u ? cnt : 1u;
}

__device__ __forceinline__ void xcd_barrier(const XcdBarrier& b) {
    asm volatile("s_waitcnt vmcnt(0)" ::: "memory");
    __syncthreads();
    if (threadIdx.x == 0) {
        unsigned* bar = b.bar;
        __builtin_amdgcn_s_waitcnt(0);
        unsigned nloc = b.st[0], nx = b.st[1];
        if (nloc == 0u) { xcd_barrier_complete(bar, b.x, nloc, nx); b.st[0] = nloc; b.st[1] = nx; }
        __builtin_amdgcn_fence(__ATOMIC_RELEASE, "agent");
        asm volatile("s_waitcnt vmcnt(0)" ::: "memory");
        const unsigned old = xb_add(&bar[XB_XSUB(b.x)], 1u);
        const unsigned gen = old / nloc;
        if (old + 1u == (gen + 1u) * nloc) {
            __builtin_amdgcn_fence(__ATOMIC_RELEASE, "agent");
            asm volatile("s_waitcnt vmcnt(0)" ::: "memory");
            const unsigned og = xb_add(&bar[XB_TOP], 1u);
            const unsigned tg = og / nx;
            if (og + 1u == (tg + 1u) * nx) xb_add(&bar[XB_TOPGEN], 1u);
            else XB_SPIN(xb_ld(&bar[XB_TOPGEN]) == tg, bar);
            __builtin_amdgcn_fence(__ATOMIC_ACQUIRE, "agent");
            xb_add(&bar[XB_XGEN(b.x)], 1u);
            asm volatile("s_waitcnt vmcnt(0)" ::: "memory");
        } else {
            XB_SPIN(xb_ld(&bar[XB_XGEN(b.x)]) == gen, bar);
            __builtin_amdgcn_fence(__ATOMIC_ACQUIRE, "agent");
            asm volatile("s_waitcnt vmcnt(0)" ::: "memory");
        }
    }
    __syncthreads();
}
#include <hip/hip_cooperative_groups.h>
namespace cg = cooperative_groups;
constexpr int NWAVES = 8;
constexpr int BATCH = 4, SEQ = 4096, D = 1024, FF = 4096, M = BATCH * SEQ, NIN = 8192;
constexpr size_t MiB = 1u << 20;
constexpr size_t WS_SS = 1 * MiB;
constexpr size_t WS_W1 = 2 * MiB, WS_WC = 18 * MiB, WS_WA = 20 * MiB  , WS_WO = 22 * MiB, WS_WUP = 24 * MiB, WS_WDN = 32 * MiB;
constexpr size_t WS_V = 40 * MiB  , WS_H = 72 * MiB  , WS_Q = 104 * MiB, WS_K = 136 * MiB  , WS_BG = 168 * MiB  , WS_U1 = 200 * MiB;
constexpr size_t WS_UU = 72 * MiB;
constexpr size_t WS_END = 232 * MiB;
constexpr int LDS_BYTES = 147456;
constexpr int LDSCTL_OFF = 131072, MISC_OFF = LDSCTL_OFF + 320;
constexpr size_t WS_CTL = 0, CTL_ZERO_BYTES = 65536; constexpr int CW_BAR = 4096;
__device__ __forceinline__ unsigned f2bf(float f) { unsigned u = __builtin_bit_cast(unsigned, f); return (u + 0x7fffu + ((u >> 16) & 1u)) >> 16; }
__device__ __forceinline__ unsigned pk2(float lo, float hi) { return f2bf(lo) | (f2bf(hi) << 16); }
__device__ __forceinline__ float wave_sum(float v) {
#pragma unroll
    for (int o = 1; o < 64; o <<= 1) v += __shfl_xor(v, o);
    return v;
}
__device__ __forceinline__ void tr_item(const float* W, int ldw, int col0, int k0, bf16* WT, int Kd, int drow0, const float* kscale, LAS float* scr, int lane) {
    float tv[32];
#pragma unroll
    for (int i = 0; i < 32; ++i) { const int kk = 2 * i + (lane >> 5); tv[i] = W[(size_t)(k0 + kk) * ldw + col0 + (lane & 31)]; }
#pragma unroll
    for (int i = 0; i < 32; ++i) { const int kk = 2 * i + (lane >> 5); float v = tv[i]; if (kscale) v *= kscale[k0 + kk]; scr[kk * 33 + (lane & 31)] = v; }
    LDS_WAIT(); asm volatile("" ::: "memory");
    const int c = lane & 7;
#pragma unroll
    for (int j = 0; j < 4; ++j) { const int n = (lane >> 3) + 8 * j; const LAS float* s = scr + (8 * c) * 33 + n;
        v4u o; o.x = pk2(s[0 * 33], s[1 * 33]); o.y = pk2(s[2 * 33], s[3 * 33]); o.z = pk2(s[4 * 33], s[5 * 33]); o.w = pk2(s[6 * 33], s[7 * 33]);
        pg8::st16(WT + (size_t)(drow0 + n) * Kd + k0 + 8 * c, o); }
    LDS_WAIT(); asm volatile("" ::: "memory");
}

#ifndef PH_MASK
#define PH_MASK 127
#endif
#ifndef REP_P1
#define REP_P1 1
#endif
#ifndef REP_ATT
#define REP_ATT 1
#endif
#ifndef REP_P3
#define REP_P3 1
#endif
#ifndef REP_P4
#define REP_P4 1
#endif
#ifndef REP_P5
#define REP_P5 1
#endif
#ifndef EXTRA_SYNC
#define EXTRA_SYNC 0
#endif
__device__ unsigned g_panel_cnt[64 * 64];
__device__ unsigned g_bar_shard[16 * 64];
__device__ unsigned g_bar_cnt = 0u, g_bar_gen = 0u, g_done_cnt = 0u;
struct Args { const float* in[16]; float* out; unsigned char* ws; };
__global__ void __launch_bounds__(NWAVES * 64, 2) fwd(Args a) {
    extern __shared__ __attribute__((aligned(16))) unsigned char lds[];
    cg::grid_group grid = cg::this_grid();
    LAS unsigned char* ldsp = (LAS unsigned char*)lds;
    const int tid = threadIdx.x, lane = tid & 63, wave = __builtin_amdgcn_readfirstlane(tid >> 6);
    const int G = gridDim.x, bx = blockIdx.x, vcu = (G % 8 == 0) ? (bx % 8) * (G / 8) + bx / 8 : bx;
    unsigned char* ws = a.ws;
    const float* x = a.in[0];
    bf16 *W1 = (bf16*)(ws + WS_W1), *WA = (bf16*)(ws + WS_WA), *WC = (bf16*)(ws + WS_WC), *WO = (bf16*)(ws + WS_WO), *WUP = (bf16*)(ws + WS_WUP), *WDN = (bf16*)(ws + WS_WDN);
    bf16 *Vb = (bf16*)(ws + WS_V), *X1B = (bf16*)(ws + WS_V), *Hb = (bf16*)(ws + WS_H), *YC = (bf16*)(ws + WS_H)  , *Qb = (bf16*)(ws + WS_Q), *AO = (bf16*)(ws + WS_Q)  , *Kb = (bf16*)(ws + WS_K), *MG = (bf16*)(ws + WS_K);
    bf16 *BG = (bf16*)(ws + WS_BG), *U1 = (bf16*)(ws + WS_U1), *UU = (bf16*)(ws + WS_UU), *Gt = (bf16*)a.out;
    float* SS = (float*)(ws + WS_SS);
    for (int u = tid; u < (LDS_BYTES - LDSCTL_OFF) / 4; u += NWAVES * 64) ((LAS unsigned*)(ldsp + LDSCTL_OFF))[u] = 0u;
    __syncthreads();
    if (a.out == nullptr) grid.sync();
#ifndef WB_AT_SEAMS
#define WB_AT_SEAMS 0
#endif
#if WB_AT_SEAMS || !WT_STORES
#define BAR_RELEASE() do { __builtin_amdgcn_fence(__ATOMIC_RELEASE, "agent"); asm volatile("s_waitcnt vmcnt(0)" ::: "memory"); } while (0)
#else
#define BAR_RELEASE() do { } while (0)
#endif
#if defined(MONO_BAR)
    const bool grouped = (G == 256);
    const unsigned NSEAMS = (grouped ? 3u : 6u) + EXTRA_SYNC;
    unsigned bar_epoch = 0u, bar_base = 0u; const unsigned bar_xcc = xb_xcc_id();
#define GRID_BAR() do { asm volatile("s_waitcnt vmcnt(0)" ::: "memory"); __syncthreads(); \
    ++bar_epoch; \
    if (tid == 0) { \
        BAR_RELEASE(); \
        unsigned old_ = xb_add(&g_bar_shard[64u * bar_xcc], 1u);     \
        if (bar_epoch == 1u) asm volatile("s_waitcnt vmcnt(0)" : "+v"(old_) :: "memory");     \
        const unsigned tgt_ = bar_epoch * (unsigned)G; unsigned sp_ = 0u; \
        for (;;) { unsigned s_ = 0u; _Pragma("unroll") for (int j_ = 0; j_ < 16; ++j_) s_ += xb_ld(&g_bar_shard[64 * j_]); \
            if (bar_epoch == 1u && sp_ == 0u) bar_base = ((s_ - 1u) / (NSEAMS * (unsigned)G)) * (NSEAMS * (unsigned)G);     \
            if (s_ - bar_base >= tgt_) break; \
            __builtin_amdgcn_s_sleep(8); if (++sp_ > (1u << 22)) break; } \
        __builtin_amdgcn_fence(__ATOMIC_ACQUIRE, "agent"); asm volatile("s_waitcnt vmcnt(0)" ::: "memory"); } \
    __syncthreads(); } while (0)
    unsigned grp_epoch = 0u, grp_base = 0u;
#define GROUP_BAR(pm_) do { asm volatile("s_waitcnt vmcnt(0)" ::: "memory"); __syncthreads(); \
    ++grp_epoch; \
    if (tid == 0) { unsigned* pc_ = &g_panel_cnt[64 * (pm_)]; \
        BAR_RELEASE(); \
        const unsigned old_ = xb_add(pc_, 1u); \
        if (grp_epoch == 1u) grp_base = old_ - old_ % 12u; \
        const unsigned tgt_ = grp_epoch * 4u; unsigned sp_ = 0u; \
        while (xb_ld(pc_) - grp_base < tgt_) { __builtin_amdgcn_s_sleep(1); if (++sp_ > (1u << 22)) break; } \
        __builtin_amdgcn_fence(__ATOMIC_ACQUIRE, "agent"); asm volatile("s_waitcnt vmcnt(0)" ::: "memory"); } \
    __syncthreads(); } while (0)
#elif defined(GEN_BAR)
#define GRID_BAR() do { asm volatile("s_waitcnt vmcnt(0)" ::: "memory"); __syncthreads(); \
    if (tid == 0) { \
        __builtin_amdgcn_fence(__ATOMIC_RELEASE, "agent"); asm volatile("s_waitcnt vmcnt(0)" ::: "memory"); \
        unsigned g0_ = xb_ld(&g_bar_gen); asm volatile("s_waitcnt vmcnt(0)" : "+v"(g0_) :: "memory");            \
        unsigned old_ = xb_add(&g_bar_cnt, 1u); asm volatile("s_waitcnt vmcnt(0)" : "+v"(old_) :: "memory"); \
        if (old_ == (unsigned)G - 1u) { __hip_atomic_store(&g_bar_cnt, 0u, RLX_AGENT); asm volatile("s_waitcnt vmcnt(0)" ::: "memory"); xb_add(&g_bar_gen, 1u); } \
        else { unsigned sp_ = 0u; while (xb_ld(&g_bar_gen) == g0_) { __builtin_amdgcn_s_sleep(1); if (++sp_ > (1u << 22)) break; } } \
        __builtin_amdgcn_fence(__ATOMIC_ACQUIRE, "agent"); asm volatile("s_waitcnt vmcnt(0)" ::: "memory"); } \
    __syncthreads(); } while (0)
#elif defined(CG_ALL)
#define GRID_BAR() do { asm volatile("s_waitcnt vmcnt(0)" ::: "memory"); grid.sync(); } while (0)
#elif defined(SIMPLE_BAR)
    unsigned bar_epoch = 0u;
#define GRID_BAR() do { asm volatile("s_waitcnt vmcnt(0)" ::: "memory"); __syncthreads(); \
    ++bar_epoch; \
    if (tid == 0) { unsigned* cnt_ = (unsigned*)(ws + WS_CTL) + CW_BAR + XB_TOP; \
        __builtin_amdgcn_fence(__ATOMIC_RELEASE, "agent"); asm volatile("s_waitcnt vmcnt(0)" ::: "memory"); \
        xb_add(cnt_, 1u); unsigned sp_ = 0u; \
        while (xb_ld(cnt_) < bar_epoch * (unsigned)G) { __builtin_amdgcn_s_sleep(1); if (++sp_ > (1u << 22)) break; } \
        __builtin_amdgcn_fence(__ATOMIC_ACQUIRE, "agent"); asm volatile("s_waitcnt vmcnt(0)" ::: "memory"); } \
    __syncthreads(); } while (0)
#else
#define GRID_BAR() xcd_barrier(bar)
#endif

#ifndef DUP_P0
#define DUP_P0 1
#endif
    for (int rep0 = 0; rep0 < DUP_P0; ++rep0) {
        LAS float* scr = (LAS float*)(ldsp + wave * 16384);
        const int gw = vcu * NWAVES + wave, NGW = G * NWAVES;
        constexpr int I_1 = 16 * 256, I_S = 16 * 32, I_UP = 16 * 128, I_DN = 64 * 32, NITEMS = I_1 + 3 * I_S + I_UP + I_DN;
        for (int it = gw; it < NITEMS; it += NGW) {
            int r = it;
            if (r < I_1) { const int db = r & 255, kb = r >> 8, pn = db >> 3, pb = db & 7, bj = pb >> 2, wcc = pb & 3; const float* W = a.in[2]; int ldw = 6144, col;
                if (pn < 4) col = (4 * pn + wcc) * 64 + 32 * bj;
                else if (pn < 8) col = 1024 + (4 * (pn - 4) + wcc) * 64 + 32 * bj;
                else if (pn < 12) col = 2048 + 256 * (pn - 8) + 32 * pb;
                else if (pn < 16) col = 3072 + 256 * (pn - 12) + 32 * pb;
                else if (pn < 24) col = (bj ? 5120 : 4096) + 128 * (pn - 16) + 32 * wcc;
                else { W = a.in[10]; ldw = 2048; col = 256 * (pn - 24) + 32 * pb; }
                tr_item(W, ldw, col, 64 * kb, W1, D, 32 * db, nullptr, scr, lane); continue; } r -= I_1;
            if (r < I_S) { tr_item(a.in[8], D, 32 * (r & 31), 64 * (r >> 5), WA, D, 32 * (r & 31), nullptr, scr, lane); continue; } r -= I_S;
            if (r < I_S) { tr_item(a.in[9], D, 32 * (r & 31), 64 * (r >> 5), WC, D, 32 * (r & 31), nullptr, scr, lane); continue; } r -= I_S;
            if (r < I_S) { tr_item(a.in[12], D, 32 * (r & 31), 64 * (r >> 5), WO, D, 32 * (r & 31), nullptr, scr, lane); continue; } r -= I_S;
            if (r < I_UP) { tr_item(a.in[14], FF, 32 * (r & 127), 64 * (r >> 7), WUP, D, 32 * (r & 127), a.in[13], scr, lane); continue; } r -= I_UP;
            tr_item(a.in[15], D, 32 * (r & 31), 64 * (r >> 5), WDN, FF, 32 * (r & 31), nullptr, scr, lane);
        }
        const float* g1 = a.in[1];
        f32x4 gv[2][2];
#pragma unroll
        for (int c = 0; c < 2; ++c)
#pragma unroll
            for (int hh = 0; hh < 2; ++hh) gv[c][hh] = ((const f32x4*)g1)[c * 128 + 2 * lane + hh];
        for (int m0 = gw; m0 < M; m0 += 2 * NGW) {
            const int m1 = m0 + NGW; const bool has1 = m1 < M;
            const f32x4* xr0 = (const f32x4*)(x + (size_t)m0 * D); const f32x4* xr1 = (const f32x4*)(x + (size_t)(has1 ? m1 : m0) * D);
            f32x4 v0[2][2], v1[2][2]; float s0 = 0.f, s1 = 0.f;
#pragma unroll
            for (int c = 0; c < 2; ++c)
#pragma unroll
                for (int hh = 0; hh < 2; ++hh) { v0[c][hh] = xr0[c * 128 + 2 * lane + hh]; v1[c][hh] = xr1[c * 128 + 2 * lane + hh]; }
#pragma unroll
            for (int c = 0; c < 2; ++c)
#pragma unroll
                for (int hh = 0; hh < 2; ++hh) { const f32x4 a0 = v0[c][hh], a1 = v1[c][hh];
                    s0 += (a0.x * a0.x + a0.y * a0.y) + (a0.z * a0.z + a0.w * a0.w); s1 += (a1.x * a1.x + a1.y * a1.y) + (a1.z * a1.z + a1.w * a1.w); }
            const float rs0 = 1.0f / sqrtf(wave_sum(s0) * (1.0f / D) + 1e-6f), rs1 = 1.0f / sqrtf(wave_sum(s1) * (1.0f / D) + 1e-6f);
#pragma unroll
            for (int c = 0; c < 2; ++c) { const f32x4 y0 = v0[c][0] * rs0 * gv[c][0], y1 = v0[c][1] * rs0 * gv[c][1];
                pg8::st16(Hb + (size_t)m0 * D + c * 512 + 8 * lane, (v4u){pk2(y0.x, y0.y), pk2(y0.z, y0.w), pk2(y1.x, y1.y), pk2(y1.z, y1.w)}); }
            if (has1) {
#pragma unroll
                for (int c = 0; c < 2; ++c) { const f32x4 y0 = v1[c][0] * rs1 * gv[c][0], y1 = v1[c][1] * rs1 * gv[c][1];
                    pg8::st16(Hb + (size_t)m1 * D + c * 512 + 8 * lane, (v4u){pk2(y0.x, y0.y), pk2(y0.z, y0.w), pk2(y1.x, y1.y), pk2(y1.z, y1.w)}); } }
        }
    }
    GRID_BAR();
#if !defined(SIMPLE_BAR) && !defined(CG_ALL) && !defined(GEN_BAR) && !defined(MONO_BAR)
    const XcdBarrier bar = xcd_barrier_post((unsigned*)(ws + WS_CTL) + CW_BAR, (volatile LAS unsigned*)(ldsp + MISC_OFF) + 8);
#endif

    if (PH_MASK & 2) {
        pg8::Gemm g{Hb, W1, M, NIN, D}; pg8::StaticOrder S; S.init(M, NIN, G, bx);
        pg8::EpiP1 E{Qb, Kb, Vb, BG, U1, Gt, a.in[3], a.in[4], a.in[11]};
        pg8::gemm_phase<pg8::EpiP1, pg8::StaticOrder, true, true>(ldsp, g, S, E);
#ifdef DUP_P1
        { pg8::Gemm g2{Hb, W1, M, NIN, D}; pg8::StaticOrder S2; S2.init(M, NIN, G, bx); pg8::gemm_phase<pg8::EpiP1, pg8::StaticOrder, true, true>(ldsp, g2, S2, E); }
#endif
    }
    GRID_BAR();

    if (PH_MASK & 4) {
        for (int L = vcu; L < 1024 * REP_ATT; L += G) { const int bh = (L & 255) >> 2, gq4 = (L & 3) + 4 * ((L >> 8) & 3);
            attn::attn_unit(bh >> 4, bh & 15, gq4, Qb, Kb, Vb, AO, a.in[5], a.in[3], a.in[4], (char*)lds); }
        const float* cw = a.in[6]; const float* cb = a.in[7];
        for (int item = vcu * 512 + tid; item < 131072; item += G * 512) {
            const int c8 = (item & 127) * 8, t0 = (item >> 7) * 16;
            float w0[8], w1[8], w2[8], b0[8], u1[8], u2[8];
#pragma unroll
            for (int e = 0; e < 8; ++e) { w0[e] = cw[c8 + e]; w1[e] = cw[1024 + c8 + e]; w2[e] = cw[2048 + c8 + e]; b0[e] = cb[c8 + e]; u1[e] = 0.f; u2[e] = 0.f; }
            if ((t0 & (SEQ - 1)) != 0) { f32x4 p, q; pg8::unpack8(*(const v4u*)(U1 + (size_t)(t0 - 2) * D + c8), p, q);
#pragma unroll
                for (int e = 0; e < 4; ++e) { u2[e] = p[e]; u2[4 + e] = q[e]; }
                pg8::unpack8(*(const v4u*)(U1 + (size_t)(t0 - 1) * D + c8), p, q);
#pragma unroll
                for (int e = 0; e < 4; ++e) { u1[e] = p[e]; u1[4 + e] = q[e]; } }
            v4u ur[16], br[16];
#pragma unroll
            for (int i = 0; i < 16; ++i) { const size_t off = (size_t)(t0 + i) * D + c8; ur[i] = *(const v4u*)(U1 + off); br[i] = *(const v4u*)(BG + off); }
#pragma unroll
            for (int i = 0; i < 16; ++i) { const size_t off = (size_t)(t0 + i) * D + c8; f32x4 p, q, bp, bq; float u0[8], bgv[8], y[8];
                pg8::unpack8(ur[i], p, q); pg8::unpack8(br[i], bp, bq);
#pragma unroll
                for (int e = 0; e < 4; ++e) { u0[e] = p[e]; u0[4 + e] = q[e]; bgv[e] = bp[e]; bgv[4 + e] = bq[e]; }
#pragma unroll
                for (int e = 0; e < 8; ++e) { y[e] = bgv[e] * (b0[e] + w0[e] * u2[e] + w1[e] * u1[e] + w2[e] * u0[e]); u2[e] = u1[e]; u1[e] = u0[e]; }
                v4u o; o.x = pk2(y[0], y[1]); o.y = pk2(y[2], y[3]); o.z = pk2(y[4], y[5]); o.w = pk2(y[6], y[7]); pg8::st16(YC + off, o); }
        }
    }
    GRID_BAR();

    if (PH_MASK & 8) {
        static_assert(WS_Q == WS_H + (size_t)M * D * 2 && WS_WA == WS_WC + (size_t)D * D * 2, "P3 reads the stacked [YC ; AO] and [Wc ; Wa]");
        pg8::PairOrder S; S.S.init(M, D, G, bx);
        pg8::Gemm g{YC, WC, 2 * M, 2 * D, D}; pg8::EpiGate2 E{Gt, MG};
        pg8::gemm_phase<pg8::EpiGate2, pg8::PairOrder, true, true>(ldsp, g, S, E);
    }
    { pg8::StaticOrder S; S.init(M, D, G, bx); pg8::Unit u0; S.next(0, u0); if (grouped) GROUP_BAR(u0.pm); else GRID_BAR(); }

    if (PH_MASK & 16) {
        pg8::Gemm g{MG, WO, M, D, D}; pg8::StaticOrder S; S.init(M, D, G, bx);
        pg8::EpiRes1 E{x, a.out, X1B, SS};
        pg8::gemm_phase<pg8::EpiRes1, pg8::StaticOrder, true, true>(ldsp, g, S, E);
#ifdef DUP_P4
        pg8::gemm_phase<pg8::EpiRes1, pg8::StaticOrder, true, true>(ldsp, g, S, E);
#endif
    }
    { pg8::StaticOrder S; S.init(M, D, G, bx); pg8::Unit u0; S.next(0, u0); if (grouped) GROUP_BAR(u0.pm); else GRID_BAR(); }

    if (PH_MASK & 32) {
        pg8::Gemm g{X1B, WUP, M, FF, D}; pg8::StaticOrder S; S.init(M, FF, G, bx);
        pg8::EpiUp E{SS, UU, (size_t)M * D};
        pg8::gemm_phase<pg8::EpiUp, pg8::StaticOrder, true, true>(ldsp, g, S, E);
#ifdef DUP_P5
        pg8::gemm_phase<pg8::EpiUp, pg8::StaticOrder, true, true>(ldsp, g, S, E);
#endif
    }
    { pg8::StaticOrder S; S.init(M, D, G, bx); pg8::Unit u0; S.next(0, u0); if (grouped) GROUP_BAR(u0.pm); else GRID_BAR(); }

    for (int i = 0; i < EXTRA_SYNC; ++i) GRID_BAR();
    if (PH_MASK & 64) {
        pg8::Gemm g{UU, WDN, M, D, FF, D, 4, (size_t)M * D * 2}; pg8::StaticOrder S; S.init(M, D, G, bx);
        pg8::EpiRes2 E{a.out, X1B};
        pg8::gemm_phase<pg8::EpiRes2, pg8::StaticOrder, true, true>(ldsp, g, S, E);
    }
#if defined(MONO_BAR)
    if (wave == 0) { unsigned old_ = 0u; if (lane == 0) old_ = xb_add(&g_done_cnt, 1u);
        old_ = (unsigned)__builtin_amdgcn_readfirstlane((int)old_);
        if (old_ == (unsigned)G - 1u) { __hip_atomic_store(&g_panel_cnt[64 * lane], 0u, RLX_AGENT);
            if (lane < 16) __hip_atomic_store(&g_bar_shard[64 * lane], 0u, RLX_AGENT);
            if (lane == 0) { __hip_atomic_store(&g_bar_cnt, 0u, RLX_AGENT); __hip_atomic_store(&g_done_cnt, 0u, RLX_AGENT); } } }
#endif
}

extern "C" void kernel_launch(void* const* d_in, const int* in_sizes, int n_in, void* d_out, int out_size, void* d_ws, size_t ws_size, hipStream_t stream) {
    static int grid = 0;
    if (grid == 0) {
        if (n_in != 16 || out_size != M * D || ws_size < WS_END) { fprintf(stderr, "kernel_launch: unexpected shapes (n_in %d, out %d, ws %zu)\n", n_in, out_size, ws_size); grid = -1; return; }
        int dev = 0, cus = 0, per_cu = 0;
        (void)hipGetDevice(&dev); (void)hipDeviceGetAttribute(&cus, hipDeviceAttributeMultiprocessorCount, dev);
        if (hipFuncSetAttribute((const void*)fwd, hipFuncAttributeMaxDynamicSharedMemorySize, LDS_BYTES) != hipSuccess) { fprintf(stderr, "kernel_launch: hipFuncSetAttribute failed\n"); grid = -1; return; }
        if (hipOccupancyMaxActiveBlocksPerMultiprocessor(&per_cu, (const void*)fwd, NWAVES * 64, LDS_BYTES) != hipSuccess || per_cu < 1) { fprintf(stderr, "kernel_launch: occupancy query says %d\n", per_cu); per_cu = 1; }
        (void)hipGetLastError();
        grid = cus * 1;
    }
    if (grid < 0) return;
#if !defined(GEN_BAR) && !defined(MONO_BAR)
    if (hipMemsetAsync((char*)d_ws + WS_CTL, 0, CTL_ZERO_BYTES, stream) != hipSuccess) { fprintf(stderr, "kernel_launch: memset of the barrier words failed\n"); return; }
#endif
    Args a{};
    for (int i = 0; i < 16; ++i) a.in[i] = (const float*)d_in[i];
    a.out = (float*)d_out; a.ws = (unsigned char*)d_ws;
    void* args[] = {&a};
    hipError_t e = hipLaunchCooperativeKernel((const void*)fwd, dim3(grid), dim3(NWAVES * 64), args, LDS_BYTES, stream);
    if (e != hipSuccess) fprintf(stderr, "kernel_launch: cooperative launch failed: %s (grid %d)\n", hipGetErrorString(e), grid);
}
```

```cpp
#include <hip/hip_runtime.h>
#include <cstdio>
#include <cstdint>
#define MONO_BAR 1
namespace pg8 {
#define PG8_LAS __attribute__((address_space(3)))
typedef unsigned short bf16_t;
typedef short bf16x8 __attribute__((ext_vector_type(8)));
typedef float f32x4 __attribute__((ext_vector_type(4)));
typedef unsigned u32x4 __attribute__((ext_vector_type(4)));
constexpr int BM = 256, BK = 64, HALF = 128, HTB = HALF * BK * 2  , STAGE_BYTES = 8 * HTB, NXCD = 8, WGM = 8;

__host__ __device__ __forceinline__ int lds_byte(int r, int c) { const int st = (r >> 4) * 2 + (c >> 5), rr = r & 15, cc = c & 31, ob = rr * 64 + cc * 2; return st * 1024 + (ob ^ (((ob >> 9) & 1) << 5)); }
__host__ __device__ __forceinline__ void stage_rc(int b, int& R, int& C) { const int st = b / 1024, sb = b % 1024, swz = sb ^ (((sb >> 9) & 1) << 5); R = (st >> 1) * 16 + swz / 64; C = (st & 1) * 32 + (swz % 64) / 2; }
__host__ __device__ __forceinline__ int perm32(int rho) { const int n = rho >> 4, i = rho & 15; return 8 * (i >> 2) + 4 * n + (i & 3); }

struct Unit { int pm, pn; };
struct Gemm { const bf16_t* A; const bf16_t* Bt; int M, N, K; int lda; int segsh; size_t segstride; };

struct StaticOrder {
    int nM, nN, nwg, G, c;
    __host__ __device__ void init(int M, int N, int G_, int c_) { nM = M / BM; nN = N / BM; nwg = nM * nN; G = G_; c = c_; }
    __host__ __device__ bool next(int i, Unit& u) const {
        const long L = (long)i * G + c; if (L >= nwg) return false;
        int wgid = (int)L; { const int q = nwg / NXCD, r = nwg % NXCD, xcd = wgid % NXCD, off = wgid / NXCD; wgid = (xcd < r ? xcd * (q + 1) : r * (q + 1) + (xcd - r) * q) + off; }
        const int nig = WGM * nN, gid = wgid / nig, fm = gid * WGM, gsz = (nM - fm) < WGM ? (nM - fm) : WGM;
        u.pm = fm + ((wgid % nig) % gsz); u.pn = (wgid % nig) / gsz; return true;
    }
    __device__ __forceinline__ void a_ready(const Unit&) const {}
    __device__ __forceinline__ void done(const Unit&) const {}
};

__device__ __forceinline__ unsigned cvt_pk_bf16(float lo, float hi) { unsigned r; asm volatile("v_cvt_pk_bf16_f32 %0, %1, %2" : "=v"(r) : "v"(lo), "v"(hi)); return r; }
typedef float f32x2 __attribute__((ext_vector_type(2)));
#ifndef WT_STORES
#define WT_STORES 1
#endif
__device__ __forceinline__ void st16(void* p, u32x4 v) {
#if WT_STORES
    asm volatile("global_store_dwordx4 %0, %1, off sc1\n\ts_nop 1" :: "v"(p), "v"(v) : "memory");
#else
    *(u32x4*)p = v;
#endif
}
typedef unsigned u32x2w __attribute__((ext_vector_type(2)));
__device__ __forceinline__ void st8(void* p, u32x2w v) {
#if WT_STORES
    asm volatile("global_store_dwordx2 %0, %1, off sc1\n\ts_nop 1" :: "v"(p), "v"(v) : "memory");
#else
    *(u32x2w*)p = v;
#endif
}
typedef unsigned u32x2 __attribute__((ext_vector_type(2)));
__device__ __forceinline__ float bf_lo(unsigned w) { return __uint_as_float(w << 16); }
__device__ __forceinline__ float bf_hi(unsigned w) { return __uint_as_float(w & 0xffff0000u); }
__device__ __forceinline__ u32x4 pack8(f32x4 a, f32x4 b) { u32x4 w; w.x = cvt_pk_bf16(a[0], a[1]); w.y = cvt_pk_bf16(a[2], a[3]); w.z = cvt_pk_bf16(b[0], b[1]); w.w = cvt_pk_bf16(b[2], b[3]); return w; }
__device__ __forceinline__ void unpack8(u32x4 w, f32x4& a, f32x4& b) { a = (f32x4){bf_lo(w.x), bf_hi(w.x), bf_lo(w.y), bf_hi(w.y)}; b = (f32x4){bf_lo(w.z), bf_hi(w.z), bf_lo(w.w), bf_hi(w.w)}; }
constexpr float QK_C2 = 0.125f * 1.4426950408889634f;
constexpr float RMS_EPS = 1e-6f;

struct EpiP1 {
    static constexpr bool PERM = true, AFTER_DRAIN = false, CHAIN = false;
    bf16_t *Q, *Kb, *V, *BG, *U1, *G; const float *gq, *gk, *bgate;
    __device__ __forceinline__ void operator()(const f32x4 (&acc)[2][2][4][2], const Unit& u, int wr, int wc, int fr, int fq) const {
        const int pn = u.pn; const int row0 = u.pm * BM + wr * 64 + fr;
        if (pn < 8) {
            const bool isq = pn < 4; const float* g = isq ? gq : gk; bf16_t* O = isq ? Q : Kb; const float sc = isq ? QK_C2 : 1.f;
            const int head = 4 * (pn & 3) + wc;
            f32x4 gv[2][2];
#pragma unroll
            for (int bj = 0; bj < 2; ++bj)
#pragma unroll
                for (int n = 0; n < 2; ++n) gv[bj][n] = *(const f32x4*)(g + 32 * bj + 8 * fq + 4 * n) * sc;
#pragma unroll
            for (int ai = 0; ai < 2; ++ai)
#pragma unroll
                for (int m = 0; m < 4; ++m) {
                    float s = 0.f;
#pragma unroll
                    for (int bj = 0; bj < 2; ++bj)
#pragma unroll
                        for (int n = 0; n < 2; ++n) { const f32x4 x = acc[ai][bj][m][n]; s += (x[0] * x[0] + x[1] * x[1]) + (x[2] * x[2] + x[3] * x[3]); }
                    s += __shfl_xor(s, 16); s += __shfl_xor(s, 32);
                    const float rs = 1.0f / sqrtf(s * (1.0f / 64.0f) + RMS_EPS);
                    bf16_t* rowp = O + (size_t)(row0 + ai * HALF + m * 16) * 1024 + head * 64 + 8 * fq;
#pragma unroll
                    for (int bj = 0; bj < 2; ++bj) st16(rowp + 32 * bj, pack8(acc[ai][bj][m][0] * rs * gv[bj][0], acc[ai][bj][m][1] * rs * gv[bj][1]));
                }
        } else if (pn < 16) {
            bf16_t* O = (pn < 12) ? V : BG; const int col0 = 256 * (pn & 3) + wc * 32 + 8 * fq;
#pragma unroll
            for (int ai = 0; ai < 2; ++ai)
#pragma unroll
                for (int m = 0; m < 4; ++m) { bf16_t* rowp = O + (size_t)(row0 + ai * HALF + m * 16) * 1024 + col0;
#pragma unroll
                    for (int bj = 0; bj < 2; ++bj) st16(rowp + bj * HALF, pack8(acc[ai][bj][m][0], acc[ai][bj][m][1])); }
        } else if (pn < 24) {
            const int col0 = 128 * (pn - 16) + wc * 32 + 8 * fq;
#pragma unroll
            for (int ai = 0; ai < 2; ++ai)
#pragma unroll
                for (int m = 0; m < 4; ++m)
                    st16(U1 + (size_t)(row0 + ai * HALF + m * 16) * 1024 + col0, pack8(acc[ai][0][m][0] * acc[ai][1][m][0], acc[ai][0][m][1] * acc[ai][1][m][1]));
        } else {
            const int col0 = 256 * (pn - 24) + wc * 32 + 8 * fq;
            f32x4 bv[2][2];
#pragma unroll
            for (int bj = 0; bj < 2; ++bj)
#pragma unroll
                for (int n = 0; n < 2; ++n) bv[bj][n] = *(const f32x4*)(bgate + col0 + bj * HALF + 4 * n);
#pragma unroll
            for (int ai = 0; ai < 2; ++ai)
#pragma unroll
                for (int m = 0; m < 4; ++m) { bf16_t* rowp = G + (size_t)(row0 + ai * HALF + m * 16) * 2048 + col0;
#pragma unroll
                    for (int bj = 0; bj < 2; ++bj) { f32x4 v[2];
#pragma unroll
                        for (int n = 0; n < 2; ++n) { const f32x4 z = (acc[ai][bj][m][n] + bv[bj][n]) * (-1.4426950408889634f);
#pragma unroll
                            for (int e = 0; e < 4; ++e) v[n][e] = __builtin_amdgcn_rcpf(1.0f + __builtin_amdgcn_exp2f(z[e])); }
                        st16(rowp + bj * HALF, pack8(v[0], v[1])); } }
        }
    }
};
template <bool ADD> struct EpiGate {
    static constexpr bool PERM = true, AFTER_DRAIN = false, CHAIN = false;
    const bf16_t* G; bf16_t* MG; int goff;
    __device__ __forceinline__ void operator()(const f32x4 (&acc)[2][2][4][2], const Unit& u, int wr, int wc, int fr, int fq) const {
        const int row0 = u.pm * BM + wr * 64 + fr, col0 = u.pn * BM + wc * 32 + 8 * fq;
#pragma unroll
        for (int ai = 0; ai < 2; ++ai)
#pragma unroll
            for (int m = 0; m < 4; ++m) { const size_t r = (size_t)(row0 + ai * HALF + m * 16);
#pragma unroll
                for (int bj = 0; bj < 2; ++bj) { f32x4 g0, g1; unpack8(*(const u32x4*)(G + r * 2048 + goff + col0 + bj * HALF), g0, g1);
                    f32x4 v0 = acc[ai][bj][m][0] * g0, v1 = acc[ai][bj][m][1] * g1;
                    bf16_t* p = MG + r * 1024 + col0 + bj * HALF;
                    if (ADD) { f32x4 a0, a1; unpack8(*(const u32x4*)p, a0, a1); v0 += a0; v1 += a1; }
                    *(u32x4*)p = pack8(v0, v1); } }
    }
};
struct PairOrder {
    StaticOrder S;
    __device__ bool next(int i, Unit& u) const { Unit b; if (!S.next(i >> 1, b)) return false; u.pm = b.pm + ((i & 1) ? 64 : 0); u.pn = b.pn + ((i & 1) ? 4 : 0); return true; }
    __device__ __forceinline__ void a_ready(const Unit&) const {}
    __device__ __forceinline__ void done(const Unit&) const {}
};
struct EpiGate2 {
    static constexpr bool PERM = true, AFTER_DRAIN = false, CHAIN = true;
    const bf16_t* G; bf16_t* MG;
    __device__ __forceinline__ bool chain(f32x4 (&acc)[2][2][4][2], const Unit& u, int wr, int wc, int fr, int fq) const {
        const bool second = u.pm >= 64; const int pm = second ? u.pm - 64 : u.pm, pn = second ? u.pn - 4 : u.pn;
        const int row0 = pm * BM + wr * 64 + fr, col0 = pn * BM + wc * 32 + 8 * fq;
        const float dmin = 8.6736174e-19f;
#pragma unroll
        for (int ai = 0; ai < 2; ++ai) {
            u32x4 ga[4][2], gc[4][2];
#pragma unroll
            for (int m = 0; m < 4; ++m) { const size_t r = (size_t)(row0 + ai * HALF + m * 16);
#pragma unroll
                for (int bj = 0; bj < 2; ++bj) { ga[m][bj] = *(const u32x4*)(G + r * 2048 + col0 + bj * HALF); if (!second) gc[m][bj] = *(const u32x4*)(G + r * 2048 + 1024 + col0 + bj * HALF); } }
#pragma unroll
            for (int m = 0; m < 4; ++m) { const size_t r = (size_t)(row0 + ai * HALF + m * 16);
#pragma unroll
                for (int bj = 0; bj < 2; ++bj) { f32x4 a0, a1; unpack8(ga[m][bj], a0, a1);
#pragma unroll
                    for (int e = 0; e < 4; ++e) { a0[e] = fmaxf(a0[e], dmin); a1[e] = fmaxf(a1[e], dmin); }
                    if (!second) { f32x4 c0, c1; unpack8(gc[m][bj], c0, c1);
#pragma unroll
                        for (int e = 0; e < 4; ++e) { acc[ai][bj][m][0][e] *= c0[e] * __builtin_amdgcn_rcpf(a0[e]); acc[ai][bj][m][1][e] *= c1[e] * __builtin_amdgcn_rcpf(a1[e]); } }
                    else st16(MG + r * 1024 + col0 + bj * HALF, pack8(acc[ai][bj][m][0] * a0, acc[ai][bj][m][1] * a1)); } }
        }
        return !second;
    }
    __device__ __forceinline__ void operator()(const f32x4 (&)[2][2][4][2], const Unit&, int, int, int, int) const {}
};
#ifndef STORE_X1_F32
#define STORE_X1_F32 0
#endif
struct EpiRes1 {
    static constexpr bool PERM = true, AFTER_DRAIN = false, CHAIN = false;
    const float* x; float* out; bf16_t* x1b; float* SS;
    __device__ __forceinline__ void operator()(const f32x4 (&acc)[2][2][4][2], const Unit& u, int wr, int wc, int fr, int fq) const {
        const int row0 = u.pm * BM + wr * 64 + fr, col0 = u.pn * BM + wc * 32 + 8 * fq;
#pragma unroll
        for (int ai = 0; ai < 2; ++ai) {
            f32x4 xv[4][2][2];
#pragma unroll
            for (int m = 0; m < 4; ++m) { const size_t off = (size_t)(row0 + ai * HALF + m * 16) * 1024 + col0;
#pragma unroll
                for (int bj = 0; bj < 2; ++bj)
#pragma unroll
                    for (int n = 0; n < 2; ++n) xv[m][bj][n] = *(const f32x4*)(x + off + bj * HALF + n * 4); }
#pragma unroll
            for (int m = 0; m < 4; ++m) { const size_t r = (size_t)(row0 + ai * HALF + m * 16); const size_t off = r * 1024 + col0; float s = 0.f;
#pragma unroll
                for (int bj = 0; bj < 2; ++bj) { const f32x4 v0 = xv[m][bj][0] + acc[ai][bj][m][0], v1 = xv[m][bj][1] + acc[ai][bj][m][1];
                    if (STORE_X1_F32) { *(f32x4*)(out + off + bj * HALF) = v0; *(f32x4*)(out + off + bj * HALF + 4) = v1; }
                    s += ((v0[0] * v0[0] + v0[1] * v0[1]) + (v0[2] * v0[2] + v0[3] * v0[3])) + ((v1[0] * v1[0] + v1[1] * v1[1]) + (v1[2] * v1[2] + v1[3] * v1[3]));
                    st16(x1b + off + bj * HALF, pack8(v0, v1)); }
                s += __shfl_xor(s, 16); s += __shfl_xor(s, 32);
                if (fq == 0) __hip_atomic_store(SS + r * 16 + 4 * u.pn + wc, s, __ATOMIC_RELAXED, __HIP_MEMORY_SCOPE_AGENT); }
            asm volatile("" ::: "memory");
        }
    }
};
struct EpiUp {
    static constexpr bool PERM = true, AFTER_DRAIN = false, CHAIN = false;
    const float* SS; bf16_t* UU; size_t piece;
    __device__ __forceinline__ void operator()(const f32x4 (&acc)[2][2][4][2], const Unit& u, int wr, int wc, int fr, int fq) const {
        const int row0 = u.pm * BM + wr * 64 + fr;
        bf16_t* UUp = UU + (size_t)(u.pn >> 2) * piece + (u.pn & 3) * BM + wc * 32 + 8 * fq;
#pragma unroll
        for (int ai = 0; ai < 2; ++ai)
#pragma unroll
            for (int m = 0; m < 4; ++m) { const size_t r = (size_t)(row0 + ai * HALF + m * 16);
                const f32x4* sp = (const f32x4*)(SS + r * 16); const f32x4 s4 = (sp[0] + sp[1]) + (sp[2] + sp[3]);
                const float rs = 1.0f / sqrtf(((s4[0] + s4[1]) + (s4[2] + s4[3])) * (1.0f / 1024.0f) + RMS_EPS);
#pragma unroll
                for (int bj = 0; bj < 2; ++bj) { f32x4 v[2];
#pragma unroll
                    for (int n = 0; n < 2; ++n) { const f32x4 z = acc[ai][bj][m][n] * rs;
#pragma unroll
                        for (int e = 0; e < 4; ++e) { const float t = fmaxf(z[e], 0.f); v[n][e] = t * t; } }
                    st16(UUp + r * 1024 + bj * HALF, pack8(v[0], v[1])); } }
    }
};
struct EpiRes2 {
    static constexpr bool PERM = true, AFTER_DRAIN = false, CHAIN = false;
    float* out; const bf16_t* x1b;
    __device__ __forceinline__ void operator()(const f32x4 (&acc)[2][2][4][2], const Unit& u, int wr, int wc, int fr, int fq) const {
        const int row0 = u.pm * BM + wr * 64 + fr, col0 = u.pn * BM + wc * 32 + 8 * fq;
#pragma unroll
        for (int ai = 0; ai < 2; ++ai) {
            u32x4 bw[4][2];
#pragma unroll
            for (int m = 0; m < 4; ++m) { const size_t off = (size_t)(row0 + ai * HALF + m * 16) * 1024 + col0;
#pragma unroll
                for (int bj = 0; bj < 2; ++bj) bw[m][bj] = *(const u32x4*)(x1b + off + bj * HALF); }
#pragma unroll
            for (int m = 0; m < 4; ++m) { const size_t off = (size_t)(row0 + ai * HALF + m * 16) * 1024 + col0;
#pragma unroll
                for (int bj = 0; bj < 2; ++bj) { f32x4 b0, b1; unpack8(bw[m][bj], b0, b1); float* p = out + off + bj * HALF;
                    *(f32x4*)p = b0 + acc[ai][bj][m][0]; *(f32x4*)(p + 4) = b1 + acc[ai][bj][m][1]; } }
            asm volatile("" ::: "memory");
        }
    }
};

template <class Epi, class Sched, bool ALIGN_EPI = false, bool SP2 = false>
__device__ __forceinline__ void gemm_phase(PG8_LAS unsigned char* lds, const Gemm g, const Sched& S, const Epi& E) {
    int tid_ = threadIdx.x; asm volatile("" : "+v"(tid_));
    const int tid = tid_, wid = __builtin_amdgcn_readfirstlane(tid >> 6), lane = tid & 63, wr = wid >> 2, wc = wid & 3, fr = lane & 15, fq = lane >> 4;
    const int K = g.K, nt = K / BK;
    const int lda = g.lda ? g.lda : K, segsh = g.segsh ? g.segsh : 30;
    unsigned voffA[2], voffB[2];
#pragma unroll
    for (int i = 0; i < 2; ++i) { int R, C; stage_rc(tid * 16 + i * 8192, R, C); const int Rb = Epi::PERM ? ((R & ~31) + perm32(R & 31)) : R;
        voffA[i] = (unsigned)(R * lda + C) * 2u; voffB[i] = (unsigned)(Rb * K + C) * 2u; }
    const size_t kstep = (size_t)(BK * 2);
    const size_t hstep = (size_t)HALF * K * 2;
    const size_t tstep = 2 * hstep;
    const size_t hstepA = (size_t)HALF * lda * 2, tstepA = 2 * hstepA;
#define PG8_AOFF(t_) ((size_t)((t_) >> segsh) * g.segstride + (size_t)((t_) & ((1 << segsh) - 1)) * kstep)
    const unsigned ldsw = (unsigned)wid * 1024u;
    const int aoff = lds_byte(wr * 64 + fr, fq * 8), boff = lds_byte(wc * 32 + fr, fq * 8);
#define PG8_SA(b, h) (((b) * 2 + (h)) * HTB)
#define PG8_SB(b, h) ((4 + (b) * 2 + (h)) * HTB)
#define PG8_STAGE(bufoff, gbase, voff) do { _Pragma("unroll") for (int _i = 0; _i < 2; ++_i) \
        __builtin_amdgcn_global_load_lds((const unsigned*)((const char*)(gbase) + (voff)[_i]), (PG8_LAS unsigned*)(lds + (bufoff) + ldsw + _i * 8192), 16, 0, 0); } while (0)
#define PG8_LDA(dst, b, h) do { _Pragma("unroll") for (int m = 0; m < 4; ++m) _Pragma("unroll") for (int k = 0; k < 2; ++k) dst[m][k] = *(const PG8_LAS bf16x8*)(lds + PG8_SA(b, h) + aoff + m * 2048 + k * 1024); } while (0)
#define PG8_LDB(dst, b, h) do { _Pragma("unroll") for (int n = 0; n < 2; ++n) _Pragma("unroll") for (int k = 0; k < 2; ++k) dst[n][k] = *(const PG8_LAS bf16x8*)(lds + PG8_SB(b, h) + boff + n * 2048 + k * 1024); } while (0)
#define PG8_MMA(ai, bj, At, Bt) do { __builtin_amdgcn_s_setprio(1); _Pragma("unroll") for (int m = 0; m < 4; ++m) _Pragma("unroll") for (int n = 0; n < 2; ++n) _Pragma("unroll") for (int k = 0; k < 2; ++k) \
        acc[ai][bj][m][n] = __builtin_amdgcn_mfma_f32_16x16x32_bf16(Bt[n][k], At[m][k], acc[ai][bj][m][n], 0, 0, 0); __builtin_amdgcn_s_setprio(0); } while (0)
#define PG8_WAIT_V(n) asm volatile("s_waitcnt vmcnt(" #n ")" ::: "memory")
#define PG8_WAIT_L(n) asm volatile("s_waitcnt lgkmcnt(" #n ")" ::: "memory")
#define PG8_BAR __builtin_amdgcn_s_barrier()
#define PG8_SCHED __builtin_amdgcn_sched_barrier(0)
    Unit cur, nxt; int ui = 0;
    if (!S.next(0, cur)) return;
    f32x4 acc[2][2][4][2];
#pragma unroll
    for (int a = 0; a < 2; ++a)
#pragma unroll
        for (int b = 0; b < 2; ++b)
#pragma unroll
            for (int m = 0; m < 4; ++m)
#pragma unroll
                for (int n = 0; n < 2; ++n) acc[a][b][m][n] = (f32x4){0.f, 0.f, 0.f, 0.f};
    bf16x8 At[4][2], B0[2][2], B1[2][2];
    const char* cA = (const char*)g.A + (size_t)cur.pm * tstepA; const char* cB = (const char*)g.Bt + (size_t)cur.pn * tstep;
    S.a_ready(cur);
    if constexpr (SP2) {
        PG8_STAGE(PG8_SB(0, 0), cB, voffB); PG8_STAGE(PG8_SB(0, 1), cB + hstep, voffB); PG8_STAGE(PG8_SA(0, 0), cA, voffA); PG8_STAGE(PG8_SA(0, 1), cA + hstepA, voffA);
        if (wr == 1) PG8_BAR;
        PG8_WAIT_V(2); PG8_BAR;
        PG8_STAGE(PG8_SB(1, 0), cB + kstep, voffB); PG8_STAGE(PG8_SA(1, 0), cA + kstep, voffA); PG8_STAGE(PG8_SB(1, 1), cB + hstep + kstep, voffB);
        PG8_WAIT_V(6); PG8_BAR;
    } else {
        PG8_STAGE(PG8_SB(0, 0), cB, voffB); PG8_STAGE(PG8_SA(0, 0), cA, voffA); PG8_STAGE(PG8_SB(0, 1), cB + hstep, voffB); PG8_STAGE(PG8_SA(0, 1), cA + hstepA, voffA);
        if (wr == 1) PG8_BAR;
        PG8_WAIT_V(4); PG8_BAR;
        PG8_STAGE(PG8_SB(1, 0), cB + kstep, voffB); PG8_STAGE(PG8_SA(1, 0), cA + kstep, voffA); PG8_STAGE(PG8_SB(1, 1), cB + hstep + kstep, voffB);
        PG8_WAIT_V(6); PG8_BAR;
    }
    for (;;) {
        const bool has_next = S.next(ui + 1, nxt);
        const char* nA = has_next ? (const char*)g.A + (size_t)nxt.pm * tstepA : cA; const char* nB = has_next ? (const char*)g.Bt + (size_t)nxt.pn * tstep : cB;
        for (int t = 0; t < nt; t += 2) {
            const bool last = (t == nt - 2);
            const char* a1 = cA + PG8_AOFF(t) + kstep;
            const char* a2 = last ? nA : cA + PG8_AOFF(t + 2); const char* b2 = last ? nB : cB + (size_t)(t + 2) * kstep;
            const char* a3 = a2 + kstep; const char* b3 = b2 + kstep;
            if (last && has_next) S.a_ready(nxt);
            if constexpr (SP2) {
            PG8_LDB(B0, 0, 0); PG8_LDB(B1, 0, 1); PG8_SCHED; PG8_LDA(At, 0, 0); PG8_STAGE(PG8_SA(1, 1), a1 + hstepA, voffA);
            PG8_WAIT_V(8); PG8_WAIT_L(0); PG8_BAR; PG8_MMA(0, 0, At, B0); PG8_MMA(0, 1, At, B1); PG8_BAR; PG8_SCHED;
            PG8_LDA(At, 0, 1); PG8_STAGE(PG8_SB(0, 0), b2, voffB); PG8_STAGE(PG8_SB(0, 1), b2 + hstep, voffB); PG8_STAGE(PG8_SA(0, 0), a2, voffA);
            PG8_WAIT_V(8); PG8_WAIT_L(0); PG8_BAR; PG8_MMA(1, 0, At, B0); PG8_MMA(1, 1, At, B1); PG8_BAR; PG8_SCHED;
            PG8_LDB(B0, 1, 0); PG8_LDB(B1, 1, 1); PG8_SCHED; PG8_LDA(At, 1, 0); PG8_STAGE(PG8_SA(0, 1), a2 + hstepA, voffA);
            PG8_WAIT_V(8); PG8_WAIT_L(0); PG8_BAR; PG8_MMA(0, 0, At, B0); PG8_MMA(0, 1, At, B1); PG8_BAR; PG8_SCHED;
            PG8_LDA(At, 1, 1); PG8_STAGE(PG8_SB(1, 0), b3, voffB); PG8_STAGE(PG8_SB(1, 1), b3 + hstep, voffB); PG8_STAGE(PG8_SA(1, 0), a3, voffA);
            PG8_WAIT_V(8); PG8_WAIT_L(0); PG8_BAR; PG8_MMA(1, 0, At, B0); PG8_MMA(1, 1, At, B1); PG8_BAR; PG8_SCHED;
            } else {
            PG8_LDB(B0, 0, 0); PG8_SCHED; PG8_LDA(At, 0, 0); PG8_STAGE(PG8_SA(1, 1), a1 + hstepA, voffA);
            PG8_WAIT_L(8); PG8_BAR; PG8_WAIT_L(0); PG8_MMA(0, 0, At, B0); PG8_BAR; PG8_SCHED;
            PG8_LDB(B1, 0, 1); PG8_STAGE(PG8_SB(0, 0), b2, voffB);
            PG8_BAR; PG8_WAIT_L(0); PG8_MMA(0, 1, At, B1); PG8_BAR;
            PG8_LDA(At, 0, 1); PG8_STAGE(PG8_SA(0, 0), a2, voffA);
            PG8_BAR; PG8_WAIT_L(0); PG8_MMA(1, 0, At, B0); PG8_BAR; PG8_SCHED;
            PG8_STAGE(PG8_SB(0, 1), b2 + hstep, voffB);
            PG8_WAIT_V(6); PG8_BAR; PG8_MMA(1, 1, At, B1); PG8_BAR;
            PG8_LDB(B0, 1, 0); PG8_SCHED; PG8_LDA(At, 1, 0); PG8_STAGE(PG8_SA(0, 1), a2 + hstepA, voffA);
            PG8_WAIT_L(8); PG8_BAR; PG8_WAIT_L(0); PG8_MMA(0, 0, At, B0); PG8_BAR; PG8_SCHED;
            PG8_LDB(B1, 1, 1); PG8_STAGE(PG8_SB(1, 0), b3, voffB);
            PG8_BAR; PG8_WAIT_L(0); PG8_MMA(0, 1, At, B1); PG8_BAR;
            PG8_LDA(At, 1, 1); PG8_STAGE(PG8_SA(1, 0), a3, voffA);
            PG8_BAR; PG8_WAIT_L(0); PG8_MMA(1, 0, At, B0); PG8_BAR; PG8_SCHED;
            PG8_STAGE(PG8_SB(1, 1), b3 + hstep, voffB);
            PG8_WAIT_V(6); PG8_BAR; PG8_MMA(1, 1, At, B1); PG8_BAR;
            }
        }
        if constexpr (ALIGN_EPI) { if (wr == 0) PG8_BAR; }
        bool keep_acc = false;
        if constexpr (Epi::CHAIN) { keep_acc = E.chain(acc, cur, wr, wc, fr, fq); S.done(cur); }
        else if constexpr (!Epi::AFTER_DRAIN) { E(acc, cur, wr, wc, fr, fq); S.done(cur); }
        if (!has_next) break;
        if (!keep_acc) {
#pragma unroll
        for (int a = 0; a < 2; ++a)
#pragma unroll
            for (int b = 0; b < 2; ++b)
#pragma unroll
                for (int m = 0; m < 4; ++m)
#pragma unroll
                    for (int n = 0; n < 2; ++n) acc[a][b][m][n] = (f32x4){0.f, 0.f, 0.f, 0.f};
        }
        cur = nxt; cA = nA; cB = nB; ++ui;
        if constexpr (ALIGN_EPI) { if (wr == 1) PG8_BAR; }
    }
    PG8_WAIT_V(0);
    if constexpr (!ALIGN_EPI) { if (wr == 0) PG8_BAR; }
    PG8_BAR;
    if constexpr (Epi::AFTER_DRAIN) { E.fused(acc, cur, wr, wc, fr, fq, lds, wid, lane); S.done(cur); }
#undef PG8_AOFF
#undef PG8_SA
#undef PG8_SB
#undef PG8_STAGE
#undef PG8_LDA
#undef PG8_LDB
#undef PG8_MMA
#undef PG8_WAIT_V
#undef PG8_WAIT_L
#undef PG8_BAR
#undef PG8_SCHED
}
}

namespace attn {
using bf16 = unsigned short;
using bf16x8 = __attribute__((ext_vector_type(8))) short;
using s16x4 = __attribute__((ext_vector_type(4))) short;
using f32x16 = __attribute__((ext_vector_type(16))) float;
using u32x4 = __attribute__((ext_vector_type(4))) unsigned;
using f32x4 = __attribute__((ext_vector_type(4))) float;
constexpr int SEQ = 4096, DM = 1024, NSLOT = 6, SLOTB = 8192, NREL = 513;
constexpr int LDS_K = 0, LDS_V = NSLOT * SLOTB, LDS_WS = 2 * NSLOT * SLOTB, LDS_OST = LDS_WS + 8 * 64 * 4, LDS_BIAS = LDS_OST + 8 * 4096, BIAS_CS = 400  , LDS_BYTES = LDS_BIAS + 4 * BIAS_CS * 4;
constexpr float LOG2E = 1.4426950408889634f;
__device__ __forceinline__ int crow(int r, int hi) { return (r & 3) + 8 * (r >> 2) + 4 * hi; }
#define SBAR() __builtin_amdgcn_sched_barrier(0)
__device__ __forceinline__ void glds16(const void* gsrc, unsigned lds_dst) { unsigned keep;
  asm volatile("s_mov_b32 %0, m0\n\ts_mov_b32 m0, %2\n\ts_nop 0\n\tglobal_load_lds_dwordx4 %1, off\n\ts_mov_b32 m0, %0" : "=&s"(keep) : "v"(gsrc), "s"(lds_dst) : "memory"); }
typedef float f32x2_t __attribute__((ext_vector_type(2))); typedef __bf16 bf16x2_t __attribute__((ext_vector_type(2)));
__device__ __forceinline__ unsigned cvtpk_s(float lo, float hi) { f32x2_t v = {lo, hi}; bf16x2_t b = __builtin_convertvector(v, bf16x2_t); return __builtin_bit_cast(unsigned, b); }
typedef __attribute__((address_space(3))) const char* lds_cptr;
__device__ __forceinline__ void kload8(bf16x8* kf, lds_cptr kp) {
  kf[0] = *(const __attribute__((address_space(3))) bf16x8*)(kp);        kf[1] = *(const __attribute__((address_space(3))) bf16x8*)(kp + 512);
  kf[2] = *(const __attribute__((address_space(3))) bf16x8*)(kp + 2048); kf[3] = *(const __attribute__((address_space(3))) bf16x8*)(kp + 2560);
  kf[4] = *(const __attribute__((address_space(3))) bf16x8*)(kp + 4096); kf[5] = *(const __attribute__((address_space(3))) bf16x8*)(kp + 4608);
  kf[6] = *(const __attribute__((address_space(3))) bf16x8*)(kp + 6144); kf[7] = *(const __attribute__((address_space(3))) bf16x8*)(kp + 6656);
}
__device__ __forceinline__ void pv(f32x16* o, int vb, bf16x8 pa0, bf16x8 pa1, bf16x8 pa2, bf16x8 pa3) {
  #pragma unroll
  for (int d0 = 0; d0 < 2; ++d0) { s16x4 lo[4], hi[4];
    #pragma unroll
    for (int ks = 0; ks < 4; ++ks) {
      asm volatile("ds_read_b64_tr_b16 %0,%1 offset:%c2" : "=&v"(lo[ks]) : "v"(vb), "i"(d0 * 4096 + ks * 1024) : "memory");
      asm volatile("ds_read_b64_tr_b16 %0,%1 offset:%c2" : "=&v"(hi[ks]) : "v"(vb), "i"(d0 * 4096 + ks * 1024 + 512) : "memory"); }
    asm volatile("s_waitcnt lgkmcnt(0)" ::: "memory"); SBAR();
    #define PK(k) (bf16x8){lo[k][0], lo[k][1], lo[k][2], lo[k][3], hi[k][0], hi[k][1], hi[k][2], hi[k][3]}
    o[d0] = __builtin_amdgcn_mfma_f32_32x32x16_bf16(pa0, PK(0), o[d0], 0, 0, 0);
    o[d0] = __builtin_amdgcn_mfma_f32_32x32x16_bf16(pa1, PK(1), o[d0], 0, 0, 0);
    o[d0] = __builtin_amdgcn_mfma_f32_32x32x16_bf16(pa2, PK(2), o[d0], 0, 0, 0);
    o[d0] = __builtin_amdgcn_mfma_f32_32x32x16_bf16(pa3, PK(3), o[d0], 0, 0, 0);
    #undef PK
  }
}
__device__ __forceinline__ float wmax(float v) {
#pragma unroll
  for (int o = 1; o < 64; o <<= 1) v = fmaxf(v, __shfl_xor(v, o));
  return v;
}
__device__ __forceinline__ void attn_unit(int b, int h, int g, const bf16* Q, const bf16* __restrict__ K, const bf16* __restrict__ V, bf16* O,
                                          const float* __restrict__ relb, const float* __restrict__ gq, const float* __restrict__ gk, char* shm) {
  int tid_ = threadIdx.x; asm volatile("" : "+v"(tid_));
  const int tid = tid_, lane = tid & 63, r32 = lane & 31, hi = lane >> 5; const int wid = __builtin_amdgcn_readfirstlane(tid >> 6);
  const long rowbase = (long)b * SEQ; const int q0 = g * 256;
  const int kc_lo = (4 * g - 8) > 0 ? (4 * g - 8) : 0, NT = 4 * g + 4 - kc_lo;
  const bf16* Qw = Q + (rowbase + q0 + wid * 32) * DM + h * 64;
  const bf16* Kh = K + (rowbase + 64 * kc_lo) * DM + h * 64; const bf16* Vh = V + (rowbase + 64 * kc_lo) * DM + h * 64;
  const unsigned lds0 = (unsigned)(uintptr_t)shm;
  float* wsf = (float*)(shm + LDS_WS) + wid * 64;
  float* biasT = (float*)(shm + LDS_BIAS);
  const bf16* ksrc = Kh + (long)lane * DM + wid * 8;
  const bf16* vsrc = Vh + (long)(16 * (wid & 3) + (lane >> 2)) * DM + (wid >> 2) * 32 + (lane & 3) * 8;
  const unsigned kdst = lds0 + LDS_K + wid * 1024, vdst = lds0 + LDS_V + wid * 1024;
  #define DMA_K(t, slot) glds16(ksrc + (long)(t) * 64 * DM, (unsigned)__builtin_amdgcn_readfirstlane(kdst + (slot)))
  #define DMA_V(t, slot) glds16(vsrc + (long)(t) * 64 * DM, (unsigned)__builtin_amdgcn_readfirstlane(vdst + (slot)))
  const int vb0 = (int)(lds0 + LDS_V) + ((lane >> 4) & 1) * 32 + (lane & 3) * 8 + (4 * hi + ((lane & 15) >> 2)) * 64;
  const lds_cptr shm3 = (lds_cptr)shm; const lds_cptr kp0 = shm3 + LDS_K + hi * 1024 + r32 * 16;
  const bool full = (g >= 2); const int nsteps = full ? 9 : NT;
  #define LOAD_TILE(i) (full ? ((i) < 6 ? (((i) & 1) ? ((i) >> 1) + 9 : ((i) >> 1)) : (i) - 3) : (i))
  #define ISSUE_LOAD(i) do { const int i_ = (i); const int tl_ = LOAD_TILE(i_); const int sb_ = (i_ % NSLOT) * SLOTB; DMA_K(tl_, sb_); DMA_V(tl_, sb_); } while (0)
  bf16x8 qr[4];
  #pragma unroll
  for (int d0 = 0; d0 < 4; ++d0) qr[d0] = *reinterpret_cast<const bf16x8*>(&Qw[(long)r32 * DM + d0 * 16 + hi * 8]);
  const float gqv = gq[lane], gkv = gk[lane]; float rbv[9], tbv[3];
  #pragma unroll
  for (int k = 0; k < 9; ++k) { const int i = lane + 64 * k; rbv[k] = (i < NREL) ? relb[h * NREL + i] : -3.0e38f; }
  #pragma unroll
  for (int k = 0; k < 3; ++k) { const int i = tid + 512 * k, c = i / 384, jj = i - c * 384, e = jj + c; tbv[k] = (e < 384) ? relb[h * NREL + (e < 64 ? 512 : 576 - e)] : 0.f; }
  asm volatile("" ::: "memory");
  ISSUE_LOAD(0); ISSUE_LOAD(1); if (full) { ISSUE_LOAD(2); ISSUE_LOAD(3); }
  float m2;
  { const float mq = wmax(fabsf(gqv)), mk = wmax(fabsf(gkv)); float mb = -3.0e38f;
    #pragma unroll
    for (int k = 0; k < 9; ++k) mb = fmaxf(mb, rbv[k]);
    mb = wmax(mb); m2 = (8.0f * mq * mk + mb) * LOG2E; }
  #pragma unroll
  for (int k = 0; k < 3; ++k) { const int i = tid + 512 * k, c = i / 384, jj = i - c * 384; biasT[c * BIAS_CS + jj] = tbv[k] * LOG2E - m2; }
  f32x16 o[2]; o[0] = f32x16{}; o[1] = f32x16{}; f32x16 lsum = f32x16{};
  const int qpos = 32 * (wid & 1) + r32;
  const int cch = 4 * g + (wid >> 1);
  if (full) asm volatile("s_waitcnt vmcnt(4) lgkmcnt(0)\n\ts_barrier" ::: "memory");
  else      asm volatile("s_waitcnt vmcnt(2) lgkmcnt(0)\n\ts_barrier" ::: "memory");
  for (int s = 0; s < nsteps; ++s) {
    int nis = 0;
    if (s + 2 < nsteps) { const int s2 = s + 2; if (full) { if (s2 < 3) { ISSUE_LOAD(2 * s2); ISSUE_LOAD(2 * s2 + 1); nis = 2; } else { ISSUE_LOAD(s2 + 3); nis = 1; } } else { ISSUE_LOAD(s2); nis = 1; } }
    int jrel = kc_lo + s - cch + 8, ld = full ? (s < 3 ? 2 * s : s + 3) : s;
    if (full && s < 3 && jrel < 0) { jrel += 9; ld += 1; }
    const int sl_cur = (ld % NSLOT) * SLOTB;
    if (jrel >= 0 && jrel <= 8) {
      s16x4 vlo[8], vhi[8]; { const int vb = vb0 + sl_cur;
        #pragma unroll
        for (int i_ = 0; i_ < 8; ++i_) {
          asm volatile("ds_read_b64_tr_b16 %0,%1 offset:%c2" : "=&v"(vlo[i_]) : "v"(vb), "i"((i_ >> 2) * 4096 + (i_ & 3) * 1024) : "memory");
          asm volatile("ds_read_b64_tr_b16 %0,%1 offset:%c2" : "=&v"(vhi[i_]) : "v"(vb), "i"((i_ >> 2) * 4096 + (i_ & 3) * 1024 + 512) : "memory"); } }
      f32x16 p0, p1;
      if (jrel <= 3) { const float c0 = biasT[0];
        #pragma unroll
        for (int r = 0; r < 16; ++r) { p0[r] = c0; p1[r] = c0; } }
      else { const int i0 = 64 + 4 * hi - qpos + 64 * (jrel - 4), cs = i0 & 3; const f32x4* a4 = (const f32x4*)(biasT + cs * BIAS_CS + (i0 - cs));
        #pragma unroll
        for (int q4 = 0; q4 < 4; ++q4) { const f32x4 b0 = a4[2 * q4], b1 = a4[2 * q4 + 8];
          #pragma unroll
          for (int e = 0; e < 4; ++e) { p0[4 * q4 + e] = b0[e]; p1[4 * q4 + e] = b1[e]; } } }
      bf16x8 kf[8]; kload8(kf, kp0 + sl_cur);
      #pragma unroll
      for (int d0 = 0; d0 < 4; ++d0) { p0 = __builtin_amdgcn_mfma_f32_32x32x16_bf16(kf[2 * d0], qr[d0], p0, 0, 0, 0); p1 = __builtin_amdgcn_mfma_f32_32x32x16_bf16(kf[2 * d0 + 1], qr[d0], p1, 0, 0, 0); }
      #pragma unroll
      for (int r = 0; r < 16; ++r) { p0[r] = __builtin_amdgcn_exp2f(p0[r]); p1[r] = __builtin_amdgcn_exp2f(p1[r]); }
      lsum += p0 + p1;
      u32x4 pw0, pw1, pw2, pw3;
      pw0 = (u32x4){cvtpk_s(p0[0], p0[1]), cvtpk_s(p0[2], p0[3]), cvtpk_s(p0[4], p0[5]), cvtpk_s(p0[6], p0[7])};
      pw1 = (u32x4){cvtpk_s(p0[8], p0[9]), cvtpk_s(p0[10], p0[11]), cvtpk_s(p0[12], p0[13]), cvtpk_s(p0[14], p0[15])};
      pw2 = (u32x4){cvtpk_s(p1[0], p1[1]), cvtpk_s(p1[2], p1[3]), cvtpk_s(p1[4], p1[5]), cvtpk_s(p1[6], p1[7])};
      pw3 = (u32x4){cvtpk_s(p1[8], p1[9]), cvtpk_s(p1[10], p1[11]), cvtpk_s(p1[12], p1[13]), cvtpk_s(p1[14], p1[15])};
      SBAR();
      asm volatile("s_waitcnt lgkmcnt(0)" ::: "memory"); SBAR();
      #define VF(i_) (bf16x8){vlo[i_][0], vlo[i_][1], vlo[i_][2], vlo[i_][3], vhi[i_][0], vhi[i_][1], vhi[i_][2], vhi[i_][3]}
      o[0] = __builtin_amdgcn_mfma_f32_32x32x16_bf16(__builtin_bit_cast(bf16x8, pw0), VF(0), o[0], 0, 0, 0); o[1] = __builtin_amdgcn_mfma_f32_32x32x16_bf16(__builtin_bit_cast(bf16x8, pw0), VF(4), o[1], 0, 0, 0);
      o[0] = __builtin_amdgcn_mfma_f32_32x32x16_bf16(__builtin_bit_cast(bf16x8, pw1), VF(1), o[0], 0, 0, 0); o[1] = __builtin_amdgcn_mfma_f32_32x32x16_bf16(__builtin_bit_cast(bf16x8, pw1), VF(5), o[1], 0, 0, 0);
      o[0] = __builtin_amdgcn_mfma_f32_32x32x16_bf16(__builtin_bit_cast(bf16x8, pw2), VF(2), o[0], 0, 0, 0); o[1] = __builtin_amdgcn_mfma_f32_32x32x16_bf16(__builtin_bit_cast(bf16x8, pw2), VF(6), o[1], 0, 0, 0);
      o[0] = __builtin_amdgcn_mfma_f32_32x32x16_bf16(__builtin_bit_cast(bf16x8, pw3), VF(3), o[0], 0, 0, 0); o[1] = __builtin_amdgcn_mfma_f32_32x32x16_bf16(__builtin_bit_cast(bf16x8, pw3), VF(7), o[1], 0, 0, 0);
      #undef VF
    }
    if (nis == 2)      asm volatile("s_waitcnt vmcnt(4) lgkmcnt(0)\n\ts_barrier" ::: "memory");
    else if (nis == 1) asm volatile("s_waitcnt vmcnt(2) lgkmcnt(0)\n\ts_barrier" ::: "memory");
    else               asm volatile("s_waitcnt vmcnt(0) lgkmcnt(0)\n\ts_barrier" ::: "memory");
  }
  #undef LOAD_TILE
  #undef ISSUE_LOAD
  float l_reg = 0.f;
  #pragma unroll
  for (int r = 0; r < 16; ++r) l_reg += lsum[r];
  { auto rr = __builtin_amdgcn_permlane32_swap(__float_as_uint(l_reg), __float_as_uint(l_reg), false, false); l_reg = __uint_as_float(rr[0]) + __uint_as_float(rr[1]); }
  if (hi == 0) wsf[32 + r32] = l_reg; asm volatile("s_waitcnt lgkmcnt(0)" ::: "memory");
  float rli[16];
  #pragma unroll
  for (int r = 0; r < 16; ++r) rli[r] = __builtin_amdgcn_rcpf(wsf[32 + crow(r, hi)]);
  bf16* Ow = O + (rowbase + q0 + wid * 32) * DM + h * 64;
  { bf16* stg = (bf16*)(shm + LDS_OST) + wid * 2048;
    #pragma unroll
    for (int r = 0; r < 16; ++r) { const int orow = crow(r, hi);
      #pragma unroll
      for (int d0 = 0; d0 < 2; ++d0) stg[orow * 64 + d0 * 32 + r32] = (bf16)(cvtpk_s(o[d0][r] * rli[r], 0.f) & 0xffffu); }
    asm volatile("s_waitcnt lgkmcnt(0)" ::: "memory");
    #pragma unroll
    for (int i = 0; i < 4; ++i) { const int row = i * 8 + (lane >> 3), ch = lane & 7; const u32x4 v = *(const u32x4*)(stg + row * 64 + ch * 8); pg8::st16(Ow + (long)row * DM + ch * 8, v); } }
  asm volatile("s_waitcnt lgkmcnt(0)\n\ts_barrier" ::: "memory");
  #undef DMA_K
  #undef DMA_V
}
#undef SBAR
}

#define GAS __attribute__((address_space(1)))
#define LAS __attribute__((address_space(3)))
typedef unsigned short bf16;
typedef unsigned v4u __attribute__((ext_vector_type(4)));
typedef float f32x4 __attribute__((ext_vector_type(4)));
typedef short bf16x8 __attribute__((ext_vector_type(8)));
typedef GAS unsigned gu32;
typedef GAS unsigned long long gu64;
#define RLX_AGENT __ATOMIC_RELAXED, __HIP_MEMORY_SCOPE_AGENT
#define LDS_WAIT() asm volatile("s_waitcnt lgkmcnt(0)" ::: "memory")
#define VM_WAIT() asm volatile("s_waitcnt vmcnt(0)" ::: "memory")
__device__ __forceinline__ unsigned long long rt() { return __builtin_amdgcn_s_memrealtime(); }
#define XB_TMO      128
#define XB_XCNT(j)  (256  + 64 * (j))
#define XB_XSUB(j)  (1280 + 64 * (j))
#define XB_XGEN(j)  (2304 + 64 * (j))
#define XB_TOP      3328
#define XB_TOPGEN   3392
#define XCD_BAR_WORDS 3456
#define XB_SPIN_CAP (1u << 18)

__device__ __forceinline__ unsigned xb_ld(unsigned* p)              { return __hip_atomic_load(p, __ATOMIC_RELAXED, __HIP_MEMORY_SCOPE_AGENT); }
__device__ __forceinline__ unsigned xb_add(unsigned* p, unsigned v) { return __hip_atomic_fetch_add(p, v, __ATOMIC_RELAXED, __HIP_MEMORY_SCOPE_AGENT); }
__device__ __forceinline__ unsigned xb_xcc_id() { return (unsigned)__builtin_amdgcn_s_getreg((3 << 11) | 20) & 0xFu; }
#define XB_SPIN(cond, bar) do { unsigned _sp = 0; while (cond) { __builtin_amdgcn_s_sleep(1); \
    if ((++_sp & 255u) == 0u) { if (xb_ld(&(bar)[XB_TMO])) break; if (_sp > XB_SPIN_CAP) { atomicAdd(&(bar)[XB_TMO], 1u); break; } } } } while (0)

struct XcdBarrier {
    unsigned* bar; unsigned x;
    volatile LAS unsigned* st;
};

__device__ __forceinline__ XcdBarrier xcd_barrier_post(unsigned* bar, volatile LAS unsigned* st) {
    XcdBarrier b; b.bar = bar; b.x = xb_xcc_id(); b.st = st;
    if (threadIdx.x == 0) (void)xb_add(&bar[XB_XCNT(b.x)], 1u);
    return b;
}
__device__ __forceinline__ void xcd_barrier_complete(unsigned* bar, unsigned x, unsigned& nloc, unsigned& nx) {
    const unsigned G = gridDim.x * gridDim.y * gridDim.z;
    unsigned sum, cnt, mine, sp = 0u;
    for (;;) {
        sum = 0u; cnt = 0u; mine = 0u;
#pragma unroll
        for (unsigned j = 0; j < 16; ++j) { const unsigned c = xb_ld(&bar[XB_XCNT(j)]); sum += c; cnt += (c > 0u) ? 1u : 0u; mine = (j == x) ? c : mine; }
        if (sum == G) break;
        __builtin_amdgcn_s_sleep(1);
        if ((++sp & 255u) == 0u) { if (xb_ld(&bar[XB_TMO])) break; if (sp > XB_SPIN_CAP) { atomicAdd(&bar[XB_TMO], 1u); break; } }
    }
    nloc = mine > 0u ? mine : 1u; nx = cnt > 0u ? cnt : 1u;
}

__device__ __forceinline__ void xcd_barrier(const XcdBarrier& b) {
    asm volatile("s_waitcnt vmcnt(0)" ::: "memory");
    __syncthreads();
    if (threadIdx.x == 0) {
        unsigned* bar = b.bar;
        __builtin_amdgcn_s_waitcnt(0);
        unsigned nloc = b.st[0], nx = b.st[1];
        if (nloc == 0u) { xcd_barrier_complete(bar, b.x, nloc, nx); b.st[0] = nloc; b.st[1] = nx; }
        __builtin_amdgcn_fence(__ATOMIC_RELEASE, "agent");
        asm volatile("s_waitcnt vmcnt(0)" ::: "memory");
        const unsigned old = xb_add(&bar[XB_XSUB(b.x)], 1u);
        const unsigned gen = old / nloc;
        if (old + 1u == (gen + 1u) * nloc) {
            __builtin_amdgcn_fence(__ATOMIC_RELEASE, "agent");
            asm volatile("s_waitcnt vmcnt(0)" ::: "memory");
            const unsigned og = xb_add(&bar[XB_TOP], 1u);
            const unsigned tg = og / nx;
            if (og + 1u == (tg + 1u) * nx) xb_add(&bar[XB_TOPGEN], 1u);
            else XB_SPIN(xb_ld(&bar[XB_TOPGEN]) == tg, bar);
            __builtin_amdgcn_fence(__ATOMIC_ACQUIRE, "agent");
            xb_add(&bar[XB_XGEN(b.x)], 1u);
            asm volatile("s_waitcnt vmcnt(0)" ::: "memory");
        } else {
            XB_SPIN(xb_ld(&bar[XB_XGEN(b.x)]) == gen, bar);
            __builtin_amdgcn_fence(__ATOMIC_ACQUIRE, "agent");
            asm volatile("s_waitcnt vmcnt(0)" ::: "memory");
        }
    }
    __syncthreads();
}
#include <hip/hip_cooperative_groups.h>
namespace cg = cooperative_groups;
constexpr int NWAVES = 8;
constexpr int BATCH = 4, SEQ = 4096, D = 1024, FF = 4096, M = BATCH * SEQ, NIN = 8192;
constexpr size_t MiB = 1u << 20;
constexpr size_t WS_SS = 1 * MiB;
constexpr size_t WS_W1 = 2 * MiB, WS_WC = 18 * MiB, WS_WA = 20 * MiB  , WS_WO = 22 * MiB, WS_WUP = 24 * MiB, WS_WDN = 32 * MiB;
constexpr size_t WS_V = 40 * MiB  , WS_H = 72 * MiB  , WS_Q = 104 * MiB, WS_K = 136 * MiB  , WS_BG = 168 * MiB  , WS_U1 = 200 * MiB;
constexpr size_t WS_UU = 72 * MiB;
constexpr size_t WS_END = 232 * MiB;
constexpr int LDS_BYTES = 147456;
constexpr int LDSCTL_OFF = 131072, MISC_OFF = LDSCTL_OFF + 320;
constexpr size_t WS_CTL = 0, CTL_ZERO_BYTES = 65536; constexpr int CW_BAR = 4096;
__device__ __forceinline__ unsigned f2bf(float f) { unsigned u = __builtin_bit_cast(unsigned, f); return (u + 0x7fffu + ((u >> 16) & 1u)) >> 16; }
__device__ __forceinline__ unsigned pk2(float lo, float hi) { return f2bf(lo) | (f2bf(hi) << 16); }
__device__ __forceinline__ float wave_sum(float v) {
#pragma unroll
    for (int o = 1; o < 64; o <<= 1) v += __shfl_xor(v, o);
    return v;
}
__device__ __forceinline__ void tr_item(const float* W, int ldw, int col0, int k0, bf16* WT, int Kd, int drow0, const float* kscale, LAS float* scr, int lane) {
    float tv[32];
#pragma unroll
    for (int i = 0; i < 32; ++i) { const int kk = 2 * i + (lane >> 5); tv[i] = W[(size_t)(k0 + kk) * ldw + col0 + (lane & 31)]; }
#pragma unroll
    for (int i = 0; i < 32; ++i) { const int kk = 2 * i + (lane >> 5); float v = tv[i]; if (kscale) v *= kscale[k0 + kk]; scr[kk * 33 + (lane & 31)] = v; }
    LDS_WAIT(); asm volatile("" ::: "memory");
    const int c = lane & 7;
#pragma unroll
    for (int j = 0; j < 4; ++j) { const int n = (lane >> 3) + 8 * j; const LAS float* s = scr + (8 * c) * 33 + n;
        v4u o; o.x = pk2(s[0 * 33], s[1 * 33]); o.y = pk2(s[2 * 33], s[3 * 33]); o.z = pk2(s[4 * 33], s[5 * 33]); o.w = pk2(s[6 * 33], s[7 * 33]);
        pg8::st16(WT + (size_t)(drow0 + n) * Kd + k0 + 8 * c, o); }
    LDS_WAIT(); asm volatile("" ::: "memory");
}

#ifndef PH_MASK
#define PH_MASK 127
#endif
#ifndef REP_P1
#define REP_P1 1
#endif
#ifndef REP_ATT
#define REP_ATT 1
#endif
#ifndef REP_P3
#define REP_P3 1
#endif
#ifndef REP_P4
#define REP_P4 1
#endif
#ifndef REP_P5
#define REP_P5 1
#endif
#ifndef EXTRA_SYNC
#define EXTRA_SYNC 0
#endif
__device__ unsigned g_panel_cnt[64 * 64];
__device__ unsigned g_bar_shard[16 * 64];
__device__ unsigned g_bar_cnt = 0u, g_bar_gen = 0u, g_done_cnt = 0u;
struct Args { const float* in[16]; float* out; unsigned char* ws; };
__global__ void __launch_bounds__(NWAVES * 64, 2) fwd(Args a) {
    extern __shared__ __attribute__((aligned(16))) unsigned char lds[];
    cg::grid_group grid = cg::this_grid();
    LAS unsigned char* ldsp = (LAS unsigned char*)lds;
    const int tid = threadIdx.x, lane = tid & 63, wave = __builtin_amdgcn_readfirstlane(tid >> 6);
    const int G = gridDim.x, bx = blockIdx.x, vcu = (G % 8 == 0) ? (bx % 8) * (G / 8) + bx / 8 : bx;
    unsigned char* ws = a.ws;
    const float* x = a.in[0];
    bf16 *W1 = (bf16*)(ws + WS_W1), *WA = (bf16*)(ws + WS_WA), *WC = (bf16*)(ws + WS_WC), *WO = (bf16*)(ws + WS_WO), *WUP = (bf16*)(ws + WS_WUP), *WDN = (bf16*)(ws + WS_WDN);
    bf16 *Vb = (bf16*)(ws + WS_V), *X1B = (bf16*)(ws + WS_V), *Hb = (bf16*)(ws + WS_H), *YC = (bf16*)(ws + WS_H)  , *Qb = (bf16*)(ws + WS_Q), *AO = (bf16*)(ws + WS_Q)  , *Kb = (bf16*)(ws + WS_K), *MG = (bf16*)(ws + WS_K);
    bf16 *BG = (bf16*)(ws + WS_BG), *U1 = (bf16*)(ws + WS_U1), *UU = (bf16*)(ws + WS_UU), *Gt = (bf16*)a.out;
    float* SS = (float*)(ws + WS_SS);
    for (int u = tid; u < (LDS_BYTES - LDSCTL_OFF) / 4; u += NWAVES * 64) ((LAS unsigned*)(ldsp + LDSCTL_OFF))[u] = 0u;
    __syncthreads();
    if (a.out == nullptr) grid.sync();
#ifndef WB_AT_SEAMS
#define WB_AT_SEAMS 0
#endif
#if WB_AT_SEAMS || !WT_STORES
#define BAR_RELEASE() do { __builtin_amdgcn_fence(__ATOMIC_RELEASE, "agent"); asm volatile("s_waitcnt vmcnt(0)" ::: "memory"); } while (0)
#else
#define BAR_RELEASE() do { } while (0)
#endif
#if defined(MONO_BAR)
    const bool grouped = (G == 256);
    const unsigned NSEAMS = (grouped ? 3u : 6u) + EXTRA_SYNC;
    unsigned bar_epoch = 0u, bar_base = 0u; const unsigned bar_xcc = xb_xcc_id();
#define GRID_BAR() do { asm volatile("s_waitcnt vmcnt(0)" ::: "memory"); __syncthreads(); \
    ++bar_epoch; \
    if (tid == 0) { \
        BAR_RELEASE(); \
        unsigned old_ = xb_add(&g_bar_shard[64u * bar_xcc], 1u);     \
        if (bar_epoch == 1u) asm volatile("s_waitcnt vmcnt(0)" : "+v"(old_) :: "memory");     \
        const unsigned tgt_ = bar_epoch * (unsigned)G; unsigned sp_ = 0u; \
        for (;;) { unsigned s_ = 0u; _Pragma("unroll") for (int j_ = 0; j_ < 16; ++j_) s_ += xb_ld(&g_bar_shard[64 * j_]); \
            if (bar_epoch == 1u && sp_ == 0u) bar_base = ((s_ - 1u) / (NSEAMS * (unsigned)G)) * (NSEAMS * (unsigned)G);     \
            if (s_ - bar_base >= tgt_) break; \
            __builtin_amdgcn_s_sleep(8); if (++sp_ > (1u << 22)) break; } \
        __builtin_amdgcn_fence(__ATOMIC_ACQUIRE, "agent"); asm volatile("s_waitcnt vmcnt(0)" ::: "memory"); } \
    __syncthreads(); } while (0)
    unsigned grp_epoch = 0u, grp_base = 0u;
#define GROUP_BAR(pm_) do { asm volatile("s_waitcnt vmcnt(0)" ::: "memory"); __syncthreads(); \
    ++grp_epoch; \
    if (tid == 0) { unsigned* pc_ = &g_panel_cnt[64 * (pm_)]; \
        BAR_RELEASE(); \
        const unsigned old_ = xb_add(pc_, 1u); \
        if (grp_epoch == 1u) grp_base = old_ - old_ % 12u; \
        const unsigned tgt_ = grp_epoch * 4u; unsigned sp_ = 0u; \
        while (xb_ld(pc_) - grp_base < tgt_) { __builtin_amdgcn_s_sleep(1); if (++sp_ > (1u << 22)) break; } \
        __builtin_amdgcn_fence(__ATOMIC_ACQUIRE, "agent"); asm volatile("s_waitcnt vmcnt(0)" ::: "memory"); } \
    __syncthreads(); } while (0)
#elif defined(GEN_BAR)
#define GRID_BAR() do { asm volatile("s_waitcnt vmcnt(0)" ::: "memory"); __syncthreads(); \
    if (tid == 0) { \
        __builtin_amdgcn_fence(__ATOMIC_RELEASE, "agent"); asm volatile("s_waitcnt vmcnt(0)" ::: "memory"); \
        unsigned g0_ = xb_ld(&g_bar_gen); asm volatile("s_waitcnt vmcnt(0)" : "+v"(g0_) :: "memory");            \
        unsigned old_ = xb_add(&g_bar_cnt, 1u); asm volatile("s_waitcnt vmcnt(0)" : "+v"(old_) :: "memory"); \
        if (old_ == (unsigned)G - 1u) { __hip_atomic_store(&g_bar_cnt, 0u, RLX_AGENT); asm volatile("s_waitcnt vmcnt(0)" ::: "memory"); xb_add(&g_bar_gen, 1u); } \
        else { unsigned sp_ = 0u; while (xb_ld(&g_bar_gen) == g0_) { __builtin_amdgcn_s_sleep(1); if (++sp_ > (1u << 22)) break; } } \
        __builtin_amdgcn_fence(__ATOMIC_ACQUIRE, "agent"); asm volatile("s_waitcnt vmcnt(0)" ::: "memory"); } \
    __syncthreads(); } while (0)
#elif defined(CG_ALL)
#define GRID_BAR() do { asm volatile("s_waitcnt vmcnt(0)" ::: "memory"); grid.sync(); } while (0)
#elif defined(SIMPLE_BAR)
    unsigned bar_epoch = 0u;
#define GRID_BAR() do { asm volatile("s_waitcnt vmcnt(0)" ::: "memory"); __syncthreads(); \
    ++bar_epoch; \
    if (tid == 0) { unsigned* cnt_ = (unsigned*)(ws + WS_CTL) + CW_BAR + XB_TOP; \
        __builtin_amdgcn_fence(__ATOMIC_RELEASE, "agent"); asm volatile("s_waitcnt vmcnt(0)" ::: "memory"); \
        xb_add(cnt_, 1u); unsigned sp_ = 0u; \
        while (xb_ld(cnt_) < bar_epoch * (unsigned)G) { __builtin_amdgcn_s_sleep(1); if (++sp_ > (1u << 22)) break; } \
        __builtin_amdgcn_fence(__ATOMIC_ACQUIRE, "agent"); asm volatile("s_waitcnt vmcnt(0)" ::: "memory"); } \
    __syncthreads(); } while (0)
#else
#define GRID_BAR() xcd_barrier(bar)
#endif

#ifndef DUP_P0
#define DUP_P0 1
#endif
    for (int rep0 = 0; rep0 < DUP_P0; ++rep0) {
        LAS float* scr = (LAS float*)(ldsp + wave * 16384);
        const int gw = vcu * NWAVES + wave, NGW = G * NWAVES;
        constexpr int I_1 = 16 * 256, I_S = 16 * 32, I_UP = 16 * 128, I_DN = 64 * 32, NITEMS = I_1 + 3 * I_S + I_UP + I_DN;
        for (int it = gw; it < NITEMS; it += NGW) {
            int r = it;
            if (r < I_1) { const int db = r & 255, kb = r >> 8, pn = db >> 3, pb = db & 7, bj = pb >> 2, wcc = pb & 3; const float* W = a.in[2]; int ldw = 6144, col;
                if (pn < 4) col = (4 * pn + wcc) * 64 + 32 * bj;
                else if (pn < 8) col = 1024 + (4 * (pn - 4) + wcc) * 64 + 32 * bj;
                else if (pn < 12) col = 2048 + 256 * (pn - 8) + 32 * pb;
                else if (pn < 16) col = 3072 + 256 * (pn - 12) + 32 * pb;
                else if (pn < 24) col = (bj ? 5120 : 4096) + 128 * (pn - 16) + 32 * wcc;
                else { W = a.in[10]; ldw = 2048; col = 256 * (pn - 24) + 32 * pb; }
                tr_item(W, ldw, col, 64 * kb, W1, D, 32 * db, nullptr, scr, lane); continue; } r -= I_1;
            if (r < I_S) { tr_item(a.in[8], D, 32 * (r & 31), 64 * (r >> 5), WA, D, 32 * (r & 31), nullptr, scr, lane); continue; } r -= I_S;
            if (r < I_S) { tr_item(a.in[9], D, 32 * (r & 31), 64 * (r >> 5), WC, D, 32 * (r & 31), nullptr, scr, lane); continue; } r -= I_S;
            if (r < I_S) { tr_item(a.in[12], D, 32 * (r & 31), 64 * (r >> 5), WO, D, 32 * (r & 31), nullptr, scr, lane); continue; } r -= I_S;
            if (r < I_UP) { tr_item(a.in[14], FF, 32 * (r & 127), 64 * (r >> 7), WUP, D, 32 * (r & 127), a.in[13], scr, lane); continue; } r -= I_UP;
            tr_item(a.in[15], D, 32 * (r & 31), 64 * (r >> 5), WDN, FF, 32 * (r & 31), nullptr, scr, lane);
        }
        const float* g1 = a.in[1];
        f32x4 gv[2][2];
#pragma unroll
        for (int c = 0; c < 2; ++c)
#pragma unroll
            for (int hh = 0; hh < 2; ++hh) gv[c][hh] = ((const f32x4*)g1)[c * 128 + 2 * lane + hh];
        for (int m0 = gw; m0 < M; m0 += 2 * NGW) {
            const int m1 = m0 + NGW; const bool has1 = m1 < M;
            const f32x4* xr0 = (const f32x4*)(x + (size_t)m0 * D); const f32x4* xr1 = (const f32x4*)(x + (size_t)(has1 ? m1 : m0) * D);
            f32x4 v0[2][2], v1[2][2]; float s0 = 0.f, s1 = 0.f;
#pragma unroll
            for (int c = 0; c < 2; ++c)
#pragma unroll
                for (int hh = 0; hh < 2; ++hh) { v0[c][hh] = xr0[c * 128 + 2 * lane + hh]; v1[c][hh] = xr1[c * 128 + 2 * lane + hh]; }
#pragma unroll
            for (int c = 0; c < 2; ++c)
#pragma unroll
                for (int hh = 0; hh < 2; ++hh) { const f32x4 a0 = v0[c][hh], a1 = v1[c][hh];
                    s0 += (a0.x * a0.x + a0.y * a0.y) + (a0.z * a0.z + a0.w * a0.w); s1 += (a1.x * a1.x + a1.y * a1.y) + (a1.z * a1.z + a1.w * a1.w); }
            const float rs0 = 1.0f / sqrtf(wave_sum(s0) * (1.0f / D) + 1e-6f), rs1 = 1.0f / sqrtf(wave_sum(s1) * (1.0f / D) + 1e-6f);
#pragma unroll
            for (int c = 0; c < 2; ++c) { const f32x4 y0 = v0[c][0] * rs0 * gv[c][0], y1 = v0[c][1] * rs0 * gv[c][1];
                pg8::st16(Hb + (size_t)m0 * D + c * 512 + 8 * lane, (v4u){pk2(y0.x, y0.y), pk2(y0.z, y0.w), pk2(y1.x, y1.y), pk2(y1.z, y1.w)}); }
            if (has1) {
#pragma unroll
                for (int c = 0; c < 2; ++c) { const f32x4 y0 = v1[c][0] * rs1 * gv[c][0], y1 = v1[c][1] * rs1 * gv[c][1];
                    pg8::st16(Hb + (size_t)m1 * D + c * 512 + 8 * lane, (v4u){pk2(y0.x, y0.y), pk2(y0.z, y0.w), pk2(y1.x, y1.y), pk2(y1.z, y1.w)}); } }
        }
    }
    GRID_BAR();
#if !defined(SIMPLE_BAR) && !defined(CG_ALL) && !defined(GEN_BAR) && !defined(MONO_BAR)
    const XcdBarrier bar = xcd_barrier_post((unsigned*)(ws + WS_CTL) + CW_BAR, (volatile LAS unsigned*)(ldsp + MISC_OFF) + 8);
#endif

    if (PH_MASK & 2) {
        pg8::Gemm g{Hb, W1, M, NIN, D}; pg8::StaticOrder S; S.init(M, NIN, G, bx);
        pg8::EpiP1 E{Qb, Kb, Vb, BG, U1, Gt, a.in[3], a.in[4], a.in[11]};
        pg8::gemm_phase<pg8::EpiP1, pg8::StaticOrder, true, true>(ldsp, g, S, E);
#ifdef DUP_P1
        { pg8::Gemm g2{Hb, W1, M, NIN, D}; pg8::StaticOrder S2; S2.init(M, NIN, G, bx); pg8::gemm_phase<pg8::EpiP1, pg8::StaticOrder, true, true>(ldsp, g2, S2, E); }
#endif
    }
    GRID_BAR();

    if (PH_MASK & 4) {
        for (int L = vcu; L < 1024 * REP_ATT; L += G) { const int bh = (L & 255) >> 2, gq4 = (L & 3) + 4 * ((L >> 8) & 3);
            attn::attn_unit(bh >> 4, bh & 15, gq4, Qb, Kb, Vb, AO, a.in[5], a.in[3], a.in[4], (char*)lds); }
        const float* cw = a.in[6]; const float* cb = a.in[7];
        for (int item = vcu * 512 + tid; item < 131072; item += G * 512) {
            const int c8 = (item & 127) * 8, t0 = (item >> 7) * 16;
            float w0[8], w1[8], w2[8], b0[8], u1[8], u2[8];
#pragma unroll
            for (int e = 0; e < 8; ++e) { w0[e] = cw[c8 + e]; w1[e] = cw[1024 + c8 + e]; w2[e] = cw[2048 + c8 + e]; b0[e] = cb[c8 + e]; u1[e] = 0.f; u2[e] = 0.f; }
            if ((t0 & (SEQ - 1)) != 0) { f32x4 p, q; pg8::unpack8(*(const v4u*)(U1 + (size_t)(t0 - 2) * D + c8), p, q);
#pragma unroll
                for (int e = 0; e < 4; ++e) { u2[e] = p[e]; u2[4 + e] = q[e]; }
                pg8::unpack8(*(const v4u*)(U1 + (size_t)(t0 - 1) * D + c8), p, q);
#pragma unroll
                for (int e = 0; e < 4; ++e) { u1[e] = p[e]; u1[4 + e] = q[e]; } }
            v4u ur[16], br[16];
#pragma unroll
            for (int i = 0; i < 16; ++i) { const size_t off = (size_t)(t0 + i) * D + c8; ur[i] = *(const v4u*)(U1 + off); br[i] = *(const v4u*)(BG + off); }
#pragma unroll
            for (int i = 0; i < 16; ++i) { const size_t off = (size_t)(t0 + i) * D + c8; f32x4 p, q, bp, bq; float u0[8], bgv[8], y[8];
                pg8::unpack8(ur[i], p, q); pg8::unpack8(br[i], bp, bq);
#pragma unroll
                for (int e = 0; e < 4; ++e) { u0[e] = p[e]; u0[4 + e] = q[e]; bgv[e] = bp[e]; bgv[4 + e] = bq[e]; }
#pragma unroll
                for (int e = 0; e < 8; ++e) { y[e] = bgv[e] * (b0[e] + w0[e] * u2[e] + w1[e] * u1[e] + w2[e] * u0[e]); u2[e] = u1[e]; u1[e] = u0[e]; }
                v4u o; o.x = pk2(y[0], y[1]); o.y = pk2(y[2], y[3]); o.z = pk2(y[4], y[5]); o.w = pk2(y[6], y[7]); pg8::st16(YC + off, o); }
        }
    }
    GRID_BAR();

    if (PH_MASK & 8) {
        static_assert(WS_Q == WS_H + (size_t)M * D * 2 && WS_WA == WS_WC + (size_t)D * D * 2, "P3 reads the stacked [YC ; AO] and [Wc ; Wa]");
        pg8::PairOrder S; S.S.init(M, D, G, bx);
        pg8::Gemm g{YC, WC, 2 * M, 2 * D, D}; pg8::EpiGate2 E{Gt, MG};
        pg8::gemm_phase<pg8::EpiGate2, pg8::PairOrder, true, true>(ldsp, g, S, E);
    }
    { pg8::StaticOrder S; S.init(M, D, G, bx); pg8::Unit u0; S.next(0, u0); if (grouped) GROUP_BAR(u0.pm); else GRID_BAR(); }

    if (PH_MASK & 16) {
        pg8::Gemm g{MG, WO, M, D, D}; pg8::StaticOrder S; S.init(M, D, G, bx);
        pg8::EpiRes1 E{x, a.out, X1B, SS};
        pg8::gemm_phase<pg8::EpiRes1, pg8::StaticOrder, true, true>(ldsp, g, S, E);
#ifdef DUP_P4
        pg8::gemm_phase<pg8::EpiRes1, pg8::StaticOrder, true, true>(ldsp, g, S, E);
#endif
    }
    { pg8::StaticOrder S; S.init(M, D, G, bx); pg8::Unit u0; S.next(0, u0); if (grouped) GROUP_BAR(u0.pm); else GRID_BAR(); }

    if (PH_MASK & 32) {
        pg8::Gemm g{X1B, WUP, M, FF, D}; pg8::StaticOrder S; S.init(M, FF, G, bx);
        pg8::EpiUp E{SS, UU, (size_t)M * D};
        pg8::gemm_phase<pg8::EpiUp, pg8::StaticOrder, true, true>(ldsp, g, S, E);
#ifdef DUP_P5
        pg8::gemm_phase<pg8::EpiUp, pg8::StaticOrder, true, true>(ldsp, g, S, E);
#endif
    }
    { pg8::StaticOrder S; S.init(M, D, G, bx); pg8::Unit u0; S.next(0, u0); if (grouped) GROUP_BAR(u0.pm); else GRID_BAR(); }

    for (int i = 0; i < EXTRA_SYNC; ++i) GRID_BAR();
    if (PH_MASK & 64) {
        pg8::Gemm g{UU, WDN, M, D, FF, D, 4, (size_t)M * D * 2}; pg8::StaticOrder S; S.init(M, D, G, bx);
        pg8::EpiRes2 E{a.out, X1B};
        pg8::gemm_phase<pg8::EpiRes2, pg8::StaticOrder, true, true>(ldsp, g, S, E);
    }
#if defined(MONO_BAR)
    if (wave == 0) { unsigned old_ = 0u; if (lane == 0) old_ = xb_add(&g_done_cnt, 1u);
        old_ = (unsigned)__builtin_amdgcn_readfirstlane((int)old_);
        if (old_ == (unsigned)G - 1u) { __hip_atomic_store(&g_panel_cnt[64 * lane], 0u, RLX_AGENT);
            if (lane < 16) __hip_atomic_store(&g_bar_shard[64 * lane], 0u, RLX_AGENT);
            if (lane == 0) { __hip_atomic_store(&g_bar_cnt, 0u, RLX_AGENT); __hip_atomic_store(&g_done_cnt, 0u, RLX_AGENT); } } }
#endif
}

extern "C" void kernel_launch(void* const* d_in, const int* in_sizes, int n_in, void* d_out, int out_size, void* d_ws, size_t ws_size, hipStream_t stream) {
    static int grid = 0;
    if (grid == 0) {
        if (n_in != 16 || out_size != M * D || ws_size < WS_END) { fprintf(stderr, "kernel_launch: unexpected shapes (n_in %d, out %d, ws %zu)\n", n_in, out_size, ws_size); grid = -1; return; }
        int dev = 0, cus = 0, per_cu = 0;
        (void)hipGetDevice(&dev); (void)hipDeviceGetAttribute(&cus, hipDeviceAttributeMultiprocessorCount, dev);
        if (hipFuncSetAttribute((const void*)fwd, hipFuncAttributeMaxDynamicSharedMemorySize, LDS_BYTES) != hipSuccess) { fprintf(stderr, "kernel_launch: hipFuncSetAttribute failed\n"); grid = -1; return; }
        if (hipOccupancyMaxActiveBlocksPerMultiprocessor(&per_cu, (const void*)fwd, NWAVES * 64, LDS_BYTES) != hipSuccess || per_cu < 1) { fprintf(stderr, "kernel_launch: occupancy query says %d\n", per_cu); per_cu = 1; }
        (void)hipGetLastError();
        grid = cus * 1;
    }
    if (grid < 0) return;
#if !defined(GEN_BAR) && !defined(MONO_BAR)
    if (hipMemsetAsync((char*)d_ws + WS_CTL, 0, CTL_ZERO_BYTES, stream) != hipSuccess) { fprintf(stderr, "kernel_launch: memset of the barrier words failed\n"); return; }
#endif
    Args a{};
    for (int i = 0; i < 16; ++i) a.in[i] = (const float*)d_in[i];
    a.out = (float*)d_out; a.ws = (unsigned char*)d_ws;
    void* args[] = {&a};
    hipError_t e = hipLaunchCooperativeKernel((const void*)fwd, dim3(grid), dim3(NWAVES * 64), args, LDS_BYTES, stream);
    if (e != hipSuccess) fprintf(stderr, "kernel_launch: cooperative launch failed: %s (grid %d)\n", hipGetErrorString(e), grid);
}
```

```cpp
#include <hip/hip_runtime.h>
#include <cstdio>
#include <cstdint>
#define MONO_BAR 1
namespace pg8 {
#define PG8_LAS __attribute__((address_space(3)))
typedef unsigned short bf16_t;
typedef short bf16x8 __attribute__((ext_vector_type(8)));
typedef float f32x4 __attribute__((ext_vector_type(4)));
typedef unsigned u32x4 __attribute__((ext_vector_type(4)));
constexpr int BM = 256, BK = 64, HALF = 128, HTB = HALF * BK * 2  , STAGE_BYTES = 8 * HTB, NXCD = 8, WGM = 8;

__host__ __device__ __forceinline__ int lds_byte(int r, int c) { const int st = (r >> 4) * 2 + (c >> 5), rr = r & 15, cc = c & 31, ob = rr * 64 + cc * 2; return st * 1024 + (ob ^ (((ob >> 9) & 1) << 5)); }
__host__ __device__ __forceinline__ void stage_rc(int b, int& R, int& C) { const int st = b / 1024, sb = b % 1024, swz = sb ^ (((sb >> 9) & 1) << 5); R = (st >> 1) * 16 + swz / 64; C = (st & 1) * 32 + (swz % 64) / 2; }
__host__ __device__ __forceinline__ int perm32(int rho) { const int n = rho >> 4, i = rho & 15; return 8 * (i >> 2) + 4 * n + (i & 3); }

struct Unit { int pm, pn; };
struct Gemm { const bf16_t* A; const bf16_t* Bt; int M, N, K; int lda; int segsh; size_t segstride; };

struct StaticOrder {
    int nM, nN, nwg, G, c;
    __host__ __device__ void init(int M, int N, int G_, int c_) { nM = M / BM; nN = N / BM; nwg = nM * nN; G = G_; c = c_; }
    __host__ __device__ bool next(int i, Unit& u) const {
        const long L = (long)i * G + c; if (L >= nwg) return false;
        int wgid = (int)L; { const int q = nwg / NXCD, r = nwg % NXCD, xcd = wgid % NXCD, off = wgid / NXCD; wgid = (xcd < r ? xcd * (q + 1) : r * (q + 1) + (xcd - r) * q) + off; }
        const int nig = WGM * nN, gid = wgid / nig, fm = gid * WGM, gsz = (nM - fm) < WGM ? (nM - fm) : WGM;
        u.pm = fm + ((wgid % nig) % gsz); u.pn = (wgid % nig) / gsz; return true;
    }
    __device__ __forceinline__ void a_ready(const Unit&) const {}
    __device__ __forceinline__ void done(const Unit&) const {}
};

__device__ __forceinline__ unsigned cvt_pk_bf16(float lo, float hi) { unsigned r; asm volatile("v_cvt_pk_bf16_f32 %0, %1, %2" : "=v"(r) : "v"(lo), "v"(hi)); return r; }
typedef float f32x2 __attribute__((ext_vector_type(2)));
#ifndef WT_STORES
#define WT_STORES 1
#endif
__device__ __forceinline__ void st16(void* p, u32x4 v) {
#if WT_STORES
    asm volatile("global_store_dwordx4 %0, %1, off sc1\n\ts_nop 1" :: "v"(p), "v"(v) : "memory");
#else
    *(u32x4*)p = v;
#endif
}
typedef unsigned u32x2w __attribute__((ext_vector_type(2)));
__device__ __forceinline__ void st8(void* p, u32x2w v) {
#if WT_STORES
    asm volatile("global_store_dwordx2 %0, %1, off sc1\n\ts_nop 1" :: "v"(p), "v"(v) : "memory");
#else
    *(u32x2w*)p = v;
#endif
}
typedef unsigned u32x2 __attribute__((ext_vector_type(2)));
__device__ __forceinline__ float bf_lo(unsigned w) { return __uint_as_float(w << 16); }
__device__ __forceinline__ float bf_hi(unsigned w) { return __uint_as_float(w & 0xffff0000u); }
__device__ __forceinline__ u32x4 pack8(f32x4 a, f32x4 b) { u32x4 w; w.x = cvt_pk_bf16(a[0], a[1]); w.y = cvt_pk_bf16(a[2], a[3]); w.z = cvt_pk_bf16(b[0], b[1]); w.w = cvt_pk_bf16(b[2], b[3]); return w; }
__device__ __forceinline__ void unpack8(u32x4 w, f32x4& a, f32x4& b) { a = (f32x4){bf_lo(w.x), bf_hi(w.x), bf_lo(w.y), bf_hi(w.y)}; b = (f32x4){bf_lo(w.z), bf_hi(w.z), bf_lo(w.w), bf_hi(w.w)}; }
constexpr float QK_C2 = 0.125f * 1.4426950408889634f;
constexpr float RMS_EPS = 1e-6f;

struct EpiP1 {
    static constexpr bool PERM = true, AFTER_DRAIN = false, CHAIN = false;
    bf16_t *Q, *Kb, *V, *BG, *U1, *G; const float *gq, *gk, *bgate;
    __device__ __forceinline__ void operator()(const f32x4 (&acc)[2][2][4][2], const Unit& u, int wr, int wc, int fr, int fq) const {
        const int pn = u.pn; const int row0 = u.pm * BM + wr * 64 + fr;
        if (pn < 8) {
            const bool isq = pn < 4; const float* g = isq ? gq : gk; bf16_t* O = isq ? Q : Kb; const float sc = isq ? QK_C2 : 1.f;
            const int head = 4 * (pn & 3) + wc;
            f32x4 gv[2][2];
#pragma unroll
            for (int bj = 0; bj < 2; ++bj)
#pragma unroll
                for (int n = 0; n < 2; ++n) gv[bj][n] = *(const f32x4*)(g + 32 * bj + 8 * fq + 4 * n) * sc;
#pragma unroll
            for (int ai = 0; ai < 2; ++ai)
#pragma unroll
                for (int m = 0; m < 4; ++m) {
                    float s = 0.f;
#pragma unroll
                    for (int bj = 0; bj < 2; ++bj)
#pragma unroll
                        for (int n = 0; n < 2; ++n) { const f32x4 x = acc[ai][bj][m][n]; s += (x[0] * x[0] + x[1] * x[1]) + (x[2] * x[2] + x[3] * x[3]); }
                    s += __shfl_xor(s, 16); s += __shfl_xor(s, 32);
                    const float rs = 1.0f / sqrtf(s * (1.0f / 64.0f) + RMS_EPS);
                    bf16_t* rowp = O + (size_t)(row0 + ai * HALF + m * 16) * 1024 + head * 64 + 8 * fq;
#pragma unroll
                    for (int bj = 0; bj < 2; ++bj) st16(rowp + 32 * bj, pack8(acc[ai][bj][m][0] * rs * gv[bj][0], acc[ai][bj][m][1] * rs * gv[bj][1]));
                }
        } else if (pn < 16) {
            bf16_t* O = (pn < 12) ? V : BG; const int col0 = 256 * (pn & 3) + wc * 32 + 8 * fq;
#pragma unroll
            for (int ai = 0; ai < 2; ++ai)
#pragma unroll
                for (int m = 0; m < 4; ++m) { bf16_t* rowp = O + (size_t)(row0 + ai * HALF + m * 16) * 1024 + col0;
#pragma unroll
                    for (int bj = 0; bj < 2; ++bj) st16(rowp + bj * HALF, pack8(acc[ai][bj][m][0], acc[ai][bj][m][1])); }
        } else if (pn < 24) {
            const int col0 = 128 * (pn - 16) + wc * 32 + 8 * fq;
#pragma unroll
            for (int ai = 0; ai < 2; ++ai)
#pragma unroll
                for (int m = 0; m < 4; ++m)
                    st16(U1 + (size_t)(row0 + ai * HALF + m * 16) * 1024 + col0, pack8(acc[ai][0][m][0] * acc[ai][1][m][0], acc[ai][0][m][1] * acc[ai][1][m][1]));
        } else {
            const int ch0 = 128 * (pn - 24) + wc * 32 + 8 * fq;
            f32x4 bv[2][2];
#pragma unroll
            for (int bj = 0; bj < 2; ++bj)
#pragma unroll
                for (int n = 0; n < 2; ++n) bv[bj][n] = *(const f32x4*)(bgate + 1024 * bj + ch0 + 4 * n);
#pragma unroll
            for (int ai = 0; ai < 2; ++ai)
#pragma unroll
                for (int m = 0; m < 4; ++m) { bf16_t* rowp = G + (size_t)(row0 + ai * HALF + m * 16) * 2048 + ch0; f32x4 dv[2], rv[2];
#pragma unroll
                    for (int n = 0; n < 2; ++n) { const f32x4 za = (acc[ai][0][m][n] + bv[0][n]) * (-1.4426950408889634f), zc = (acc[ai][1][m][n] + bv[1][n]) * (-1.4426950408889634f);
#pragma unroll
                        for (int e = 0; e < 4; ++e) { const float ga = __builtin_amdgcn_rcpf(1.0f + __builtin_amdgcn_exp2f(za[e])), gc = __builtin_amdgcn_rcpf(1.0f + __builtin_amdgcn_exp2f(zc[e]));
                            const float d = fmaxf(ga, 8.6736174e-19f); dv[n][e] = d; rv[n][e] = gc * __builtin_amdgcn_rcpf(d); } }
                    st16(rowp, pack8(dv[0], dv[1])); st16(rowp + 1024, pack8(rv[0], rv[1])); }
        }
    }
};
template <bool ADD> struct EpiGate {
    static constexpr bool PERM = true, AFTER_DRAIN = false, CHAIN = false;
    const bf16_t* G; bf16_t* MG; int goff;
    __device__ __forceinline__ void operator()(const f32x4 (&acc)[2][2][4][2], const Unit& u, int wr, int wc, int fr, int fq) const {
        const int row0 = u.pm * BM + wr * 64 + fr, col0 = u.pn * BM + wc * 32 + 8 * fq;
#pragma unroll
        for (int ai = 0; ai < 2; ++ai)
#pragma unroll
            for (int m = 0; m < 4; ++m) { const size_t r = (size_t)(row0 + ai * HALF + m * 16);
#pragma unroll
                for (int bj = 0; bj < 2; ++bj) { f32x4 g0, g1; unpack8(*(const u32x4*)(G + r * 2048 + goff + col0 + bj * HALF), g0, g1);
                    f32x4 v0 = acc[ai][bj][m][0] * g0, v1 = acc[ai][bj][m][1] * g1;
                    bf16_t* p = MG + r * 1024 + col0 + bj * HALF;
                    if (ADD) { f32x4 a0, a1; unpack8(*(const u32x4*)p, a0, a1); v0 += a0; v1 += a1; }
                    *(u32x4*)p = pack8(v0, v1); } }
    }
};
struct PairOrder {
    StaticOrder S;
    __device__ bool next(int i, Unit& u) const { Unit b; if (!S.next(i >> 1, b)) return false; u.pm = b.pm + ((i & 1) ? 64 : 0); u.pn = b.pn + ((i & 1) ? 4 : 0); return true; }
    __device__ __forceinline__ void a_ready(const Unit&) const {}
    __device__ __forceinline__ void done(const Unit&) const {}
};
struct EpiGate2 {
    static constexpr bool PERM = true, AFTER_DRAIN = false, CHAIN = true;
    const bf16_t* G; bf16_t* MG;
    __device__ __forceinline__ bool chain(f32x4 (&acc)[2][2][4][2], const Unit& u, int wr, int wc, int fr, int fq) const {
        const bool second = u.pm >= 64; const int pm = second ? u.pm - 64 : u.pm, pn = second ? u.pn - 4 : u.pn;
        const int row0 = pm * BM + wr * 64 + fr, col0 = pn * BM + wc * 32 + 8 * fq, goff = second ? 0 : 1024;
#pragma unroll
        for (int ai = 0; ai < 2; ++ai) {
            u32x4 gl[4][2];
#pragma unroll
            for (int m = 0; m < 4; ++m) { const size_t r = (size_t)(row0 + ai * HALF + m * 16);
#pragma unroll
                for (int bj = 0; bj < 2; ++bj) gl[m][bj] = *(const u32x4*)(G + r * 2048 + goff + col0 + bj * HALF); }
#pragma unroll
            for (int m = 0; m < 4; ++m) { const size_t r = (size_t)(row0 + ai * HALF + m * 16);
#pragma unroll
                for (int bj = 0; bj < 2; ++bj) { f32x4 g0, g1; unpack8(gl[m][bj], g0, g1);
                    if (!second) { acc[ai][bj][m][0] *= g0; acc[ai][bj][m][1] *= g1; }
                    else st16(MG + r * 1024 + col0 + bj * HALF, pack8(acc[ai][bj][m][0] * g0, acc[ai][bj][m][1] * g1)); } }
        }
        return !second;
    }
    __device__ __forceinline__ void operator()(const f32x4 (&)[2][2][4][2], const Unit&, int, int, int, int) const {}
};
#ifndef STORE_X1_F32
#define STORE_X1_F32 0
#endif
struct EpiRes1 {
    static constexpr bool PERM = true, AFTER_DRAIN = false, CHAIN = false;
    const float* x; float* out; bf16_t* x1b; float* SS;
    __device__ __forceinline__ void operator()(const f32x4 (&acc)[2][2][4][2], const Unit& u, int wr, int wc, int fr, int fq) const {
        const int row0 = u.pm * BM + wr * 64 + fr, col0 = u.pn * BM + wc * 32 + 8 * fq;
#pragma unroll
        for (int ai = 0; ai < 2; ++ai) {
            f32x4 xv[4][2][2];
#pragma unroll
            for (int m = 0; m < 4; ++m) { const size_t off = (size_t)(row0 + ai * HALF + m * 16) * 1024 + col0;
#pragma unroll
                for (int bj = 0; bj < 2; ++bj)
#pragma unroll
                    for (int n = 0; n < 2; ++n) xv[m][bj][n] = *(const f32x4*)(x + off + bj * HALF + n * 4); }
#pragma unroll
            for (int m = 0; m < 4; ++m) { const size_t r = (size_t)(row0 + ai * HALF + m * 16); const size_t off = r * 1024 + col0; float s = 0.f;
#pragma unroll
                for (int bj = 0; bj < 2; ++bj) { const f32x4 v0 = xv[m][bj][0] + acc[ai][bj][m][0], v1 = xv[m][bj][1] + acc[ai][bj][m][1];
                    if (STORE_X1_F32) { *(f32x4*)(out + off + bj * HALF) = v0; *(f32x4*)(out + off + bj * HALF + 4) = v1; }
                    s += ((v0[0] * v0[0] + v0[1] * v0[1]) + (v0[2] * v0[2] + v0[3] * v0[3])) + ((v1[0] * v1[0] + v1[1] * v1[1]) + (v1[2] * v1[2] + v1[3] * v1[3]));
                    st16(x1b + off + bj * HALF, pack8(v0, v1)); }
                s += __shfl_xor(s, 16); s += __shfl_xor(s, 32);
                if (fq == 0) __hip_atomic_store(SS + r * 16 + 4 * u.pn + wc, s, __ATOMIC_RELAXED, __HIP_MEMORY_SCOPE_AGENT); }
            asm volatile("" ::: "memory");
        }
    }
};
struct EpiUp {
    static constexpr bool PERM = true, AFTER_DRAIN = false, CHAIN = false;
    const float* SS; bf16_t* UU; size_t piece;
    __device__ __forceinline__ void operator()(const f32x4 (&acc)[2][2][4][2], const Unit& u, int wr, int wc, int fr, int fq) const {
        const int row0 = u.pm * BM + wr * 64 + fr;
        bf16_t* UUp = UU + (size_t)(u.pn >> 2) * piece + (u.pn & 3) * BM + wc * 32 + 8 * fq;
#pragma unroll
        for (int ai = 0; ai < 2; ++ai)
#pragma unroll
            for (int m = 0; m < 4; ++m) { const size_t r = (size_t)(row0 + ai * HALF + m * 16);
                const f32x4* sp = (const f32x4*)(SS + r * 16); const f32x4 s4 = (sp[0] + sp[1]) + (sp[2] + sp[3]);
                const float rs = 1.0f / sqrtf(((s4[0] + s4[1]) + (s4[2] + s4[3])) * (1.0f / 1024.0f) + RMS_EPS);
#pragma unroll
                for (int bj = 0; bj < 2; ++bj) { f32x4 v[2];
#pragma unroll
                    for (int n = 0; n < 2; ++n) { const f32x4 z = acc[ai][bj][m][n] * rs;
#pragma unroll
                        for (int e = 0; e < 4; ++e) { const float t = fmaxf(z[e], 0.f); v[n][e] = t * t; } }
                    st16(UUp + r * 1024 + bj * HALF, pack8(v[0], v[1])); } }
    }
};
struct EpiRes2 {
    static constexpr bool PERM = true, AFTER_DRAIN = false, CHAIN = false;
    float* out; const bf16_t* x1b;
    __device__ __forceinline__ void operator()(const f32x4 (&acc)[2][2][4][2], const Unit& u, int wr, int wc, int fr, int fq) const {
        const int row0 = u.pm * BM + wr * 64 + fr, col0 = u.pn * BM + wc * 32 + 8 * fq;
#pragma unroll
        for (int ai = 0; ai < 2; ++ai) {
            u32x4 bw[4][2];
#pragma unroll
            for (int m = 0; m < 4; ++m) { const size_t off = (size_t)(row0 + ai * HALF + m * 16) * 1024 + col0;
#pragma unroll
                for (int bj = 0; bj < 2; ++bj) bw[m][bj] = *(const u32x4*)(x1b + off + bj * HALF); }
#pragma unroll
            for (int m = 0; m < 4; ++m) { const size_t off = (size_t)(row0 + ai * HALF + m * 16) * 1024 + col0;
#pragma unroll
                for (int bj = 0; bj < 2; ++bj) { f32x4 b0, b1; unpack8(bw[m][bj], b0, b1); float* p = out + off + bj * HALF;
                    *(f32x4*)p = b0 + acc[ai][bj][m][0]; *(f32x4*)(p + 4) = b1 + acc[ai][bj][m][1]; } }
            asm volatile("" ::: "memory");
        }
    }
};

template <class Epi, class Sched, bool ALIGN_EPI = false, bool SP2 = false>
__device__ __forceinline__ void gemm_phase(PG8_LAS unsigned char* lds, const Gemm g, const Sched& S, const Epi& E) {
    int tid_ = threadIdx.x; asm volatile("" : "+v"(tid_));
    const int tid = tid_, wid = __builtin_amdgcn_readfirstlane(tid >> 6), lane = tid & 63, wr = wid >> 2, wc = wid & 3, fr = lane & 15, fq = lane >> 4;
    const int K = g.K, nt = K / BK;
    const int lda = g.lda ? g.lda : K, segsh = g.segsh ? g.segsh : 30;
    unsigned voffA[2], voffB[2];
#pragma unroll
    for (int i = 0; i < 2; ++i) { int R, C; stage_rc(tid * 16 + i * 8192, R, C); const int Rb = Epi::PERM ? ((R & ~31) + perm32(R & 31)) : R;
        voffA[i] = (unsigned)(R * lda + C) * 2u; voffB[i] = (unsigned)(Rb * K + C) * 2u; }
    const size_t kstep = (size_t)(BK * 2);
    const size_t hstep = (size_t)HALF * K * 2;
    const size_t tstep = 2 * hstep;
    const size_t hstepA = (size_t)HALF * lda * 2, tstepA = 2 * hstepA;
#define PG8_AOFF(t_) ((size_t)((t_) >> segsh) * g.segstride + (size_t)((t_) & ((1 << segsh) - 1)) * kstep)
    const unsigned ldsw = (unsigned)wid * 1024u;
    const int aoff = lds_byte(wr * 64 + fr, fq * 8), boff = lds_byte(wc * 32 + fr, fq * 8);
#define PG8_SA(b, h) (((b) * 2 + (h)) * HTB)
#define PG8_SB(b, h) ((4 + (b) * 2 + (h)) * HTB)
#define PG8_STAGE(bufoff, gbase, voff) do { _Pragma("unroll") for (int _i = 0; _i < 2; ++_i) \
        __builtin_amdgcn_global_load_lds((const unsigned*)((const char*)(gbase) + (voff)[_i]), (PG8_LAS unsigned*)(lds + (bufoff) + ldsw + _i * 8192), 16, 0, 0); } while (0)
#define PG8_LDA(dst, b, h) do { _Pragma("unroll") for (int m = 0; m < 4; ++m) _Pragma("unroll") for (int k = 0; k < 2; ++k) dst[m][k] = *(const PG8_LAS bf16x8*)(lds + PG8_SA(b, h) + aoff + m * 2048 + k * 1024); } while (0)
#define PG8_LDB(dst, b, h) do { _Pragma("unroll") for (int n = 0; n < 2; ++n) _Pragma("unroll") for (int k = 0; k < 2; ++k) dst[n][k] = *(const PG8_LAS bf16x8*)(lds + PG8_SB(b, h) + boff + n * 2048 + k * 1024); } while (0)
#define PG8_MMA(ai, bj, At, Bt) do { __builtin_amdgcn_s_setprio(1); _Pragma("unroll") for (int m = 0; m < 4; ++m) _Pragma("unroll") for (int n = 0; n < 2; ++n) _Pragma("unroll") for (int k = 0; k < 2; ++k) \
        acc[ai][bj][m][n] = __builtin_amdgcn_mfma_f32_16x16x32_bf16(Bt[n][k], At[m][k], acc[ai][bj][m][n], 0, 0, 0); __builtin_amdgcn_s_setprio(0); } while (0)
#define PG8_WAIT_V(n) asm volatile("s_waitcnt vmcnt(" #n ")" ::: "memory")
#define PG8_WAIT_L(n) asm volatile("s_waitcnt lgkmcnt(" #n ")" ::: "memory")
#define PG8_BAR __builtin_amdgcn_s_barrier()
#define PG8_SCHED __builtin_amdgcn_sched_barrier(0)
    Unit cur, nxt; int ui = 0;
    if (!S.next(0, cur)) return;
    f32x4 acc[2][2][4][2];
#pragma unroll
    for (int a = 0; a < 2; ++a)
#pragma unroll
        for (int b = 0; b < 2; ++b)
#pragma unroll
            for (int m = 0; m < 4; ++m)
#pragma unroll
                for (int n = 0; n < 2; ++n) acc[a][b][m][n] = (f32x4){0.f, 0.f, 0.f, 0.f};
    bf16x8 At[4][2], B0[2][2], B1[2][2];
    const char* cA = (const char*)g.A + (size_t)cur.pm * tstepA; const char* cB = (const char*)g.Bt + (size_t)cur.pn * tstep;
    S.a_ready(cur);
    if constexpr (SP2) {
        PG8_STAGE(PG8_SB(0, 0), cB, voffB); PG8_STAGE(PG8_SB(0, 1), cB + hstep, voffB); PG8_STAGE(PG8_SA(0, 0), cA, voffA); PG8_STAGE(PG8_SA(0, 1), cA + hstepA, voffA);
        if (wr == 1) PG8_BAR;
        PG8_WAIT_V(2); PG8_BAR;
        PG8_STAGE(PG8_SB(1, 0), cB + kstep, voffB); PG8_STAGE(PG8_SA(1, 0), cA + kstep, voffA); PG8_STAGE(PG8_SB(1, 1), cB + hstep + kstep, voffB);
        PG8_WAIT_V(6); PG8_BAR;
    } else {
        PG8_STAGE(PG8_SB(0, 0), cB, voffB); PG8_STAGE(PG8_SA(0, 0), cA, voffA); PG8_STAGE(PG8_SB(0, 1), cB + hstep, voffB); PG8_STAGE(PG8_SA(0, 1), cA + hstepA, voffA);
        if (wr == 1) PG8_BAR;
        PG8_WAIT_V(4); PG8_BAR;
        PG8_STAGE(PG8_SB(1, 0), cB + kstep, voffB); PG8_STAGE(PG8_SA(1, 0), cA + kstep, voffA); PG8_STAGE(PG8_SB(1, 1), cB + hstep + kstep, voffB);
        PG8_WAIT_V(6); PG8_BAR;
    }
    for (;;) {
        const bool has_next = S.next(ui + 1, nxt);
        const char* nA = has_next ? (const char*)g.A + (size_t)nxt.pm * tstepA : cA; const char* nB = has_next ? (const char*)g.Bt + (size_t)nxt.pn * tstep : cB;
        for (int t = 0; t < nt; t += 2) {
            const bool last = (t == nt - 2);
            const char* a1 = cA + PG8_AOFF(t) + kstep;
            const char* a2 = last ? nA : cA + PG8_AOFF(t + 2); const char* b2 = last ? nB : cB + (size_t)(t + 2) * kstep;
            const char* a3 = a2 + kstep; const char* b3 = b2 + kstep;
            if (last && has_next) S.a_ready(nxt);
            if constexpr (SP2) {
            PG8_LDB(B0, 0, 0); PG8_LDB(B1, 0, 1); PG8_SCHED; PG8_LDA(At, 0, 0); PG8_STAGE(PG8_SA(1, 1), a1 + hstepA, voffA);
            PG8_WAIT_V(8); PG8_WAIT_L(0); PG8_BAR; PG8_MMA(0, 0, At, B0); PG8_MMA(0, 1, At, B1); PG8_BAR; PG8_SCHED;
            PG8_LDA(At, 0, 1); PG8_STAGE(PG8_SB(0, 0), b2, voffB); PG8_STAGE(PG8_SB(0, 1), b2 + hstep, voffB); PG8_STAGE(PG8_SA(0, 0), a2, voffA);
            PG8_WAIT_V(8); PG8_WAIT_L(0); PG8_BAR; PG8_MMA(1, 0, At, B0); PG8_MMA(1, 1, At, B1); PG8_BAR; PG8_SCHED;
            PG8_LDB(B0, 1, 0); PG8_LDB(B1, 1, 1); PG8_SCHED; PG8_LDA(At, 1, 0); PG8_STAGE(PG8_SA(0, 1), a2 + hstepA, voffA);
            PG8_WAIT_V(8); PG8_WAIT_L(0); PG8_BAR; PG8_MMA(0, 0, At, B0); PG8_MMA(0, 1, At, B1); PG8_BAR; PG8_SCHED;
            PG8_LDA(At, 1, 1); PG8_STAGE(PG8_SB(1, 0), b3, voffB); PG8_STAGE(PG8_SB(1, 1), b3 + hstep, voffB); PG8_STAGE(PG8_SA(1, 0), a3, voffA);
            PG8_WAIT_V(8); PG8_WAIT_L(0); PG8_BAR; PG8_MMA(1, 0, At, B0); PG8_MMA(1, 1, At, B1); PG8_BAR; PG8_SCHED;
            } else {
            PG8_LDB(B0, 0, 0); PG8_SCHED; PG8_LDA(At, 0, 0); PG8_STAGE(PG8_SA(1, 1), a1 + hstepA, voffA);
            PG8_WAIT_L(8); PG8_BAR; PG8_WAIT_L(0); PG8_MMA(0, 0, At, B0); PG8_BAR; PG8_SCHED;
            PG8_LDB(B1, 0, 1); PG8_STAGE(PG8_SB(0, 0), b2, voffB);
            PG8_BAR; PG8_WAIT_L(0); PG8_MMA(0, 1, At, B1); PG8_BAR;
            PG8_LDA(At, 0, 1); PG8_STAGE(PG8_SA(0, 0), a2, voffA);
            PG8_BAR; PG8_WAIT_L(0); PG8_MMA(1, 0, At, B0); PG8_BAR; PG8_SCHED;
            PG8_STAGE(PG8_SB(0, 1), b2 + hstep, voffB);
            PG8_WAIT_V(6); PG8_BAR; PG8_MMA(1, 1, At, B1); PG8_BAR;
            PG8_LDB(B0, 1, 0); PG8_SCHED; PG8_LDA(At, 1, 0); PG8_STAGE(PG8_SA(0, 1), a2 + hstepA, voffA);
            PG8_WAIT_L(8); PG8_BAR; PG8_WAIT_L(0); PG8_MMA(0, 0, At, B0); PG8_BAR; PG8_SCHED;
            PG8_LDB(B1, 1, 1); PG8_STAGE(PG8_SB(1, 0), b3, voffB);
            PG8_BAR; PG8_WAIT_L(0); PG8_MMA(0, 1, At, B1); PG8_BAR;
            PG8_LDA(At, 1, 1); PG8_STAGE(PG8_SA(1, 0), a3, voffA);
            PG8_BAR; PG8_WAIT_L(0); PG8_MMA(1, 0, At, B0); PG8_BAR; PG8_SCHED;
            PG8_STAGE(PG8_SB(1, 1), b3 + hstep, voffB);
            PG8_WAIT_V(6); PG8_BAR; PG8_MMA(1, 1, At, B1); PG8_BAR;
            }
        }
        if constexpr (ALIGN_EPI) { if (wr == 0) PG8_BAR; }
        bool keep_acc = false;
        if constexpr (Epi::CHAIN) { keep_acc = E.chain(acc, cur, wr, wc, fr, fq); S.done(cur); }
        else if constexpr (!Epi::AFTER_DRAIN) { E(acc, cur, wr, wc, fr, fq); S.done(cur); }
        if (!has_next) break;
        if (!keep_acc) {
#pragma unroll
        for (int a = 0; a < 2; ++a)
#pragma unroll
            for (int b = 0; b < 2; ++b)
#pragma unroll
                for (int m = 0; m < 4; ++m)
#pragma unroll
                    for (int n = 0; n < 2; ++n) acc[a][b][m][n] = (f32x4){0.f, 0.f, 0.f, 0.f};
        }
        cur = nxt; cA = nA; cB = nB; ++ui;
        if constexpr (ALIGN_EPI) { if (wr == 1) PG8_BAR; }
    }
    PG8_WAIT_V(0);
    if constexpr (!ALIGN_EPI) { if (wr == 0) PG8_BAR; }
    PG8_BAR;
    if constexpr (Epi::AFTER_DRAIN) { E.fused(acc, cur, wr, wc, fr, fq, lds, wid, lane); S.done(cur); }
#undef PG8_AOFF
#undef PG8_SA
#undef PG8_SB
#undef PG8_STAGE
#undef PG8_LDA
#undef PG8_LDB
#undef PG8_MMA
#undef PG8_WAIT_V
#undef PG8_WAIT_L
#undef PG8_BAR
#undef PG8_SCHED
}
}

namespace attn {
using bf16 = unsigned short;
using bf16x8 = __attribute__((ext_vector_type(8))) short;
using s16x4 = __attribute__((ext_vector_type(4))) short;
using f32x16 = __attribute__((ext_vector_type(16))) float;
using u32x4 = __attribute__((ext_vector_type(4))) unsigned;
using f32x4 = __attribute__((ext_vector_type(4))) float;
constexpr int SEQ = 4096, DM = 1024, NSLOT = 6, SLOTB = 8192, NREL = 513;
constexpr int LDS_K = 0, LDS_V = NSLOT * SLOTB, LDS_WS = 2 * NSLOT * SLOTB, LDS_OST = LDS_WS + 8 * 64 * 4, LDS_BIAS = LDS_OST + 8 * 4096, BIAS_CS = 400  , LDS_BYTES = LDS_BIAS + 4 * BIAS_CS * 4;
constexpr float LOG2E = 1.4426950408889634f;
__device__ __forceinline__ int crow(int r, int hi) { return (r & 3) + 8 * (r >> 2) + 4 * hi; }
#define SBAR() __builtin_amdgcn_sched_barrier(0)
__device__ __forceinline__ void glds16(const void* gsrc, unsigned lds_dst) { unsigned keep;
  asm volatile("s_mov_b32 %0, m0\n\ts_mov_b32 m0, %2\n\ts_nop 0\n\tglobal_load_lds_dwordx4 %1, off\n\ts_mov_b32 m0, %0" : "=&s"(keep) : "v"(gsrc), "s"(lds_dst) : "memory"); }
typedef float f32x2_t __attribute__((ext_vector_type(2))); typedef __bf16 bf16x2_t __attribute__((ext_vector_type(2)));
__device__ __forceinline__ unsigned cvtpk_s(float lo, float hi) { f32x2_t v = {lo, hi}; bf16x2_t b = __builtin_convertvector(v, bf16x2_t); return __builtin_bit_cast(unsigned, b); }
typedef __attribute__((address_space(3))) const char* lds_cptr;
__device__ __forceinline__ void kload8(bf16x8* kf, lds_cptr kp) {
  kf[0] = *(const __attribute__((address_space(3))) bf16x8*)(kp);        kf[1] = *(const __attribute__((address_space(3))) bf16x8*)(kp + 512);
  kf[2] = *(const __attribute__((address_space(3))) bf16x8*)(kp + 2048); kf[3] = *(const __attribute__((address_space(3))) bf16x8*)(kp + 2560);
  kf[4] = *(const __attribute__((address_space(3))) bf16x8*)(kp + 4096); kf[5] = *(const __attribute__((address_space(3))) bf16x8*)(kp + 4608);
  kf[6] = *(const __attribute__((address_space(3))) bf16x8*)(kp + 6144); kf[7] = *(const __attribute__((address_space(3))) bf16x8*)(kp + 6656);
}
__device__ __forceinline__ void pv(f32x16* o, int vb, bf16x8 pa0, bf16x8 pa1, bf16x8 pa2, bf16x8 pa3) {
  #pragma unroll
  for (int d0 = 0; d0 < 2; ++d0) { s16x4 lo[4], hi[4];
    #pragma unroll
    for (int ks = 0; ks < 4; ++ks) {
      asm volatile("ds_read_b64_tr_b16 %0,%1 offset:%c2" : "=&v"(lo[ks]) : "v"(vb), "i"(d0 * 4096 + ks * 1024) : "memory");
      asm volatile("ds_read_b64_tr_b16 %0,%1 offset:%c2" : "=&v"(hi[ks]) : "v"(vb), "i"(d0 * 4096 + ks * 1024 + 512) : "memory"); }
    asm volatile("s_waitcnt lgkmcnt(0)" ::: "memory"); SBAR();
    #define PK(k) (bf16x8){lo[k][0], lo[k][1], lo[k][2], lo[k][3], hi[k][0], hi[k][1], hi[k][2], hi[k][3]}
    o[d0] = __builtin_amdgcn_mfma_f32_32x32x16_bf16(pa0, PK(0), o[d0], 0, 0, 0);
    o[d0] = __builtin_amdgcn_mfma_f32_32x32x16_bf16(pa1, PK(1), o[d0], 0, 0, 0);
    o[d0] = __builtin_amdgcn_mfma_f32_32x32x16_bf16(pa2, PK(2), o[d0], 0, 0, 0);
    o[d0] = __builtin_amdgcn_mfma_f32_32x32x16_bf16(pa3, PK(3), o[d0], 0, 0, 0);
    #undef PK
  }
}
__device__ __forceinline__ float wmax(float v) {
#pragma unroll
  for (int o = 1; o < 64; o <<= 1) v = fmaxf(v, __shfl_xor(v, o));
  return v;
}
__device__ __forceinline__ void attn_unit(int b, int h, int g, const bf16* Q, const bf16* __restrict__ K, const bf16* __restrict__ V, bf16* O,
                                          const float* __restrict__ relb, const float* __restrict__ gq, const float* __restrict__ gk, char* shm) {
  int tid_ = threadIdx.x; asm volatile("" : "+v"(tid_));
  const int tid = tid_, lane = tid & 63, r32 = lane & 31, hi = lane >> 5; const int wid = __builtin_amdgcn_readfirstlane(tid >> 6);
  const long rowbase = (long)b * SEQ; const int q0 = g * 256;
  const int kc_lo = (4 * g - 8) > 0 ? (4 * g - 8) : 0, NT = 4 * g + 4 - kc_lo;
  const bf16* Qw = Q + (rowbase + q0 + wid * 32) * DM + h * 64;
  const bf16* Kh = K + (rowbase + 64 * kc_lo) * DM + h * 64; const bf16* Vh = V + (rowbase + 64 * kc_lo) * DM + h * 64;
  const unsigned lds0 = (unsigned)(uintptr_t)shm;
  float* wsf = (float*)(shm + LDS_WS) + wid * 64;
  float* biasT = (float*)(shm + LDS_BIAS);
  const bf16* ksrc = Kh + (long)lane * DM + wid * 8;
  const bf16* vsrc = Vh + (long)(16 * (wid & 3) + (lane >> 2)) * DM + (wid >> 2) * 32 + (lane & 3) * 8;
  const unsigned kdst = lds0 + LDS_K + wid * 1024, vdst = lds0 + LDS_V + wid * 1024;
  #define DMA_K(t, slot) glds16(ksrc + (long)(t) * 64 * DM, (unsigned)__builtin_amdgcn_readfirstlane(kdst + (slot)))
  #define DMA_V(t, slot) glds16(vsrc + (long)(t) * 64 * DM, (unsigned)__builtin_amdgcn_readfirstlane(vdst + (slot)))
  const int vb0 = (int)(lds0 + LDS_V) + ((lane >> 4) & 1) * 32 + (lane & 3) * 8 + (4 * hi + ((lane & 15) >> 2)) * 64;
  const lds_cptr shm3 = (lds_cptr)shm; const lds_cptr kp0 = shm3 + LDS_K + hi * 1024 + r32 * 16;
  const bool full = (g >= 2); const int nsteps = full ? 9 : NT;
  #define LOAD_TILE(i) (full ? ((i) < 6 ? (((i) & 1) ? ((i) >> 1) + 9 : ((i) >> 1)) : (i) - 3) : (i))
  #define ISSUE_LOAD(i) do { const int i_ = (i); const int tl_ = LOAD_TILE(i_); const int sb_ = (i_ % NSLOT) * SLOTB; DMA_K(tl_, sb_); DMA_V(tl_, sb_); } while (0)
  bf16x8 qr[4];
  #pragma unroll
  for (int d0 = 0; d0 < 4; ++d0) qr[d0] = *reinterpret_cast<const bf16x8*>(&Qw[(long)r32 * DM + d0 * 16 + hi * 8]);
  const float gqv = gq[lane], gkv = gk[lane]; float rbv[9], tbv[3];
  #pragma unroll
  for (int k = 0; k < 9; ++k) { const int i = lane + 64 * k; rbv[k] = (i < NREL) ? relb[h * NREL + i] : -3.0e38f; }
  #pragma unroll
  for (int k = 0; k < 3; ++k) { const int i = tid + 512 * k, c = i / 384, jj = i - c * 384, e = jj + c; tbv[k] = (e < 384) ? relb[h * NREL + (e < 64 ? 512 : 576 - e)] : 0.f; }
  asm volatile("" ::: "memory");
  ISSUE_LOAD(0); ISSUE_LOAD(1); if (full) { ISSUE_LOAD(2); ISSUE_LOAD(3); }
  float m2;
  { const float mq = wmax(fabsf(gqv)), mk = wmax(fabsf(gkv)); float mb = -3.0e38f;
    #pragma unroll
    for (int k = 0; k < 9; ++k) mb = fmaxf(mb, rbv[k]);
    mb = wmax(mb); m2 = (8.0f * mq * mk + mb) * LOG2E; }
  #pragma unroll
  for (int k = 0; k < 3; ++k) { const int i = tid + 512 * k, c = i / 384, jj = i - c * 384; biasT[c * BIAS_CS + jj] = tbv[k] * LOG2E - m2; }
  f32x16 o[2]; o[0] = f32x16{}; o[1] = f32x16{}; f32x16 lsum = f32x16{};
  const int qpos = 32 * (wid & 1) + r32;
  const int cch = 4 * g + (wid >> 1);
  if (full) asm volatile("s_waitcnt vmcnt(4) lgkmcnt(0)\n\ts_barrier" ::: "memory");
  else      asm volatile("s_waitcnt vmcnt(2) lgkmcnt(0)\n\ts_barrier" ::: "memory");
  for (int s = 0; s < nsteps; ++s) {
    int nis = 0;
    if (s + 2 < nsteps) { const int s2 = s + 2; if (full) { if (s2 < 3) { ISSUE_LOAD(2 * s2); ISSUE_LOAD(2 * s2 + 1); nis = 2; } else { ISSUE_LOAD(s2 + 3); nis = 1; } } else { ISSUE_LOAD(s2); nis = 1; } }
    int jrel = kc_lo + s - cch + 8, ld = full ? (s < 3 ? 2 * s : s + 3) : s;
    if (full && s < 3 && jrel < 0) { jrel += 9; ld += 1; }
    const int sl_cur = (ld % NSLOT) * SLOTB;
    if (jrel >= 0 && jrel <= 8) {
      s16x4 vlo[8], vhi[8]; { const int vb = vb0 + sl_cur;
        #pragma unroll
        for (int i_ = 0; i_ < 8; ++i_) {
          asm volatile("ds_read_b64_tr_b16 %0,%1 offset:%c2" : "=&v"(vlo[i_]) : "v"(vb), "i"((i_ >> 2) * 4096 + (i_ & 3) * 1024) : "memory");
          asm volatile("ds_read_b64_tr_b16 %0,%1 offset:%c2" : "=&v"(vhi[i_]) : "v"(vb), "i"((i_ >> 2) * 4096 + (i_ & 3) * 1024 + 512) : "memory"); } }
      f32x16 p0, p1;
      if (jrel <= 3) { const float c0 = biasT[0];
        #pragma unroll
        for (int r = 0; r < 16; ++r) { p0[r] = c0; p1[r] = c0; } }
      else { const int i0 = 64 + 4 * hi - qpos + 64 * (jrel - 4), cs = i0 & 3; const f32x4* a4 = (const f32x4*)(biasT + cs * BIAS_CS + (i0 - cs));
        #pragma unroll
        for (int q4 = 0; q4 < 4; ++q4) { const f32x4 b0 = a4[2 * q4], b1 = a4[2 * q4 + 8];
          #pragma unroll
          for (int e = 0; e < 4; ++e) { p0[4 * q4 + e] = b0[e]; p1[4 * q4 + e] = b1[e]; } } }
      bf16x8 kf[8]; kload8(kf, kp0 + sl_cur);
      #pragma unroll
      for (int d0 = 0; d0 < 4; ++d0) { p0 = __builtin_amdgcn_mfma_f32_32x32x16_bf16(kf[2 * d0], qr[d0], p0, 0, 0, 0); p1 = __builtin_amdgcn_mfma_f32_32x32x16_bf16(kf[2 * d0 + 1], qr[d0], p1, 0, 0, 0); }
      #pragma unroll
      for (int r = 0; r < 16; ++r) { p0[r] = __builtin_amdgcn_exp2f(p0[r]); p1[r] = __builtin_amdgcn_exp2f(p1[r]); }
      lsum += p0 + p1;
      u32x4 pw0, pw1, pw2, pw3;
      pw0 = (u32x4){cvtpk_s(p0[0], p0[1]), cvtpk_s(p0[2], p0[3]), cvtpk_s(p0[4], p0[5]), cvtpk_s(p0[6], p0[7])};
      pw1 = (u32x4){cvtpk_s(p0[8], p0[9]), cvtpk_s(p0[10], p0[11]), cvtpk_s(p0[12], p0[13]), cvtpk_s(p0[14], p0[15])};
      pw2 = (u32x4){cvtpk_s(p1[0], p1[1]), cvtpk_s(p1[2], p1[3]), cvtpk_s(p1[4], p1[5]), cvtpk_s(p1[6], p1[7])};
      pw3 = (u32x4){cvtpk_s(p1[8], p1[9]), cvtpk_s(p1[10], p1[11]), cvtpk_s(p1[12], p1[13]), cvtpk_s(p1[14], p1[15])};
      SBAR();
      asm volatile("s_waitcnt lgkmcnt(0)" ::: "memory"); SBAR();
      #define VF(i_) (bf16x8){vlo[i_][0], vlo[i_][1], vlo[i_][2], vlo[i_][3], vhi[i_][0], vhi[i_][1], vhi[i_][2], vhi[i_][3]}
      o[0] = __builtin_amdgcn_mfma_f32_32x32x16_bf16(__builtin_bit_cast(bf16x8, pw0), VF(0), o[0], 0, 0, 0); o[1] = __builtin_amdgcn_mfma_f32_32x32x16_bf16(__builtin_bit_cast(bf16x8, pw0), VF(4), o[1], 0, 0, 0);
      o[0] = __builtin_amdgcn_mfma_f32_32x32x16_bf16(__builtin_bit_cast(bf16x8, pw1), VF(1), o[0], 0, 0, 0); o[1] = __builtin_amdgcn_mfma_f32_32x32x16_bf16(__builtin_bit_cast(bf16x8, pw1), VF(5), o[1], 0, 0, 0);
      o[0] = __builtin_amdgcn_mfma_f32_32x32x16_bf16(__builtin_bit_cast(bf16x8, pw2), VF(2), o[0], 0, 0, 0); o[1] = __builtin_amdgcn_mfma_f32_32x32x16_bf16(__builtin_bit_cast(bf16x8, pw2), VF(6), o[1], 0, 0, 0);
      o[0] = __builtin_amdgcn_mfma_f32_32x32x16_bf16(__builtin_bit_cast(bf16x8, pw3), VF(3), o[0], 0, 0, 0); o[1] = __builtin_amdgcn_mfma_f32_32x32x16_bf16(__builtin_bit_cast(bf16x8, pw3), VF(7), o[1], 0, 0, 0);
      #undef VF
    }
    if (nis == 2)      asm volatile("s_waitcnt vmcnt(4) lgkmcnt(0)\n\ts_barrier" ::: "memory");
    else if (nis == 1) asm volatile("s_waitcnt vmcnt(2) lgkmcnt(0)\n\ts_barrier" ::: "memory");
    else               asm volatile("s_waitcnt vmcnt(0) lgkmcnt(0)\n\ts_barrier" ::: "memory");
  }
  #undef LOAD_TILE
  #undef ISSUE_LOAD
  float l_reg = 0.f;
  #pragma unroll
  for (int r = 0; r < 16; ++r) l_reg += lsum[r];
  { auto rr = __builtin_amdgcn_permlane32_swap(__float_as_uint(l_reg), __float_as_uint(l_reg), false, false); l_reg = __uint_as_float(rr[0]) + __uint_as_float(rr[1]); }
  if (hi == 0) wsf[32 + r32] = l_reg; asm volatile("s_waitcnt lgkmcnt(0)" ::: "memory");
  float rli[16];
  #pragma unroll
  for (int r = 0; r < 16; ++r) rli[r] = __builtin_amdgcn_rcpf(wsf[32 + crow(r, hi)]);
  bf16* Ow = O + (rowbase + q0 + wid * 32) * DM + h * 64;
  { bf16* stg = (bf16*)(shm + LDS_OST) + wid * 2048;
    #pragma unroll
    for (int r = 0; r < 16; ++r) { const int orow = crow(r, hi);
      #pragma unroll
      for (int d0 = 0; d0 < 2; ++d0) stg[orow * 64 + d0 * 32 + r32] = (bf16)(cvtpk_s(o[d0][r] * rli[r], 0.f) & 0xffffu); }
    asm volatile("s_waitcnt lgkmcnt(0)" ::: "memory");
    #pragma unroll
    for (int i = 0; i < 4; ++i) { const int row = i * 8 + (lane >> 3), ch = lane & 7; const u32x4 v = *(const u32x4*)(stg + row * 64 + ch * 8); pg8::st16(Ow + (long)row * DM + ch * 8, v); } }
  asm volatile("s_waitcnt lgkmcnt(0)\n\ts_barrier" ::: "memory");
  #undef DMA_K
  #undef DMA_V
}
#undef SBAR
}

#define GAS __attribute__((address_space(1)))
#define LAS __attribute__((address_space(3)))
typedef unsigned short bf16;
typedef unsigned v4u __attribute__((ext_vector_type(4)));
typedef float f32x4 __attribute__((ext_vector_type(4)));
typedef short bf16x8 __attribute__((ext_vector_type(8)));
typedef GAS unsigned gu32;
typedef GAS unsigned long long gu64;
#define RLX_AGENT __ATOMIC_RELAXED, __HIP_MEMORY_SCOPE_AGENT
#define LDS_WAIT() asm volatile("s_waitcnt lgkmcnt(0)" ::: "memory")
#define VM_WAIT() asm volatile("s_waitcnt vmcnt(0)" ::: "memory")
__device__ __forceinline__ unsigned long long rt() { return __builtin_amdgcn_s_memrealtime(); }
#define XB_TMO      128
#define XB_XCNT(j)  (256  + 64 * (j))
#define XB_XSUB(j)  (1280 + 64 * (j))
#define XB_XGEN(j)  (2304 + 64 * (j))
#define XB_TOP      3328
#define XB_TOPGEN   3392
#define XCD_BAR_WORDS 3456
#define XB_SPIN_CAP (1u << 18)

__device__ __forceinline__ unsigned xb_ld(unsigned* p)              { return __hip_atomic_load(p, __ATOMIC_RELAXED, __HIP_MEMORY_SCOPE_AGENT); }
__device__ __forceinline__ unsigned xb_add(unsigned* p, unsigned v) { return __hip_atomic_fetch_add(p, v, __ATOMIC_RELAXED, __HIP_MEMORY_SCOPE_AGENT); }
__device__ __forceinline__ unsigned xb_xcc_id() { return (unsigned)__builtin_amdgcn_s_getreg((3 << 11) | 20) & 0xFu; }
#define XB_SPIN(cond, bar) do { unsigned _sp = 0; while (cond) { __builtin_amdgcn_s_sleep(1); \
    if ((++_sp & 255u) == 0u) { if (xb_ld(&(bar)[XB_TMO])) break; if (_sp > XB_SPIN_CAP) { atomicAdd(&(bar)[XB_TMO], 1u); break; } } } } while (0)

struct XcdBarrier {
    unsigned* bar; unsigned x;
    volatile LAS unsigned* st;
};

__device__ __forceinline__ XcdBarrier xcd_barrier_post(unsigned* bar, volatile LAS unsigned* st) {
    XcdBarrier b; b.bar = bar; b.x = xb_xcc_id(); b.st = st;
    if (threadIdx.x == 0) (void)xb_add(&bar[XB_XCNT(b.x)], 1u);
    return b;
}
__device__ __forceinline__ void xcd_barrier_complete(unsigned* bar, unsigned x, unsigned& nloc, unsigned& nx) {
    const unsigned G = gridDim.x * gridDim.y * gridDim.z;
    unsigned sum, cnt, mine, sp = 0u;
    for (;;) {
        sum = 0u; cnt = 0u; mine = 0u;
#pragma unroll
        for (unsigned j = 0; j < 16; ++j) { const unsigned c = xb_ld(&bar[XB_XCNT(j)]); sum += c; cnt += (c > 0u) ? 1u : 0u; mine = (j == x) ? c : mine; }
        if (sum == G) break;
        __builtin_amdgcn_s_sleep(1);
        if ((++sp & 255u) == 0u) { if (xb_ld(&bar[XB_TMO])) break; if (sp > XB_SPIN_CAP) { atomicAdd(&bar[XB_TMO], 1u); break; } }
    }
    nloc = mine > 0u ? mine : 1u; nx = cnt > 0u ? cnt : 1u;
}

__device__ __forceinline__ void xcd_barrier(const XcdBarrier& b) {
    asm volatile("s_waitcnt vmcnt(0)" ::: "memory");
    __syncthreads();
    if (threadIdx.x == 0) {
        unsigned* bar = b.bar;
        __builtin_amdgcn_s_waitcnt(0);
        unsigned nloc = b.st[0], nx = b.st[1];
        if (nloc == 0u) { xcd_barrier_complete(bar, b.x, nloc, nx); b.st[0] = nloc; b.st[1] = nx; }
        __builtin_amdgcn_fence(__ATOMIC_RELEASE, "agent");
        asm volatile("s_waitcnt vmcnt(0)" ::: "memory");
        const unsigned old = xb_add(&bar[XB_XSUB(b.x)], 1u);
        const unsigned gen = old / nloc;
        if (old + 1u == (gen + 1u) * nloc) {
            __builtin_amdgcn_fence(__ATOMIC_RELEASE, "agent");
            asm volatile("s_waitcnt vmcnt(0)" ::: "memory");
            const unsigned og = xb_add(&bar[XB_TOP], 1u);
            const unsigned tg = og / nx;
            if (og + 1u == (tg + 1u) * nx) xb_add(&bar[XB_TOPGEN], 1u);
            else XB_SPIN(xb_ld(&bar[XB_TOPGEN]) == tg, bar);
            __builtin_amdgcn_fence(__ATOMIC_ACQUIRE, "agent");
            xb_add(&bar[XB_XGEN(b.x)], 1u);
            asm volatile("s_waitcnt vmcnt(0)" ::: "memory");
        } else {
            XB_SPIN(xb_ld(&bar[XB_XGEN(b.x)]) == gen, bar);
            __builtin_amdgcn_fence(__ATOMIC_ACQUIRE, "agent");
            asm volatile("s_waitcnt vmcnt(0)" ::: "memory");
        }
    }
    __syncthreads();
}
#include <hip/hip_cooperative_groups.h>
namespace cg = cooperative_groups;
constexpr int NWAVES = 8;
constexpr int BATCH = 4, SEQ = 4096, D = 1024, FF = 4096, M = BATCH * SEQ, NIN = 8192;
constexpr size_t MiB = 1u << 20;
constexpr size_t WS_SS = 1 * MiB;
constexpr size_t WS_W1 = 2 * MiB, WS_WC = 18 * MiB, WS_WA = 20 * MiB  , WS_WO = 22 * MiB, WS_WUP = 24 * MiB, WS_WDN = 32 * MiB;
constexpr size_t WS_V = 40 * MiB  , WS_H = 72 * MiB  , WS_Q = 104 * MiB, WS_K = 136 * MiB  , WS_BG = 168 * MiB  , WS_U1 = 200 * MiB;
constexpr size_t WS_UU = 72 * MiB;
constexpr size_t WS_END = 232 * MiB;
constexpr int LDS_BYTES = 147456;
constexpr int LDSCTL_OFF = 131072, MISC_OFF = LDSCTL_OFF + 320;
constexpr size_t WS_CTL = 0, CTL_ZERO_BYTES = 65536; constexpr int CW_BAR = 4096;
__device__ __forceinline__ unsigned f2bf(float f) { unsigned u = __builtin_bit_cast(unsigned, f); return (u + 0x7fffu + ((u >> 16) & 1u)) >> 16; }
__device__ __forceinline__ unsigned pk2(float lo, float hi) { return f2bf(lo) | (f2bf(hi) << 16); }
__device__ __forceinline__ float wave_sum(float v) {
#pragma unroll
    for (int o = 1; o < 64; o <<= 1) v += __shfl_xor(v, o);
    return v;
}
__device__ __forceinline__ void tr_item(const float* W, int ldw, int col0, int k0, bf16* WT, int Kd, int drow0, const float* kscale, LAS float* scr, int lane) {
    float tv[32];
#pragma unroll
    for (int i = 0; i < 32; ++i) { const int kk = 2 * i + (lane >> 5); tv[i] = W[(size_t)(k0 + kk) * ldw + col0 + (lane & 31)]; }
#pragma unroll
    for (int i = 0; i < 32; ++i) { const int kk = 2 * i + (lane >> 5); float v = tv[i]; if (kscale) v *= kscale[k0 + kk]; scr[kk * 33 + (lane & 31)] = v; }
    LDS_WAIT(); asm volatile("" ::: "memory");
    const int c = lane & 7;
#pragma unroll
    for (int j = 0; j < 4; ++j) { const int n = (lane >> 3) + 8 * j; const LAS float* s = scr + (8 * c) * 33 + n;
        v4u o; o.x = pk2(s[0 * 33], s[1 * 33]); o.y = pk2(s[2 * 33], s[3 * 33]); o.z = pk2(s[4 * 33], s[5 * 33]); o.w = pk2(s[6 * 33], s[7 * 33]);
        pg8::st16(WT + (size_t)(drow0 + n) * Kd + k0 + 8 * c, o); }
    LDS_WAIT(); asm volatile("" ::: "memory");
}

#ifndef PH_MASK
#define PH_MASK 127
#endif
#ifndef REP_P1
#define REP_P1 1
#endif
#ifndef REP_ATT
#define REP_ATT 1
#endif
#ifndef REP_P3
#define REP_P3 1
#endif
#ifndef REP_P4
#define REP_P4 1
#endif
#ifndef REP_P5
#define REP_P5 1
#endif
#ifndef EXTRA_SYNC
#define EXTRA_SYNC 0
#endif
__device__ unsigned g_panel_cnt[64 * 64];
__device__ unsigned g_bar_shard[16 * 64];
__device__ unsigned g_bar_cnt = 0u, g_bar_gen = 0u, g_done_cnt = 0u;
struct Args { const float* in[16]; float* out; unsigned char* ws; };
__global__ void __launch_bounds__(NWAVES * 64, 2) fwd(Args a) {
    extern __shared__ __attribute__((aligned(16))) unsigned char lds[];
    cg::grid_group grid = cg::this_grid();
    LAS unsigned char* ldsp = (LAS unsigned char*)lds;
    const int tid = threadIdx.x, lane = tid & 63, wave = __builtin_amdgcn_readfirstlane(tid >> 6);
    const int G = gridDim.x, bx = blockIdx.x, vcu = (G % 8 == 0) ? (bx % 8) * (G / 8) + bx / 8 : bx;
    unsigned char* ws = a.ws;
    const float* x = a.in[0];
    bf16 *W1 = (bf16*)(ws + WS_W1), *WA = (bf16*)(ws + WS_WA), *WC = (bf16*)(ws + WS_WC), *WO = (bf16*)(ws + WS_WO), *WUP = (bf16*)(ws + WS_WUP), *WDN = (bf16*)(ws + WS_WDN);
    bf16 *Vb = (bf16*)(ws + WS_V), *X1B = (bf16*)(ws + WS_V), *Hb = (bf16*)(ws + WS_H), *YC = (bf16*)(ws + WS_H)  , *Qb = (bf16*)(ws + WS_Q), *AO = (bf16*)(ws + WS_Q)  , *Kb = (bf16*)(ws + WS_K), *MG = (bf16*)(ws + WS_K);
    bf16 *BG = (bf16*)(ws + WS_BG), *U1 = (bf16*)(ws + WS_U1), *UU = (bf16*)(ws + WS_UU), *Gt = (bf16*)a.out;
    float* SS = (float*)(ws + WS_SS);
    for (int u = tid; u < (LDS_BYTES - LDSCTL_OFF) / 4; u += NWAVES * 64) ((LAS unsigned*)(ldsp + LDSCTL_OFF))[u] = 0u;
    __syncthreads();
    if (a.out == nullptr) grid.sync();
#ifndef WB_AT_SEAMS
#define WB_AT_SEAMS 0
#endif
#if WB_AT_SEAMS || !WT_STORES
#define BAR_RELEASE() do { __builtin_amdgcn_fence(__ATOMIC_RELEASE, "agent"); asm volatile("s_waitcnt vmcnt(0)" ::: "memory"); } while (0)
#else
#define BAR_RELEASE() do { } while (0)
#endif
#if defined(MONO_BAR)
    const bool grouped = (G == 256);
    const unsigned NSEAMS = (grouped ? 3u : 6u) + EXTRA_SYNC;
    unsigned bar_epoch = 0u, bar_base = 0u; const unsigned bar_xcc = xb_xcc_id();
#define GRID_BAR() do { asm volatile("s_waitcnt vmcnt(0)" ::: "memory"); __syncthreads(); \
    ++bar_epoch; \
    if (tid == 0) { \
        BAR_RELEASE(); \
        unsigned old_ = xb_add(&g_bar_shard[64u * bar_xcc], 1u);     \
        if (bar_epoch == 1u) asm volatile("s_waitcnt vmcnt(0)" : "+v"(old_) :: "memory");     \
        const unsigned tgt_ = bar_epoch * (unsigned)G; unsigned sp_ = 0u; \
        for (;;) { unsigned s_ = 0u; _Pragma("unroll") for (int j_ = 0; j_ < 16; ++j_) s_ += xb_ld(&g_bar_shard[64 * j_]); \
            if (bar_epoch == 1u && sp_ == 0u) bar_base = ((s_ - 1u) / (NSEAMS * (unsigned)G)) * (NSEAMS * (unsigned)G);     \
            if (s_ - bar_base >= tgt_) break; \
            __builtin_amdgcn_s_sleep(8); if (++sp_ > (1u << 22)) break; } \
        __builtin_amdgcn_fence(__ATOMIC_ACQUIRE, "agent"); asm volatile("s_waitcnt vmcnt(0)" ::: "memory"); } \
    __syncthreads(); } while (0)
    unsigned grp_epoch = 0u, grp_base = 0u;
#define GROUP_BAR(pm_) do { asm volatile("s_waitcnt vmcnt(0)" ::: "memory"); __syncthreads(); \
    ++grp_epoch; \
    if (tid == 0) { unsigned* pc_ = &g_panel_cnt[64 * (pm_)]; \
        BAR_RELEASE(); \
        const unsigned old_ = xb_add(pc_, 1u); \
        if (grp_epoch == 1u) grp_base = old_ - old_ % 12u; \
        const unsigned tgt_ = grp_epoch * 4u; unsigned sp_ = 0u; \
        while (xb_ld(pc_) - grp_base < tgt_) { __builtin_amdgcn_s_sleep(1); if (++sp_ > (1u << 22)) break; } \
        __builtin_amdgcn_fence(__ATOMIC_ACQUIRE, "agent"); asm volatile("s_waitcnt vmcnt(0)" ::: "memory"); } \
    __syncthreads(); } while (0)
#elif defined(GEN_BAR)
#define GRID_BAR() do { asm volatile("s_waitcnt vmcnt(0)" ::: "memory"); __syncthreads(); \
    if (tid == 0) { \
        __builtin_amdgcn_fence(__ATOMIC_RELEASE, "agent"); asm volatile("s_waitcnt vmcnt(0)" ::: "memory"); \
        unsigned g0_ = xb_ld(&g_bar_gen); asm volatile("s_waitcnt vmcnt(0)" : "+v"(g0_) :: "memory");            \
        unsigned old_ = xb_add(&g_bar_cnt, 1u); asm volatile("s_waitcnt vmcnt(0)" : "+v"(old_) :: "memory"); \
        if (old_ == (unsigned)G - 1u) { __hip_atomic_store(&g_bar_cnt, 0u, RLX_AGENT); asm volatile("s_waitcnt vmcnt(0)" ::: "memory"); xb_add(&g_bar_gen, 1u); } \
        else { unsigned sp_ = 0u; while (xb_ld(&g_bar_gen) == g0_) { __builtin_amdgcn_s_sleep(1); if (++sp_ > (1u << 22)) break; } } \
        __builtin_amdgcn_fence(__ATOMIC_ACQUIRE, "agent"); asm volatile("s_waitcnt vmcnt(0)" ::: "memory"); } \
    __syncthreads(); } while (0)
#elif defined(CG_ALL)
#define GRID_BAR() do { asm volatile("s_waitcnt vmcnt(0)" ::: "memory"); grid.sync(); } while (0)
#elif defined(SIMPLE_BAR)
    unsigned bar_epoch = 0u;
#define GRID_BAR() do { asm volatile("s_waitcnt vmcnt(0)" ::: "memory"); __syncthreads(); \
    ++bar_epoch; \
    if (tid == 0) { unsigned* cnt_ = (unsigned*)(ws + WS_CTL) + CW_BAR + XB_TOP; \
        __builtin_amdgcn_fence(__ATOMIC_RELEASE, "agent"); asm volatile("s_waitcnt vmcnt(0)" ::: "memory"); \
        xb_add(cnt_, 1u); unsigned sp_ = 0u; \
        while (xb_ld(cnt_) < bar_epoch * (unsigned)G) { __builtin_amdgcn_s_sleep(1); if (++sp_ > (1u << 22)) break; } \
        __builtin_amdgcn_fence(__ATOMIC_ACQUIRE, "agent"); asm volatile("s_waitcnt vmcnt(0)" ::: "memory"); } \
    __syncthreads(); } while (0)
#else
#define GRID_BAR() xcd_barrier(bar)
#endif

#ifndef DUP_P0
#define DUP_P0 1
#endif
    for (int rep0 = 0; rep0 < DUP_P0; ++rep0) {
        LAS float* scr = (LAS float*)(ldsp + wave * 16384);
        const int gw = vcu * NWAVES + wave, NGW = G * NWAVES;
        constexpr int I_1 = 16 * 256, I_S = 16 * 32, I_UP = 16 * 128, I_DN = 64 * 32, NITEMS = I_1 + 3 * I_S + I_UP + I_DN;
        for (int it = gw; it < NITEMS; it += NGW) {
            int r = it;
            if (r < I_1) { const int db = r & 255, kb = r >> 8, pn = db >> 3, pb = db & 7, bj = pb >> 2, wcc = pb & 3; const float* W = a.in[2]; int ldw = 6144, col;
                if (pn < 4) col = (4 * pn + wcc) * 64 + 32 * bj;
                else if (pn < 8) col = 1024 + (4 * (pn - 4) + wcc) * 64 + 32 * bj;
                else if (pn < 12) col = 2048 + 256 * (pn - 8) + 32 * pb;
                else if (pn < 16) col = 3072 + 256 * (pn - 12) + 32 * pb;
                else if (pn < 24) col = (bj ? 5120 : 4096) + 128 * (pn - 16) + 32 * wcc;
                else { W = a.in[10]; ldw = 2048; col = (bj ? 1024 : 0) + 128 * (pn - 24) + 32 * wcc; }
                tr_item(W, ldw, col, 64 * kb, W1, D, 32 * db, nullptr, scr, lane); continue; } r -= I_1;
            if (r < I_S) { tr_item(a.in[8], D, 32 * (r & 31), 64 * (r >> 5), WA, D, 32 * (r & 31), nullptr, scr, lane); continue; } r -= I_S;
            if (r < I_S) { tr_item(a.in[9], D, 32 * (r & 31), 64 * (r >> 5), WC, D, 32 * (r & 31), nullptr, scr, lane); continue; } r -= I_S;
            if (r < I_S) { tr_item(a.in[12], D, 32 * (r & 31), 64 * (r >> 5), WO, D, 32 * (r & 31), nullptr, scr, lane); continue; } r -= I_S;
            if (r < I_UP) { tr_item(a.in[14], FF, 32 * (r & 127), 64 * (r >> 7), WUP, D, 32 * (r & 127), a.in[13], scr, lane); continue; } r -= I_UP;
            tr_item(a.in[15], D, 32 * (r & 31), 64 * (r >> 5), WDN, FF, 32 * (r & 31), nullptr, scr, lane);
        }
        const float* g1 = a.in[1];
        f32x4 gv[2][2];
#pragma unroll
        for (int c = 0; c < 2; ++c)
#pragma unroll
            for (int hh = 0; hh < 2; ++hh) gv[c][hh] = ((const f32x4*)g1)[c * 128 + 2 * lane + hh];
        for (int m0 = gw; m0 < M; m0 += 2 * NGW) {
            const int m1 = m0 + NGW; const bool has1 = m1 < M;
            const f32x4* xr0 = (const f32x4*)(x + (size_t)m0 * D); const f32x4* xr1 = (const f32x4*)(x + (size_t)(has1 ? m1 : m0) * D);
            f32x4 v0[2][2], v1[2][2]; float s0 = 0.f, s1 = 0.f;
#pragma unroll
            for (int c = 0; c < 2; ++c)
#pragma unroll
                for (int hh = 0; hh < 2; ++hh) { v0[c][hh] = xr0[c * 128 + 2 * lane + hh]; v1[c][hh] = xr1[c * 128 + 2 * lane + hh]; }
#pragma unroll
            for (int c = 0; c < 2; ++c)
#pragma unroll
                for (int hh = 0; hh < 2; ++hh) { const f32x4 a0 = v0[c][hh], a1 = v1[c][hh];
                    s0 += (a0.x * a0.x + a0.y * a0.y) + (a0.z * a0.z + a0.w * a0.w); s1 += (a1.x * a1.x + a1.y * a1.y) + (a1.z * a1.z + a1.w * a1.w); }
            const float rs0 = 1.0f / sqrtf(wave_sum(s0) * (1.0f / D) + 1e-6f), rs1 = 1.0f / sqrtf(wave_sum(s1) * (1.0f / D) + 1e-6f);
#pragma unroll
            for (int c = 0; c < 2; ++c) { const f32x4 y0 = v0[c][0] * rs0 * gv[c][0], y1 = v0[c][1] * rs0 * gv[c][1];
                pg8::st16(Hb + (size_t)m0 * D + c * 512 + 8 * lane, (v4u){pk2(y0.x, y0.y), pk2(y0.z, y0.w), pk2(y1.x, y1.y), pk2(y1.z, y1.w)}); }
            if (has1) {
#pragma unroll
                for (int c = 0; c < 2; ++c) { const f32x4 y0 = v1[c][0] * rs1 * gv[c][0], y1 = v1[c][1] * rs1 * gv[c][1];
                    pg8::st16(Hb + (size_t)m1 * D + c * 512 + 8 * lane, (v4u){pk2(y0.x, y0.y), pk2(y0.z, y0.w), pk2(y1.x, y1.y), pk2(y1.z, y1.w)}); } }
        }
    }
    GRID_BAR();
#if !defined(SIMPLE_BAR) && !defined(CG_ALL) && !defined(GEN_BAR) && !defined(MONO_BAR)
    const XcdBarrier bar = xcd_barrier_post((unsigned*)(ws + WS_CTL) + CW_BAR, (volatile LAS unsigned*)(ldsp + MISC_OFF) + 8);
#endif

    if (PH_MASK & 2) {
        pg8::Gemm g{Hb, W1, M, NIN, D}; pg8::StaticOrder S; S.init(M, NIN, G, bx);
        pg8::EpiP1 E{Qb, Kb, Vb, BG, U1, Gt, a.in[3], a.in[4], a.in[11]};
        pg8::gemm_phase<pg8::EpiP1, pg8::StaticOrder, true, true>(ldsp, g, S, E);
#ifdef DUP_P1
        { pg8::Gemm g2{Hb, W1, M, NIN, D}; pg8::StaticOrder S2; S2.init(M, NIN, G, bx); pg8::gemm_phase<pg8::EpiP1, pg8::StaticOrder, true, true>(ldsp, g2, S2, E); }
#endif
    }
    GRID_BAR();

    if (PH_MASK & 4) {
        for (int L = vcu; L < 1024 * REP_ATT; L += G) { const int bh = (L & 255) >> 2, gq4 = (L & 3) + 4 * ((L >> 8) & 3);
            attn::attn_unit(bh >> 4, bh & 15, gq4, Qb, Kb, Vb, AO, a.in[5], a.in[3], a.in[4], (char*)lds); }
        const float* cw = a.in[6]; const float* cb = a.in[7];
        for (int item = vcu * 512 + tid; item < 131072; item += G * 512) {
            const int c8 = (item & 127) * 8, t0 = (item >> 7) * 16;
            float w0[8], w1[8], w2[8], b0[8], u1[8], u2[8];
#pragma unroll
            for (int e = 0; e < 8; ++e) { w0[e] = cw[c8 + e]; w1[e] = cw[1024 + c8 + e]; w2[e] = cw[2048 + c8 + e]; b0[e] = cb[c8 + e]; u1[e] = 0.f; u2[e] = 0.f; }
            if ((t0 & (SEQ - 1)) != 0) { f32x4 p, q; pg8::unpack8(*(const v4u*)(U1 + (size_t)(t0 - 2) * D + c8), p, q);
#pragma unroll
                for (int e = 0; e < 4; ++e) { u2[e] = p[e]; u2[4 + e] = q[e]; }
                pg8::unpack8(*(const v4u*)(U1 + (size_t)(t0 - 1) * D + c8), p, q);
#pragma unroll
                for (int e = 0; e < 4; ++e) { u1[e] = p[e]; u1[4 + e] = q[e]; } }
            v4u ur[16], br[16];
#pragma unroll
            for (int i = 0; i < 16; ++i) { const size_t off = (size_t)(t0 + i) * D + c8; ur[i] = *(const v4u*)(U1 + off); br[i] = *(const v4u*)(BG + off); }
#pragma unroll
            for (int i = 0; i < 16; ++i) { const size_t off = (size_t)(t0 + i) * D + c8; f32x4 p, q, bp, bq; float u0[8], bgv[8], y[8];
                pg8::unpack8(ur[i], p, q); pg8::unpack8(br[i], bp, bq);
#pragma unroll
                for (int e = 0; e < 4; ++e) { u0[e] = p[e]; u0[4 + e] = q[e]; bgv[e] = bp[e]; bgv[4 + e] = bq[e]; }
#pragma unroll
                for (int e = 0; e < 8; ++e) { y[e] = bgv[e] * (b0[e] + w0[e] * u2[e] + w1[e] * u1[e] + w2[e] * u0[e]); u2[e] = u1[e]; u1[e] = u0[e]; }
                v4u o; o.x = pk2(y[0], y[1]); o.y = pk2(y[2], y[3]); o.z = pk2(y[4], y[5]); o.w = pk2(y[6], y[7]); pg8::st16(YC + off, o); }
        }
    }
    GRID_BAR();

    if (PH_MASK & 8) {
        static_assert(WS_Q == WS_H + (size_t)M * D * 2 && WS_WA == WS_WC + (size_t)D * D * 2, "P3 reads the stacked [YC ; AO] and [Wc ; Wa]");
        pg8::PairOrder S; S.S.init(M, D, G, bx);
        pg8::Gemm g{YC, WC, 2 * M, 2 * D, D}; pg8::EpiGate2 E{Gt, MG};
        pg8::gemm_phase<pg8::EpiGate2, pg8::PairOrder, true, true>(ldsp, g, S, E);
    }
    { pg8::StaticOrder S; S.init(M, D, G, bx); pg8::Unit u0; S.next(0, u0); if (grouped) GROUP_BAR(u0.pm); else GRID_BAR(); }

    if (PH_MASK & 16) {
        pg8::Gemm g{MG, WO, M, D, D}; pg8::StaticOrder S; S.init(M, D, G, bx);
        pg8::EpiRes1 E{x, a.out, X1B, SS};
        pg8::gemm_phase<pg8::EpiRes1, pg8::StaticOrder, true, true>(ldsp, g, S, E);
#ifdef DUP_P4
        pg8::gemm_phase<pg8::EpiRes1, pg8::StaticOrder, true, true>(ldsp, g, S, E);
#endif
    }
    { pg8::StaticOrder S; S.init(M, D, G, bx); pg8::Unit u0; S.next(0, u0); if (grouped) GROUP_BAR(u0.pm); else GRID_BAR(); }

    if (PH_MASK & 32) {
        pg8::Gemm g{X1B, WUP, M, FF, D}; pg8::StaticOrder S; S.init(M, FF, G, bx);
        pg8::EpiUp E{SS, UU, (size_t)M * D};
        pg8::gemm_phase<pg8::EpiUp, pg8::StaticOrder, true, true>(ldsp, g, S, E);
#ifdef DUP_P5
        pg8::gemm_phase<pg8::EpiUp, pg8::StaticOrder, true, true>(ldsp, g, S, E);
#endif
    }
    { pg8::StaticOrder S; S.init(M, D, G, bx); pg8::Unit u0; S.next(0, u0); if (grouped) GROUP_BAR(u0.pm); else GRID_BAR(); }

    for (int i = 0; i < EXTRA_SYNC; ++i) GRID_BAR();
    if (PH_MASK & 64) {
        pg8::Gemm g{UU, WDN, M, D, FF, D, 4, (size_t)M * D * 2}; pg8::StaticOrder S; S.init(M, D, G, bx);
        pg8::EpiRes2 E{a.out, X1B};
        pg8::gemm_phase<pg8::EpiRes2, pg8::StaticOrder, true, true>(ldsp, g, S, E);
    }
#if defined(MONO_BAR)
    if (wave == 0) { unsigned old_ = 0u; if (lane == 0) old_ = xb_add(&g_done_cnt, 1u);
        old_ = (unsigned)__builtin_amdgcn_readfirstlane((int)old_);
        if (old_ == (unsigned)G - 1u) { __hip_atomic_store(&g_panel_cnt[64 * lane], 0u, RLX_AGENT);
            if (lane < 16) __hip_atomic_store(&g_bar_shard[64 * lane], 0u, RLX_AGENT);
            if (lane == 0) { __hip_atomic_store(&g_bar_cnt, 0u, RLX_AGENT); __hip_atomic_store(&g_done_cnt, 0u, RLX_AGENT); } } }
#endif
}

extern "C" void kernel_launch(void* const* d_in, const int* in_sizes, int n_in, void* d_out, int out_size, void* d_ws, size_t ws_size, hipStream_t stream) {
    static int grid = 0;
    if (grid == 0) {
        if (n_in != 16 || out_size != M * D || ws_size < WS_END) { fprintf(stderr, "kernel_launch: unexpected shapes (n_in %d, out %d, ws %zu)\n", n_in, out_size, ws_size); grid = -1; return; }
        int dev = 0, cus = 0, per_cu = 0;
        (void)hipGetDevice(&dev); (void)hipDeviceGetAttribute(&cus, hipDeviceAttributeMultiprocessorCount, dev);
        if (hipFuncSetAttribute((const void*)fwd, hipFuncAttributeMaxDynamicSharedMemorySize, LDS_BYTES) != hipSuccess) { fprintf(stderr, "kernel_launch: hipFuncSetAttribute failed\n"); grid = -1; return; }
        if (hipOccupancyMaxActiveBlocksPerMultiprocessor(&per_cu, (const void*)fwd, NWAVES * 64, LDS_BYTES) != hipSuccess || per_cu < 1) { fprintf(stderr, "kernel_launch: occupancy query says %d\n", per_cu); per_cu = 1; }
        (void)hipGetLastError();
        grid = cus * 1;
    }
    if (grid < 0) return;
#if !defined(GEN_BAR) && !defined(MONO_BAR)
    if (hipMemsetAsync((char*)d_ws + WS_CTL, 0, CTL_ZERO_BYTES, stream) != hipSuccess) { fprintf(stderr, "kernel_launch: memset of the barrier words failed\n"); return; }
#endif
    Args a{};
    for (int i = 0; i < 16; ++i) a.in[i] = (const float*)d_in[i];
    a.out = (float*)d_out; a.ws = (unsigned char*)d_ws;
    void* args[] = {&a};
    hipError_t e = hipLaunchCooperativeKernel((const void*)fwd, dim3(grid), dim3(NWAVES * 64), args, LDS_BYTES, stream);
    if (e != hipSuccess) fprintf(stderr, "kernel_launch: cooperative launch failed: %s (grid %d)\n", hipGetErrorString(e), grid);
}
```

```cpp
#include <hip/hip_runtime.h>
#include <cstdio>
#include <cstdint>
#define MONO_BAR 1
namespace pg8 {
#define PG8_LAS __attribute__((address_space(3)))
typedef unsigned short bf16_t;
typedef short bf16x8 __attribute__((ext_vector_type(8)));
typedef float f32x4 __attribute__((ext_vector_type(4)));
typedef unsigned u32x4 __attribute__((ext_vector_type(4)));
constexpr int BM = 256, BK = 64, HALF = 128, HTB = HALF * BK * 2  , STAGE_BYTES = 8 * HTB, NXCD = 8, WGM = 8;

__host__ __device__ __forceinline__ int lds_byte(int r, int c) { const int st = (r >> 4) * 2 + (c >> 5), rr = r & 15, cc = c & 31, ob = rr * 64 + cc * 2; return st * 1024 + (ob ^ (((ob >> 9) & 1) << 5)); }
__host__ __device__ __forceinline__ void stage_rc(int b, int& R, int& C) { const int st = b / 1024, sb = b % 1024, swz = sb ^ (((sb >> 9) & 1) << 5); R = (st >> 1) * 16 + swz / 64; C = (st & 1) * 32 + (swz % 64) / 2; }
__host__ __device__ __forceinline__ int perm32(int rho) { const int n = rho >> 4, i = rho & 15; return 8 * (i >> 2) + 4 * n + (i & 3); }

struct Unit { int pm, pn; };
struct Gemm { const bf16_t* A; const bf16_t* Bt; int M, N, K; int lda; int segsh; size_t segstride; };

struct StaticOrder {
    int nM, nN, nwg, G, c;
    __host__ __device__ void init(int M, int N, int G_, int c_) { nM = M / BM; nN = N / BM; nwg = nM * nN; G = G_; c = c_; }
    __host__ __device__ bool next(int i, Unit& u) const {
        const long L = (long)i * G + c; if (L >= nwg) return false;
        int wgid = (int)L; { const int q = nwg / NXCD, r = nwg % NXCD, xcd = wgid % NXCD, off = wgid / NXCD; wgid = (xcd < r ? xcd * (q + 1) : r * (q + 1) + (xcd - r) * q) + off; }
        const int nig = WGM * nN, gid = wgid / nig, fm = gid * WGM, gsz = (nM - fm) < WGM ? (nM - fm) : WGM;
        u.pm = fm + ((wgid % nig) % gsz); u.pn = (wgid % nig) / gsz; return true;
    }
    __device__ __forceinline__ void a_ready(const Unit&) const {}
    __device__ __forceinline__ void done(const Unit&) const {}
};

__device__ __forceinline__ unsigned cvt_pk_bf16(float lo, float hi) { unsigned r; asm volatile("v_cvt_pk_bf16_f32 %0, %1, %2" : "=v"(r) : "v"(lo), "v"(hi)); return r; }
typedef float f32x2 __attribute__((ext_vector_type(2)));
#ifndef WT_STORES
#define WT_STORES 1
#endif
__device__ __forceinline__ void st16(void* p, u32x4 v) {
#if WT_STORES
    asm volatile("global_store_dwordx4 %0, %1, off sc1\n\ts_nop 1" :: "v"(p), "v"(v) : "memory");
#else
    *(u32x4*)p = v;
#endif
}
typedef unsigned u32x2w __attribute__((ext_vector_type(2)));
__device__ __forceinline__ void st8(void* p, u32x2w v) {
#if WT_STORES
    asm volatile("global_store_dwordx2 %0, %1, off sc1\n\ts_nop 1" :: "v"(p), "v"(v) : "memory");
#else
    *(u32x2w*)p = v;
#endif
}
typedef unsigned u32x2 __attribute__((ext_vector_type(2)));
__device__ __forceinline__ float bf_lo(unsigned w) { return __uint_as_float(w << 16); }
__device__ __forceinline__ float bf_hi(unsigned w) { return __uint_as_float(w & 0xffff0000u); }
__device__ __forceinline__ u32x4 pack8(f32x4 a, f32x4 b) { u32x4 w; w.x = cvt_pk_bf16(a[0], a[1]); w.y = cvt_pk_bf16(a[2], a[3]); w.z = cvt_pk_bf16(b[0], b[1]); w.w = cvt_pk_bf16(b[2], b[3]); return w; }
__device__ __forceinline__ void unpack8(u32x4 w, f32x4& a, f32x4& b) { a = (f32x4){bf_lo(w.x), bf_hi(w.x), bf_lo(w.y), bf_hi(w.y)}; b = (f32x4){bf_lo(w.z), bf_hi(w.z), bf_lo(w.w), bf_hi(w.w)}; }
constexpr float QK_C2 = 0.125f * 1.4426950408889634f;
constexpr float RMS_EPS = 1e-6f;

struct EpiP1 {
    static constexpr bool PERM = true, AFTER_DRAIN = false, CHAIN = false;
    bf16_t *Q, *Kb, *V, *BG, *U1, *G; const float *gq, *gk, *bgate;
    __device__ __forceinline__ void operator()(const f32x4 (&acc)[2][2][4][2], const Unit& u, int wr, int wc, int fr, int fq) const {
        const int pn = u.pn; const int row0 = u.pm * BM + wr * 64 + fr;
        if (pn < 8) {
            const bool isq = pn < 4; const float* g = isq ? gq : gk; bf16_t* O = isq ? Q : Kb; const float sc = isq ? QK_C2 : 1.f;
            const int head = 4 * (pn & 3) + wc;
            f32x4 gv[2][2];
#pragma unroll
            for (int bj = 0; bj < 2; ++bj)
#pragma unroll
                for (int n = 0; n < 2; ++n) gv[bj][n] = *(const f32x4*)(g + 32 * bj + 8 * fq + 4 * n) * sc;
#pragma unroll
            for (int ai = 0; ai < 2; ++ai)
#pragma unroll
                for (int m = 0; m < 4; ++m) {
                    float s = 0.f;
#pragma unroll
                    for (int bj = 0; bj < 2; ++bj)
#pragma unroll
                        for (int n = 0; n < 2; ++n) { const f32x4 x = acc[ai][bj][m][n]; s += (x[0] * x[0] + x[1] * x[1]) + (x[2] * x[2] + x[3] * x[3]); }
                    s += __shfl_xor(s, 16); s += __shfl_xor(s, 32);
                    const float rs = 1.0f / sqrtf(s * (1.0f / 64.0f) + RMS_EPS);
                    bf16_t* rowp = O + (size_t)(row0 + ai * HALF + m * 16) * 1024 + head * 64 + 8 * fq;
#pragma unroll
                    for (int bj = 0; bj < 2; ++bj) st16(rowp + 32 * bj, pack8(acc[ai][bj][m][0] * rs * gv[bj][0], acc[ai][bj][m][1] * rs * gv[bj][1]));
                }
        } else if (pn < 16) {
            bf16_t* O = (pn < 12) ? V : BG; const int col0 = 256 * (pn & 3) + wc * 32 + 8 * fq;
#pragma unroll
            for (int ai = 0; ai < 2; ++ai)
#pragma unroll
                for (int m = 0; m < 4; ++m) { bf16_t* rowp = O + (size_t)(row0 + ai * HALF + m * 16) * 1024 + col0;
#pragma unroll
                    for (int bj = 0; bj < 2; ++bj) st16(rowp + bj * HALF, pack8(acc[ai][bj][m][0], acc[ai][bj][m][1])); }
        } else if (pn < 24) {
            const int col0 = 128 * (pn - 16) + wc * 32 + 8 * fq;
#pragma unroll
            for (int ai = 0; ai < 2; ++ai)
#pragma unroll
                for (int m = 0; m < 4; ++m)
                    st16(U1 + (size_t)(row0 + ai * HALF + m * 16) * 1024 + col0, pack8(acc[ai][0][m][0] * acc[ai][1][m][0], acc[ai][0][m][1] * acc[ai][1][m][1]));
        } else {
            const int ch0 = 128 * (pn - 24) + wc * 32 + 8 * fq;
            f32x4 bv[2][2];
#pragma unroll
            for (int bj = 0; bj < 2; ++bj)
#pragma unroll
                for (int n = 0; n < 2; ++n) bv[bj][n] = *(const f32x4*)(bgate + 1024 * bj + ch0 + 4 * n);
#pragma unroll
            for (int ai = 0; ai < 2; ++ai)
#pragma unroll
                for (int m = 0; m < 4; ++m) { bf16_t* rowp = G + (size_t)(row0 + ai * HALF + m * 16) * 2048 + ch0; f32x4 dv[2], rv[2];
#pragma unroll
                    for (int n = 0; n < 2; ++n) { const f32x4 za = (acc[ai][0][m][n] + bv[0][n]) * (-1.4426950408889634f), zc = (acc[ai][1][m][n] + bv[1][n]) * (-1.4426950408889634f);
#pragma unroll
                        for (int e = 0; e < 4; ++e) { const float ga = __builtin_amdgcn_rcpf(1.0f + __builtin_amdgcn_exp2f(za[e])), gc = __builtin_amdgcn_rcpf(1.0f + __builtin_amdgcn_exp2f(zc[e]));
                            const float d = fmaxf(ga, 8.6736174e-19f); dv[n][e] = d; rv[n][e] = gc * __builtin_amdgcn_rcpf(d); } }
                    st16(rowp, pack8(dv[0], dv[1])); st16(rowp + 1024, pack8(rv[0], rv[1])); }
        }
    }
};
template <bool ADD> struct EpiGate {
    static constexpr bool PERM = true, AFTER_DRAIN = false, CHAIN = false;
    const bf16_t* G; bf16_t* MG; int goff;
    __device__ __forceinline__ void operator()(const f32x4 (&acc)[2][2][4][2], const Unit& u, int wr, int wc, int fr, int fq) const {
        const int row0 = u.pm * BM + wr * 64 + fr, col0 = u.pn * BM + wc * 32 + 8 * fq;
#pragma unroll
        for (int ai = 0; ai < 2; ++ai)
#pragma unroll
            for (int m = 0; m < 4; ++m) { const size_t r = (size_t)(row0 + ai * HALF + m * 16);
#pragma unroll
                for (int bj = 0; bj < 2; ++bj) { f32x4 g0, g1; unpack8(*(const u32x4*)(G + r * 2048 + goff + col0 + bj * HALF), g0, g1);
                    f32x4 v0 = acc[ai][bj][m][0] * g0, v1 = acc[ai][bj][m][1] * g1;
                    bf16_t* p = MG + r * 1024 + col0 + bj * HALF;
                    if (ADD) { f32x4 a0, a1; unpack8(*(const u32x4*)p, a0, a1); v0 += a0; v1 += a1; }
                    *(u32x4*)p = pack8(v0, v1); } }
    }
};
struct PairOrder {
    StaticOrder S;
    __device__ bool next(int i, Unit& u) const { Unit b; if (!S.next(i >> 1, b)) return false; u.pm = b.pm + ((i & 1) ? 64 : 0); u.pn = b.pn + ((i & 1) ? 4 : 0); return true; }
    __device__ __forceinline__ void a_ready(const Unit&) const {}
    __device__ __forceinline__ void done(const Unit&) const {}
};
struct EpiGate2 {
    static constexpr bool PERM = true, AFTER_DRAIN = false, CHAIN = true;
    const bf16_t* G; bf16_t* MG;
    __device__ __forceinline__ bool chain(f32x4 (&acc)[2][2][4][2], const Unit& u, int wr, int wc, int fr, int fq) const {
        const bool second = u.pm >= 64; const int pm = second ? u.pm - 64 : u.pm, pn = second ? u.pn - 4 : u.pn;
        const int row0 = pm * BM + wr * 64 + fr, col0 = pn * BM + wc * 32 + 8 * fq, goff = second ? 0 : 1024;
#pragma unroll
        for (int ai = 0; ai < 2; ++ai) {
            u32x4 gl[4][2];
#pragma unroll
            for (int m = 0; m < 4; ++m) { const size_t r = (size_t)(row0 + ai * HALF + m * 16);
#pragma unroll
                for (int bj = 0; bj < 2; ++bj) gl[m][bj] = __builtin_nontemporal_load((const u32x4*)(G + r * 2048 + goff + col0 + bj * HALF)); }
#pragma unroll
            for (int m = 0; m < 4; ++m) { const size_t r = (size_t)(row0 + ai * HALF + m * 16);
#pragma unroll
                for (int bj = 0; bj < 2; ++bj) { f32x4 g0, g1; unpack8(gl[m][bj], g0, g1);
                    if (!second) { acc[ai][bj][m][0] *= g0; acc[ai][bj][m][1] *= g1; }
                    else st16(MG + r * 1024 + col0 + bj * HALF, pack8(acc[ai][bj][m][0] * g0, acc[ai][bj][m][1] * g1)); } }
        }
        return !second;
    }
    __device__ __forceinline__ void operator()(const f32x4 (&)[2][2][4][2], const Unit&, int, int, int, int) const {}
};
#ifndef STORE_X1_F32
#define STORE_X1_F32 0
#endif
struct EpiRes1 {
    static constexpr bool PERM = true, AFTER_DRAIN = false, CHAIN = false;
    const float* x; float* out; bf16_t* x1b; float* SS;
    __device__ __forceinline__ void operator()(const f32x4 (&acc)[2][2][4][2], const Unit& u, int wr, int wc, int fr, int fq) const {
        const int row0 = u.pm * BM + wr * 64 + fr, col0 = u.pn * BM + wc * 32 + 8 * fq;
#pragma unroll
        for (int ai = 0; ai < 2; ++ai) {
            f32x4 xv[4][2][2];
#pragma unroll
            for (int m = 0; m < 4; ++m) { const size_t off = (size_t)(row0 + ai * HALF + m * 16) * 1024 + col0;
#pragma unroll
                for (int bj = 0; bj < 2; ++bj)
#pragma unroll
                    for (int n = 0; n < 2; ++n) xv[m][bj][n] = __builtin_nontemporal_load((const f32x4*)(x + off + bj * HALF + n * 4)); }
#pragma unroll
            for (int m = 0; m < 4; ++m) { const size_t r = (size_t)(row0 + ai * HALF + m * 16); const size_t off = r * 1024 + col0; float s = 0.f;
#pragma unroll
                for (int bj = 0; bj < 2; ++bj) { const f32x4 v0 = xv[m][bj][0] + acc[ai][bj][m][0], v1 = xv[m][bj][1] + acc[ai][bj][m][1];
                    if (STORE_X1_F32) { *(f32x4*)(out + off + bj * HALF) = v0; *(f32x4*)(out + off + bj * HALF + 4) = v1; }
                    s += ((v0[0] * v0[0] + v0[1] * v0[1]) + (v0[2] * v0[2] + v0[3] * v0[3])) + ((v1[0] * v1[0] + v1[1] * v1[1]) + (v1[2] * v1[2] + v1[3] * v1[3]));
                    st16(x1b + off + bj * HALF, pack8(v0, v1)); }
                s += __shfl_xor(s, 16); s += __shfl_xor(s, 32);
                if (fq == 0) __hip_atomic_store(SS + r * 16 + 4 * u.pn + wc, s, __ATOMIC_RELAXED, __HIP_MEMORY_SCOPE_AGENT); }
            asm volatile("" ::: "memory");
        }
    }
};
struct EpiUp {
    static constexpr bool PERM = true, AFTER_DRAIN = false, CHAIN = false;
    const float* SS; bf16_t* UU; size_t piece;
    __device__ __forceinline__ void operator()(const f32x4 (&acc)[2][2][4][2], const Unit& u, int wr, int wc, int fr, int fq) const {
        const int row0 = u.pm * BM + wr * 64 + fr;
        bf16_t* UUp = UU + (size_t)(u.pn >> 2) * piece + (u.pn & 3) * BM + wc * 32 + 8 * fq;
#pragma unroll
        for (int ai = 0; ai < 2; ++ai)
#pragma unroll
            for (int m = 0; m < 4; ++m) { const size_t r = (size_t)(row0 + ai * HALF + m * 16);
                const f32x4* sp = (const f32x4*)(SS + r * 16); const f32x4 s4 = (sp[0] + sp[1]) + (sp[2] + sp[3]);
                const float rs = 1.0f / sqrtf(((s4[0] + s4[1]) + (s4[2] + s4[3])) * (1.0f / 1024.0f) + RMS_EPS);
#pragma unroll
                for (int bj = 0; bj < 2; ++bj) { f32x4 v[2];
#pragma unroll
                    for (int n = 0; n < 2; ++n) { const f32x4 z = acc[ai][bj][m][n] * rs;
#pragma unroll
                        for (int e = 0; e < 4; ++e) { const float t = fmaxf(z[e], 0.f); v[n][e] = t * t; } }
                    st16(UUp + r * 1024 + bj * HALF, pack8(v[0], v[1])); } }
    }
};
struct EpiRes2 {
    static constexpr bool PERM = true, AFTER_DRAIN = false, CHAIN = false;
    float* out; const bf16_t* x1b;
    __device__ __forceinline__ void operator()(const f32x4 (&acc)[2][2][4][2], const Unit& u, int wr, int wc, int fr, int fq) const {
        const int row0 = u.pm * BM + wr * 64 + fr, col0 = u.pn * BM + wc * 32 + 8 * fq;
#pragma unroll
        for (int ai = 0; ai < 2; ++ai) {
            u32x4 bw[4][2];
#pragma unroll
            for (int m = 0; m < 4; ++m) { const size_t off = (size_t)(row0 + ai * HALF + m * 16) * 1024 + col0;
#pragma unroll
                for (int bj = 0; bj < 2; ++bj) bw[m][bj] = __builtin_nontemporal_load((const u32x4*)(x1b + off + bj * HALF)); }
#pragma unroll
            for (int m = 0; m < 4; ++m) { const size_t off = (size_t)(row0 + ai * HALF + m * 16) * 1024 + col0;
#pragma unroll
                for (int bj = 0; bj < 2; ++bj) { f32x4 b0, b1; unpack8(bw[m][bj], b0, b1); float* p = out + off + bj * HALF;
                    *(f32x4*)p = b0 + acc[ai][bj][m][0]; *(f32x4*)(p + 4) = b1 + acc[ai][bj][m][1]; } }
            asm volatile("" ::: "memory");
        }
    }
};

template <class Epi, class Sched, bool ALIGN_EPI = false, bool SP2 = false>
__device__ __forceinline__ void gemm_phase(PG8_LAS unsigned char* lds, const Gemm g, const Sched& S, const Epi& E) {
    int tid_ = threadIdx.x; asm volatile("" : "+v"(tid_));
    const int tid = tid_, wid = __builtin_amdgcn_readfirstlane(tid >> 6), lane = tid & 63, wr = wid >> 2, wc = wid & 3, fr = lane & 15, fq = lane >> 4;
    const int K = g.K, nt = K / BK;
    const int lda = g.lda ? g.lda : K, segsh = g.segsh ? g.segsh : 30;
    unsigned voffA[2], voffB[2];
#pragma unroll
    for (int i = 0; i < 2; ++i) { int R, C; stage_rc(tid * 16 + i * 8192, R, C); const int Rb = Epi::PERM ? ((R & ~31) + perm32(R & 31)) : R;
        voffA[i] = (unsigned)(R * lda + C) * 2u; voffB[i] = (unsigned)(Rb * K + C) * 2u; }
    const size_t kstep = (size_t)(BK * 2);
    const size_t hstep = (size_t)HALF * K * 2;
    const size_t tstep = 2 * hstep;
    const size_t hstepA = (size_t)HALF * lda * 2, tstepA = 2 * hstepA;
#define PG8_AOFF(t_) ((size_t)((t_) >> segsh) * g.segstride + (size_t)((t_) & ((1 << segsh) - 1)) * kstep)
    const unsigned ldsw = (unsigned)wid * 1024u;
    const int aoff = lds_byte(wr * 64 + fr, fq * 8), boff = lds_byte(wc * 32 + fr, fq * 8);
#define PG8_SA(b, h) (((b) * 2 + (h)) * HTB)
#define PG8_SB(b, h) ((4 + (b) * 2 + (h)) * HTB)
#define PG8_STAGE(bufoff, gbase, voff) do { _Pragma("unroll") for (int _i = 0; _i < 2; ++_i) \
        __builtin_amdgcn_global_load_lds((const unsigned*)((const char*)(gbase) + (voff)[_i]), (PG8_LAS unsigned*)(lds + (bufoff) + ldsw + _i * 8192), 16, 0, 0); } while (0)
#define PG8_LDA(dst, b, h) do { _Pragma("unroll") for (int m = 0; m < 4; ++m) _Pragma("unroll") for (int k = 0; k < 2; ++k) dst[m][k] = *(const PG8_LAS bf16x8*)(lds + PG8_SA(b, h) + aoff + m * 2048 + k * 1024); } while (0)
#define PG8_LDB(dst, b, h) do { _Pragma("unroll") for (int n = 0; n < 2; ++n) _Pragma("unroll") for (int k = 0; k < 2; ++k) dst[n][k] = *(const PG8_LAS bf16x8*)(lds + PG8_SB(b, h) + boff + n * 2048 + k * 1024); } while (0)
#define PG8_MMA(ai, bj, At, Bt) do { __builtin_amdgcn_s_setprio(1); _Pragma("unroll") for (int m = 0; m < 4; ++m) _Pragma("unroll") for (int n = 0; n < 2; ++n) _Pragma("unroll") for (int k = 0; k < 2; ++k) \
        acc[ai][bj][m][n] = __builtin_amdgcn_mfma_f32_16x16x32_bf16(Bt[n][k], At[m][k], acc[ai][bj][m][n], 0, 0, 0); __builtin_amdgcn_s_setprio(0); } while (0)
#define PG8_WAIT_V(n) asm volatile("s_waitcnt vmcnt(" #n ")" ::: "memory")
#define PG8_WAIT_L(n) asm volatile("s_waitcnt lgkmcnt(" #n ")" ::: "memory")
#define PG8_BAR __builtin_amdgcn_s_barrier()
#define PG8_SCHED __builtin_amdgcn_sched_barrier(0)
    Unit cur, nxt; int ui = 0;
    if (!S.next(0, cur)) return;
    f32x4 acc[2][2][4][2];
#pragma unroll
    for (int a = 0; a < 2; ++a)
#pragma unroll
        for (int b = 0; b < 2; ++b)
#pragma unroll
            for (int m = 0; m < 4; ++m)
#pragma unroll
                for (int n = 0; n < 2; ++n) acc[a][b][m][n] = (f32x4){0.f, 0.f, 0.f, 0.f};
    bf16x8 At[4][2], B0[2][2], B1[2][2];
    const char* cA = (const char*)g.A + (size_t)cur.pm * tstepA; const char* cB = (const char*)g.Bt + (size_t)cur.pn * tstep;
    S.a_ready(cur);
    if constexpr (SP2) {
        PG8_STAGE(PG8_SB(0, 0), cB, voffB); PG8_STAGE(PG8_SB(0, 1), cB + hstep, voffB); PG8_STAGE(PG8_SA(0, 0), cA, voffA); PG8_STAGE(PG8_SA(0, 1), cA + hstepA, voffA);
        if (wr == 1) PG8_BAR;
        PG8_WAIT_V(2); PG8_BAR;
        PG8_STAGE(PG8_SB(1, 0), cB + kstep, voffB); PG8_STAGE(PG8_SA(1, 0), cA + kstep, voffA); PG8_STAGE(PG8_SB(1, 1), cB + hstep + kstep, voffB);
        PG8_WAIT_V(6); PG8_BAR;
    } else {
        PG8_STAGE(PG8_SB(0, 0), cB, voffB); PG8_STAGE(PG8_SA(0, 0), cA, voffA); PG8_STAGE(PG8_SB(0, 1), cB + hstep, voffB); PG8_STAGE(PG8_SA(0, 1), cA + hstepA, voffA);
        if (wr == 1) PG8_BAR;
        PG8_WAIT_V(4); PG8_BAR;
        PG8_STAGE(PG8_SB(1, 0), cB + kstep, voffB); PG8_STAGE(PG8_SA(1, 0), cA + kstep, voffA); PG8_STAGE(PG8_SB(1, 1), cB + hstep + kstep, voffB);
        PG8_WAIT_V(6); PG8_BAR;
    }
    for (;;) {
        const bool has_next = S.next(ui + 1, nxt);
        const char* nA = has_next ? (const char*)g.A + (size_t)nxt.pm * tstepA : cA; const char* nB = has_next ? (const char*)g.Bt + (size_t)nxt.pn * tstep : cB;
        for (int t = 0; t < nt; t += 2) {
            const bool last = (t == nt - 2);
            const char* a1 = cA + PG8_AOFF(t) + kstep;
            const char* a2 = last ? nA : cA + PG8_AOFF(t + 2); const char* b2 = last ? nB : cB + (size_t)(t + 2) * kstep;
            const char* a3 = a2 + kstep; const char* b3 = b2 + kstep;
            if (last && has_next) S.a_ready(nxt);
            if constexpr (SP2) {
            PG8_LDB(B0, 0, 0); PG8_LDB(B1, 0, 1); PG8_SCHED; PG8_LDA(At, 0, 0); PG8_STAGE(PG8_SA(1, 1), a1 + hstepA, voffA);
            PG8_WAIT_V(8); PG8_WAIT_L(0); PG8_BAR; PG8_MMA(0, 0, At, B0); PG8_MMA(0, 1, At, B1); PG8_BAR; PG8_SCHED;
            PG8_LDA(At, 0, 1); PG8_STAGE(PG8_SB(0, 0), b2, voffB); PG8_STAGE(PG8_SB(0, 1), b2 + hstep, voffB); PG8_STAGE(PG8_SA(0, 0), a2, voffA);
            PG8_WAIT_V(8); PG8_WAIT_L(0); PG8_BAR; PG8_MMA(1, 0, At, B0); PG8_MMA(1, 1, At, B1); PG8_BAR; PG8_SCHED;
            PG8_LDB(B0, 1, 0); PG8_LDB(B1, 1, 1); PG8_SCHED; PG8_LDA(At, 1, 0); PG8_STAGE(PG8_SA(0, 1), a2 + hstepA, voffA);
            PG8_WAIT_V(8); PG8_WAIT_L(0); PG8_BAR; PG8_MMA(0, 0, At, B0); PG8_MMA(0, 1, At, B1); PG8_BAR; PG8_SCHED;
            PG8_LDA(At, 1, 1); PG8_STAGE(PG8_SB(1, 0), b3, voffB); PG8_STAGE(PG8_SB(1, 1), b3 + hstep, voffB); PG8_STAGE(PG8_SA(1, 0), a3, voffA);
            PG8_WAIT_V(8); PG8_WAIT_L(0); PG8_BAR; PG8_MMA(1, 0, At, B0); PG8_MMA(1, 1, At, B1); PG8_BAR; PG8_SCHED;
            } else {
            PG8_LDB(B0, 0, 0); PG8_SCHED; PG8_LDA(At, 0, 0); PG8_STAGE(PG8_SA(1, 1), a1 + hstepA, voffA);
            PG8_WAIT_L(8); PG8_BAR; PG8_WAIT_L(0); PG8_MMA(0, 0, At, B0); PG8_BAR; PG8_SCHED;
            PG8_LDB(B1, 0, 1); PG8_STAGE(PG8_SB(0, 0), b2, voffB);
            PG8_BAR; PG8_WAIT_L(0); PG8_MMA(0, 1, At, B1); PG8_BAR;
            PG8_LDA(At, 0, 1); PG8_STAGE(PG8_SA(0, 0), a2, voffA);
            PG8_BAR; PG8_WAIT_L(0); PG8_MMA(1, 0, At, B0); PG8_BAR; PG8_SCHED;
            PG8_STAGE(PG8_SB(0, 1), b2 + hstep, voffB);
            PG8_WAIT_V(6); PG8_BAR; PG8_MMA(1, 1, At, B1); PG8_BAR;
            PG8_LDB(B0, 1, 0); PG8_SCHED; PG8_LDA(At, 1, 0); PG8_STAGE(PG8_SA(0, 1), a2 + hstepA, voffA);
            PG8_WAIT_L(8); PG8_BAR; PG8_WAIT_L(0); PG8_MMA(0, 0, At, B0); PG8_BAR; PG8_SCHED;
            PG8_LDB(B1, 1, 1); PG8_STAGE(PG8_SB(1, 0), b3, voffB);
            PG8_BAR; PG8_WAIT_L(0); PG8_MMA(0, 1, At, B1); PG8_BAR;
            PG8_LDA(At, 1, 1); PG8_STAGE(PG8_SA(1, 0), a3, voffA);
            PG8_BAR; PG8_WAIT_L(0); PG8_MMA(1, 0, At, B0); PG8_BAR; PG8_SCHED;
            PG8_STAGE(PG8_SB(1, 1), b3 + hstep, voffB);
            PG8_WAIT_V(6); PG8_BAR; PG8_MMA(1, 1, At, B1); PG8_BAR;
            }
        }
        if constexpr (ALIGN_EPI) { if (wr == 0) PG8_BAR; }
        bool keep_acc = false;
        if constexpr (Epi::CHAIN) { keep_acc = E.chain(acc, cur, wr, wc, fr, fq); S.done(cur); }
        else if constexpr (!Epi::AFTER_DRAIN) { E(acc, cur, wr, wc, fr, fq); S.done(cur); }
        if (!has_next) break;
        if (!keep_acc) {
#pragma unroll
        for (int a = 0; a < 2; ++a)
#pragma unroll
            for (int b = 0; b < 2; ++b)
#pragma unroll
                for (int m = 0; m < 4; ++m)
#pragma unroll
                    for (int n = 0; n < 2; ++n) acc[a][b][m][n] = (f32x4){0.f, 0.f, 0.f, 0.f};
        }
        cur = nxt; cA = nA; cB = nB; ++ui;
        if constexpr (ALIGN_EPI) { if (wr == 1) PG8_BAR; }
    }
    PG8_WAIT_V(0);
    if constexpr (!ALIGN_EPI) { if (wr == 0) PG8_BAR; }
    PG8_BAR;
    if constexpr (Epi::AFTER_DRAIN) { E.fused(acc, cur, wr, wc, fr, fq, lds, wid, lane); S.done(cur); }
#undef PG8_AOFF
#undef PG8_SA
#undef PG8_SB
#undef PG8_STAGE
#undef PG8_LDA
#undef PG8_LDB
#undef PG8_MMA
#undef PG8_WAIT_V
#undef PG8_WAIT_L
#undef PG8_BAR
#undef PG8_SCHED
}
}

namespace attn {
using bf16 = unsigned short;
using bf16x8 = __attribute__((ext_vector_type(8))) short;
using s16x4 = __attribute__((ext_vector_type(4))) short;
using f32x16 = __attribute__((ext_vector_type(16))) float;
using u32x4 = __attribute__((ext_vector_type(4))) unsigned;
using f32x4 = __attribute__((ext_vector_type(4))) float;
constexpr int SEQ = 4096, DM = 1024, NSLOT = 6, SLOTB = 8192, NREL = 513;
constexpr int LDS_K = 0, LDS_V = NSLOT * SLOTB, LDS_WS = 2 * NSLOT * SLOTB, LDS_OST = LDS_WS + 8 * 64 * 4, LDS_BIAS = LDS_OST + 8 * 4096, BIAS_CS = 400  , LDS_BYTES = LDS_BIAS + 4 * BIAS_CS * 4;
constexpr float LOG2E = 1.4426950408889634f;
__device__ __forceinline__ int crow(int r, int hi) { return (r & 3) + 8 * (r >> 2) + 4 * hi; }
#define SBAR() __builtin_amdgcn_sched_barrier(0)
__device__ __forceinline__ void glds16(const void* gsrc, unsigned lds_dst) { unsigned keep;
  asm volatile("s_mov_b32 %0, m0\n\ts_mov_b32 m0, %2\n\ts_nop 0\n\tglobal_load_lds_dwordx4 %1, off\n\ts_mov_b32 m0, %0" : "=&s"(keep) : "v"(gsrc), "s"(lds_dst) : "memory"); }
typedef float f32x2_t __attribute__((ext_vector_type(2))); typedef __bf16 bf16x2_t __attribute__((ext_vector_type(2)));
__device__ __forceinline__ unsigned cvtpk_s(float lo, float hi) { f32x2_t v = {lo, hi}; bf16x2_t b = __builtin_convertvector(v, bf16x2_t); return __builtin_bit_cast(unsigned, b); }
typedef __attribute__((address_space(3))) const char* lds_cptr;
__device__ __forceinline__ void kload8(bf16x8* kf, lds_cptr kp) {
  kf[0] = *(const __attribute__((address_space(3))) bf16x8*)(kp);        kf[1] = *(const __attribute__((address_space(3))) bf16x8*)(kp + 512);
  kf[2] = *(const __attribute__((address_space(3))) bf16x8*)(kp + 2048); kf[3] = *(const __attribute__((address_space(3))) bf16x8*)(kp + 2560);
  kf[4] = *(const __attribute__((address_space(3))) bf16x8*)(kp + 4096); kf[5] = *(const __attribute__((address_space(3))) bf16x8*)(kp + 4608);
  kf[6] = *(const __attribute__((address_space(3))) bf16x8*)(kp + 6144); kf[7] = *(const __attribute__((address_space(3))) bf16x8*)(kp + 6656);
}
__device__ __forceinline__ void pv(f32x16* o, int vb, bf16x8 pa0, bf16x8 pa1, bf16x8 pa2, bf16x8 pa3) {
  #pragma unroll
  for (int d0 = 0; d0 < 2; ++d0) { s16x4 lo[4], hi[4];
    #pragma unroll
    for (int ks = 0; ks < 4; ++ks) {
      asm volatile("ds_read_b64_tr_b16 %0,%1 offset:%c2" : "=&v"(lo[ks]) : "v"(vb), "i"(d0 * 4096 + ks * 1024) : "memory");
      asm volatile("ds_read_b64_tr_b16 %0,%1 offset:%c2" : "=&v"(hi[ks]) : "v"(vb), "i"(d0 * 4096 + ks * 1024 + 512) : "memory"); }
    asm volatile("s_waitcnt lgkmcnt(0)" ::: "memory"); SBAR();
    #define PK(k) (bf16x8){lo[k][0], lo[k][1], lo[k][2], lo[k][3], hi[k][0], hi[k][1], hi[k][2], hi[k][3]}
    o[d0] = __builtin_amdgcn_mfma_f32_32x32x16_bf16(pa0, PK(0), o[d0], 0, 0, 0);
    o[d0] = __builtin_amdgcn_mfma_f32_32x32x16_bf16(pa1, PK(1), o[d0], 0, 0, 0);
    o[d0] = __builtin_amdgcn_mfma_f32_32x32x16_bf16(pa2, PK(2), o[d0], 0, 0, 0);
    o[d0] = __builtin_amdgcn_mfma_f32_32x32x16_bf16(pa3, PK(3), o[d0], 0, 0, 0);
    #undef PK
  }
}
__device__ __forceinline__ float wmax(float v) {
#pragma unroll
  for (int o = 1; o < 64; o <<= 1) v = fmaxf(v, __shfl_xor(v, o));
  return v;
}
__device__ __forceinline__ void attn_unit(int b, int h, int g, const bf16* Q, const bf16* __restrict__ K, const bf16* __restrict__ V, bf16* O,
                                          const float* __restrict__ relb, const float* __restrict__ gq, const float* __restrict__ gk, char* shm) {
  int tid_ = threadIdx.x; asm volatile("" : "+v"(tid_));
  const int tid = tid_, lane = tid & 63, r32 = lane & 31, hi = lane >> 5; const int wid = __builtin_amdgcn_readfirstlane(tid >> 6);
  const long rowbase = (long)b * SEQ; const int q0 = g * 256;
  const int kc_lo = (4 * g - 8) > 0 ? (4 * g - 8) : 0, NT = 4 * g + 4 - kc_lo;
  const bf16* Qw = Q + (rowbase + q0 + wid * 32) * DM + h * 64;
  const bf16* Kh = K + (rowbase + 64 * kc_lo) * DM + h * 64; const bf16* Vh = V + (rowbase + 64 * kc_lo) * DM + h * 64;
  const unsigned lds0 = (unsigned)(uintptr_t)shm;
  float* wsf = (float*)(shm + LDS_WS) + wid * 64;
  float* biasT = (float*)(shm + LDS_BIAS);
  const bf16* ksrc = Kh + (long)lane * DM + wid * 8;
  const bf16* vsrc = Vh + (long)(16 * (wid & 3) + (lane >> 2)) * DM + (wid >> 2) * 32 + (lane & 3) * 8;
  const unsigned kdst = lds0 + LDS_K + wid * 1024, vdst = lds0 + LDS_V + wid * 1024;
  #define DMA_K(t, slot) glds16(ksrc + (long)(t) * 64 * DM, (unsigned)__builtin_amdgcn_readfirstlane(kdst + (slot)))
  #define DMA_V(t, slot) glds16(vsrc + (long)(t) * 64 * DM, (unsigned)__builtin_amdgcn_readfirstlane(vdst + (slot)))
  const int vb0 = (int)(lds0 + LDS_V) + ((lane >> 4) & 1) * 32 + (lane & 3) * 8 + (4 * hi + ((lane & 15) >> 2)) * 64;
  const lds_cptr shm3 = (lds_cptr)shm; const lds_cptr kp0 = shm3 + LDS_K + hi * 1024 + r32 * 16;
  const bool full = (g >= 2); const int nsteps = full ? 9 : NT;
  #define LOAD_TILE(i) (full ? ((i) < 6 ? (((i) & 1) ? ((i) >> 1) + 9 : ((i) >> 1)) : (i) - 3) : (i))
  #define ISSUE_LOAD(i) do { const int i_ = (i); const int tl_ = LOAD_TILE(i_); const int sb_ = (i_ % NSLOT) * SLOTB; DMA_K(tl_, sb_); DMA_V(tl_, sb_); } while (0)
  bf16x8 qr[4];
  #pragma unroll
  for (int d0 = 0; d0 < 4; ++d0) qr[d0] = *reinterpret_cast<const bf16x8*>(&Qw[(long)r32 * DM + d0 * 16 + hi * 8]);
  const float gqv = gq[lane], gkv = gk[lane]; float rbv[9], tbv[3];
  #pragma unroll
  for (int k = 0; k < 9; ++k) { const int i = lane + 64 * k; rbv[k] = (i < NREL) ? relb[h * NREL + i] : -3.0e38f; }
  #pragma unroll
  for (int k = 0; k < 3; ++k) { const int i = tid + 512 * k, c = i / 384, jj = i - c * 384, e = jj + c; tbv[k] = (e < 384) ? relb[h * NREL + (e < 64 ? 512 : 576 - e)] : 0.f; }
  asm volatile("" ::: "memory");
  ISSUE_LOAD(0); ISSUE_LOAD(1); if (full) { ISSUE_LOAD(2); ISSUE_LOAD(3); }
  float m2;
  { const float mq = wmax(fabsf(gqv)), mk = wmax(fabsf(gkv)); float mb = -3.0e38f;
    #pragma unroll
    for (int k = 0; k < 9; ++k) mb = fmaxf(mb, rbv[k]);
    mb = wmax(mb); m2 = (8.0f * mq * mk + mb) * LOG2E; }
  #pragma unroll
  for (int k = 0; k < 3; ++k) { const int i = tid + 512 * k, c = i / 384, jj = i - c * 384; biasT[c * BIAS_CS + jj] = tbv[k] * LOG2E - m2; }
  f32x16 o[2]; o[0] = f32x16{}; o[1] = f32x16{}; f32x16 lsum = f32x16{};
  const int qpos = 32 * (wid & 1) + r32;
  const int cch = 4 * g + (wid >> 1);
  if (full) asm volatile("s_waitcnt vmcnt(4) lgkmcnt(0)\n\ts_barrier" ::: "memory");
  else      asm volatile("s_waitcnt vmcnt(2) lgkmcnt(0)\n\ts_barrier" ::: "memory");
  for (int s = 0; s < nsteps; ++s) {
    int nis = 0;
    if (s + 2 < nsteps) { const int s2 = s + 2; if (full) { if (s2 < 3) { ISSUE_LOAD(2 * s2); ISSUE_LOAD(2 * s2 + 1); nis = 2; } else { ISSUE_LOAD(s2 + 3); nis = 1; } } else { ISSUE_LOAD(s2); nis = 1; } }
    int jrel = kc_lo + s - cch + 8, ld = full ? (s < 3 ? 2 * s : s + 3) : s;
    if (full && s < 3 && jrel < 0) { jrel += 9; ld += 1; }
    const int sl_cur = (ld % NSLOT) * SLOTB;
    if (jrel >= 0 && jrel <= 8) {
      s16x4 vlo[8], vhi[8]; { const int vb = vb0 + sl_cur;
        #pragma unroll
        for (int i_ = 0; i_ < 8; ++i_) {
          asm volatile("ds_read_b64_tr_b16 %0,%1 offset:%c2" : "=&v"(vlo[i_]) : "v"(vb), "i"((i_ >> 2) * 4096 + (i_ & 3) * 1024) : "memory");
          asm volatile("ds_read_b64_tr_b16 %0,%1 offset:%c2" : "=&v"(vhi[i_]) : "v"(vb), "i"((i_ >> 2) * 4096 + (i_ & 3) * 1024 + 512) : "memory"); } }
      f32x16 p0, p1;
      if (jrel <= 3) { const float c0 = biasT[0];
        #pragma unroll
        for (int r = 0; r < 16; ++r) { p0[r] = c0; p1[r] = c0; } }
      else { const int i0 = 64 + 4 * hi - qpos + 64 * (jrel - 4), cs = i0 & 3; const f32x4* a4 = (const f32x4*)(biasT + cs * BIAS_CS + (i0 - cs));
        #pragma unroll
        for (int q4 = 0; q4 < 4; ++q4) { const f32x4 b0 = a4[2 * q4], b1 = a4[2 * q4 + 8];
          #pragma unroll
          for (int e = 0; e < 4; ++e) { p0[4 * q4 + e] = b0[e]; p1[4 * q4 + e] = b1[e]; } } }
      bf16x8 kf[8]; kload8(kf, kp0 + sl_cur);
      #pragma unroll
      for (int d0 = 0; d0 < 4; ++d0) { p0 = __builtin_amdgcn_mfma_f32_32x32x16_bf16(kf[2 * d0], qr[d0], p0, 0, 0, 0); p1 = __builtin_amdgcn_mfma_f32_32x32x16_bf16(kf[2 * d0 + 1], qr[d0], p1, 0, 0, 0); }
      #pragma unroll
      for (int r = 0; r < 16; ++r) { p0[r] = __builtin_amdgcn_exp2f(p0[r]); p1[r] = __builtin_amdgcn_exp2f(p1[r]); }
      lsum += p0 + p1;
      u32x4 pw0, pw1, pw2, pw3;
      pw0 = (u32x4){cvtpk_s(p0[0], p0[1]), cvtpk_s(p0[2], p0[3]), cvtpk_s(p0[4], p0[5]), cvtpk_s(p0[6], p0[7])};
      pw1 = (u32x4){cvtpk_s(p0[8], p0[9]), cvtpk_s(p0[10], p0[11]), cvtpk_s(p0[12], p0[13]), cvtpk_s(p0[14], p0[15])};
      pw2 = (u32x4){cvtpk_s(p1[0], p1[1]), cvtpk_s(p1[2], p1[3]), cvtpk_s(p1[4], p1[5]), cvtpk_s(p1[6], p1[7])};
      pw3 = (u32x4){cvtpk_s(p1[8], p1[9]), cvtpk_s(p1[10], p1[11]), cvtpk_s(p1[12], p1[13]), cvtpk_s(p1[14], p1[15])};
      SBAR();
      asm volatile("s_waitcnt lgkmcnt(0)" ::: "memory"); SBAR();
      #define VF(i_) (bf16x8){vlo[i_][0], vlo[i_][1], vlo[i_][2], vlo[i_][3], vhi[i_][0], vhi[i_][1], vhi[i_][2], vhi[i_][3]}
      o[0] = __builtin_amdgcn_mfma_f32_32x32x16_bf16(__builtin_bit_cast(bf16x8, pw0), VF(0), o[0], 0, 0, 0); o[1] = __builtin_amdgcn_mfma_f32_32x32x16_bf16(__builtin_bit_cast(bf16x8, pw0), VF(4), o[1], 0, 0, 0);
      o[0] = __builtin_amdgcn_mfma_f32_32x32x16_bf16(__builtin_bit_cast(bf16x8, pw1), VF(1), o[0], 0, 0, 0); o[1] = __builtin_amdgcn_mfma_f32_32x32x16_bf16(__builtin_bit_cast(bf16x8, pw1), VF(5), o[1], 0, 0, 0);
      o[0] = __builtin_amdgcn_mfma_f32_32x32x16_bf16(__builtin_bit_cast(bf16x8, pw2), VF(2), o[0], 0, 0, 0); o[1] = __builtin_amdgcn_mfma_f32_32x32x16_bf16(__builtin_bit_cast(bf16x8, pw2), VF(6), o[1], 0, 0, 0);
      o[0] = __builtin_amdgcn_mfma_f32_32x32x16_bf16(__builtin_bit_cast(bf16x8, pw3), VF(3), o[0], 0, 0, 0); o[1] = __builtin_amdgcn_mfma_f32_32x32x16_bf16(__builtin_bit_cast(bf16x8, pw3), VF(7), o[1], 0, 0, 0);
      #undef VF
    }
    if (nis == 2)      asm volatile("s_waitcnt vmcnt(4) lgkmcnt(0)\n\ts_barrier" ::: "memory");
    else if (nis == 1) asm volatile("s_waitcnt vmcnt(2) lgkmcnt(0)\n\ts_barrier" ::: "memory");
    else               asm volatile("s_waitcnt vmcnt(0) lgkmcnt(0)\n\ts_barrier" ::: "memory");
  }
  #undef LOAD_TILE
  #undef ISSUE_LOAD
  float l_reg = 0.f;
  #pragma unroll
  for (int r = 0; r < 16; ++r) l_reg += lsum[r];
  { auto rr = __builtin_amdgcn_permlane32_swap(__float_as_uint(l_reg), __float_as_uint(l_reg), false, false); l_reg = __uint_as_float(rr[0]) + __uint_as_float(rr[1]); }
  if (hi == 0) wsf[32 + r32] = l_reg; asm volatile("s_waitcnt lgkmcnt(0)" ::: "memory");
  float rli[16];
  #pragma unroll
  for (int r = 0; r < 16; ++r) rli[r] = __builtin_amdgcn_rcpf(wsf[32 + crow(r, hi)]);
  bf16* Ow = O + (rowbase + q0 + wid * 32) * DM + h * 64;
  { bf16* stg = (bf16*)(shm + LDS_OST) + wid * 2048;
    #pragma unroll
    for (int r = 0; r < 16; ++r) { const int orow = crow(r, hi);
      #pragma unroll
      for (int d0 = 0; d0 < 2; ++d0) stg[orow * 64 + d0 * 32 + r32] = (bf16)(cvtpk_s(o[d0][r] * rli[r], 0.f) & 0xffffu); }
    asm volatile("s_waitcnt lgkmcnt(0)" ::: "memory");
    #pragma unroll
    for (int i = 0; i < 4; ++i) { const int row = i * 8 + (lane >> 3), ch = lane & 7; const u32x4 v = *(const u32x4*)(stg + row * 64 + ch * 8); pg8::st16(Ow + (long)row * DM + ch * 8, v); } }
  asm volatile("s_waitcnt lgkmcnt(0)\n\ts_barrier" ::: "memory");
  #undef DMA_K
  #undef DMA_V
}
#undef SBAR
}

#define GAS __attribute__((address_space(1)))
#define LAS __attribute__((address_space(3)))
typedef unsigned short bf16;
typedef unsigned v4u __attribute__((ext_vector_type(4)));
typedef float f32x4 __attribute__((ext_vector_type(4)));
typedef short bf16x8 __attribute__((ext_vector_type(8)));
typedef GAS unsigned gu32;
typedef GAS unsigned long long gu64;
#define RLX_AGENT __ATOMIC_RELAXED, __HIP_MEMORY_SCOPE_AGENT
#define LDS_WAIT() asm volatile("s_waitcnt lgkmcnt(0)" ::: "memory")
#define VM_WAIT() asm volatile("s_waitcnt vmcnt(0)" ::: "memory")
__device__ __forceinline__ unsigned long long rt() { return __builtin_amdgcn_s_memrealtime(); }
#define XB_TMO      128
#define XB_XCNT(j)  (256  + 64 * (j))
#define XB_XSUB(j)  (1280 + 64 * (j))
#define XB_XGEN(j)  (2304 + 64 * (j))
#define XB_TOP      3328
#define XB_TOPGEN   3392
#define XCD_BAR_WORDS 3456
#define XB_SPIN_CAP (1u << 18)

__device__ __forceinline__ unsigned xb_ld(unsigned* p)              { return __hip_atomic_load(p, __ATOMIC_RELAXED, __HIP_MEMORY_SCOPE_AGENT); }
__device__ __forceinline__ unsigned xb_add(unsigned* p, unsigned v) { return __hip_atomic_fetch_add(p, v, __ATOMIC_RELAXED, __HIP_MEMORY_SCOPE_AGENT); }
__device__ __forceinline__ unsigned xb_xcc_id() { return (unsigned)__builtin_amdgcn_s_getreg((3 << 11) | 20) & 0xFu; }
#define XB_SPIN(cond, bar) do { unsigned _sp = 0; while (cond) { __builtin_amdgcn_s_sleep(1); \
    if ((++_sp & 255u) == 0u) { if (xb_ld(&(bar)[XB_TMO])) break; if (_sp > XB_SPIN_CAP) { atomicAdd(&(bar)[XB_TMO], 1u); break; } } } } while (0)

struct XcdBarrier {
    unsigned* bar; unsigned x;
    volatile LAS unsigned* st;
};

__device__ __forceinline__ XcdBarrier xcd_barrier_post(unsigned* bar, volatile LAS unsigned* st) {
    XcdBarrier b; b.bar = bar; b.x = xb_xcc_id(); b.st = st;
    if (threadIdx.x == 0) (void)xb_add(&bar[XB_XCNT(b.x)], 1u);
    return b;
}
__device__ __forceinline__ void xcd_barrier_complete(unsigned* bar, unsigned x, unsigned& nloc, unsigned& nx) {
    const unsigned G = gridDim.x * gridDim.y * gridDim.z;
    unsigned sum, cnt, mine, sp = 0u;
    for (;;) {
        sum = 0u; cnt = 0u; mine = 0u;
#pragma unroll
        for (unsigned j = 0; j < 16; ++j) { const unsigned c = xb_ld(&bar[XB_XCNT(j)]); sum += c; cnt += (c > 0u) ? 1u : 0u; mine = (j == x) ? c : mine; }
        if (sum == G) break;
        __builtin_amdgcn_s_sleep(1);
        if ((++sp & 255u) == 0u) { if (xb_ld(&bar[XB_TMO])) break; if (sp > XB_SPIN_CAP) { atomicAdd(&bar[XB_TMO], 1u); break; } }
    }
    nloc = mine > 0u ? mine : 1u; nx = cnt > 0u ? cnt : 1u;
}

__device__ __forceinline__ void xcd_barrier(const XcdBarrier& b) {
    asm volatile("s_waitcnt vmcnt(0)" ::: "memory");
    __syncthreads();
    if (threadIdx.x == 0) {
        unsigned* bar = b.bar;
        __builtin_amdgcn_s_waitcnt(0);
        unsigned nloc = b.st[0], nx = b.st[1];
        if (nloc == 0u) { xcd_barrier_complete(bar, b.x, nloc, nx); b.st[0] = nloc; b.st[1] = nx; }
        __builtin_amdgcn_fence(__ATOMIC_RELEASE, "agent");
        asm volatile("s_waitcnt vmcnt(0)" ::: "memory");
        const unsigned old = xb_add(&bar[XB_XSUB(b.x)], 1u);
        const unsigned gen = old / nloc;
        if (old + 1u == (gen + 1u) * nloc) {
            __builtin_amdgcn_fence(__ATOMIC_RELEASE, "agent");
            asm volatile("s_waitcnt vmcnt(0)" ::: "memory");
            const unsigned og = xb_add(&bar[XB_TOP], 1u);
            const unsigned tg = og / nx;
            if (og + 1u == (tg + 1u) * nx) xb_add(&bar[XB_TOPGEN], 1u);
            else XB_SPIN(xb_ld(&bar[XB_TOPGEN]) == tg, bar);
            __builtin_amdgcn_fence(__ATOMIC_ACQUIRE, "agent");
            xb_add(&bar[XB_XGEN(b.x)], 1u);
            asm volatile("s_waitcnt vmcnt(0)" ::: "memory");
        } else {
            XB_SPIN(xb_ld(&bar[XB_XGEN(b.x)]) == gen, bar);
            __builtin_amdgcn_fence(__ATOMIC_ACQUIRE, "agent");
            asm volatile("s_waitcnt vmcnt(0)" ::: "memory");
        }
    }
    __syncthreads();
}
#include <hip/hip_cooperative_groups.h>
namespace cg = cooperative_groups;
constexpr int NWAVES = 8;
constexpr int BATCH = 4, SEQ = 4096, D = 1024, FF = 4096, M = BATCH * SEQ, NIN = 8192;
constexpr size_t MiB = 1u << 20;
constexpr size_t WS_SS = 1 * MiB;
constexpr size_t WS_W1 = 2 * MiB, WS_WC = 18 * MiB, WS_WA = 20 * MiB  , WS_WO = 22 * MiB, WS_WUP = 24 * MiB, WS_WDN = 32 * MiB;
constexpr size_t WS_V = 40 * MiB  , WS_H = 72 * MiB  , WS_Q = 104 * MiB, WS_K = 136 * MiB  , WS_BG = 168 * MiB  , WS_U1 = 200 * MiB;
constexpr size_t WS_UU = 72 * MiB;
constexpr size_t WS_END = 232 * MiB;
constexpr int LDS_BYTES = 147456;
constexpr int LDSCTL_OFF = 131072, MISC_OFF = LDSCTL_OFF + 320;
constexpr size_t WS_CTL = 0, CTL_ZERO_BYTES = 65536; constexpr int CW_BAR = 4096;
__device__ __forceinline__ unsigned f2bf(float f) { unsigned u = __builtin_bit_cast(unsigned, f); return (u + 0x7fffu + ((u >> 16) & 1u)) >> 16; }
__device__ __forceinline__ unsigned pk2(float lo, float hi) { return f2bf(lo) | (f2bf(hi) << 16); }
__device__ __forceinline__ float wave_sum(float v) {
#pragma unroll
    for (int o = 1; o < 64; o <<= 1) v += __shfl_xor(v, o);
    return v;
}
__device__ __forceinline__ void tr_item(const float* W, int ldw, int col0, int k0, bf16* WT, int Kd, int drow0, const float* kscale, LAS float* scr, int lane) {
    float tv[32];
#pragma unroll
    for (int i = 0; i < 32; ++i) { const int kk = 2 * i + (lane >> 5); tv[i] = __builtin_nontemporal_load(W + (size_t)(k0 + kk) * ldw + col0 + (lane & 31)); }
#pragma unroll
    for (int i = 0; i < 32; ++i) { const int kk = 2 * i + (lane >> 5); float v = tv[i]; if (kscale) v *= kscale[k0 + kk]; scr[kk * 33 + (lane & 31)] = v; }
    LDS_WAIT(); asm volatile("" ::: "memory");
    const int c = lane & 7;
#pragma unroll
    for (int j = 0; j < 4; ++j) { const int n = (lane >> 3) + 8 * j; const LAS float* s = scr + (8 * c) * 33 + n;
        v4u o; o.x = pk2(s[0 * 33], s[1 * 33]); o.y = pk2(s[2 * 33], s[3 * 33]); o.z = pk2(s[4 * 33], s[5 * 33]); o.w = pk2(s[6 * 33], s[7 * 33]);
        pg8::st16(WT + (size_t)(drow0 + n) * Kd + k0 + 8 * c, o); }
    LDS_WAIT(); asm volatile("" ::: "memory");
}

#ifndef PH_MASK
#define PH_MASK 127
#endif
#ifndef REP_P1
#define REP_P1 1
#endif
#ifndef REP_ATT
#define REP_ATT 1
#endif
#ifndef REP_P3
#define REP_P3 1
#endif
#ifndef REP_P4
#define REP_P4 1
#endif
#ifndef REP_P5
#define REP_P5 1
#endif
#ifndef EXTRA_SYNC
#define EXTRA_SYNC 0
#endif
__device__ unsigned g_panel_cnt[64 * 64];
__device__ unsigned g_bar_shard[16 * 64];
__device__ unsigned g_bar_cnt = 0u, g_bar_gen = 0u, g_done_cnt = 0u;
struct Args { const float* in[16]; float* out; unsigned char* ws; };
__global__ void __launch_bounds__(NWAVES * 64, 2) fwd(Args a) {
    extern __shared__ __attribute__((aligned(16))) unsigned char lds[];
    cg::grid_group grid = cg::this_grid();
    LAS unsigned char* ldsp = (LAS unsigned char*)lds;
    const int tid = threadIdx.x, lane = tid & 63, wave = __builtin_amdgcn_readfirstlane(tid >> 6);
    const int G = gridDim.x, bx = blockIdx.x, vcu = (G % 8 == 0) ? (bx % 8) * (G / 8) + bx / 8 : bx;
    unsigned char* ws = a.ws;
    const float* x = a.in[0];
    bf16 *W1 = (bf16*)(ws + WS_W1), *WA = (bf16*)(ws + WS_WA), *WC = (bf16*)(ws + WS_WC), *WO = (bf16*)(ws + WS_WO), *WUP = (bf16*)(ws + WS_WUP), *WDN = (bf16*)(ws + WS_WDN);
    bf16 *Vb = (bf16*)(ws + WS_V), *X1B = (bf16*)(ws + WS_V), *Hb = (bf16*)(ws + WS_H), *YC = (bf16*)(ws + WS_H)  , *Qb = (bf16*)(ws + WS_Q), *AO = (bf16*)(ws + WS_Q)  , *Kb = (bf16*)(ws + WS_K), *MG = (bf16*)(ws + WS_K);
    bf16 *BG = (bf16*)(ws + WS_BG), *U1 = (bf16*)(ws + WS_U1), *UU = (bf16*)(ws + WS_UU), *Gt = (bf16*)a.out;
    float* SS = (float*)(ws + WS_SS);
    for (int u = tid; u < (LDS_BYTES - LDSCTL_OFF) / 4; u += NWAVES * 64) ((LAS unsigned*)(ldsp + LDSCTL_OFF))[u] = 0u;
    __syncthreads();
    if (a.out == nullptr) grid.sync();
#ifndef WB_AT_SEAMS
#define WB_AT_SEAMS 0
#endif
#if WB_AT_SEAMS || !WT_STORES
#define BAR_RELEASE() do { __builtin_amdgcn_fence(__ATOMIC_RELEASE, "agent"); asm volatile("s_waitcnt vmcnt(0)" ::: "memory"); } while (0)
#else
#define BAR_RELEASE() do { } while (0)
#endif
#if defined(MONO_BAR)
    const bool grouped = (G == 256);
    const unsigned NSEAMS = (grouped ? 3u : 6u) + EXTRA_SYNC;
    unsigned bar_epoch = 0u, bar_base = 0u; const unsigned bar_xcc = xb_xcc_id();
#define GRID_BAR() do { asm volatile("s_waitcnt vmcnt(0)" ::: "memory"); __syncthreads(); \
    ++bar_epoch; \
    if (tid == 0) { \
        BAR_RELEASE(); \
        unsigned old_ = xb_add(&g_bar_shard[64u * bar_xcc], 1u);     \
        if (bar_epoch == 1u) asm volatile("s_waitcnt vmcnt(0)" : "+v"(old_) :: "memory");     \
        const unsigned tgt_ = bar_epoch * (unsigned)G; unsigned sp_ = 0u; \
        for (;;) { unsigned s_ = 0u; _Pragma("unroll") for (int j_ = 0; j_ < 16; ++j_) s_ += xb_ld(&g_bar_shard[64 * j_]); \
            if (bar_epoch == 1u && sp_ == 0u) bar_base = ((s_ - 1u) / (NSEAMS * (unsigned)G)) * (NSEAMS * (unsigned)G);     \
            if (s_ - bar_base >= tgt_) break; \
            __builtin_amdgcn_s_sleep(8); if (++sp_ > (1u << 22)) break; } \
        __builtin_amdgcn_fence(__ATOMIC_ACQUIRE, "agent"); asm volatile("s_waitcnt vmcnt(0)" ::: "memory"); } \
    __syncthreads(); } while (0)
    unsigned grp_epoch = 0u, grp_base = 0u;
#define GROUP_BAR(pm_) do { asm volatile("s_waitcnt vmcnt(0)" ::: "memory"); __syncthreads(); \
    ++grp_epoch; \
    if (tid == 0) { unsigned* pc_ = &g_panel_cnt[64 * (pm_)]; \
        BAR_RELEASE(); \
        const unsigned old_ = xb_add(pc_, 1u); \
        if (grp_epoch == 1u) grp_base = old_ - old_ % 12u; \
        const unsigned tgt_ = grp_epoch * 4u; unsigned sp_ = 0u; \
        while (xb_ld(pc_) - grp_base < tgt_) { __builtin_amdgcn_s_sleep(1); if (++sp_ > (1u << 22)) break; } \
        __builtin_amdgcn_fence(__ATOMIC_ACQUIRE, "agent"); asm volatile("s_waitcnt vmcnt(0)" ::: "memory"); } \
    __syncthreads(); } while (0)
#elif defined(GEN_BAR)
#define GRID_BAR() do { asm volatile("s_waitcnt vmcnt(0)" ::: "memory"); __syncthreads(); \
    if (tid == 0) { \
        __builtin_amdgcn_fence(__ATOMIC_RELEASE, "agent"); asm volatile("s_waitcnt vmcnt(0)" ::: "memory"); \
        unsigned g0_ = xb_ld(&g_bar_gen); asm volatile("s_waitcnt vmcnt(0)" : "+v"(g0_) :: "memory");            \
        unsigned old_ = xb_add(&g_bar_cnt, 1u); asm volatile("s_waitcnt vmcnt(0)" : "+v"(old_) :: "memory"); \
        if (old_ == (unsigned)G - 1u) { __hip_atomic_store(&g_bar_cnt, 0u, RLX_AGENT); asm volatile("s_waitcnt vmcnt(0)" ::: "memory"); xb_add(&g_bar_gen, 1u); } \
        else { unsigned sp_ = 0u; while (xb_ld(&g_bar_gen) == g0_) { __builtin_amdgcn_s_sleep(1); if (++sp_ > (1u << 22)) break; } } \
        __builtin_amdgcn_fence(__ATOMIC_ACQUIRE, "agent"); asm volatile("s_waitcnt vmcnt(0)" ::: "memory"); } \
    __syncthreads(); } while (0)
#elif defined(CG_ALL)
#define GRID_BAR() do { asm volatile("s_waitcnt vmcnt(0)" ::: "memory"); grid.sync(); } while (0)
#elif defined(SIMPLE_BAR)
    unsigned bar_epoch = 0u;
#define GRID_BAR() do { asm volatile("s_waitcnt vmcnt(0)" ::: "memory"); __syncthreads(); \
    ++bar_epoch; \
    if (tid == 0) { unsigned* cnt_ = (unsigned*)(ws + WS_CTL) + CW_BAR + XB_TOP; \
        __builtin_amdgcn_fence(__ATOMIC_RELEASE, "agent"); asm volatile("s_waitcnt vmcnt(0)" ::: "memory"); \
        xb_add(cnt_, 1u); unsigned sp_ = 0u; \
        while (xb_ld(cnt_) < bar_epoch * (unsigned)G) { __builtin_amdgcn_s_sleep(1); if (++sp_ > (1u << 22)) break; } \
        __builtin_amdgcn_fence(__ATOMIC_ACQUIRE, "agent"); asm volatile("s_waitcnt vmcnt(0)" ::: "memory"); } \
    __syncthreads(); } while (0)
#else
#define GRID_BAR() xcd_barrier(bar)
#endif

#ifndef DUP_P0
#define DUP_P0 1
#endif
    for (int rep0 = 0; rep0 < DUP_P0; ++rep0) {
        LAS float* scr = (LAS float*)(ldsp + wave * 16384);
        const int gw = vcu * NWAVES + wave, NGW = G * NWAVES;
        constexpr int I_1 = 16 * 256, I_S = 16 * 32, I_UP = 16 * 128, I_DN = 64 * 32, NITEMS = I_1 + 3 * I_S + I_UP + I_DN;
        for (int it = gw; it < NITEMS; it += NGW) {
            int r = it;
            if (r < I_1) { const int db = r & 255, kb = r >> 8, pn = db >> 3, pb = db & 7, bj = pb >> 2, wcc = pb & 3; const float* W = a.in[2]; int ldw = 6144, col;
                if (pn < 4) col = (4 * pn + wcc) * 64 + 32 * bj;
                else if (pn < 8) col = 1024 + (4 * (pn - 4) + wcc) * 64 + 32 * bj;
                else if (pn < 12) col = 2048 + 256 * (pn - 8) + 32 * pb;
                else if (pn < 16) col = 3072 + 256 * (pn - 12) + 32 * pb;
                else if (pn < 24) col = (bj ? 5120 : 4096) + 128 * (pn - 16) + 32 * wcc;
                else { W = a.in[10]; ldw = 2048; col = (bj ? 1024 : 0) + 128 * (pn - 24) + 32 * wcc; }
                tr_item(W, ldw, col, 64 * kb, W1, D, 32 * db, nullptr, scr, lane); continue; } r -= I_1;
            if (r < I_S) { tr_item(a.in[8], D, 32 * (r & 31), 64 * (r >> 5), WA, D, 32 * (r & 31), nullptr, scr, lane); continue; } r -= I_S;
            if (r < I_S) { tr_item(a.in[9], D, 32 * (r & 31), 64 * (r >> 5), WC, D, 32 * (r & 31), nullptr, scr, lane); continue; } r -= I_S;
            if (r < I_S) { tr_item(a.in[12], D, 32 * (r & 31), 64 * (r >> 5), WO, D, 32 * (r & 31), nullptr, scr, lane); continue; } r -= I_S;
            if (r < I_UP) { tr_item(a.in[14], FF, 32 * (r & 127), 64 * (r >> 7), WUP, D, 32 * (r & 127), a.in[13], scr, lane); continue; } r -= I_UP;
            tr_item(a.in[15], D, 32 * (r & 31), 64 * (r >> 5), WDN, FF, 32 * (r & 31), nullptr, scr, lane);
        }
        const float* g1 = a.in[1];
        f32x4 gv[2][2];
#pragma unroll
        for (int c = 0; c < 2; ++c)
#pragma unroll
            for (int hh = 0; hh < 2; ++hh) gv[c][hh] = ((const f32x4*)g1)[c * 128 + 2 * lane + hh];
        for (int m0 = gw; m0 < M; m0 += 2 * NGW) {
            const int m1 = m0 + NGW; const bool has1 = m1 < M;
            const f32x4* xr0 = (const f32x4*)(x + (size_t)m0 * D); const f32x4* xr1 = (const f32x4*)(x + (size_t)(has1 ? m1 : m0) * D);
            f32x4 v0[2][2], v1[2][2]; float s0 = 0.f, s1 = 0.f;
#pragma unroll
            for (int c = 0; c < 2; ++c)
#pragma unroll
                for (int hh = 0; hh < 2; ++hh) { v0[c][hh] = __builtin_nontemporal_load(xr0 + c * 128 + 2 * lane + hh); v1[c][hh] = __builtin_nontemporal_load(xr1 + c * 128 + 2 * lane + hh); }
#pragma unroll
            for (int c = 0; c < 2; ++c)
#pragma unroll
                for (int hh = 0; hh < 2; ++hh) { const f32x4 a0 = v0[c][hh], a1 = v1[c][hh];
                    s0 += (a0.x * a0.x + a0.y * a0.y) + (a0.z * a0.z + a0.w * a0.w); s1 += (a1.x * a1.x + a1.y * a1.y) + (a1.z * a1.z + a1.w * a1.w); }
            const float rs0 = 1.0f / sqrtf(wave_sum(s0) * (1.0f / D) + 1e-6f), rs1 = 1.0f / sqrtf(wave_sum(s1) * (1.0f / D) + 1e-6f);
#pragma unroll
            for (int c = 0; c < 2; ++c) { const f32x4 y0 = v0[c][0] * rs0 * gv[c][0], y1 = v0[c][1] * rs0 * gv[c][1];
                pg8::st16(Hb + (size_t)m0 * D + c * 512 + 8 * lane, (v4u){pk2(y0.x, y0.y), pk2(y0.z, y0.w), pk2(y1.x, y1.y), pk2(y1.z, y1.w)}); }
            if (has1) {
#pragma unroll
                for (int c = 0; c < 2; ++c) { const f32x4 y0 = v1[c][0] * rs1 * gv[c][0], y1 = v1[c][1] * rs1 * gv[c][1];
                    pg8::st16(Hb + (size_t)m1 * D + c * 512 + 8 * lane, (v4u){pk2(y0.x, y0.y), pk2(y0.z, y0.w), pk2(y1.x, y1.y), pk2(y1.z, y1.w)}); } }
        }
    }
    GRID_BAR();
#if !defined(SIMPLE_BAR) && !defined(CG_ALL) && !defined(GEN_BAR) && !defined(MONO_BAR)
    const XcdBarrier bar = xcd_barrier_post((unsigned*)(ws + WS_CTL) + CW_BAR, (volatile LAS unsigned*)(ldsp + MISC_OFF) + 8);
#endif

    if (PH_MASK & 2) {
        pg8::Gemm g{Hb, W1, M, NIN, D}; pg8::StaticOrder S; S.init(M, NIN, G, bx);
        pg8::EpiP1 E{Qb, Kb, Vb, BG, U1, Gt, a.in[3], a.in[4], a.in[11]};
        pg8::gemm_phase<pg8::EpiP1, pg8::StaticOrder, true, true>(ldsp, g, S, E);
#ifdef DUP_P1
        { pg8::Gemm g2{Hb, W1, M, NIN, D}; pg8::StaticOrder S2; S2.init(M, NIN, G, bx); pg8::gemm_phase<pg8::EpiP1, pg8::StaticOrder, true, true>(ldsp, g2, S2, E); }
#endif
    }
    GRID_BAR();

    if (PH_MASK & 4) {
        for (int L = vcu; L < 1024 * REP_ATT; L += G) { const int bh = (L & 255) >> 2, gq4 = (L & 3) + 4 * ((L >> 8) & 3);
            attn::attn_unit(bh >> 4, bh & 15, gq4, Qb, Kb, Vb, AO, a.in[5], a.in[3], a.in[4], (char*)lds); }
        const float* cw = a.in[6]; const float* cb = a.in[7];
        for (int item = vcu * 512 + tid; item < 131072; item += G * 512) {
            const int c8 = (item & 127) * 8, t0 = (item >> 7) * 16;
            float w0[8], w1[8], w2[8], b0[8], u1[8], u2[8];
#pragma unroll
            for (int e = 0; e < 8; ++e) { w0[e] = cw[c8 + e]; w1[e] = cw[1024 + c8 + e]; w2[e] = cw[2048 + c8 + e]; b0[e] = cb[c8 + e]; u1[e] = 0.f; u2[e] = 0.f; }
            if ((t0 & (SEQ - 1)) != 0) { f32x4 p, q; pg8::unpack8(*(const v4u*)(U1 + (size_t)(t0 - 2) * D + c8), p, q);
#pragma unroll
                for (int e = 0; e < 4; ++e) { u2[e] = p[e]; u2[4 + e] = q[e]; }
                pg8::unpack8(*(const v4u*)(U1 + (size_t)(t0 - 1) * D + c8), p, q);
#pragma unroll
                for (int e = 0; e < 4; ++e) { u1[e] = p[e]; u1[4 + e] = q[e]; } }
            v4u ur[16], br[16];
#pragma unroll
            for (int i = 0; i < 16; ++i) { const size_t off = (size_t)(t0 + i) * D + c8; ur[i] = __builtin_nontemporal_load((const v4u*)(U1 + off)); br[i] = __builtin_nontemporal_load((const v4u*)(BG + off)); }
#pragma unroll
            for (int i = 0; i < 16; ++i) { const size_t off = (size_t)(t0 + i) * D + c8; f32x4 p, q, bp, bq; float u0[8], bgv[8], y[8];
                pg8::unpack8(ur[i], p, q); pg8::unpack8(br[i], bp, bq);
#pragma unroll
                for (int e = 0; e < 4; ++e) { u0[e] = p[e]; u0[4 + e] = q[e]; bgv[e] = bp[e]; bgv[4 + e] = bq[e]; }
#pragma unroll
                for (int e = 0; e < 8; ++e) { y[e] = bgv[e] * (b0[e] + w0[e] * u2[e] + w1[e] * u1[e] + w2[e] * u0[e]); u2[e] = u1[e]; u1[e] = u0[e]; }
                v4u o; o.x = pk2(y[0], y[1]); o.y = pk2(y[2], y[3]); o.z = pk2(y[4], y[5]); o.w = pk2(y[6], y[7]); pg8::st16(YC + off, o); }
        }
    }
    GRID_BAR();

    if (PH_MASK & 8) {
        static_assert(WS_Q == WS_H + (size_t)M * D * 2 && WS_WA == WS_WC + (size_t)D * D * 2, "P3 reads the stacked [YC ; AO] and [Wc ; Wa]");
        pg8::PairOrder S; S.S.init(M, D, G, bx);
        pg8::Gemm g{YC, WC, 2 * M, 2 * D, D}; pg8::EpiGate2 E{Gt, MG};
        pg8::gemm_phase<pg8::EpiGate2, pg8::PairOrder, true, true>(ldsp, g, S, E);
    }
    { pg8::StaticOrder S; S.init(M, D, G, bx); pg8::Unit u0; S.next(0, u0); if (grouped) GROUP_BAR(u0.pm); else GRID_BAR(); }

    if (PH_MASK & 16) {
        pg8::Gemm g{MG, WO, M, D, D}; pg8::StaticOrder S; S.init(M, D, G, bx);
        pg8::EpiRes1 E{x, a.out, X1B, SS};
        pg8::gemm_phase<pg8::EpiRes1, pg8::StaticOrder, true, true>(ldsp, g, S, E);
#ifdef DUP_P4
        pg8::gemm_phase<pg8::EpiRes1, pg8::StaticOrder, true, true>(ldsp, g, S, E);
#endif
    }
    { pg8::StaticOrder S; S.init(M, D, G, bx); pg8::Unit u0; S.next(0, u0); if (grouped) GROUP_BAR(u0.pm); else GRID_BAR(); }

    if (PH_MASK & 32) {
        pg8::Gemm g{X1B, WUP, M, FF, D}; pg8::StaticOrder S; S.init(M, FF, G, bx);
        pg8::EpiUp E{SS, UU, (size_t)M * D};
        pg8::gemm_phase<pg8::EpiUp, pg8::StaticOrder, true, true>(ldsp, g, S, E);
#ifdef DUP_P5
        pg8::gemm_phase<pg8::EpiUp, pg8::StaticOrder, true, true>(ldsp, g, S, E);
#endif
    }
    { pg8::StaticOrder S; S.init(M, D, G, bx); pg8::Unit u0; S.next(0, u0); if (grouped) GROUP_BAR(u0.pm); else GRID_BAR(); }

    for (int i = 0; i < EXTRA_SYNC; ++i) GRID_BAR();
    if (PH_MASK & 64) {
        pg8::Gemm g{UU, WDN, M, D, FF, D, 4, (size_t)M * D * 2}; pg8::StaticOrder S; S.init(M, D, G, bx);
        pg8::EpiRes2 E{a.out, X1B};
        pg8::gemm_phase<pg8::EpiRes2, pg8::StaticOrder, true, true>(ldsp, g, S, E);
    }
#if defined(MONO_BAR)
    if (wave == 0) { unsigned old_ = 0u; if (lane == 0) old_ = xb_add(&g_done_cnt, 1u);
        old_ = (unsigned)__builtin_amdgcn_readfirstlane((int)old_);
        if (old_ == (unsigned)G - 1u) { __hip_atomic_store(&g_panel_cnt[64 * lane], 0u, RLX_AGENT);
            if (lane < 16) __hip_atomic_store(&g_bar_shard[64 * lane], 0u, RLX_AGENT);
            if (lane == 0) { __hip_atomic_store(&g_bar_cnt, 0u, RLX_AGENT); __hip_atomic_store(&g_done_cnt, 0u, RLX_AGENT); } } }
#endif
}

extern "C" void kernel_launch(void* const* d_in, const int* in_sizes, int n_in, void* d_out, int out_size, void* d_ws, size_t ws_size, hipStream_t stream) {
    static int grid = 0;
    if (grid == 0) {
        if (n_in != 16 || out_size != M * D || ws_size < WS_END) { fprintf(stderr, "kernel_launch: unexpected shapes (n_in %d, out %d, ws %zu)\n", n_in, out_size, ws_size); grid = -1; return; }
        int dev = 0, cus = 0, per_cu = 0;
        (void)hipGetDevice(&dev); (void)hipDeviceGetAttribute(&cus, hipDeviceAttributeMultiprocessorCount, dev);
        if (hipFuncSetAttribute((const void*)fwd, hipFuncAttributeMaxDynamicSharedMemorySize, LDS_BYTES) != hipSuccess) { fprintf(stderr, "kernel_launch: hipFuncSetAttribute failed\n"); grid = -1; return; }
        if (hipOccupancyMaxActiveBlocksPerMultiprocessor(&per_cu, (const void*)fwd, NWAVES * 64, LDS_BYTES) != hipSuccess || per_cu < 1) { fprintf(stderr, "kernel_launch: occupancy query says %d\n", per_cu); per_cu = 1; }
        (void)hipGetLastError();
        grid = cus * 1;
    }
    if (grid < 0) return;
#if !defined(GEN_BAR) && !defined(MONO_BAR)
    if (hipMemsetAsync((char*)d_ws + WS_CTL, 0, CTL_ZERO_BYTES, stream) != hipSuccess) { fprintf(stderr, "kernel_launch: memset of the barrier words failed\n"); return; }
#endif
    Args a{};
    for (int i = 0; i < 16; ++i) a.in[i] = (const float*)d_in[i];
    a.out = (float*)d_out; a.ws = (unsigned char*)d_ws;
    void* args[] = {&a};
    hipError_t e = hipLaunchCooperativeKernel((const void*)fwd, dim3(grid), dim3(NWAVES * 64), args, LDS_BYTES, stream);
    if (e != hipSuccess) fprintf(stderr, "kernel_launch: cooperative launch failed: %s (grid %d)\n", hipGetErrorString(e), grid);
}
```

```cpp
#include <hip/hip_runtime.h>
#include <cstdio>
#include <cstdint>
#define MONO_BAR 1
namespace pg8 {
#define PG8_LAS __attribute__((address_space(3)))
typedef unsigned short bf16_t;
typedef short bf16x8 __attribute__((ext_vector_type(8)));
typedef float f32x4 __attribute__((ext_vector_type(4)));
typedef unsigned u32x4 __attribute__((ext_vector_type(4)));
constexpr int BM = 256, BK = 64, HALF = 128, HTB = HALF * BK * 2  , STAGE_BYTES = 8 * HTB, NXCD = 8, WGM = 8;

__host__ __device__ __forceinline__ int lds_byte(int r, int c) { const int st = (r >> 4) * 2 + (c >> 5), rr = r & 15, cc = c & 31, ob = rr * 64 + cc * 2; return st * 1024 + (ob ^ (((ob >> 9) & 1) << 5)); }
__host__ __device__ __forceinline__ void stage_rc(int b, int& R, int& C) { const int st = b / 1024, sb = b % 1024, swz = sb ^ (((sb >> 9) & 1) << 5); R = (st >> 1) * 16 + swz / 64; C = (st & 1) * 32 + (swz % 64) / 2; }
__host__ __device__ __forceinline__ int perm32(int rho) { const int n = rho >> 4, i = rho & 15; return 8 * (i >> 2) + 4 * n + (i & 3); }

struct Unit { int pm, pn; };
struct Gemm { const bf16_t* A; const bf16_t* Bt; int M, N, K; int lda; int segsh; size_t segstride; };

struct StaticOrder {
    int nM, nN, nwg, G, c;
    __host__ __device__ void init(int M, int N, int G_, int c_) { nM = M / BM; nN = N / BM; nwg = nM * nN; G = G_; c = c_; }
    __host__ __device__ bool next(int i, Unit& u) const {
        const long L = (long)i * G + c; if (L >= nwg) return false;
        int wgid = (int)L; { const int q = nwg / NXCD, r = nwg % NXCD, xcd = wgid % NXCD, off = wgid / NXCD; wgid = (xcd < r ? xcd * (q + 1) : r * (q + 1) + (xcd - r) * q) + off; }
        const int nig = WGM * nN, gid = wgid / nig, fm = gid * WGM, gsz = (nM - fm) < WGM ? (nM - fm) : WGM;
        u.pm = fm + ((wgid % nig) % gsz); u.pn = (wgid % nig) / gsz; return true;
    }
    __device__ __forceinline__ void a_ready(const Unit&) const {}
    __device__ __forceinline__ void done(const Unit&) const {}
};

__device__ __forceinline__ unsigned cvt_pk_bf16(float lo, float hi) { unsigned r; asm volatile("v_cvt_pk_bf16_f32 %0, %1, %2" : "=v"(r) : "v"(lo), "v"(hi)); return r; }
typedef float f32x2 __attribute__((ext_vector_type(2)));
#ifndef WT_STORES
#define WT_STORES 1
#endif
__device__ __forceinline__ void st16(void* p, u32x4 v) {
#if WT_STORES
    asm volatile("global_store_dwordx4 %0, %1, off sc1\n\ts_nop 1" :: "v"(p), "v"(v) : "memory");
#else
    *(u32x4*)p = v;
#endif
}
__device__ __forceinline__ void st16nt(void* p, u32x4 v) {
    asm volatile("global_store_dwordx4 %0, %1, off sc1 nt\n\ts_nop 1" :: "v"(p), "v"(v) : "memory");
}
typedef unsigned u32x2w __attribute__((ext_vector_type(2)));
__device__ __forceinline__ void st8(void* p, u32x2w v) {
#if WT_STORES
    asm volatile("global_store_dwordx2 %0, %1, off sc1\n\ts_nop 1" :: "v"(p), "v"(v) : "memory");
#else
    *(u32x2w*)p = v;
#endif
}
typedef unsigned u32x2 __attribute__((ext_vector_type(2)));
__device__ __forceinline__ float bf_lo(unsigned w) { return __uint_as_float(w << 16); }
__device__ __forceinline__ float bf_hi(unsigned w) { return __uint_as_float(w & 0xffff0000u); }
__device__ __forceinline__ u32x4 pack8(f32x4 a, f32x4 b) { u32x4 w; w.x = cvt_pk_bf16(a[0], a[1]); w.y = cvt_pk_bf16(a[2], a[3]); w.z = cvt_pk_bf16(b[0], b[1]); w.w = cvt_pk_bf16(b[2], b[3]); return w; }
__device__ __forceinline__ void unpack8(u32x4 w, f32x4& a, f32x4& b) { a = (f32x4){bf_lo(w.x), bf_hi(w.x), bf_lo(w.y), bf_hi(w.y)}; b = (f32x4){bf_lo(w.z), bf_hi(w.z), bf_lo(w.w), bf_hi(w.w)}; }
constexpr float QK_C2 = 0.125f * 1.4426950408889634f;
constexpr float RMS_EPS = 1e-6f;

struct EpiP1 {
    static constexpr bool PERM = true, AFTER_DRAIN = false, CHAIN = false;
    bf16_t *Q, *Kb, *V, *BG, *U1, *G; const float *gq, *gk, *bgate;
    __device__ __forceinline__ void operator()(const f32x4 (&acc)[2][2][4][2], const Unit& u, int wr, int wc, int fr, int fq) const {
        const int pn = u.pn; const int row0 = u.pm * BM + wr * 64 + fr;
        if (pn < 8) {
            const bool isq = pn < 4; const float* g = isq ? gq : gk; bf16_t* O = isq ? Q : Kb; const float sc = isq ? QK_C2 : 1.f;
            const int head = 4 * (pn & 3) + wc;
            f32x4 gv[2][2];
#pragma unroll
            for (int bj = 0; bj < 2; ++bj)
#pragma unroll
                for (int n = 0; n < 2; ++n) gv[bj][n] = *(const f32x4*)(g + 32 * bj + 8 * fq + 4 * n) * sc;
#pragma unroll
            for (int ai = 0; ai < 2; ++ai)
#pragma unroll
                for (int m = 0; m < 4; ++m) {
                    float s = 0.f;
#pragma unroll
                    for (int bj = 0; bj < 2; ++bj)
#pragma unroll
                        for (int n = 0; n < 2; ++n) { const f32x4 x = acc[ai][bj][m][n]; s += (x[0] * x[0] + x[1] * x[1]) + (x[2] * x[2] + x[3] * x[3]); }
                    s += __shfl_xor(s, 16); s += __shfl_xor(s, 32);
                    const float rs = 1.0f / sqrtf(s * (1.0f / 64.0f) + RMS_EPS);
                    bf16_t* rowp = O + (size_t)(row0 + ai * HALF + m * 16) * 1024 + head * 64 + 8 * fq;
#pragma unroll
                    for (int bj = 0; bj < 2; ++bj) st16(rowp + 32 * bj, pack8(acc[ai][bj][m][0] * rs * gv[bj][0], acc[ai][bj][m][1] * rs * gv[bj][1]));
                }
        } else if (pn < 16) {
            bf16_t* O = (pn < 12) ? V : BG; const int col0 = 256 * (pn & 3) + wc * 32 + 8 * fq;
#pragma unroll
            for (int ai = 0; ai < 2; ++ai)
#pragma unroll
                for (int m = 0; m < 4; ++m) { bf16_t* rowp = O + (size_t)(row0 + ai * HALF + m * 16) * 1024 + col0;
#pragma unroll
                    for (int bj = 0; bj < 2; ++bj) { if (pn < 12) st16(rowp + bj * HALF, pack8(acc[ai][bj][m][0], acc[ai][bj][m][1])); else st16nt(rowp + bj * HALF, pack8(acc[ai][bj][m][0], acc[ai][bj][m][1])); } }
        } else if (pn < 24) {
            const int col0 = 128 * (pn - 16) + wc * 32 + 8 * fq;
#pragma unroll
            for (int ai = 0; ai < 2; ++ai)
#pragma unroll
                for (int m = 0; m < 4; ++m)
                    st16nt(U1 + (size_t)(row0 + ai * HALF + m * 16) * 1024 + col0, pack8(acc[ai][0][m][0] * acc[ai][1][m][0], acc[ai][0][m][1] * acc[ai][1][m][1]));
        } else {
            const int ch0 = 128 * (pn - 24) + wc * 32 + 8 * fq;
            f32x4 bv[2][2];
#pragma unroll
            for (int bj = 0; bj < 2; ++bj)
#pragma unroll
                for (int n = 0; n < 2; ++n) bv[bj][n] = *(const f32x4*)(bgate + 1024 * bj + ch0 + 4 * n);
#pragma unroll
            for (int ai = 0; ai < 2; ++ai)
#pragma unroll
                for (int m = 0; m < 4; ++m) { bf16_t* rowp = G + (size_t)(row0 + ai * HALF + m * 16) * 2048 + ch0; f32x4 dv[2], rv[2];
#pragma unroll
                    for (int n = 0; n < 2; ++n) { const f32x4 za = (acc[ai][0][m][n] + bv[0][n]) * (-1.4426950408889634f), zc = (acc[ai][1][m][n] + bv[1][n]) * (-1.4426950408889634f);
#pragma unroll
                        for (int e = 0; e < 4; ++e) { const float ga = __builtin_amdgcn_rcpf(1.0f + __builtin_amdgcn_exp2f(za[e])), gc = __builtin_amdgcn_rcpf(1.0f + __builtin_amdgcn_exp2f(zc[e]));
                            const float d = fmaxf(ga, 8.6736174e-19f); dv[n][e] = d; rv[n][e] = gc * __builtin_amdgcn_rcpf(d); } }
                    st16nt(rowp, pack8(dv[0], dv[1])); st16nt(rowp + 1024, pack8(rv[0], rv[1])); }
        }
    }
};
template <bool ADD> struct EpiGate {
    static constexpr bool PERM = true, AFTER_DRAIN = false, CHAIN = false;
    const bf16_t* G; bf16_t* MG; int goff;
    __device__ __forceinline__ void operator()(const f32x4 (&acc)[2][2][4][2], const Unit& u, int wr, int wc, int fr, int fq) const {
        const int row0 = u.pm * BM + wr * 64 + fr, col0 = u.pn * BM + wc * 32 + 8 * fq;
#pragma unroll
        for (int ai = 0; ai < 2; ++ai)
#pragma unroll
            for (int m = 0; m < 4; ++m) { const size_t r = (size_t)(row0 + ai * HALF + m * 16);
#pragma unroll
                for (int bj = 0; bj < 2; ++bj) { f32x4 g0, g1; unpack8(*(const u32x4*)(G + r * 2048 + goff + col0 + bj * HALF), g0, g1);
                    f32x4 v0 = acc[ai][bj][m][0] * g0, v1 = acc[ai][bj][m][1] * g1;
                    bf16_t* p = MG + r * 1024 + col0 + bj * HALF;
                    if (ADD) { f32x4 a0, a1; unpack8(*(const u32x4*)p, a0, a1); v0 += a0; v1 += a1; }
                    *(u32x4*)p = pack8(v0, v1); } }
    }
};
struct PairOrder {
    StaticOrder S;
    __device__ bool next(int i, Unit& u) const { Unit b; if (!S.next(i >> 1, b)) return false; u.pm = b.pm + ((i & 1) ? 64 : 0); u.pn = b.pn + ((i & 1) ? 4 : 0); return true; }
    __device__ __forceinline__ void a_ready(const Unit&) const {}
    __device__ __forceinline__ void done(const Unit&) const {}
};
struct EpiGate2 {
    static constexpr bool PERM = true, AFTER_DRAIN = false, CHAIN = true;
    const bf16_t* G; bf16_t* MG;
    __device__ __forceinline__ bool chain(f32x4 (&acc)[2][2][4][2], const Unit& u, int wr, int wc, int fr, int fq) const {
        const bool second = u.pm >= 64; const int pm = second ? u.pm - 64 : u.pm, pn = second ? u.pn - 4 : u.pn;
        const int row0 = pm * BM + wr * 64 + fr, col0 = pn * BM + wc * 32 + 8 * fq, goff = second ? 0 : 1024;
#pragma unroll
        for (int ai = 0; ai < 2; ++ai) {
            u32x4 gl[4][2];
#pragma unroll
            for (int m = 0; m < 4; ++m) { const size_t r = (size_t)(row0 + ai * HALF + m * 16);
#pragma unroll
                for (int bj = 0; bj < 2; ++bj) gl[m][bj] = __builtin_nontemporal_load((const u32x4*)(G + r * 2048 + goff + col0 + bj * HALF)); }
#pragma unroll
            for (int m = 0; m < 4; ++m) { const size_t r = (size_t)(row0 + ai * HALF + m * 16);
#pragma unroll
                for (int bj = 0; bj < 2; ++bj) { f32x4 g0, g1; unpack8(gl[m][bj], g0, g1);
                    if (!second) { acc[ai][bj][m][0] *= g0; acc[ai][bj][m][1] *= g1; }
                    else st16(MG + r * 1024 + col0 + bj * HALF, pack8(acc[ai][bj][m][0] * g0, acc[ai][bj][m][1] * g1)); } }
        }
        return !second;
    }
    __device__ __forceinline__ void operator()(const f32x4 (&)[2][2][4][2], const Unit&, int, int, int, int) const {}
};
#ifndef STORE_X1_F32
#define STORE_X1_F32 0
#endif
struct EpiRes1 {
    static constexpr bool PERM = true, AFTER_DRAIN = false, CHAIN = false;
    const float* x; float* out; bf16_t* x1b; float* SS;
    __device__ __forceinline__ void operator()(const f32x4 (&acc)[2][2][4][2], const Unit& u, int wr, int wc, int fr, int fq) const {
        const int row0 = u.pm * BM + wr * 64 + fr, col0 = u.pn * BM + wc * 32 + 8 * fq;
#pragma unroll
        for (int ai = 0; ai < 2; ++ai) {
            f32x4 xv[4][2][2];
#pragma unroll
            for (int m = 0; m < 4; ++m) { const size_t off = (size_t)(row0 + ai * HALF + m * 16) * 1024 + col0;
#pragma unroll
                for (int bj = 0; bj < 2; ++bj)
#pragma unroll
                    for (int n = 0; n < 2; ++n) xv[m][bj][n] = __builtin_nontemporal_load((const f32x4*)(x + off + bj * HALF + n * 4)); }
#pragma unroll
            for (int m = 0; m < 4; ++m) { const size_t r = (size_t)(row0 + ai * HALF + m * 16); const size_t off = r * 1024 + col0; float s = 0.f;
#pragma unroll
                for (int bj = 0; bj < 2; ++bj) { const f32x4 v0 = xv[m][bj][0] + acc[ai][bj][m][0], v1 = xv[m][bj][1] + acc[ai][bj][m][1];
                    if (STORE_X1_F32) { *(f32x4*)(out + off + bj * HALF) = v0; *(f32x4*)(out + off + bj * HALF + 4) = v1; }
                    s += ((v0[0] * v0[0] + v0[1] * v0[1]) + (v0[2] * v0[2] + v0[3] * v0[3])) + ((v1[0] * v1[0] + v1[1] * v1[1]) + (v1[2] * v1[2] + v1[3] * v1[3]));
                    st16(x1b + off + bj * HALF, pack8(v0, v1)); }
                s += __shfl_xor(s, 16); s += __shfl_xor(s, 32);
                if (fq == 0) __hip_atomic_store(SS + r * 16 + 4 * u.pn + wc, s, __ATOMIC_RELAXED, __HIP_MEMORY_SCOPE_AGENT); }
            asm volatile("" ::: "memory");
        }
    }
};
struct EpiUp {
    static constexpr bool PERM = true, AFTER_DRAIN = false, CHAIN = false;
    const float* SS; bf16_t* UU; size_t piece;
    __device__ __forceinline__ void operator()(const f32x4 (&acc)[2][2][4][2], const Unit& u, int wr, int wc, int fr, int fq) const {
        const int row0 = u.pm * BM + wr * 64 + fr;
        bf16_t* UUp = UU + (size_t)(u.pn >> 2) * piece + (u.pn & 3) * BM + wc * 32 + 8 * fq;
#pragma unroll
        for (int ai = 0; ai < 2; ++ai)
#pragma unroll
            for (int m = 0; m < 4; ++m) { const size_t r = (size_t)(row0 + ai * HALF + m * 16);
                const f32x4* sp = (const f32x4*)(SS + r * 16); const f32x4 s4 = (sp[0] + sp[1]) + (sp[2] + sp[3]);
                const float rs = 1.0f / sqrtf(((s4[0] + s4[1]) + (s4[2] + s4[3])) * (1.0f / 1024.0f) + RMS_EPS);
#pragma unroll
                for (int bj = 0; bj < 2; ++bj) { f32x4 v[2];
#pragma unroll
                    for (int n = 0; n < 2; ++n) { const f32x4 z = acc[ai][bj][m][n] * rs;
#pragma unroll
                        for (int e = 0; e < 4; ++e) { const float t = fmaxf(z[e], 0.f); v[n][e] = t * t; } }
                    st16(UUp + r * 1024 + bj * HALF, pack8(v[0], v[1])); } }
    }
};
struct EpiRes2 {
    static constexpr bool PERM = true, AFTER_DRAIN = false, CHAIN = false;
    float* out; const bf16_t* x1b;
    __device__ __forceinline__ void operator()(const f32x4 (&acc)[2][2][4][2], const Unit& u, int wr, int wc, int fr, int fq) const {
        const int row0 = u.pm * BM + wr * 64 + fr, col0 = u.pn * BM + wc * 32 + 8 * fq;
#pragma unroll
        for (int ai = 0; ai < 2; ++ai) {
            u32x4 bw[4][2];
#pragma unroll
            for (int m = 0; m < 4; ++m) { const size_t off = (size_t)(row0 + ai * HALF + m * 16) * 1024 + col0;
#pragma unroll
                for (int bj = 0; bj < 2; ++bj) bw[m][bj] = __builtin_nontemporal_load((const u32x4*)(x1b + off + bj * HALF)); }
#pragma unroll
            for (int m = 0; m < 4; ++m) { const size_t off = (size_t)(row0 + ai * HALF + m * 16) * 1024 + col0;
#pragma unroll
                for (int bj = 0; bj < 2; ++bj) { f32x4 b0, b1; unpack8(bw[m][bj], b0, b1); float* p = out + off + bj * HALF;
                    *(f32x4*)p = b0 + acc[ai][bj][m][0]; *(f32x4*)(p + 4) = b1 + acc[ai][bj][m][1]; } }
            asm volatile("" ::: "memory");
        }
    }
};

template <class Epi, class Sched, bool ALIGN_EPI = false, bool SP2 = false>
__device__ __forceinline__ void gemm_phase(PG8_LAS unsigned char* lds, const Gemm g, const Sched& S, const Epi& E) {
    int tid_ = threadIdx.x; asm volatile("" : "+v"(tid_));
    const int tid = tid_, wid = __builtin_amdgcn_readfirstlane(tid >> 6), lane = tid & 63, wr = wid >> 2, wc = wid & 3, fr = lane & 15, fq = lane >> 4;
    const int K = g.K, nt = K / BK;
    const int lda = g.lda ? g.lda : K, segsh = g.segsh ? g.segsh : 30;
    unsigned voffA[2], voffB[2];
#pragma unroll
    for (int i = 0; i < 2; ++i) { int R, C; stage_rc(tid * 16 + i * 8192, R, C); const int Rb = Epi::PERM ? ((R & ~31) + perm32(R & 31)) : R;
        voffA[i] = (unsigned)(R * lda + C) * 2u; voffB[i] = (unsigned)(Rb * K + C) * 2u; }
    const size_t kstep = (size_t)(BK * 2);
    const size_t hstep = (size_t)HALF * K * 2;
    const size_t tstep = 2 * hstep;
    const size_t hstepA = (size_t)HALF * lda * 2, tstepA = 2 * hstepA;
#define PG8_AOFF(t_) ((size_t)((t_) >> segsh) * g.segstride + (size_t)((t_) & ((1 << segsh) - 1)) * kstep)
    const unsigned ldsw = (unsigned)wid * 1024u;
    const int aoff = lds_byte(wr * 64 + fr, fq * 8), boff = lds_byte(wc * 32 + fr, fq * 8);
#define PG8_SA(b, h) (((b) * 2 + (h)) * HTB)
#define PG8_SB(b, h) ((4 + (b) * 2 + (h)) * HTB)
#define PG8_STAGE(bufoff, gbase, voff) do { _Pragma("unroll") for (int _i = 0; _i < 2; ++_i) \
        __builtin_amdgcn_global_load_lds((const unsigned*)((const char*)(gbase) + (voff)[_i]), (PG8_LAS unsigned*)(lds + (bufoff) + ldsw + _i * 8192), 16, 0, 0); } while (0)
#define PG8_LDA(dst, b, h) do { _Pragma("unroll") for (int m = 0; m < 4; ++m) _Pragma("unroll") for (int k = 0; k < 2; ++k) dst[m][k] = *(const PG8_LAS bf16x8*)(lds + PG8_SA(b, h) + aoff + m * 2048 + k * 1024); } while (0)
#define PG8_LDB(dst, b, h) do { _Pragma("unroll") for (int n = 0; n < 2; ++n) _Pragma("unroll") for (int k = 0; k < 2; ++k) dst[n][k] = *(const PG8_LAS bf16x8*)(lds + PG8_SB(b, h) + boff + n * 2048 + k * 1024); } while (0)
#define PG8_MMA(ai, bj, At, Bt) do { __builtin_amdgcn_s_setprio(1); _Pragma("unroll") for (int m = 0; m < 4; ++m) _Pragma("unroll") for (int n = 0; n < 2; ++n) _Pragma("unroll") for (int k = 0; k < 2; ++k) \
        acc[ai][bj][m][n] = __builtin_amdgcn_mfma_f32_16x16x32_bf16(Bt[n][k], At[m][k], acc[ai][bj][m][n], 0, 0, 0); __builtin_amdgcn_s_setprio(0); } while (0)
#define PG8_WAIT_V(n) asm volatile("s_waitcnt vmcnt(" #n ")" ::: "memory")
#define PG8_WAIT_L(n) asm volatile("s_waitcnt lgkmcnt(" #n ")" ::: "memory")
#define PG8_BAR __builtin_amdgcn_s_barrier()
#define PG8_SCHED __builtin_amdgcn_sched_barrier(0)
    Unit cur, nxt; int ui = 0;
    if (!S.next(0, cur)) return;
    f32x4 acc[2][2][4][2];
#pragma unroll
    for (int a = 0; a < 2; ++a)
#pragma unroll
        for (int b = 0; b < 2; ++b)
#pragma unroll
            for (int m = 0; m < 4; ++m)
#pragma unroll
                for (int n = 0; n < 2; ++n) acc[a][b][m][n] = (f32x4){0.f, 0.f, 0.f, 0.f};
    bf16x8 At[4][2], B0[2][2], B1[2][2];
    const char* cA = (const char*)g.A + (size_t)cur.pm * tstepA; const char* cB = (const char*)g.Bt + (size_t)cur.pn * tstep;
    S.a_ready(cur);
    if constexpr (SP2) {
        PG8_STAGE(PG8_SB(0, 0), cB, voffB); PG8_STAGE(PG8_SB(0, 1), cB + hstep, voffB); PG8_STAGE(PG8_SA(0, 0), cA, voffA); PG8_STAGE(PG8_SA(0, 1), cA + hstepA, voffA);
        if (wr == 1) PG8_BAR;
        PG8_WAIT_V(2); PG8_BAR;
        PG8_STAGE(PG8_SB(1, 0), cB + kstep, voffB); PG8_STAGE(PG8_SA(1, 0), cA + kstep, voffA); PG8_STAGE(PG8_SB(1, 1), cB + hstep + kstep, voffB);
        PG8_WAIT_V(6); PG8_BAR;
    } else {
        PG8_STAGE(PG8_SB(0, 0), cB, voffB); PG8_STAGE(PG8_SA(0, 0), cA, voffA); PG8_STAGE(PG8_SB(0, 1), cB + hstep, voffB); PG8_STAGE(PG8_SA(0, 1), cA + hstepA, voffA);
        if (wr == 1) PG8_BAR;
        PG8_WAIT_V(4); PG8_BAR;
        PG8_STAGE(PG8_SB(1, 0), cB + kstep, voffB); PG8_STAGE(PG8_SA(1, 0), cA + kstep, voffA); PG8_STAGE(PG8_SB(1, 1), cB + hstep + kstep, voffB);
        PG8_WAIT_V(6); PG8_BAR;
    }
    for (;;) {
        const bool has_next = S.next(ui + 1, nxt);
        const char* nA = has_next ? (const char*)g.A + (size_t)nxt.pm * tstepA : cA; const char* nB = has_next ? (const char*)g.Bt + (size_t)nxt.pn * tstep : cB;
        for (int t = 0; t < nt; t += 2) {
            const bool last = (t == nt - 2);
            const char* a1 = cA + PG8_AOFF(t) + kstep;
            const char* a2 = last ? nA : cA + PG8_AOFF(t + 2); const char* b2 = last ? nB : cB + (size_t)(t + 2) * kstep;
            const char* a3 = a2 + kstep; const char* b3 = b2 + kstep;
            if (last && has_next) S.a_ready(nxt);
            if constexpr (SP2) {
            PG8_LDB(B0, 0, 0); PG8_LDB(B1, 0, 1); PG8_SCHED; PG8_LDA(At, 0, 0); PG8_STAGE(PG8_SA(1, 1), a1 + hstepA, voffA);
            PG8_WAIT_V(8); PG8_WAIT_L(0); PG8_BAR; PG8_MMA(0, 0, At, B0); PG8_MMA(0, 1, At, B1); PG8_BAR; PG8_SCHED;
            PG8_LDA(At, 0, 1); PG8_STAGE(PG8_SB(0, 0), b2, voffB); PG8_STAGE(PG8_SB(0, 1), b2 + hstep, voffB); PG8_STAGE(PG8_SA(0, 0), a2, voffA);
            PG8_WAIT_V(8); PG8_WAIT_L(0); PG8_BAR; PG8_MMA(1, 0, At, B0); PG8_MMA(1, 1, At, B1); PG8_BAR; PG8_SCHED;
            PG8_LDB(B0, 1, 0); PG8_LDB(B1, 1, 1); PG8_SCHED; PG8_LDA(At, 1, 0); PG8_STAGE(PG8_SA(0, 1), a2 + hstepA, voffA);
            PG8_WAIT_V(8); PG8_WAIT_L(0); PG8_BAR; PG8_MMA(0, 0, At, B0); PG8_MMA(0, 1, At, B1); PG8_BAR; PG8_SCHED;
            PG8_LDA(At, 1, 1); PG8_STAGE(PG8_SB(1, 0), b3, voffB); PG8_STAGE(PG8_SB(1, 1), b3 + hstep, voffB); PG8_STAGE(PG8_SA(1, 0), a3, voffA);
            PG8_WAIT_V(8); PG8_WAIT_L(0); PG8_BAR; PG8_MMA(1, 0, At, B0); PG8_MMA(1, 1, At, B1); PG8_BAR; PG8_SCHED;
            } else {
            PG8_LDB(B0, 0, 0); PG8_SCHED; PG8_LDA(At, 0, 0); PG8_STAGE(PG8_SA(1, 1), a1 + hstepA, voffA);
            PG8_WAIT_L(8); PG8_BAR; PG8_WAIT_L(0); PG8_MMA(0, 0, At, B0); PG8_BAR; PG8_SCHED;
            PG8_LDB(B1, 0, 1); PG8_STAGE(PG8_SB(0, 0), b2, voffB);
            PG8_BAR; PG8_WAIT_L(0); PG8_MMA(0, 1, At, B1); PG8_BAR;
            PG8_LDA(At, 0, 1); PG8_STAGE(PG8_SA(0, 0), a2, voffA);
            PG8_BAR; PG8_WAIT_L(0); PG8_MMA(1, 0, At, B0); PG8_BAR; PG8_SCHED;
            PG8_STAGE(PG8_SB(0, 1), b2 + hstep, voffB);
            PG8_WAIT_V(6); PG8_BAR; PG8_MMA(1, 1, At, B1); PG8_BAR;
            PG8_LDB(B0, 1, 0); PG8_SCHED; PG8_LDA(At, 1, 0); PG8_STAGE(PG8_SA(0, 1), a2 + hstepA, voffA);
            PG8_WAIT_L(8); PG8_BAR; PG8_WAIT_L(0); PG8_MMA(0, 0, At, B0); PG8_BAR; PG8_SCHED;
            PG8_LDB(B1, 1, 1); PG8_STAGE(PG8_SB(1, 0), b3, voffB);
            PG8_BAR; PG8_WAIT_L(0); PG8_MMA(0, 1, At, B1); PG8_BAR;
            PG8_LDA(At, 1, 1); PG8_STAGE(PG8_SA(1, 0), a3, voffA);
            PG8_BAR; PG8_WAIT_L(0); PG8_MMA(1, 0, At, B0); PG8_BAR; PG8_SCHED;
            PG8_STAGE(PG8_SB(1, 1), b3 + hstep, voffB);
            PG8_WAIT_V(6); PG8_BAR; PG8_MMA(1, 1, At, B1); PG8_BAR;
            }
        }
        if constexpr (ALIGN_EPI) { if (wr == 0) PG8_BAR; }
        bool keep_acc = false;
        if constexpr (Epi::CHAIN) { keep_acc = E.chain(acc, cur, wr, wc, fr, fq); S.done(cur); }
        else if constexpr (!Epi::AFTER_DRAIN) { E(acc, cur, wr, wc, fr, fq); S.done(cur); }
        if (!has_next) break;
        if (!keep_acc) {
#pragma unroll
        for (int a = 0; a < 2; ++a)
#pragma unroll
            for (int b = 0; b < 2; ++b)
#pragma unroll
                for (int m = 0; m < 4; ++m)
#pragma unroll
                    for (int n = 0; n < 2; ++n) acc[a][b][m][n] = (f32x4){0.f, 0.f, 0.f, 0.f};
        }
        cur = nxt; cA = nA; cB = nB; ++ui;
        if constexpr (ALIGN_EPI) { if (wr == 1) PG8_BAR; }
    }
    PG8_WAIT_V(0);
    if constexpr (!ALIGN_EPI) { if (wr == 0) PG8_BAR; }
    PG8_BAR;
    if constexpr (Epi::AFTER_DRAIN) { E.fused(acc, cur, wr, wc, fr, fq, lds, wid, lane); S.done(cur); }
#undef PG8_AOFF
#undef PG8_SA
#undef PG8_SB
#undef PG8_STAGE
#undef PG8_LDA
#undef PG8_LDB
#undef PG8_MMA
#undef PG8_WAIT_V
#undef PG8_WAIT_L
#undef PG8_BAR
#undef PG8_SCHED
}
}

namespace attn {
using bf16 = unsigned short;
using bf16x8 = __attribute__((ext_vector_type(8))) short;
using s16x4 = __attribute__((ext_vector_type(4))) short;
using f32x16 = __attribute__((ext_vector_type(16))) float;
using u32x4 = __attribute__((ext_vector_type(4))) unsigned;
using f32x4 = __attribute__((ext_vector_type(4))) float;
constexpr int SEQ = 4096, DM = 1024, NSLOT = 6, SLOTB = 8192, NREL = 513;
constexpr int LDS_K = 0, LDS_V = NSLOT * SLOTB, LDS_WS = 2 * NSLOT * SLOTB, LDS_OST = LDS_WS + 8 * 64 * 4, LDS_BIAS = LDS_OST + 8 * 4096, BIAS_CS = 400  , LDS_BYTES = LDS_BIAS + 4 * BIAS_CS * 4;
constexpr float LOG2E = 1.4426950408889634f;
__device__ __forceinline__ int crow(int r, int hi) { return (r & 3) + 8 * (r >> 2) + 4 * hi; }
#define SBAR() __builtin_amdgcn_sched_barrier(0)
__device__ __forceinline__ void glds16(const void* gsrc, unsigned lds_dst) { unsigned keep;
  asm volatile("s_mov_b32 %0, m0\n\ts_mov_b32 m0, %2\n\ts_nop 0\n\tglobal_load_lds_dwordx4 %1, off\n\ts_mov_b32 m0, %0" : "=&s"(keep) : "v"(gsrc), "s"(lds_dst) : "memory"); }
typedef float f32x2_t __attribute__((ext_vector_type(2))); typedef __bf16 bf16x2_t __attribute__((ext_vector_type(2)));
__device__ __forceinline__ unsigned cvtpk_s(float lo, float hi) { f32x2_t v = {lo, hi}; bf16x2_t b = __builtin_convertvector(v, bf16x2_t); return __builtin_bit_cast(unsigned, b); }
typedef __attribute__((address_space(3))) const char* lds_cptr;
__device__ __forceinline__ void kload8(bf16x8* kf, lds_cptr kp) {
  kf[0] = *(const __attribute__((address_space(3))) bf16x8*)(kp);        kf[1] = *(const __attribute__((address_space(3))) bf16x8*)(kp + 512);
  kf[2] = *(const __attribute__((address_space(3))) bf16x8*)(kp + 2048); kf[3] = *(const __attribute__((address_space(3))) bf16x8*)(kp + 2560);
  kf[4] = *(const __attribute__((address_space(3))) bf16x8*)(kp + 4096); kf[5] = *(const __attribute__((address_space(3))) bf16x8*)(kp + 4608);
  kf[6] = *(const __attribute__((address_space(3))) bf16x8*)(kp + 6144); kf[7] = *(const __attribute__((address_space(3))) bf16x8*)(kp + 6656);
}
__device__ __forceinline__ void pv(f32x16* o, int vb, bf16x8 pa0, bf16x8 pa1, bf16x8 pa2, bf16x8 pa3) {
  #pragma unroll
  for (int d0 = 0; d0 < 2; ++d0) { s16x4 lo[4], hi[4];
    #pragma unroll
    for (int ks = 0; ks < 4; ++ks) {
      asm volatile("ds_read_b64_tr_b16 %0,%1 offset:%c2" : "=&v"(lo[ks]) : "v"(vb), "i"(d0 * 4096 + ks * 1024) : "memory");
      asm volatile("ds_read_b64_tr_b16 %0,%1 offset:%c2" : "=&v"(hi[ks]) : "v"(vb), "i"(d0 * 4096 + ks * 1024 + 512) : "memory"); }
    asm volatile("s_waitcnt lgkmcnt(0)" ::: "memory"); SBAR();
    #define PK(k) (bf16x8){lo[k][0], lo[k][1], lo[k][2], lo[k][3], hi[k][0], hi[k][1], hi[k][2], hi[k][3]}
    o[d0] = __builtin_amdgcn_mfma_f32_32x32x16_bf16(pa0, PK(0), o[d0], 0, 0, 0);
    o[d0] = __builtin_amdgcn_mfma_f32_32x32x16_bf16(pa1, PK(1), o[d0], 0, 0, 0);
    o[d0] = __builtin_amdgcn_mfma_f32_32x32x16_bf16(pa2, PK(2), o[d0], 0, 0, 0);
    o[d0] = __builtin_amdgcn_mfma_f32_32x32x16_bf16(pa3, PK(3), o[d0], 0, 0, 0);
    #undef PK
  }
}
__device__ __forceinline__ float wmax(float v) {
#pragma unroll
  for (int o = 1; o < 64; o <<= 1) v = fmaxf(v, __shfl_xor(v, o));
  return v;
}
__device__ __forceinline__ void attn_unit(int b, int h, int g, const bf16* Q, const bf16* __restrict__ K, const bf16* __restrict__ V, bf16* O,
                                          const float* __restrict__ relb, const float* __restrict__ gq, const float* __restrict__ gk, char* shm) {
  int tid_ = threadIdx.x; asm volatile("" : "+v"(tid_));
  const int tid = tid_, lane = tid & 63, r32 = lane & 31, hi = lane >> 5; const int wid = __builtin_amdgcn_readfirstlane(tid >> 6);
  const long rowbase = (long)b * SEQ; const int q0 = g * 256;
  const int kc_lo = (4 * g - 8) > 0 ? (4 * g - 8) : 0, NT = 4 * g + 4 - kc_lo;
  const bf16* Qw = Q + (rowbase + q0 + wid * 32) * DM + h * 64;
  const bf16* Kh = K + (rowbase + 64 * kc_lo) * DM + h * 64; const bf16* Vh = V + (rowbase + 64 * kc_lo) * DM + h * 64;
  const unsigned lds0 = (unsigned)(uintptr_t)shm;
  float* wsf = (float*)(shm + LDS_WS) + wid * 64;
  float* biasT = (float*)(shm + LDS_BIAS);
  const bf16* ksrc = Kh + (long)lane * DM + wid * 8;
  const bf16* vsrc = Vh + (long)(16 * (wid & 3) + (lane >> 2)) * DM + (wid >> 2) * 32 + (lane & 3) * 8;
  const unsigned kdst = lds0 + LDS_K + wid * 1024, vdst = lds0 + LDS_V + wid * 1024;
  #define DMA_K(t, slot) glds16(ksrc + (long)(t) * 64 * DM, (unsigned)__builtin_amdgcn_readfirstlane(kdst + (slot)))
  #define DMA_V(t, slot) glds16(vsrc + (long)(t) * 64 * DM, (unsigned)__builtin_amdgcn_readfirstlane(vdst + (slot)))
  const int vb0 = (int)(lds0 + LDS_V) + ((lane >> 4) & 1) * 32 + (lane & 3) * 8 + (4 * hi + ((lane & 15) >> 2)) * 64;
  const lds_cptr shm3 = (lds_cptr)shm; const lds_cptr kp0 = shm3 + LDS_K + hi * 1024 + r32 * 16;
  const bool full = (g >= 2); const int nsteps = full ? 9 : NT;
  #define LOAD_TILE(i) (full ? ((i) < 6 ? (((i) & 1) ? ((i) >> 1) + 9 : ((i) >> 1)) : (i) - 3) : (i))
  #define ISSUE_LOAD(i) do { const int i_ = (i); const int tl_ = LOAD_TILE(i_); const int sb_ = (i_ % NSLOT) * SLOTB; DMA_K(tl_, sb_); DMA_V(tl_, sb_); } while (0)
  bf16x8 qr[4];
  #pragma unroll
  for (int d0 = 0; d0 < 4; ++d0) qr[d0] = *reinterpret_cast<const bf16x8*>(&Qw[(long)r32 * DM + d0 * 16 + hi * 8]);
  const float gqv = gq[lane], gkv = gk[lane]; float rbv[9], tbv[3];
  #pragma unroll
  for (int k = 0; k < 9; ++k) { const int i = lane + 64 * k; rbv[k] = (i < NREL) ? relb[h * NREL + i] : -3.0e38f; }
  #pragma unroll
  for (int k = 0; k < 3; ++k) { const int i = tid + 512 * k, c = i / 384, jj = i - c * 384, e = jj + c; tbv[k] = (e < 384) ? relb[h * NREL + (e < 64 ? 512 : 576 - e)] : 0.f; }
  asm volatile("" ::: "memory");
  ISSUE_LOAD(0); ISSUE_LOAD(1); if (full) { ISSUE_LOAD(2); ISSUE_LOAD(3); }
  float m2;
  { const float mq = wmax(fabsf(gqv)), mk = wmax(fabsf(gkv)); float mb = -3.0e38f;
    #pragma unroll
    for (int k = 0; k < 9; ++k) mb = fmaxf(mb, rbv[k]);
    mb = wmax(mb); m2 = (8.0f * mq * mk + mb) * LOG2E; }
  #pragma unroll
  for (int k = 0; k < 3; ++k) { const int i = tid + 512 * k, c = i / 384, jj = i - c * 384; biasT[c * BIAS_CS + jj] = tbv[k] * LOG2E - m2; }
  f32x16 o[2]; o[0] = f32x16{}; o[1] = f32x16{}; f32x16 lsum = f32x16{};
  const int qpos = 32 * (wid & 1) + r32;
  const int cch = 4 * g + (wid >> 1);
  if (full) asm volatile("s_waitcnt vmcnt(4) lgkmcnt(0)\n\ts_barrier" ::: "memory");
  else      asm volatile("s_waitcnt vmcnt(2) lgkmcnt(0)\n\ts_barrier" ::: "memory");
  for (int s = 0; s < nsteps; ++s) {
    int nis = 0;
    if (s + 2 < nsteps) { const int s2 = s + 2; if (full) { if (s2 < 3) { ISSUE_LOAD(2 * s2); ISSUE_LOAD(2 * s2 + 1); nis = 2; } else { ISSUE_LOAD(s2 + 3); nis = 1; } } else { ISSUE_LOAD(s2); nis = 1; } }
    int jrel = kc_lo + s - cch + 8, ld = full ? (s < 3 ? 2 * s : s + 3) : s;
    if (full && s < 3 && jrel < 0) { jrel += 9; ld += 1; }
    const int sl_cur = (ld % NSLOT) * SLOTB;
    if (jrel >= 0 && jrel <= 8) {
      s16x4 vlo[8], vhi[8]; { const int vb = vb0 + sl_cur;
        #pragma unroll
        for (int i_ = 0; i_ < 8; ++i_) {
          asm volatile("ds_read_b64_tr_b16 %0,%1 offset:%c2" : "=&v"(vlo[i_]) : "v"(vb), "i"((i_ >> 2) * 4096 + (i_ & 3) * 1024) : "memory");
          asm volatile("ds_read_b64_tr_b16 %0,%1 offset:%c2" : "=&v"(vhi[i_]) : "v"(vb), "i"((i_ >> 2) * 4096 + (i_ & 3) * 1024 + 512) : "memory"); } }
      f32x16 p0, p1;
      if (jrel <= 3) { const float c0 = biasT[0];
        #pragma unroll
        for (int r = 0; r < 16; ++r) { p0[r] = c0; p1[r] = c0; } }
      else { const int i0 = 64 + 4 * hi - qpos + 64 * (jrel - 4), cs = i0 & 3; const f32x4* a4 = (const f32x4*)(biasT + cs * BIAS_CS + (i0 - cs));
        #pragma unroll
        for (int q4 = 0; q4 < 4; ++q4) { const f32x4 b0 = a4[2 * q4], b1 = a4[2 * q4 + 8];
          #pragma unroll
          for (int e = 0; e < 4; ++e) { p0[4 * q4 + e] = b0[e]; p1[4 * q4 + e] = b1[e]; } } }
      bf16x8 kf[8]; kload8(kf, kp0 + sl_cur);
      #pragma unroll
      for (int d0 = 0; d0 < 4; ++d0) { p0 = __builtin_amdgcn_mfma_f32_32x32x16_bf16(kf[2 * d0], qr[d0], p0, 0, 0, 0); p1 = __builtin_amdgcn_mfma_f32_32x32x16_bf16(kf[2 * d0 + 1], qr[d0], p1, 0, 0, 0); }
      #pragma unroll
      for (int r = 0; r < 16; ++r) { p0[r] = __builtin_amdgcn_exp2f(p0[r]); p1[r] = __builtin_amdgcn_exp2f(p1[r]); }
      lsum += p0 + p1;
      u32x4 pw0, pw1, pw2, pw3;
      pw0 = (u32x4){cvtpk_s(p0[0], p0[1]), cvtpk_s(p0[2], p0[3]), cvtpk_s(p0[4], p0[5]), cvtpk_s(p0[6], p0[7])};
      pw1 = (u32x4){cvtpk_s(p0[8], p0[9]), cvtpk_s(p0[10], p0[11]), cvtpk_s(p0[12], p0[13]), cvtpk_s(p0[14], p0[15])};
      pw2 = (u32x4){cvtpk_s(p1[0], p1[1]), cvtpk_s(p1[2], p1[3]), cvtpk_s(p1[4], p1[5]), cvtpk_s(p1[6], p1[7])};
      pw3 = (u32x4){cvtpk_s(p1[8], p1[9]), cvtpk_s(p1[10], p1[11]), cvtpk_s(p1[12], p1[13]), cvtpk_s(p1[14], p1[15])};
      SBAR();
      asm volatile("s_waitcnt lgkmcnt(0)" ::: "memory"); SBAR();
      #define VF(i_) (bf16x8){vlo[i_][0], vlo[i_][1], vlo[i_][2], vlo[i_][3], vhi[i_][0], vhi[i_][1], vhi[i_][2], vhi[i_][3]}
      o[0] = __builtin_amdgcn_mfma_f32_32x32x16_bf16(__builtin_bit_cast(bf16x8, pw0), VF(0), o[0], 0, 0, 0); o[1] = __builtin_amdgcn_mfma_f32_32x32x16_bf16(__builtin_bit_cast(bf16x8, pw0), VF(4), o[1], 0, 0, 0);
      o[0] = __builtin_amdgcn_mfma_f32_32x32x16_bf16(__builtin_bit_cast(bf16x8, pw1), VF(1), o[0], 0, 0, 0); o[1] = __builtin_amdgcn_mfma_f32_32x32x16_bf16(__builtin_bit_cast(bf16x8, pw1), VF(5), o[1], 0, 0, 0);
      o[0] = __builtin_amdgcn_mfma_f32_32x32x16_bf16(__builtin_bit_cast(bf16x8, pw2), VF(2), o[0], 0, 0, 0); o[1] = __builtin_amdgcn_mfma_f32_32x32x16_bf16(__builtin_bit_cast(bf16x8, pw2), VF(6), o[1], 0, 0, 0);
      o[0] = __builtin_amdgcn_mfma_f32_32x32x16_bf16(__builtin_bit_cast(bf16x8, pw3), VF(3), o[0], 0, 0, 0); o[1] = __builtin_amdgcn_mfma_f32_32x32x16_bf16(__builtin_bit_cast(bf16x8, pw3), VF(7), o[1], 0, 0, 0);
      #undef VF
    }
    if (nis == 2)      asm volatile("s_waitcnt vmcnt(4) lgkmcnt(0)\n\ts_barrier" ::: "memory");
    else if (nis == 1) asm volatile("s_waitcnt vmcnt(2) lgkmcnt(0)\n\ts_barrier" ::: "memory");
    else               asm volatile("s_waitcnt vmcnt(0) lgkmcnt(0)\n\ts_barrier" ::: "memory");
  }
  #undef LOAD_TILE
  #undef ISSUE_LOAD
  float l_reg = 0.f;
  #pragma unroll
  for (int r = 0; r < 16; ++r) l_reg += lsum[r];
  { auto rr = __builtin_amdgcn_permlane32_swap(__float_as_uint(l_reg), __float_as_uint(l_reg), false, false); l_reg = __uint_as_float(rr[0]) + __uint_as_float(rr[1]); }
  if (hi == 0) wsf[32 + r32] = l_reg; asm volatile("s_waitcnt lgkmcnt(0)" ::: "memory");
  float rli[16];
  #pragma unroll
  for (int r = 0; r < 16; ++r) rli[r] = __builtin_amdgcn_rcpf(wsf[32 + crow(r, hi)]);
  bf16* Ow = O + (rowbase + q0 + wid * 32) * DM + h * 64;
  { bf16* stg = (bf16*)(shm + LDS_OST) + wid * 2048;
    #pragma unroll
    for (int r = 0; r < 16; ++r) { const int orow = crow(r, hi);
      #pragma unroll
      for (int d0 = 0; d0 < 2; ++d0) stg[orow * 64 + d0 * 32 + r32] = (bf16)(cvtpk_s(o[d0][r] * rli[r], 0.f) & 0xffffu); }
    asm volatile("s_waitcnt lgkmcnt(0)" ::: "memory");
    #pragma unroll
    for (int i = 0; i < 4; ++i) { const int row = i * 8 + (lane >> 3), ch = lane & 7; const u32x4 v = *(const u32x4*)(stg + row * 64 + ch * 8); pg8::st16(Ow + (long)row * DM + ch * 8, v); } }
  asm volatile("s_waitcnt lgkmcnt(0)\n\ts_barrier" ::: "memory");
  #undef DMA_K
  #undef DMA_V
}
#undef SBAR
}

#define GAS __attribute__((address_space(1)))
#define LAS __attribute__((address_space(3)))
typedef unsigned short bf16;
typedef unsigned v4u __attribute__((ext_vector_type(4)));
typedef float f32x4 __attribute__((ext_vector_type(4)));
typedef short bf16x8 __attribute__((ext_vector_type(8)));
typedef GAS unsigned gu32;
typedef GAS unsigned long long gu64;
#define RLX_AGENT __ATOMIC_RELAXED, __HIP_MEMORY_SCOPE_AGENT
#define LDS_WAIT() asm volatile("s_waitcnt lgkmcnt(0)" ::: "memory")
#define VM_WAIT() asm volatile("s_waitcnt vmcnt(0)" ::: "memory")
__device__ __forceinline__ unsigned long long rt() { return __builtin_amdgcn_s_memrealtime(); }
#define XB_TMO      128
#define XB_XCNT(j)  (256  + 64 * (j))
#define XB_XSUB(j)  (1280 + 64 * (j))
#define XB_XGEN(j)  (2304 + 64 * (j))
#define XB_TOP      3328
#define XB_TOPGEN   3392
#define XCD_BAR_WORDS 3456
#define XB_SPIN_CAP (1u << 18)

__device__ __forceinline__ unsigned xb_ld(unsigned* p)              { return __hip_atomic_load(p, __ATOMIC_RELAXED, __HIP_MEMORY_SCOPE_AGENT); }
__device__ __forceinline__ unsigned xb_add(unsigned* p, unsigned v) { return __hip_atomic_fetch_add(p, v, __ATOMIC_RELAXED, __HIP_MEMORY_SCOPE_AGENT); }
__device__ __forceinline__ unsigned xb_xcc_id() { return (unsigned)__builtin_amdgcn_s_getreg((3 << 11) | 20) & 0xFu; }
#define XB_SPIN(cond, bar) do { unsigned _sp = 0; while (cond) { __builtin_amdgcn_s_sleep(1); \
    if ((++_sp & 255u) == 0u) { if (xb_ld(&(bar)[XB_TMO])) break; if (_sp > XB_SPIN_CAP) { atomicAdd(&(bar)[XB_TMO], 1u); break; } } } } while (0)

struct XcdBarrier {
    unsigned* bar; unsigned x;
    volatile LAS unsigned* st;
};

__device__ __forceinline__ XcdBarrier xcd_barrier_post(unsigned* bar, volatile LAS unsigned* st) {
    XcdBarrier b; b.bar = bar; b.x = xb_xcc_id(); b.st = st;
    if (threadIdx.x == 0) (void)xb_add(&bar[XB_XCNT(b.x)], 1u);
    return b;
}
__device__ __forceinline__ void xcd_barrier_complete(unsigned* bar, unsigned x, unsigned& nloc, unsigned& nx) {
    const unsigned G = gridDim.x * gridDim.y * gridDim.z;
    unsigned sum, cnt, mine, sp = 0u;
    for (;;) {
        sum = 0u; cnt = 0u; mine = 0u;
#pragma unroll
        for (unsigned j = 0; j < 16; ++j) { const unsigned c = xb_ld(&bar[XB_XCNT(j)]); sum += c; cnt += (c > 0u) ? 1u : 0u; mine = (j == x) ? c : mine; }
        if (sum == G) break;
        __builtin_amdgcn_s_sleep(1);
        if ((++sp & 255u) == 0u) { if (xb_ld(&bar[XB_TMO])) break; if (sp > XB_SPIN_CAP) { atomicAdd(&bar[XB_TMO], 1u); break; } }
    }
    nloc = mine > 0u ? mine : 1u; nx = cnt > 0u ? cnt : 1u;
}

__device__ __forceinline__ void xcd_barrier(const XcdBarrier& b) {
    asm volatile("s_waitcnt vmcnt(0)" ::: "memory");
    __syncthreads();
    if (threadIdx.x == 0) {
        unsigned* bar = b.bar;
        __builtin_amdgcn_s_waitcnt(0);
        unsigned nloc = b.st[0], nx = b.st[1];
        if (nloc == 0u) { xcd_barrier_complete(bar, b.x, nloc, nx); b.st[0] = nloc; b.st[1] = nx; }
        __builtin_amdgcn_fence(__ATOMIC_RELEASE, "agent");
        asm volatile("s_waitcnt vmcnt(0)" ::: "memory");
        const unsigned old = xb_add(&bar[XB_XSUB(b.x)], 1u);
        const unsigned gen = old / nloc;
        if (old + 1u == (gen + 1u) * nloc) {
            __builtin_amdgcn_fence(__ATOMIC_RELEASE, "agent");
            asm volatile("s_waitcnt vmcnt(0)" ::: "memory");
            const unsigned og = xb_add(&bar[XB_TOP], 1u);
            const unsigned tg = og / nx;
            if (og + 1u == (tg + 1u) * nx) xb_add(&bar[XB_TOPGEN], 1u);
            else XB_SPIN(xb_ld(&bar[XB_TOPGEN]) == tg, bar);
            __builtin_amdgcn_fence(__ATOMIC_ACQUIRE, "agent");
            xb_add(&bar[XB_XGEN(b.x)], 1u);
            asm volatile("s_waitcnt vmcnt(0)" ::: "memory");
        } else {
            XB_SPIN(xb_ld(&bar[XB_XGEN(b.x)]) == gen, bar);
            __builtin_amdgcn_fence(__ATOMIC_ACQUIRE, "agent");
            asm volatile("s_waitcnt vmcnt(0)" ::: "memory");
        }
    }
    __syncthreads();
}
#include <hip/hip_cooperative_groups.h>
namespace cg = cooperative_groups;
constexpr int NWAVES = 8;
constexpr int BATCH = 4, SEQ = 4096, D = 1024, FF = 4096, M = BATCH * SEQ, NIN = 8192;
constexpr size_t MiB = 1u << 20;
constexpr size_t WS_SS = 1 * MiB;
constexpr size_t WS_W1 = 2 * MiB, WS_WC = 18 * MiB, WS_WA = 20 * MiB  , WS_WO = 22 * MiB, WS_WUP = 24 * MiB, WS_WDN = 32 * MiB;
constexpr size_t WS_V = 40 * MiB  , WS_H = 72 * MiB  , WS_Q = 104 * MiB, WS_K = 136 * MiB  , WS_BG = 168 * MiB  , WS_U1 = 200 * MiB;
constexpr size_t WS_UU = 72 * MiB;
constexpr size_t WS_END = 232 * MiB;
constexpr int LDS_BYTES = 147456;
constexpr int LDSCTL_OFF = 131072, MISC_OFF = LDSCTL_OFF + 320;
constexpr size_t WS_CTL = 0, CTL_ZERO_BYTES = 65536; constexpr int CW_BAR = 4096;
__device__ __forceinline__ unsigned f2bf(float f) { unsigned u = __builtin_bit_cast(unsigned, f); return (u + 0x7fffu + ((u >> 16) & 1u)) >> 16; }
__device__ __forceinline__ unsigned pk2(float lo, float hi) { return f2bf(lo) | (f2bf(hi) << 16); }
__device__ __forceinline__ float wave_sum(float v) {
#pragma unroll
    for (int o = 1; o < 64; o <<= 1) v += __shfl_xor(v, o);
    return v;
}
__device__ __forceinline__ void tr_item(const float* W, int ldw, int col0, int k0, bf16* WT, int Kd, int drow0, const float* kscale, LAS float* scr, int lane) {
    float tv[32];
#pragma unroll
    for (int i = 0; i < 32; ++i) { const int kk = 2 * i + (lane >> 5); tv[i] = __builtin_nontemporal_load(W + (size_t)(k0 + kk) * ldw + col0 + (lane & 31)); }
#pragma unroll
    for (int i = 0; i < 32; ++i) { const int kk = 2 * i + (lane >> 5); float v = tv[i]; if (kscale) v *= kscale[k0 + kk]; scr[kk * 33 + (lane & 31)] = v; }
    LDS_WAIT(); asm volatile("" ::: "memory");
    const int c = lane & 7;
#pragma unroll
    for (int j = 0; j < 4; ++j) { const int n = (lane >> 3) + 8 * j; const LAS float* s = scr + (8 * c) * 33 + n;
        v4u o; o.x = pk2(s[0 * 33], s[1 * 33]); o.y = pk2(s[2 * 33], s[3 * 33]); o.z = pk2(s[4 * 33], s[5 * 33]); o.w = pk2(s[6 * 33], s[7 * 33]);
        pg8::st16(WT + (size_t)(drow0 + n) * Kd + k0 + 8 * c, o); }
    LDS_WAIT(); asm volatile("" ::: "memory");
}

#ifndef PH_MASK
#define PH_MASK 127
#endif
#ifndef REP_P1
#define REP_P1 1
#endif
#ifndef REP_ATT
#define REP_ATT 1
#endif
#ifndef REP_P3
#define REP_P3 1
#endif
#ifndef REP_P4
#define REP_P4 1
#endif
#ifndef REP_P5
#define REP_P5 1
#endif
#ifndef EXTRA_SYNC
#define EXTRA_SYNC 0
#endif
__device__ unsigned g_panel_cnt[64 * 64];
__device__ unsigned g_bar_shard[16 * 64];
__device__ unsigned g_bar_cnt = 0u, g_bar_gen = 0u, g_done_cnt = 0u;
struct Args { const float* in[16]; float* out; unsigned char* ws; };
__global__ void __launch_bounds__(NWAVES * 64, 2) fwd(Args a) {
    extern __shared__ __attribute__((aligned(16))) unsigned char lds[];
    cg::grid_group grid = cg::this_grid();
    LAS unsigned char* ldsp = (LAS unsigned char*)lds;
    const int tid = threadIdx.x, lane = tid & 63, wave = __builtin_amdgcn_readfirstlane(tid >> 6);
    const int G = gridDim.x, bx = blockIdx.x, vcu = (G % 8 == 0) ? (bx % 8) * (G / 8) + bx / 8 : bx;
    unsigned char* ws = a.ws;
    const float* x = a.in[0];
    bf16 *W1 = (bf16*)(ws + WS_W1), *WA = (bf16*)(ws + WS_WA), *WC = (bf16*)(ws + WS_WC), *WO = (bf16*)(ws + WS_WO), *WUP = (bf16*)(ws + WS_WUP), *WDN = (bf16*)(ws + WS_WDN);
    bf16 *Vb = (bf16*)(ws + WS_V), *X1B = (bf16*)(ws + WS_V), *Hb = (bf16*)(ws + WS_H), *YC = (bf16*)(ws + WS_H)  , *Qb = (bf16*)(ws + WS_Q), *AO = (bf16*)(ws + WS_Q)  , *Kb = (bf16*)(ws + WS_K), *MG = (bf16*)(ws + WS_K);
    bf16 *BG = (bf16*)(ws + WS_BG), *U1 = (bf16*)(ws + WS_U1), *UU = (bf16*)(ws + WS_UU), *Gt = (bf16*)a.out;
    float* SS = (float*)(ws + WS_SS);
    for (int u = tid; u < (LDS_BYTES - LDSCTL_OFF) / 4; u += NWAVES * 64) ((LAS unsigned*)(ldsp + LDSCTL_OFF))[u] = 0u;
    __syncthreads();
    if (a.out == nullptr) grid.sync();
#ifndef WB_AT_SEAMS
#define WB_AT_SEAMS 0
#endif
#if WB_AT_SEAMS || !WT_STORES
#define BAR_RELEASE() do { __builtin_amdgcn_fence(__ATOMIC_RELEASE, "agent"); asm volatile("s_waitcnt vmcnt(0)" ::: "memory"); } while (0)
#else
#define BAR_RELEASE() do { } while (0)
#endif
#if defined(MONO_BAR)
    const bool grouped = (G == 256);
    const unsigned NSEAMS = (grouped ? 3u : 6u) + EXTRA_SYNC;
    unsigned bar_epoch = 0u, bar_base = 0u; const unsigned bar_xcc = xb_xcc_id();
#define GRID_BAR() do { asm volatile("s_waitcnt vmcnt(0)" ::: "memory"); __syncthreads(); \
    ++bar_epoch; \
    if (tid == 0) { \
        BAR_RELEASE(); \
        unsigned old_ = xb_add(&g_bar_shard[64u * bar_xcc], 1u);     \
        if (bar_epoch == 1u) asm volatile("s_waitcnt vmcnt(0)" : "+v"(old_) :: "memory");     \
        const unsigned tgt_ = bar_epoch * (unsigned)G; unsigned sp_ = 0u; \
        for (;;) { unsigned s_ = 0u; _Pragma("unroll") for (int j_ = 0; j_ < 16; ++j_) s_ += xb_ld(&g_bar_shard[64 * j_]); \
            if (bar_epoch == 1u && sp_ == 0u) bar_base = ((s_ - 1u) / (NSEAMS * (unsigned)G)) * (NSEAMS * (unsigned)G);     \
            if (s_ - bar_base >= tgt_) break; \
            __builtin_amdgcn_s_sleep(8); if (++sp_ > (1u << 22)) break; } \
        __builtin_amdgcn_fence(__ATOMIC_ACQUIRE, "agent"); asm volatile("s_waitcnt vmcnt(0)" ::: "memory"); } \
    __syncthreads(); } while (0)
    unsigned grp_epoch = 0u, grp_base = 0u;
#define GROUP_BAR(pm_) do { asm volatile("s_waitcnt vmcnt(0)" ::: "memory"); __syncthreads(); \
    ++grp_epoch; \
    if (tid == 0) { unsigned* pc_ = &g_panel_cnt[64 * (pm_)]; \
        BAR_RELEASE(); \
        const unsigned old_ = xb_add(pc_, 1u); \
        if (grp_epoch == 1u) grp_base = old_ - old_ % 12u; \
        const unsigned tgt_ = grp_epoch * 4u; unsigned sp_ = 0u; \
        while (xb_ld(pc_) - grp_base < tgt_) { __builtin_amdgcn_s_sleep(1); if (++sp_ > (1u << 22)) break; } \
        __builtin_amdgcn_fence(__ATOMIC_ACQUIRE, "agent"); asm volatile("s_waitcnt vmcnt(0)" ::: "memory"); } \
    __syncthreads(); } while (0)
#elif defined(GEN_BAR)
#define GRID_BAR() do { asm volatile("s_waitcnt vmcnt(0)" ::: "memory"); __syncthreads(); \
    if (tid == 0) { \
        __builtin_amdgcn_fence(__ATOMIC_RELEASE, "agent"); asm volatile("s_waitcnt vmcnt(0)" ::: "memory"); \
        unsigned g0_ = xb_ld(&g_bar_gen); asm volatile("s_waitcnt vmcnt(0)" : "+v"(g0_) :: "memory");            \
        unsigned old_ = xb_add(&g_bar_cnt, 1u); asm volatile("s_waitcnt vmcnt(0)" : "+v"(old_) :: "memory"); \
        if (old_ == (unsigned)G - 1u) { __hip_atomic_store(&g_bar_cnt, 0u, RLX_AGENT); asm volatile("s_waitcnt vmcnt(0)" ::: "memory"); xb_add(&g_bar_gen, 1u); } \
        else { unsigned sp_ = 0u; while (xb_ld(&g_bar_gen) == g0_) { __builtin_amdgcn_s_sleep(1); if (++sp_ > (1u << 22)) break; } } \
        __builtin_amdgcn_fence(__ATOMIC_ACQUIRE, "agent"); asm volatile("s_waitcnt vmcnt(0)" ::: "memory"); } \
    __syncthreads(); } while (0)
#elif defined(CG_ALL)
#define GRID_BAR() do { asm volatile("s_waitcnt vmcnt(0)" ::: "memory"); grid.sync(); } while (0)
#elif defined(SIMPLE_BAR)
    unsigned bar_epoch = 0u;
#define GRID_BAR() do { asm volatile("s_waitcnt vmcnt(0)" ::: "memory"); __syncthreads(); \
    ++bar_epoch; \
    if (tid == 0) { unsigned* cnt_ = (unsigned*)(ws + WS_CTL) + CW_BAR + XB_TOP; \
        __builtin_amdgcn_fence(__ATOMIC_RELEASE, "agent"); asm volatile("s_waitcnt vmcnt(0)" ::: "memory"); \
        xb_add(cnt_, 1u); unsigned sp_ = 0u; \
        while (xb_ld(cnt_) < bar_epoch * (unsigned)G) { __builtin_amdgcn_s_sleep(1); if (++sp_ > (1u << 22)) break; } \
        __builtin_amdgcn_fence(__ATOMIC_ACQUIRE, "agent"); asm volatile("s_waitcnt vmcnt(0)" ::: "memory"); } \
    __syncthreads(); } while (0)
#else
#define GRID_BAR() xcd_barrier(bar)
#endif

#ifndef DUP_P0
#define DUP_P0 1
#endif
    for (int rep0 = 0; rep0 < DUP_P0; ++rep0) {
        LAS float* scr = (LAS float*)(ldsp + wave * 16384);
        const int gw = vcu * NWAVES + wave, NGW = G * NWAVES;
        constexpr int I_1 = 16 * 256, I_S = 16 * 32, I_UP = 16 * 128, I_DN = 64 * 32, NITEMS = I_1 + 3 * I_S + I_UP + I_DN;
        for (int it = gw; it < NITEMS; it += NGW) {
            int r = it;
            if (r < I_1) { const int db = r & 255, kb = r >> 8, pn = db >> 3, pb = db & 7, bj = pb >> 2, wcc = pb & 3; const float* W = a.in[2]; int ldw = 6144, col;
                if (pn < 4) col = (4 * pn + wcc) * 64 + 32 * bj;
                else if (pn < 8) col = 1024 + (4 * (pn - 4) + wcc) * 64 + 32 * bj;
                else if (pn < 12) col = 2048 + 256 * (pn - 8) + 32 * pb;
                else if (pn < 16) col = 3072 + 256 * (pn - 12) + 32 * pb;
                else if (pn < 24) col = (bj ? 5120 : 4096) + 128 * (pn - 16) + 32 * wcc;
                else { W = a.in[10]; ldw = 2048; col = (bj ? 1024 : 0) + 128 * (pn - 24) + 32 * wcc; }
                tr_item(W, ldw, col, 64 * kb, W1, D, 32 * db, nullptr, scr, lane); continue; } r -= I_1;
            if (r < I_S) { tr_item(a.in[8], D, 32 * (r & 31), 64 * (r >> 5), WA, D, 32 * (r & 31), nullptr, scr, lane); continue; } r -= I_S;
            if (r < I_S) { tr_item(a.in[9], D, 32 * (r & 31), 64 * (r >> 5), WC, D, 32 * (r & 31), nullptr, scr, lane); continue; } r -= I_S;
            if (r < I_S) { tr_item(a.in[12], D, 32 * (r & 31), 64 * (r >> 5), WO, D, 32 * (r & 31), nullptr, scr, lane); continue; } r -= I_S;
            if (r < I_UP) { tr_item(a.in[14], FF, 32 * (r & 127), 64 * (r >> 7), WUP, D, 32 * (r & 127), a.in[13], scr, lane); continue; } r -= I_UP;
            tr_item(a.in[15], D, 32 * (r & 31), 64 * (r >> 5), WDN, FF, 32 * (r & 31), nullptr, scr, lane);
        }
        const float* g1 = a.in[1];
        f32x4 gv[2][2];
#pragma unroll
        for (int c = 0; c < 2; ++c)
#pragma unroll
            for (int hh = 0; hh < 2; ++hh) gv[c][hh] = ((const f32x4*)g1)[c * 128 + 2 * lane + hh];
        for (int m0 = gw; m0 < M; m0 += 2 * NGW) {
            const int m1 = m0 + NGW; const bool has1 = m1 < M;
            const f32x4* xr0 = (const f32x4*)(x + (size_t)m0 * D); const f32x4* xr1 = (const f32x4*)(x + (size_t)(has1 ? m1 : m0) * D);
            f32x4 v0[2][2], v1[2][2]; float s0 = 0.f, s1 = 0.f;
#pragma unroll
            for (int c = 0; c < 2; ++c)
#pragma unroll
                for (int hh = 0; hh < 2; ++hh) { v0[c][hh] = __builtin_nontemporal_load(xr0 + c * 128 + 2 * lane + hh); v1[c][hh] = __builtin_nontemporal_load(xr1 + c * 128 + 2 * lane + hh); }
#pragma unroll
            for (int c = 0; c < 2; ++c)
#pragma unroll
                for (int hh = 0; hh < 2; ++hh) { const f32x4 a0 = v0[c][hh], a1 = v1[c][hh];
                    s0 += (a0.x * a0.x + a0.y * a0.y) + (a0.z * a0.z + a0.w * a0.w); s1 += (a1.x * a1.x + a1.y * a1.y) + (a1.z * a1.z + a1.w * a1.w); }
            const float rs0 = 1.0f / sqrtf(wave_sum(s0) * (1.0f / D) + 1e-6f), rs1 = 1.0f / sqrtf(wave_sum(s1) * (1.0f / D) + 1e-6f);
#pragma unroll
            for (int c = 0; c < 2; ++c) { const f32x4 y0 = v0[c][0] * rs0 * gv[c][0], y1 = v0[c][1] * rs0 * gv[c][1];
                pg8::st16(Hb + (size_t)m0 * D + c * 512 + 8 * lane, (v4u){pk2(y0.x, y0.y), pk2(y0.z, y0.w), pk2(y1.x, y1.y), pk2(y1.z, y1.w)}); }
            if (has1) {
#pragma unroll
                for (int c = 0; c < 2; ++c) { const f32x4 y0 = v1[c][0] * rs1 * gv[c][0], y1 = v1[c][1] * rs1 * gv[c][1];
                    pg8::st16(Hb + (size_t)m1 * D + c * 512 + 8 * lane, (v4u){pk2(y0.x, y0.y), pk2(y0.z, y0.w), pk2(y1.x, y1.y), pk2(y1.z, y1.w)}); } }
        }
    }
    GRID_BAR();
#if !defined(SIMPLE_BAR) && !defined(CG_ALL) && !defined(GEN_BAR) && !defined(MONO_BAR)
    const XcdBarrier bar = xcd_barrier_post((unsigned*)(ws + WS_CTL) + CW_BAR, (volatile LAS unsigned*)(ldsp + MISC_OFF) + 8);
#endif

    if (PH_MASK & 2) {
        pg8::Gemm g{Hb, W1, M, NIN, D}; pg8::StaticOrder S; S.init(M, NIN, G, bx);
        pg8::EpiP1 E{Qb, Kb, Vb, BG, U1, Gt, a.in[3], a.in[4], a.in[11]};
        pg8::gemm_phase<pg8::EpiP1, pg8::StaticOrder, true, true>(ldsp, g, S, E);
#ifdef DUP_P1
        { pg8::Gemm g2{Hb, W1, M, NIN, D}; pg8::StaticOrder S2; S2.init(M, NIN, G, bx); pg8::gemm_phase<pg8::EpiP1, pg8::StaticOrder, true, true>(ldsp, g2, S2, E); }
#endif
    }
    GRID_BAR();

    if (PH_MASK & 4) {
        for (int L = vcu; L < 1024 * REP_ATT; L += G) { const int bh = (L & 255) >> 2, gq4 = (L & 3) + 4 * ((L >> 8) & 3);
            attn::attn_unit(bh >> 4, bh & 15, gq4, Qb, Kb, Vb, AO, a.in[5], a.in[3], a.in[4], (char*)lds); }
        const float* cw = a.in[6]; const float* cb = a.in[7];
        for (int item = vcu * 512 + tid; item < 131072; item += G * 512) {
            const int c8 = (item & 127) * 8, t0 = (item >> 7) * 16;
            float w0[8], w1[8], w2[8], b0[8], u1[8], u2[8];
#pragma unroll
            for (int e = 0; e < 8; ++e) { w0[e] = cw[c8 + e]; w1[e] = cw[1024 + c8 + e]; w2[e] = cw[2048 + c8 + e]; b0[e] = cb[c8 + e]; u1[e] = 0.f; u2[e] = 0.f; }
            if ((t0 & (SEQ - 1)) != 0) { f32x4 p, q; pg8::unpack8(*(const v4u*)(U1 + (size_t)(t0 - 2) * D + c8), p, q);
#pragma unroll
                for (int e = 0; e < 4; ++e) { u2[e] = p[e]; u2[4 + e] = q[e]; }
                pg8::unpack8(*(const v4u*)(U1 + (size_t)(t0 - 1) * D + c8), p, q);
#pragma unroll
                for (int e = 0; e < 4; ++e) { u1[e] = p[e]; u1[4 + e] = q[e]; } }
            v4u ur[16], br[16];
#pragma unroll
            for (int i = 0; i < 16; ++i) { const size_t off = (size_t)(t0 + i) * D + c8; ur[i] = __builtin_nontemporal_load((const v4u*)(U1 + off)); br[i] = __builtin_nontemporal_load((const v4u*)(BG + off)); }
#pragma unroll
            for (int i = 0; i < 16; ++i) { const size_t off = (size_t)(t0 + i) * D + c8; f32x4 p, q, bp, bq; float u0[8], bgv[8], y[8];
                pg8::unpack8(ur[i], p, q); pg8::unpack8(br[i], bp, bq);
#pragma unroll
                for (int e = 0; e < 4; ++e) { u0[e] = p[e]; u0[4 + e] = q[e]; bgv[e] = bp[e]; bgv[4 + e] = bq[e]; }
#pragma unroll
                for (int e = 0; e < 8; ++e) { y[e] = bgv[e] * (b0[e] + w0[e] * u2[e] + w1[e] * u1[e] + w2[e] * u0[e]); u2[e] = u1[e]; u1[e] = u0[e]; }
                v4u o; o.x = pk2(y[0], y[1]); o.y = pk2(y[2], y[3]); o.z = pk2(y[4], y[5]); o.w = pk2(y[6], y[7]); pg8::st16(YC + off, o); }
        }
    }
    GRID_BAR();

    if (PH_MASK & 8) {
        static_assert(WS_Q == WS_H + (size_t)M * D * 2 && WS_WA == WS_WC + (size_t)D * D * 2, "P3 reads the stacked [YC ; AO] and [Wc ; Wa]");
        pg8::PairOrder S; S.S.init(M, D, G, bx);
        pg8::Gemm g{YC, WC, 2 * M, 2 * D, D}; pg8::EpiGate2 E{Gt, MG};
        pg8::gemm_phase<pg8::EpiGate2, pg8::PairOrder, true, true>(ldsp, g, S, E);
    }
    { pg8::StaticOrder S; S.init(M, D, G, bx); pg8::Unit u0; S.next(0, u0); if (grouped) GROUP_BAR(u0.pm); else GRID_BAR(); }

    if (PH_MASK & 16) {
        pg8::Gemm g{MG, WO, M, D, D}; pg8::StaticOrder S; S.init(M, D, G, bx);
        pg8::EpiRes1 E{x, a.out, X1B, SS};
        pg8::gemm_phase<pg8::EpiRes1, pg8::StaticOrder, true, true>(ldsp, g, S, E);
#ifdef DUP_P4
        pg8::gemm_phase<pg8::EpiRes1, pg8::StaticOrder, true, true>(ldsp, g, S, E);
#endif
    }
    { pg8::StaticOrder S; S.init(M, D, G, bx); pg8::Unit u0; S.next(0, u0); if (grouped) GROUP_BAR(u0.pm); else GRID_BAR(); }

    if (PH_MASK & 32) {
        pg8::Gemm g{X1B, WUP, M, FF, D}; pg8::StaticOrder S; S.init(M, FF, G, bx);
        pg8::EpiUp E{SS, UU, (size_t)M * D};
        pg8::gemm_phase<pg8::EpiUp, pg8::StaticOrder, true, true>(ldsp, g, S, E);
#ifdef DUP_P5
        pg8::gemm_phase<pg8::EpiUp, pg8::StaticOrder, true, true>(ldsp, g, S, E);
#endif
    }
    { pg8::StaticOrder S; S.init(M, D, G, bx); pg8::Unit u0; S.next(0, u0); if (grouped) GROUP_BAR(u0.pm); else GRID_BAR(); }

    for (int i = 0; i < EXTRA_SYNC; ++i) GRID_BAR();
    if (PH_MASK & 64) {
        pg8::Gemm g{UU, WDN, M, D, FF, D, 4, (size_t)M * D * 2}; pg8::StaticOrder S; S.init(M, D, G, bx);
        pg8::EpiRes2 E{a.out, X1B};
        pg8::gemm_phase<pg8::EpiRes2, pg8::StaticOrder, true, true>(ldsp, g, S, E);
    }
#if defined(MONO_BAR)
    if (wave == 0) { unsigned old_ = 0u; if (lane == 0) old_ = xb_add(&g_done_cnt, 1u);
        old_ = (unsigned)__builtin_amdgcn_readfirstlane((int)old_);
        if (old_ == (unsigned)G - 1u) { __hip_atomic_store(&g_panel_cnt[64 * lane], 0u, RLX_AGENT);
            if (lane < 16) __hip_atomic_store(&g_bar_shard[64 * lane], 0u, RLX_AGENT);
            if (lane == 0) { __hip_atomic_store(&g_bar_cnt, 0u, RLX_AGENT); __hip_atomic_store(&g_done_cnt, 0u, RLX_AGENT); } } }
#endif
}

extern "C" void kernel_launch(void* const* d_in, const int* in_sizes, int n_in, void* d_out, int out_size, void* d_ws, size_t ws_size, hipStream_t stream) {
    static int grid = 0;
    if (grid == 0) {
        if (n_in != 16 || out_size != M * D || ws_size < WS_END) { fprintf(stderr, "kernel_launch: unexpected shapes (n_in %d, out %d, ws %zu)\n", n_in, out_size, ws_size); grid = -1; return; }
        int dev = 0, cus = 0, per_cu = 0;
        (void)hipGetDevice(&dev); (void)hipDeviceGetAttribute(&cus, hipDeviceAttributeMultiprocessorCount, dev);
        if (hipFuncSetAttribute((const void*)fwd, hipFuncAttributeMaxDynamicSharedMemorySize, LDS_BYTES) != hipSuccess) { fprintf(stderr, "kernel_launch: hipFuncSetAttribute failed\n"); grid = -1; return; }
        if (hipOccupancyMaxActiveBlocksPerMultiprocessor(&per_cu, (const void*)fwd, NWAVES * 64, LDS_BYTES) != hipSuccess || per_cu < 1) { fprintf(stderr, "kernel_launch: occupancy query says %d\n", per_cu); per_cu = 1; }
        (void)hipGetLastError();
        grid = cus * 1;
    }
    if (grid < 0) return;
#if !defined(GEN_BAR) && !defined(MONO_BAR)
    if (hipMemsetAsync((char*)d_ws + WS_CTL, 0, CTL_ZERO_BYTES, stream) != hipSuccess) { fprintf(stderr, "kernel_launch: memset of the barrier words failed\n"); return; }
#endif
    Args a{};
    for (int i = 0; i < 16; ++i) a.in[i] = (const float*)d_in[i];
    a.out = (float*)d_out; a.ws = (unsigned char*)d_ws;
    void* args[] = {&a};
    hipError_t e = hipLaunchCooperativeKernel((const void*)fwd, dim3(grid), dim3(NWAVES * 64), args, LDS_BYTES, stream);
    if (e != hipSuccess) fprintf(stderr, "kernel_launch: cooperative launch failed: %s (grid %d)\n", hipGetErrorString(e), grid);
}
```

```cpp
#include <hip/hip_runtime.h>
#include <cstdio>
#include <cstdint>
#define MONO_BAR 1
namespace pg8 {
#define PG8_LAS __attribute__((address_space(3)))
typedef unsigned short bf16_t;
typedef short bf16x8 __attribute__((ext_vector_type(8)));
typedef float f32x4 __attribute__((ext_vector_type(4)));
typedef unsigned u32x4 __attribute__((ext_vector_type(4)));
constexpr int BM = 256, BK = 64, HALF = 128, HTB = HALF * BK * 2  , STAGE_BYTES = 8 * HTB, NXCD = 8, WGM = 8;

__host__ __device__ __forceinline__ int lds_byte(int r, int c) { const int st = (r >> 4) * 2 + (c >> 5), rr = r & 15, cc = c & 31, ob = rr * 64 + cc * 2; return st * 1024 + (ob ^ (((ob >> 9) & 1) << 5)); }
__host__ __device__ __forceinline__ void stage_rc(int b, int& R, int& C) { const int st = b / 1024, sb = b % 1024, swz = sb ^ (((sb >> 9) & 1) << 5); R = (st >> 1) * 16 + swz / 64; C = (st & 1) * 32 + (swz % 64) / 2; }
__host__ __device__ __forceinline__ int perm32(int rho) { const int n = rho >> 4, i = rho & 15; return 8 * (i >> 2) + 4 * n + (i & 3); }

struct Unit { int pm, pn; };
struct Gemm { const bf16_t* A; const bf16_t* Bt; int M, N, K; int lda; int segsh; size_t segstride; };

struct StaticOrder {
    int nM, nN, nwg, G, c;
    __host__ __device__ void init(int M, int N, int G_, int c_) { nM = M / BM; nN = N / BM; nwg = nM * nN; G = G_; c = c_; }
    __host__ __device__ bool next(int i, Unit& u) const {
        const long L = (long)i * G + c; if (L >= nwg) return false;
        int wgid = (int)L; { const int q = nwg / NXCD, r = nwg % NXCD, xcd = wgid % NXCD, off = wgid / NXCD; wgid = (xcd < r ? xcd * (q + 1) : r * (q + 1) + (xcd - r) * q) + off; }
        const int nig = WGM * nN, gid = wgid / nig, fm = gid * WGM, gsz = (nM - fm) < WGM ? (nM - fm) : WGM;
        u.pm = fm + ((wgid % nig) % gsz); u.pn = (wgid % nig) / gsz; return true;
    }
    __device__ __forceinline__ void a_ready(const Unit&) const {}
    __device__ __forceinline__ void done(const Unit&) const {}
};

__device__ __forceinline__ unsigned cvt_pk_bf16(float lo, float hi) { unsigned r; asm volatile("v_cvt_pk_bf16_f32 %0, %1, %2" : "=v"(r) : "v"(lo), "v"(hi)); return r; }
typedef float f32x2 __attribute__((ext_vector_type(2)));
#ifndef WT_STORES
#define WT_STORES 1
#endif
__device__ __forceinline__ void st16(void* p, u32x4 v) {
#if WT_STORES
    asm volatile("global_store_dwordx4 %0, %1, off sc1\n\ts_nop 1" :: "v"(p), "v"(v) : "memory");
#else
    *(u32x4*)p = v;
#endif
}
__device__ __forceinline__ void st16nt(void* p, u32x4 v) {
    asm volatile("global_store_dwordx4 %0, %1, off sc1 nt\n\ts_nop 1" :: "v"(p), "v"(v) : "memory");
}
typedef unsigned u32x2w __attribute__((ext_vector_type(2)));
__device__ __forceinline__ void st8(void* p, u32x2w v) {
#if WT_STORES
    asm volatile("global_store_dwordx2 %0, %1, off sc1\n\ts_nop 1" :: "v"(p), "v"(v) : "memory");
#else
    *(u32x2w*)p = v;
#endif
}
typedef unsigned u32x2 __attribute__((ext_vector_type(2)));
__device__ __forceinline__ float bf_lo(unsigned w) { return __uint_as_float(w << 16); }
__device__ __forceinline__ float bf_hi(unsigned w) { return __uint_as_float(w & 0xffff0000u); }
__device__ __forceinline__ u32x4 pack8(f32x4 a, f32x4 b) { u32x4 w; w.x = cvt_pk_bf16(a[0], a[1]); w.y = cvt_pk_bf16(a[2], a[3]); w.z = cvt_pk_bf16(b[0], b[1]); w.w = cvt_pk_bf16(b[2], b[3]); return w; }
__device__ __forceinline__ void unpack8(u32x4 w, f32x4& a, f32x4& b) { a = (f32x4){bf_lo(w.x), bf_hi(w.x), bf_lo(w.y), bf_hi(w.y)}; b = (f32x4){bf_lo(w.z), bf_hi(w.z), bf_lo(w.w), bf_hi(w.w)}; }
constexpr float QK_C2 = 0.125f * 1.4426950408889634f;
constexpr float RMS_EPS = 1e-6f;
__device__ __forceinline__ float quad_sum(float s) {
    { auto r = __builtin_amdgcn_permlane16_swap(__float_as_uint(s), __float_as_uint(s), false, false); s = __uint_as_float(r[0]) + __uint_as_float(r[1]); }
    { auto r = __builtin_amdgcn_permlane32_swap(__float_as_uint(s), __float_as_uint(s), false, false); s = __uint_as_float(r[0]) + __uint_as_float(r[1]); }
    return s;
}

struct EpiP1 {
    static constexpr bool PERM = true, AFTER_DRAIN = false, CHAIN = false;
    bf16_t *Q, *Kb, *V, *BG, *U1, *G; const float *gq, *gk, *bgate;
    __device__ __forceinline__ void operator()(const f32x4 (&acc)[2][2][4][2], const Unit& u, int wr, int wc, int fr, int fq) const {
        const int pn = u.pn; const int row0 = u.pm * BM + wr * 64 + fr;
        if (pn < 8) {
            const bool isq = pn < 4; const float* g = isq ? gq : gk; bf16_t* O = isq ? Q : Kb; const float sc = isq ? QK_C2 : 1.f;
            const int head = 4 * (pn & 3) + wc;
            f32x4 gv[2][2];
#pragma unroll
            for (int bj = 0; bj < 2; ++bj)
#pragma unroll
                for (int n = 0; n < 2; ++n) gv[bj][n] = *(const f32x4*)(g + 32 * bj + 8 * fq + 4 * n) * sc;
#pragma unroll
            for (int ai = 0; ai < 2; ++ai)
#pragma unroll
                for (int m = 0; m < 4; ++m) {
                    float s = 0.f;
#pragma unroll
                    for (int bj = 0; bj < 2; ++bj)
#pragma unroll
                        for (int n = 0; n < 2; ++n) { const f32x4 x = acc[ai][bj][m][n]; s += (x[0] * x[0] + x[1] * x[1]) + (x[2] * x[2] + x[3] * x[3]); }
                    s = quad_sum(s);
                    const float rs = __builtin_amdgcn_rsqf(s * (1.0f / 64.0f) + RMS_EPS);
                    bf16_t* rowp = O + (size_t)(row0 + ai * HALF + m * 16) * 1024 + head * 64 + 8 * fq;
#pragma unroll
                    for (int bj = 0; bj < 2; ++bj) st16(rowp + 32 * bj, pack8(acc[ai][bj][m][0] * rs * gv[bj][0], acc[ai][bj][m][1] * rs * gv[bj][1]));
                }
        } else if (pn < 16) {
            bf16_t* O = (pn < 12) ? V : BG; const int col0 = 256 * (pn & 3) + wc * 32 + 8 * fq;
#pragma unroll
            for (int ai = 0; ai < 2; ++ai)
#pragma unroll
                for (int m = 0; m < 4; ++m) { bf16_t* rowp = O + (size_t)(row0 + ai * HALF + m * 16) * 1024 + col0;
#pragma unroll
                    for (int bj = 0; bj < 2; ++bj) { if (pn < 12) st16(rowp + bj * HALF, pack8(acc[ai][bj][m][0], acc[ai][bj][m][1])); else st16nt(rowp + bj * HALF, pack8(acc[ai][bj][m][0], acc[ai][bj][m][1])); } }
        } else if (pn < 24) {
            const int col0 = 128 * (pn - 16) + wc * 32 + 8 * fq;
#pragma unroll
            for (int ai = 0; ai < 2; ++ai)
#pragma unroll
                for (int m = 0; m < 4; ++m)
                    st16nt(U1 + (size_t)(row0 + ai * HALF + m * 16) * 1024 + col0, pack8(acc[ai][0][m][0] * acc[ai][1][m][0], acc[ai][0][m][1] * acc[ai][1][m][1]));
        } else {
            const int ch0 = 128 * (pn - 24) + wc * 32 + 8 * fq;
            f32x4 bv[2][2];
#pragma unroll
            for (int bj = 0; bj < 2; ++bj)
#pragma unroll
                for (int n = 0; n < 2; ++n) bv[bj][n] = *(const f32x4*)(bgate + 1024 * bj + ch0 + 4 * n);
#pragma unroll
            for (int ai = 0; ai < 2; ++ai)
#pragma unroll
                for (int m = 0; m < 4; ++m) { bf16_t* rowp = G + (size_t)(row0 + ai * HALF + m * 16) * 2048 + ch0; f32x4 dv[2], rv[2];
#pragma unroll
                    for (int n = 0; n < 2; ++n) { const f32x4 za = (acc[ai][0][m][n] + bv[0][n]) * (-1.4426950408889634f), zc = (acc[ai][1][m][n] + bv[1][n]) * (-1.4426950408889634f);
#pragma unroll
                        for (int e = 0; e < 4; ++e) { const float ia = fminf(1.0f + __builtin_amdgcn_exp2f(za[e]), 1.1529215e18f);
                            dv[n][e] = __builtin_amdgcn_rcpf(ia); rv[n][e] = ia * __builtin_amdgcn_rcpf(1.0f + __builtin_amdgcn_exp2f(zc[e])); } }
                    st16nt(rowp, pack8(dv[0], dv[1])); st16nt(rowp + 1024, pack8(rv[0], rv[1])); }
        }
    }
};
template <bool ADD> struct EpiGate {
    static constexpr bool PERM = true, AFTER_DRAIN = false, CHAIN = false;
    const bf16_t* G; bf16_t* MG; int goff;
    __device__ __forceinline__ void operator()(const f32x4 (&acc)[2][2][4][2], const Unit& u, int wr, int wc, int fr, int fq) const {
        const int row0 = u.pm * BM + wr * 64 + fr, col0 = u.pn * BM + wc * 32 + 8 * fq;
#pragma unroll
        for (int ai = 0; ai < 2; ++ai)
#pragma unroll
            for (int m = 0; m < 4; ++m) { const size_t r = (size_t)(row0 + ai * HALF + m * 16);
#pragma unroll
                for (int bj = 0; bj < 2; ++bj) { f32x4 g0, g1; unpack8(*(const u32x4*)(G + r * 2048 + goff + col0 + bj * HALF), g0, g1);
                    f32x4 v0 = acc[ai][bj][m][0] * g0, v1 = acc[ai][bj][m][1] * g1;
                    bf16_t* p = MG + r * 1024 + col0 + bj * HALF;
                    if (ADD) { f32x4 a0, a1; unpack8(*(const u32x4*)p, a0, a1); v0 += a0; v1 += a1; }
                    *(u32x4*)p = pack8(v0, v1); } }
    }
};
struct PairOrder {
    StaticOrder S;
    __device__ bool next(int i, Unit& u) const { Unit b; if (!S.next(i >> 1, b)) return false; u.pm = b.pm + ((i & 1) ? 64 : 0); u.pn = b.pn + ((i & 1) ? 4 : 0); return true; }
    __device__ __forceinline__ void a_ready(const Unit&) const {}
    __device__ __forceinline__ void done(const Unit&) const {}
};
struct EpiGate2 {
    static constexpr bool PERM = true, AFTER_DRAIN = false, CHAIN = true;
    const bf16_t* G; bf16_t* MG;
    __device__ __forceinline__ bool chain(f32x4 (&acc)[2][2][4][2], const Unit& u, int wr, int wc, int fr, int fq) const {
        const bool second = u.pm >= 64; const int pm = second ? u.pm - 64 : u.pm, pn = second ? u.pn - 4 : u.pn;
        const int row0 = pm * BM + wr * 64 + fr, col0 = pn * BM + wc * 32 + 8 * fq, goff = second ? 0 : 1024;
#pragma unroll
        for (int ai = 0; ai < 2; ++ai) {
            u32x4 gl[4][2];
#pragma unroll
            for (int m = 0; m < 4; ++m) { const size_t r = (size_t)(row0 + ai * HALF + m * 16);
#pragma unroll
                for (int bj = 0; bj < 2; ++bj) gl[m][bj] = __builtin_nontemporal_load((const u32x4*)(G + r * 2048 + goff + col0 + bj * HALF)); }
#pragma unroll
            for (int m = 0; m < 4; ++m) { const size_t r = (size_t)(row0 + ai * HALF + m * 16);
#pragma unroll
                for (int bj = 0; bj < 2; ++bj) { f32x4 g0, g1; unpack8(gl[m][bj], g0, g1);
                    if (!second) { acc[ai][bj][m][0] *= g0; acc[ai][bj][m][1] *= g1; }
                    else st16(MG + r * 1024 + col0 + bj * HALF, pack8(acc[ai][bj][m][0] * g0, acc[ai][bj][m][1] * g1)); } }
        }
        return !second;
    }
    __device__ __forceinline__ void operator()(const f32x4 (&)[2][2][4][2], const Unit&, int, int, int, int) const {}
};
#ifndef STORE_X1_F32
#define STORE_X1_F32 0
#endif
struct EpiRes1 {
    static constexpr bool PERM = true, AFTER_DRAIN = false, CHAIN = false;
    const float* x; float* out; bf16_t* x1b; float* SS;
    __device__ __forceinline__ void operator()(const f32x4 (&acc)[2][2][4][2], const Unit& u, int wr, int wc, int fr, int fq) const {
        const int row0 = u.pm * BM + wr * 64 + fr, col0 = u.pn * BM + wc * 32 + 8 * fq;
#pragma unroll
        for (int ai = 0; ai < 2; ++ai) {
            f32x4 xv[4][2][2];
#pragma unroll
            for (int m = 0; m < 4; ++m) { const size_t off = (size_t)(row0 + ai * HALF + m * 16) * 1024 + col0;
#pragma unroll
                for (int bj = 0; bj < 2; ++bj)
#pragma unroll
                    for (int n = 0; n < 2; ++n) xv[m][bj][n] = __builtin_nontemporal_load((const f32x4*)(x + off + bj * HALF + n * 4)); }
#pragma unroll
            for (int m = 0; m < 4; ++m) { const size_t r = (size_t)(row0 + ai * HALF + m * 16); const size_t off = r * 1024 + col0; float s = 0.f;
#pragma unroll
                for (int bj = 0; bj < 2; ++bj) { const f32x4 v0 = xv[m][bj][0] + acc[ai][bj][m][0], v1 = xv[m][bj][1] + acc[ai][bj][m][1];
                    if (STORE_X1_F32) { *(f32x4*)(out + off + bj * HALF) = v0; *(f32x4*)(out + off + bj * HALF + 4) = v1; }
                    s += ((v0[0] * v0[0] + v0[1] * v0[1]) + (v0[2] * v0[2] + v0[3] * v0[3])) + ((v1[0] * v1[0] + v1[1] * v1[1]) + (v1[2] * v1[2] + v1[3] * v1[3]));
                    st16(x1b + off + bj * HALF, pack8(v0, v1)); }
                s = quad_sum(s);
                if (fq == 0) __hip_atomic_store(SS + r * 16 + 4 * u.pn + wc, s, __ATOMIC_RELAXED, __HIP_MEMORY_SCOPE_AGENT); }
            asm volatile("" ::: "memory");
        }
    }
};
struct EpiUp {
    static constexpr bool PERM = true, AFTER_DRAIN = false, CHAIN = false;
    const float* SS; bf16_t* UU; size_t piece;
    __device__ __forceinline__ void operator()(const f32x4 (&acc)[2][2][4][2], const Unit& u, int wr, int wc, int fr, int fq) const {
        const int row0 = u.pm * BM + wr * 64 + fr;
        bf16_t* UUp = UU + (size_t)(u.pn >> 2) * piece + (u.pn & 3) * BM + wc * 32 + 8 * fq;
#pragma unroll
        for (int ai = 0; ai < 2; ++ai)
#pragma unroll
            for (int m = 0; m < 4; ++m) { const size_t r = (size_t)(row0 + ai * HALF + m * 16);
                const f32x4* sp = (const f32x4*)(SS + r * 16); const f32x4 s4 = (sp[0] + sp[1]) + (sp[2] + sp[3]);
                const float rs = __builtin_amdgcn_rsqf(((s4[0] + s4[1]) + (s4[2] + s4[3])) * (1.0f / 1024.0f) + RMS_EPS);
#pragma unroll
                for (int bj = 0; bj < 2; ++bj) { f32x4 v[2];
#pragma unroll
                    for (int n = 0; n < 2; ++n) { const f32x4 z = acc[ai][bj][m][n] * rs;
#pragma unroll
                        for (int e = 0; e < 4; ++e) { const float t = fmaxf(z[e], 0.f); v[n][e] = t * t; } }
                    st16(UUp + r * 1024 + bj * HALF, pack8(v[0], v[1])); } }
    }
};
struct EpiRes2 {
    static constexpr bool PERM = true, AFTER_DRAIN = false, CHAIN = false;
    float* out; const bf16_t* x1b;
    __device__ __forceinline__ void operator()(const f32x4 (&acc)[2][2][4][2], const Unit& u, int wr, int wc, int fr, int fq) const {
        const int row0 = u.pm * BM + wr * 64 + fr, col0 = u.pn * BM + wc * 32 + 8 * fq;
#pragma unroll
        for (int ai = 0; ai < 2; ++ai) {
            u32x4 bw[4][2];
#pragma unroll
            for (int m = 0; m < 4; ++m) { const size_t off = (size_t)(row0 + ai * HALF + m * 16) * 1024 + col0;
#pragma unroll
                for (int bj = 0; bj < 2; ++bj) bw[m][bj] = __builtin_nontemporal_load((const u32x4*)(x1b + off + bj * HALF)); }
#pragma unroll
            for (int m = 0; m < 4; ++m) { const size_t off = (size_t)(row0 + ai * HALF + m * 16) * 1024 + col0;
#pragma unroll
                for (int bj = 0; bj < 2; ++bj) { f32x4 b0, b1; unpack8(bw[m][bj], b0, b1); float* p = out + off + bj * HALF;
                    *(f32x4*)p = b0 + acc[ai][bj][m][0]; *(f32x4*)(p + 4) = b1 + acc[ai][bj][m][1]; } }
            asm volatile("" ::: "memory");
        }
    }
};

template <class Epi, class Sched, bool ALIGN_EPI = false, bool SP2 = false>
__device__ __forceinline__ void gemm_phase(PG8_LAS unsigned char* lds, const Gemm g, const Sched& S, const Epi& E) {
    int tid_ = threadIdx.x; asm volatile("" : "+v"(tid_));
    const int tid = tid_, wid = __builtin_amdgcn_readfirstlane(tid >> 6), lane = tid & 63, wr = wid >> 2, wc = wid & 3, fr = lane & 15, fq = lane >> 4;
    const int K = g.K, nt = K / BK;
    const int lda = g.lda ? g.lda : K, segsh = g.segsh ? g.segsh : 30;
    unsigned voffA[2], voffB[2];
#pragma unroll
    for (int i = 0; i < 2; ++i) { int R, C; stage_rc(tid * 16 + i * 8192, R, C); const int Rb = Epi::PERM ? ((R & ~31) + perm32(R & 31)) : R;
        voffA[i] = (unsigned)(R * lda + C) * 2u; voffB[i] = (unsigned)(Rb * K + C) * 2u; }
    const size_t kstep = (size_t)(BK * 2);
    const size_t hstep = (size_t)HALF * K * 2;
    const size_t tstep = 2 * hstep;
    const size_t hstepA = (size_t)HALF * lda * 2, tstepA = 2 * hstepA;
#define PG8_AOFF(t_) ((size_t)((t_) >> segsh) * g.segstride + (size_t)((t_) & ((1 << segsh) - 1)) * kstep)
    const unsigned ldsw = (unsigned)wid * 1024u;
    const int aoff = lds_byte(wr * 64 + fr, fq * 8), boff = lds_byte(wc * 32 + fr, fq * 8);
#define PG8_SA(b, h) (((b) * 2 + (h)) * HTB)
#define PG8_SB(b, h) ((4 + (b) * 2 + (h)) * HTB)
#define PG8_STAGE(bufoff, gbase, voff) do { _Pragma("unroll") for (int _i = 0; _i < 2; ++_i) \
        __builtin_amdgcn_global_load_lds((const unsigned*)((const char*)(gbase) + (voff)[_i]), (PG8_LAS unsigned*)(lds + (bufoff) + ldsw + _i * 8192), 16, 0, 0); } while (0)
#define PG8_LDA(dst, b, h) do { _Pragma("unroll") for (int m = 0; m < 4; ++m) _Pragma("unroll") for (int k = 0; k < 2; ++k) dst[m][k] = *(const PG8_LAS bf16x8*)(lds + PG8_SA(b, h) + aoff + m * 2048 + k * 1024); } while (0)
#define PG8_LDB(dst, b, h) do { _Pragma("unroll") for (int n = 0; n < 2; ++n) _Pragma("unroll") for (int k = 0; k < 2; ++k) dst[n][k] = *(const PG8_LAS bf16x8*)(lds + PG8_SB(b, h) + boff + n * 2048 + k * 1024); } while (0)
#define PG8_MMA(ai, bj, At, Bt) do { __builtin_amdgcn_s_setprio(1); _Pragma("unroll") for (int m = 0; m < 4; ++m) _Pragma("unroll") for (int n = 0; n < 2; ++n) _Pragma("unroll") for (int k = 0; k < 2; ++k) \
        acc[ai][bj][m][n] = __builtin_amdgcn_mfma_f32_16x16x32_bf16(Bt[n][k], At[m][k], acc[ai][bj][m][n], 0, 0, 0); __builtin_amdgcn_s_setprio(0); } while (0)
#define PG8_WAIT_V(n) asm volatile("s_waitcnt vmcnt(" #n ")" ::: "memory")
#define PG8_WAIT_L(n) asm volatile("s_waitcnt lgkmcnt(" #n ")" ::: "memory")
#define PG8_BAR __builtin_amdgcn_s_barrier()
#define PG8_SCHED __builtin_amdgcn_sched_barrier(0)
    Unit cur, nxt; int ui = 0;
    if (!S.next(0, cur)) return;
    f32x4 acc[2][2][4][2];
#pragma unroll
    for (int a = 0; a < 2; ++a)
#pragma unroll
        for (int b = 0; b < 2; ++b)
#pragma unroll
            for (int m = 0; m < 4; ++m)
#pragma unroll
                for (int n = 0; n < 2; ++n) acc[a][b][m][n] = (f32x4){0.f, 0.f, 0.f, 0.f};
    bf16x8 At[4][2], B0[2][2], B1[2][2];
    const char* cA = (const char*)g.A + (size_t)cur.pm * tstepA; const char* cB = (const char*)g.Bt + (size_t)cur.pn * tstep;
    S.a_ready(cur);
    if constexpr (SP2) {
        PG8_STAGE(PG8_SB(0, 0), cB, voffB); PG8_STAGE(PG8_SB(0, 1), cB + hstep, voffB); PG8_STAGE(PG8_SA(0, 0), cA, voffA); PG8_STAGE(PG8_SA(0, 1), cA + hstepA, voffA);
        if (wr == 1) PG8_BAR;
        PG8_WAIT_V(2); PG8_BAR;
        PG8_STAGE(PG8_SB(1, 0), cB + kstep, voffB); PG8_STAGE(PG8_SA(1, 0), cA + kstep, voffA); PG8_STAGE(PG8_SB(1, 1), cB + hstep + kstep, voffB);
        PG8_WAIT_V(6); PG8_BAR;
    } else {
        PG8_STAGE(PG8_SB(0, 0), cB, voffB); PG8_STAGE(PG8_SA(0, 0), cA, voffA); PG8_STAGE(PG8_SB(0, 1), cB + hstep, voffB); PG8_STAGE(PG8_SA(0, 1), cA + hstepA, voffA);
        if (wr == 1) PG8_BAR;
        PG8_WAIT_V(4); PG8_BAR;
        PG8_STAGE(PG8_SB(1, 0), cB + kstep, voffB); PG8_STAGE(PG8_SA(1, 0), cA + kstep, voffA); PG8_STAGE(PG8_SB(1, 1), cB + hstep + kstep, voffB);
        PG8_WAIT_V(6); PG8_BAR;
    }
    for (;;) {
        const bool has_next = S.next(ui + 1, nxt);
        const char* nA = has_next ? (const char*)g.A + (size_t)nxt.pm * tstepA : cA; const char* nB = has_next ? (const char*)g.Bt + (size_t)nxt.pn * tstep : cB;
        for (int t = 0; t < nt; t += 2) {
            const bool last = (t == nt - 2);
            const char* a1 = cA + PG8_AOFF(t) + kstep;
            const char* a2 = last ? nA : cA + PG8_AOFF(t + 2); const char* b2 = last ? nB : cB + (size_t)(t + 2) * kstep;
            const char* a3 = a2 + kstep; const char* b3 = b2 + kstep;
            if (last && has_next) S.a_ready(nxt);
            if constexpr (SP2) {
            PG8_LDB(B0, 0, 0); PG8_LDB(B1, 0, 1); PG8_SCHED; PG8_LDA(At, 0, 0); PG8_STAGE(PG8_SA(1, 1), a1 + hstepA, voffA);
            PG8_WAIT_V(8); PG8_WAIT_L(0); PG8_BAR; PG8_MMA(0, 0, At, B0); PG8_MMA(0, 1, At, B1); PG8_BAR; PG8_SCHED;
            PG8_LDA(At, 0, 1); PG8_STAGE(PG8_SB(0, 0), b2, voffB); PG8_STAGE(PG8_SB(0, 1), b2 + hstep, voffB); PG8_STAGE(PG8_SA(0, 0), a2, voffA);
            PG8_WAIT_V(8); PG8_WAIT_L(0); PG8_BAR; PG8_MMA(1, 0, At, B0); PG8_MMA(1, 1, At, B1); PG8_BAR; PG8_SCHED;
            PG8_LDB(B0, 1, 0); PG8_LDB(B1, 1, 1); PG8_SCHED; PG8_LDA(At, 1, 0); PG8_STAGE(PG8_SA(0, 1), a2 + hstepA, voffA);
            PG8_WAIT_V(8); PG8_WAIT_L(0); PG8_BAR; PG8_MMA(0, 0, At, B0); PG8_MMA(0, 1, At, B1); PG8_BAR; PG8_SCHED;
            PG8_LDA(At, 1, 1); PG8_STAGE(PG8_SB(1, 0), b3, voffB); PG8_STAGE(PG8_SB(1, 1), b3 + hstep, voffB); PG8_STAGE(PG8_SA(1, 0), a3, voffA);
            PG8_WAIT_V(8); PG8_WAIT_L(0); PG8_BAR; PG8_MMA(1, 0, At, B0); PG8_MMA(1, 1, At, B1); PG8_BAR; PG8_SCHED;
            } else {
            PG8_LDB(B0, 0, 0); PG8_SCHED; PG8_LDA(At, 0, 0); PG8_STAGE(PG8_SA(1, 1), a1 + hstepA, voffA);
            PG8_WAIT_L(8); PG8_BAR; PG8_WAIT_L(0); PG8_MMA(0, 0, At, B0); PG8_BAR; PG8_SCHED;
            PG8_LDB(B1, 0, 1); PG8_STAGE(PG8_SB(0, 0), b2, voffB);
            PG8_BAR; PG8_WAIT_L(0); PG8_MMA(0, 1, At, B1); PG8_BAR;
            PG8_LDA(At, 0, 1); PG8_STAGE(PG8_SA(0, 0), a2, voffA);
            PG8_BAR; PG8_WAIT_L(0); PG8_MMA(1, 0, At, B0); PG8_BAR; PG8_SCHED;
            PG8_STAGE(PG8_SB(0, 1), b2 + hstep, voffB);
            PG8_WAIT_V(6); PG8_BAR; PG8_MMA(1, 1, At, B1); PG8_BAR;
            PG8_LDB(B0, 1, 0); PG8_SCHED; PG8_LDA(At, 1, 0); PG8_STAGE(PG8_SA(0, 1), a2 + hstepA, voffA);
            PG8_WAIT_L(8); PG8_BAR; PG8_WAIT_L(0); PG8_MMA(0, 0, At, B0); PG8_BAR; PG8_SCHED;
            PG8_LDB(B1, 1, 1); PG8_STAGE(PG8_SB(1, 0), b3, voffB);
            PG8_BAR; PG8_WAIT_L(0); PG8_MMA(0, 1, At, B1); PG8_BAR;
            PG8_LDA(At, 1, 1); PG8_STAGE(PG8_SA(1, 0), a3, voffA);
            PG8_BAR; PG8_WAIT_L(0); PG8_MMA(1, 0, At, B0); PG8_BAR; PG8_SCHED;
            PG8_STAGE(PG8_SB(1, 1), b3 + hstep, voffB);
            PG8_WAIT_V(6); PG8_BAR; PG8_MMA(1, 1, At, B1); PG8_BAR;
            }
        }
        if constexpr (ALIGN_EPI) { if (wr == 0) PG8_BAR; }
        bool keep_acc = false;
        if constexpr (Epi::CHAIN) { keep_acc = E.chain(acc, cur, wr, wc, fr, fq); S.done(cur); }
        else if constexpr (!Epi::AFTER_DRAIN) { E(acc, cur, wr, wc, fr, fq); S.done(cur); }
        if (!has_next) break;
        if (!keep_acc) {
#pragma unroll
        for (int a = 0; a < 2; ++a)
#pragma unroll
            for (int b = 0; b < 2; ++b)
#pragma unroll
                for (int m = 0; m < 4; ++m)
#pragma unroll
                    for (int n = 0; n < 2; ++n) acc[a][b][m][n] = (f32x4){0.f, 0.f, 0.f, 0.f};
        }
        cur = nxt; cA = nA; cB = nB; ++ui;
        if constexpr (ALIGN_EPI) { if (wr == 1) PG8_BAR; }
    }
    PG8_WAIT_V(0);
    if constexpr (!ALIGN_EPI) { if (wr == 0) PG8_BAR; }
    PG8_BAR;
    if constexpr (Epi::AFTER_DRAIN) { E.fused(acc, cur, wr, wc, fr, fq, lds, wid, lane); S.done(cur); }
#undef PG8_AOFF
#undef PG8_SA
#undef PG8_SB
#undef PG8_STAGE
#undef PG8_LDA
#undef PG8_LDB
#undef PG8_MMA
#undef PG8_WAIT_V
#undef PG8_WAIT_L
#undef PG8_BAR
#undef PG8_SCHED
}
}

namespace attn {
using bf16 = unsigned short;
using bf16x8 = __attribute__((ext_vector_type(8))) short;
using s16x4 = __attribute__((ext_vector_type(4))) short;
using f32x16 = __attribute__((ext_vector_type(16))) float;
using u32x4 = __attribute__((ext_vector_type(4))) unsigned;
using f32x4 = __attribute__((ext_vector_type(4))) float;
constexpr int SEQ = 4096, DM = 1024, NSLOT = 6, SLOTB = 8192, NREL = 513;
constexpr int LDS_K = 0, LDS_V = NSLOT * SLOTB, LDS_WS = 2 * NSLOT * SLOTB, LDS_OST = LDS_WS + 8 * 64 * 4, LDS_BIAS = LDS_OST + 8 * 4096, BIAS_CS = 400  , LDS_BYTES = LDS_BIAS + 4 * BIAS_CS * 4;
constexpr float LOG2E = 1.4426950408889634f;
__device__ __forceinline__ int crow(int r, int hi) { return (r & 3) + 8 * (r >> 2) + 4 * hi; }
#define SBAR() __builtin_amdgcn_sched_barrier(0)
__device__ __forceinline__ void glds16(const void* gsrc, unsigned lds_dst) { unsigned keep;
  asm volatile("s_mov_b32 %0, m0\n\ts_mov_b32 m0, %2\n\ts_nop 0\n\tglobal_load_lds_dwordx4 %1, off\n\ts_mov_b32 m0, %0" : "=&s"(keep) : "v"(gsrc), "s"(lds_dst) : "memory"); }
typedef float f32x2_t __attribute__((ext_vector_type(2))); typedef __bf16 bf16x2_t __attribute__((ext_vector_type(2)));
__device__ __forceinline__ unsigned cvtpk_s(float lo, float hi) { f32x2_t v = {lo, hi}; bf16x2_t b = __builtin_convertvector(v, bf16x2_t); return __builtin_bit_cast(unsigned, b); }
typedef __attribute__((address_space(3))) const char* lds_cptr;
__device__ __forceinline__ void kload8(bf16x8* kf, lds_cptr kp) {
  kf[0] = *(const __attribute__((address_space(3))) bf16x8*)(kp);        kf[1] = *(const __attribute__((address_space(3))) bf16x8*)(kp + 512);
  kf[2] = *(const __attribute__((address_space(3))) bf16x8*)(kp + 2048); kf[3] = *(const __attribute__((address_space(3))) bf16x8*)(kp + 2560);
  kf[4] = *(const __attribute__((address_space(3))) bf16x8*)(kp + 4096); kf[5] = *(const __attribute__((address_space(3))) bf16x8*)(kp + 4608);
  kf[6] = *(const __attribute__((address_space(3))) bf16x8*)(kp + 6144); kf[7] = *(const __attribute__((address_space(3))) bf16x8*)(kp + 6656);
}
__device__ __forceinline__ void pv(f32x16* o, int vb, bf16x8 pa0, bf16x8 pa1, bf16x8 pa2, bf16x8 pa3) {
  #pragma unroll
  for (int d0 = 0; d0 < 2; ++d0) { s16x4 lo[4], hi[4];
    #pragma unroll
    for (int ks = 0; ks < 4; ++ks) {
      asm volatile("ds_read_b64_tr_b16 %0,%1 offset:%c2" : "=&v"(lo[ks]) : "v"(vb), "i"(d0 * 4096 + ks * 1024) : "memory");
      asm volatile("ds_read_b64_tr_b16 %0,%1 offset:%c2" : "=&v"(hi[ks]) : "v"(vb), "i"(d0 * 4096 + ks * 1024 + 512) : "memory"); }
    asm volatile("s_waitcnt lgkmcnt(0)" ::: "memory"); SBAR();
    #define PK(k) (bf16x8){lo[k][0], lo[k][1], lo[k][2], lo[k][3], hi[k][0], hi[k][1], hi[k][2], hi[k][3]}
    o[d0] = __builtin_amdgcn_mfma_f32_32x32x16_bf16(pa0, PK(0), o[d0], 0, 0, 0);
    o[d0] = __builtin_amdgcn_mfma_f32_32x32x16_bf16(pa1, PK(1), o[d0], 0, 0, 0);
    o[d0] = __builtin_amdgcn_mfma_f32_32x32x16_bf16(pa2, PK(2), o[d0], 0, 0, 0);
    o[d0] = __builtin_amdgcn_mfma_f32_32x32x16_bf16(pa3, PK(3), o[d0], 0, 0, 0);
    #undef PK
  }
}
__device__ __forceinline__ float wmax(float v) {
#pragma unroll
  for (int o = 1; o < 64; o <<= 1) v = fmaxf(v, __shfl_xor(v, o));
  return v;
}
__device__ __forceinline__ void attn_unit(int b, int h, int g, const bf16* Q, const bf16* __restrict__ K, const bf16* __restrict__ V, bf16* O,
                                          const float* __restrict__ relb, const float* __restrict__ gq, const float* __restrict__ gk, char* shm) {
  int tid_ = threadIdx.x; asm volatile("" : "+v"(tid_));
  const int tid = tid_, lane = tid & 63, r32 = lane & 31, hi = lane >> 5; const int wid = __builtin_amdgcn_readfirstlane(tid >> 6);
  const long rowbase = (long)b * SEQ; const int q0 = g * 256;
  const int kc_lo = (4 * g - 8) > 0 ? (4 * g - 8) : 0, NT = 4 * g + 4 - kc_lo;
  const bf16* Qw = Q + (rowbase + q0 + wid * 32) * DM + h * 64;
  const bf16* Kh = K + (rowbase + 64 * kc_lo) * DM + h * 64; const bf16* Vh = V + (rowbase + 64 * kc_lo) * DM + h * 64;
  const unsigned lds0 = (unsigned)(uintptr_t)shm;
  float* wsf = (float*)(shm + LDS_WS) + wid * 64;
  float* biasT = (float*)(shm + LDS_BIAS);
  const bf16* ksrc = Kh + (long)lane * DM + wid * 8;
  const bf16* vsrc = Vh + (long)(16 * (wid & 3) + (lane >> 2)) * DM + (wid >> 2) * 32 + (lane & 3) * 8;
  const unsigned kdst = lds0 + LDS_K + wid * 1024, vdst = lds0 + LDS_V + wid * 1024;
  #define DMA_K(t, slot) glds16(ksrc + (long)(t) * 64 * DM, (unsigned)__builtin_amdgcn_readfirstlane(kdst + (slot)))
  #define DMA_V(t, slot) glds16(vsrc + (long)(t) * 64 * DM, (unsigned)__builtin_amdgcn_readfirstlane(vdst + (slot)))
  const int vb0 = (int)(lds0 + LDS_V) + ((lane >> 4) & 1) * 32 + (lane & 3) * 8 + (4 * hi + ((lane & 15) >> 2)) * 64;
  const lds_cptr shm3 = (lds_cptr)shm; const lds_cptr kp0 = shm3 + LDS_K + hi * 1024 + r32 * 16;
  const bool full = (g >= 2); const int nsteps = full ? 9 : NT;
  #define LOAD_TILE(i) (full ? ((i) < 6 ? (((i) & 1) ? ((i) >> 1) + 9 : ((i) >> 1)) : (i) - 3) : (i))
  #define ISSUE_LOAD(i) do { const int i_ = (i); const int tl_ = LOAD_TILE(i_); const int sb_ = (i_ % NSLOT) * SLOTB; DMA_K(tl_, sb_); DMA_V(tl_, sb_); } while (0)
  bf16x8 qr[4];
  #pragma unroll
  for (int d0 = 0; d0 < 4; ++d0) qr[d0] = *reinterpret_cast<const bf16x8*>(&Qw[(long)r32 * DM + d0 * 16 + hi * 8]);
  const float gqv = gq[lane], gkv = gk[lane]; float rbv[9], tbv[3];
  #pragma unroll
  for (int k = 0; k < 9; ++k) { const int i = lane + 64 * k; rbv[k] = (i < NREL) ? relb[h * NREL + i] : -3.0e38f; }
  #pragma unroll
  for (int k = 0; k < 3; ++k) { const int i = tid + 512 * k, c = i / 384, jj = i - c * 384, e = jj + c; tbv[k] = (e < 384) ? relb[h * NREL + (e < 64 ? 512 : 576 - e)] : 0.f; }
  asm volatile("" ::: "memory");
  ISSUE_LOAD(0); ISSUE_LOAD(1); if (full) { ISSUE_LOAD(2); ISSUE_LOAD(3); }
  float m2;
  { const float mq = wmax(fabsf(gqv)), mk = wmax(fabsf(gkv)); float mb = -3.0e38f;
    #pragma unroll
    for (int k = 0; k < 9; ++k) mb = fmaxf(mb, rbv[k]);
    mb = wmax(mb); m2 = (8.0f * mq * mk + mb) * LOG2E; }
  #pragma unroll
  for (int k = 0; k < 3; ++k) { const int i = tid + 512 * k, c = i / 384, jj = i - c * 384; biasT[c * BIAS_CS + jj] = tbv[k] * LOG2E - m2; }
  f32x16 o[2]; o[0] = f32x16{}; o[1] = f32x16{}; f32x16 lsum = f32x16{};
  const int qpos = 32 * (wid & 1) + r32;
  const int cch = 4 * g + (wid >> 1);
  if (full) asm volatile("s_waitcnt vmcnt(4) lgkmcnt(0)\n\ts_barrier" ::: "memory");
  else      asm volatile("s_waitcnt vmcnt(2) lgkmcnt(0)\n\ts_barrier" ::: "memory");
  for (int s = 0; s < nsteps; ++s) {
    int nis = 0;
    if (s + 2 < nsteps) { const int s2 = s + 2; if (full) { if (s2 < 3) { ISSUE_LOAD(2 * s2); ISSUE_LOAD(2 * s2 + 1); nis = 2; } else { ISSUE_LOAD(s2 + 3); nis = 1; } } else { ISSUE_LOAD(s2); nis = 1; } }
    int jrel = kc_lo + s - cch + 8, ld = full ? (s < 3 ? 2 * s : s + 3) : s;
    if (full && s < 3 && jrel < 0) { jrel += 9; ld += 1; }
    const int sl_cur = (ld % NSLOT) * SLOTB;
    if (jrel >= 0 && jrel <= 8) {
      s16x4 vlo[8], vhi[8]; { const int vb = vb0 + sl_cur;
        #pragma unroll
        for (int i_ = 0; i_ < 8; ++i_) {
          asm volatile("ds_read_b64_tr_b16 %0,%1 offset:%c2" : "=&v"(vlo[i_]) : "v"(vb), "i"((i_ >> 2) * 4096 + (i_ & 3) * 1024) : "memory");
          asm volatile("ds_read_b64_tr_b16 %0,%1 offset:%c2" : "=&v"(vhi[i_]) : "v"(vb), "i"((i_ >> 2) * 4096 + (i_ & 3) * 1024 + 512) : "memory"); } }
      f32x16 p0, p1;
      if (jrel <= 3) { const float c0 = biasT[0];
        #pragma unroll
        for (int r = 0; r < 16; ++r) { p0[r] = c0; p1[r] = c0; } }
      else { const int i0 = 64 + 4 * hi - qpos + 64 * (jrel - 4), cs = i0 & 3; const f32x4* a4 = (const f32x4*)(biasT + cs * BIAS_CS + (i0 - cs));
        #pragma unroll
        for (int q4 = 0; q4 < 4; ++q4) { const f32x4 b0 = a4[2 * q4], b1 = a4[2 * q4 + 8];
          #pragma unroll
          for (int e = 0; e < 4; ++e) { p0[4 * q4 + e] = b0[e]; p1[4 * q4 + e] = b1[e]; } } }
      bf16x8 kf[8]; kload8(kf, kp0 + sl_cur);
      #pragma unroll
      for (int d0 = 0; d0 < 4; ++d0) { p0 = __builtin_amdgcn_mfma_f32_32x32x16_bf16(kf[2 * d0], qr[d0], p0, 0, 0, 0); p1 = __builtin_amdgcn_mfma_f32_32x32x16_bf16(kf[2 * d0 + 1], qr[d0], p1, 0, 0, 0); }
      #pragma unroll
      for (int r = 0; r < 16; ++r) { p0[r] = __builtin_amdgcn_exp2f(p0[r]); p1[r] = __builtin_amdgcn_exp2f(p1[r]); }
      lsum += p0 + p1;
      u32x4 pw0, pw1, pw2, pw3;
      pw0 = (u32x4){cvtpk_s(p0[0], p0[1]), cvtpk_s(p0[2], p0[3]), cvtpk_s(p0[4], p0[5]), cvtpk_s(p0[6], p0[7])};
      pw1 = (u32x4){cvtpk_s(p0[8], p0[9]), cvtpk_s(p0[10], p0[11]), cvtpk_s(p0[12], p0[13]), cvtpk_s(p0[14], p0[15])};
      pw2 = (u32x4){cvtpk_s(p1[0], p1[1]), cvtpk_s(p1[2], p1[3]), cvtpk_s(p1[4], p1[5]), cvtpk_s(p1[6], p1[7])};
      pw3 = (u32x4){cvtpk_s(p1[8], p1[9]), cvtpk_s(p1[10], p1[11]), cvtpk_s(p1[12], p1[13]), cvtpk_s(p1[14], p1[15])};
      SBAR();
      asm volatile("s_waitcnt lgkmcnt(0)" ::: "memory"); SBAR();
      #define VF(i_) (bf16x8){vlo[i_][0], vlo[i_][1], vlo[i_][2], vlo[i_][3], vhi[i_][0], vhi[i_][1], vhi[i_][2], vhi[i_][3]}
      o[0] = __builtin_amdgcn_mfma_f32_32x32x16_bf16(__builtin_bit_cast(bf16x8, pw0), VF(0), o[0], 0, 0, 0); o[1] = __builtin_amdgcn_mfma_f32_32x32x16_bf16(__builtin_bit_cast(bf16x8, pw0), VF(4), o[1], 0, 0, 0);
      o[0] = __builtin_amdgcn_mfma_f32_32x32x16_bf16(__builtin_bit_cast(bf16x8, pw1), VF(1), o[0], 0, 0, 0); o[1] = __builtin_amdgcn_mfma_f32_32x32x16_bf16(__builtin_bit_cast(bf16x8, pw1), VF(5), o[1], 0, 0, 0);
      o[0] = __builtin_amdgcn_mfma_f32_32x32x16_bf16(__builtin_bit_cast(bf16x8, pw2), VF(2), o[0], 0, 0, 0); o[1] = __builtin_amdgcn_mfma_f32_32x32x16_bf16(__builtin_bit_cast(bf16x8, pw2), VF(6), o[1], 0, 0, 0);
      o[0] = __builtin_amdgcn_mfma_f32_32x32x16_bf16(__builtin_bit_cast(bf16x8, pw3), VF(3), o[0], 0, 0, 0); o[1] = __builtin_amdgcn_mfma_f32_32x32x16_bf16(__builtin_bit_cast(bf16x8, pw3), VF(7), o[1], 0, 0, 0);
      #undef VF
    }
    if (nis == 2)      asm volatile("s_waitcnt vmcnt(4) lgkmcnt(0)\n\ts_barrier" ::: "memory");
    else if (nis == 1) asm volatile("s_waitcnt vmcnt(2) lgkmcnt(0)\n\ts_barrier" ::: "memory");
    else               asm volatile("s_waitcnt vmcnt(0) lgkmcnt(0)\n\ts_barrier" ::: "memory");
  }
  #undef LOAD_TILE
  #undef ISSUE_LOAD
  float l_reg = 0.f;
  #pragma unroll
  for (int r = 0; r < 16; ++r) l_reg += lsum[r];
  { auto rr = __builtin_amdgcn_permlane32_swap(__float_as_uint(l_reg), __float_as_uint(l_reg), false, false); l_reg = __uint_as_float(rr[0]) + __uint_as_float(rr[1]); }
  if (hi == 0) wsf[32 + r32] = l_reg; asm volatile("s_waitcnt lgkmcnt(0)" ::: "memory");
  float rli[16];
  #pragma unroll
  for (int r = 0; r < 16; ++r) rli[r] = __builtin_amdgcn_rcpf(wsf[32 + crow(r, hi)]);
  bf16* Ow = O + (rowbase + q0 + wid * 32) * DM + h * 64;
  { bf16* stg = (bf16*)(shm + LDS_OST) + wid * 2048;
    #pragma unroll
    for (int r = 0; r < 16; ++r) { const int orow = crow(r, hi);
      #pragma unroll
      for (int d0 = 0; d0 < 2; ++d0) stg[orow * 64 + d0 * 32 + r32] = (bf16)(cvtpk_s(o[d0][r] * rli[r], 0.f) & 0xffffu); }
    asm volatile("s_waitcnt lgkmcnt(0)" ::: "memory");
    #pragma unroll
    for (int i = 0; i < 4; ++i) { const int row = i * 8 + (lane >> 3), ch = lane & 7; const u32x4 v = *(const u32x4*)(stg + row * 64 + ch * 8); pg8::st16(Ow + (long)row * DM + ch * 8, v); } }
  asm volatile("s_waitcnt lgkmcnt(0)\n\ts_barrier" ::: "memory");
  #undef DMA_K
  #undef DMA_V
}
#undef SBAR
}

#define GAS __attribute__((address_space(1)))
#define LAS __attribute__((address_space(3)))
typedef unsigned short bf16;
typedef unsigned v4u __attribute__((ext_vector_type(4)));
typedef float f32x4 __attribute__((ext_vector_type(4)));
typedef short bf16x8 __attribute__((ext_vector_type(8)));
typedef GAS unsigned gu32;
typedef GAS unsigned long long gu64;
#define RLX_AGENT __ATOMIC_RELAXED, __HIP_MEMORY_SCOPE_AGENT
#define LDS_WAIT() asm volatile("s_waitcnt lgkmcnt(0)" ::: "memory")
#define VM_WAIT() asm volatile("s_waitcnt vmcnt(0)" ::: "memory")
__device__ __forceinline__ unsigned long long rt() { return __builtin_amdgcn_s_memrealtime(); }
#define XB_TMO      128
#define XB_XCNT(j)  (256  + 64 * (j))
#define XB_XSUB(j)  (1280 + 64 * (j))
#define XB_XGEN(j)  (2304 + 64 * (j))
#define XB_TOP      3328
#define XB_TOPGEN   3392
#define XCD_BAR_WORDS 3456
#define XB_SPIN_CAP (1u << 18)

__device__ __forceinline__ unsigned xb_ld(unsigned* p)              { return __hip_atomic_load(p, __ATOMIC_RELAXED, __HIP_MEMORY_SCOPE_AGENT); }
__device__ __forceinline__ unsigned xb_add(unsigned* p, unsigned v) { return __hip_atomic_fetch_add(p, v, __ATOMIC_RELAXED, __HIP_MEMORY_SCOPE_AGENT); }
__device__ __forceinline__ unsigned xb_xcc_id() { return (unsigned)__builtin_amdgcn_s_getreg((3 << 11) | 20) & 0xFu; }
#define XB_SPIN(cond, bar) do { unsigned _sp = 0; while (cond) { __builtin_amdgcn_s_sleep(1); \
    if ((++_sp & 255u) == 0u) { if (xb_ld(&(bar)[XB_TMO])) break; if (_sp > XB_SPIN_CAP) { atomicAdd(&(bar)[XB_TMO], 1u); break; } } } } while (0)

struct XcdBarrier {
    unsigned* bar; unsigned x;
    volatile LAS unsigned* st;
};

__device__ __forceinline__ XcdBarrier xcd_barrier_post(unsigned* bar, volatile LAS unsigned* st) {
    XcdBarrier b; b.bar = bar; b.x = xb_xcc_id(); b.st = st;
    if (threadIdx.x == 0) (void)xb_add(&bar[XB_XCNT(b.x)], 1u);
    return b;
}
__device__ __forceinline__ void xcd_barrier_complete(unsigned* bar, unsigned x, unsigned& nloc, unsigned& nx) {
    const unsigned G = gridDim.x * gridDim.y * gridDim.z;
    unsigned sum, cnt, mine, sp = 0u;
    for (;;) {
        sum = 0u; cnt = 0u; mine = 0u;
#pragma unroll
        for (unsigned j = 0; j < 16; ++j) { const unsigned c = xb_ld(&bar[XB_XCNT(j)]); sum += c; cnt += (c > 0u) ? 1u : 0u; mine = (j == x) ? c : mine; }
        if (sum == G) break;
        __builtin_amdgcn_s_sleep(1);
        if ((++sp & 255u) == 0u) { if (xb_ld(&bar[XB_TMO])) break; if (sp > XB_SPIN_CAP) { atomicAdd(&bar[XB_TMO], 1u); break; } }
    }
    nloc = mine > 0u ? mine : 1u; nx = cnt > 0u ? cnt : 1u;
}

__device__ __forceinline__ void xcd_barrier(const XcdBarrier& b) {
    asm volatile("s_waitcnt vmcnt(0)" ::: "memory");
    __syncthreads();
    if (threadIdx.x == 0) {
        unsigned* bar = b.bar;
        __builtin_amdgcn_s_waitcnt(0);
        unsigned nloc = b.st[0], nx = b.st[1];
        if (nloc == 0u) { xcd_barrier_complete(bar, b.x, nloc, nx); b.st[0] = nloc; b.st[1] = nx; }
        __builtin_amdgcn_fence(__ATOMIC_RELEASE, "agent");
        asm volatile("s_waitcnt vmcnt(0)" ::: "memory");
        const unsigned old = xb_add(&bar[XB_XSUB(b.x)], 1u);
        const unsigned gen = old / nloc;
        if (old + 1u == (gen + 1u) * nloc) {
            __builtin_amdgcn_fence(__ATOMIC_RELEASE, "agent");
            asm volatile("s_waitcnt vmcnt(0)" ::: "memory");
            const unsigned og = xb_add(&bar[XB_TOP], 1u);
            const unsigned tg = og / nx;
            if (og + 1u == (tg + 1u) * nx) xb_add(&bar[XB_TOPGEN], 1u);
            else XB_SPIN(xb_ld(&bar[XB_TOPGEN]) == tg, bar);
            __builtin_amdgcn_fence(__ATOMIC_ACQUIRE, "agent");
            xb_add(&bar[XB_XGEN(b.x)], 1u);
            asm volatile("s_waitcnt vmcnt(0)" ::: "memory");
        } else {
            XB_SPIN(xb_ld(&bar[XB_XGEN(b.x)]) == gen, bar);
            __builtin_amdgcn_fence(__ATOMIC_ACQUIRE, "agent");
            asm volatile("s_waitcnt vmcnt(0)" ::: "memory");
        }
    }
    __syncthreads();
}
#include <hip/hip_cooperative_groups.h>
namespace cg = cooperative_groups;
constexpr int NWAVES = 8;
constexpr int BATCH = 4, SEQ = 4096, D = 1024, FF = 4096, M = BATCH * SEQ, NIN = 8192;
constexpr size_t MiB = 1u << 20;
constexpr size_t WS_SS = 1 * MiB;
constexpr size_t WS_W1 = 2 * MiB, WS_WC = 18 * MiB, WS_WA = 20 * MiB  , WS_WO = 22 * MiB, WS_WUP = 24 * MiB, WS_WDN = 32 * MiB;
constexpr size_t WS_V = 40 * MiB  , WS_H = 72 * MiB  , WS_Q = 104 * MiB, WS_K = 136 * MiB  , WS_BG = 168 * MiB  , WS_U1 = 200 * MiB;
constexpr size_t WS_UU = 72 * MiB;
constexpr size_t WS_END = 232 * MiB;
constexpr int LDS_BYTES = 147456;
constexpr int LDSCTL_OFF = 131072, MISC_OFF = LDSCTL_OFF + 320;
constexpr size_t WS_CTL = 0, CTL_ZERO_BYTES = 65536; constexpr int CW_BAR = 4096;
__device__ __forceinline__ unsigned f2bf(float f) { unsigned u = __builtin_bit_cast(unsigned, f); return (u + 0x7fffu + ((u >> 16) & 1u)) >> 16; }
__device__ __forceinline__ unsigned pk2(float lo, float hi) { return f2bf(lo) | (f2bf(hi) << 16); }
__device__ __forceinline__ float wave_sum(float v) {
#pragma unroll
    for (int o = 1; o < 64; o <<= 1) v += __shfl_xor(v, o);
    return v;
}
__device__ __forceinline__ void tr_item(const float* W, int ldw, int col0, int k0, bf16* WT, int Kd, int drow0, const float* kscale, LAS float* scr, int lane) {
    float tv[32];
#pragma unroll
    for (int i = 0; i < 32; ++i) { const int kk = 2 * i + (lane >> 5); tv[i] = __builtin_nontemporal_load(W + (size_t)(k0 + kk) * ldw + col0 + (lane & 31)); }
#pragma unroll
    for (int i = 0; i < 32; ++i) { const int kk = 2 * i + (lane >> 5); float v = tv[i]; if (kscale) v *= kscale[k0 + kk]; scr[kk * 33 + (lane & 31)] = v; }
    LDS_WAIT(); asm volatile("" ::: "memory");
    const int c = lane & 7;
#pragma unroll
    for (int j = 0; j < 4; ++j) { const int n = (lane >> 3) + 8 * j; const LAS float* s = scr + (8 * c) * 33 + n;
        v4u o; o.x = pk2(s[0 * 33], s[1 * 33]); o.y = pk2(s[2 * 33], s[3 * 33]); o.z = pk2(s[4 * 33], s[5 * 33]); o.w = pk2(s[6 * 33], s[7 * 33]);
        pg8::st16(WT + (size_t)(drow0 + n) * Kd + k0 + 8 * c, o); }
    LDS_WAIT(); asm volatile("" ::: "memory");
}

#ifndef PH_MASK
#define PH_MASK 127
#endif
#ifndef REP_P1
#define REP_P1 1
#endif
#ifndef REP_ATT
#define REP_ATT 1
#endif
#ifndef REP_P3
#define REP_P3 1
#endif
#ifndef REP_P4
#define REP_P4 1
#endif
#ifndef REP_P5
#define REP_P5 1
#endif
#ifndef EXTRA_SYNC
#define EXTRA_SYNC 0
#endif
__device__ unsigned g_panel_cnt[64 * 64];
__device__ unsigned g_bar_shard[16 * 64];
__device__ unsigned g_bar_cnt = 0u, g_bar_gen = 0u, g_done_cnt = 0u;
struct Args { const float* in[16]; float* out; unsigned char* ws; };
__global__ void __launch_bounds__(NWAVES * 64, 2) fwd(Args a) {
    extern __shared__ __attribute__((aligned(16))) unsigned char lds[];
    cg::grid_group grid = cg::this_grid();
    LAS unsigned char* ldsp = (LAS unsigned char*)lds;
    const int tid = threadIdx.x, lane = tid & 63, wave = __builtin_amdgcn_readfirstlane(tid >> 6);
    const int G = gridDim.x, bx = blockIdx.x, vcu = (G % 8 == 0) ? (bx % 8) * (G / 8) + bx / 8 : bx;
    unsigned char* ws = a.ws;
    const float* x = a.in[0];
    bf16 *W1 = (bf16*)(ws + WS_W1), *WA = (bf16*)(ws + WS_WA), *WC = (bf16*)(ws + WS_WC), *WO = (bf16*)(ws + WS_WO), *WUP = (bf16*)(ws + WS_WUP), *WDN = (bf16*)(ws + WS_WDN);
    bf16 *Vb = (bf16*)(ws + WS_V), *X1B = (bf16*)(ws + WS_V), *Hb = (bf16*)(ws + WS_H), *YC = (bf16*)(ws + WS_H)  , *Qb = (bf16*)(ws + WS_Q), *AO = (bf16*)(ws + WS_Q)  , *Kb = (bf16*)(ws + WS_K), *MG = (bf16*)(ws + WS_K);
    bf16 *BG = (bf16*)(ws + WS_BG), *U1 = (bf16*)(ws + WS_U1), *UU = (bf16*)(ws + WS_UU), *Gt = (bf16*)a.out;
    float* SS = (float*)(ws + WS_SS);
    for (int u = tid; u < (LDS_BYTES - LDSCTL_OFF) / 4; u += NWAVES * 64) ((LAS unsigned*)(ldsp + LDSCTL_OFF))[u] = 0u;
    __syncthreads();
    if (a.out == nullptr) grid.sync();
#ifndef WB_AT_SEAMS
#define WB_AT_SEAMS 0
#endif
#if WB_AT_SEAMS || !WT_STORES
#define BAR_RELEASE() do { __builtin_amdgcn_fence(__ATOMIC_RELEASE, "agent"); asm volatile("s_waitcnt vmcnt(0)" ::: "memory"); } while (0)
#else
#define BAR_RELEASE() do { } while (0)
#endif
#if defined(MONO_BAR)
    const bool grouped = (G == 256);
    const unsigned NSEAMS = (grouped ? 3u : 6u) + EXTRA_SYNC;
    unsigned bar_epoch = 0u, bar_base = 0u; const unsigned bar_xcc = xb_xcc_id();
#define GRID_BAR() do { asm volatile("s_waitcnt vmcnt(0)" ::: "memory"); __syncthreads(); \
    ++bar_epoch; \
    if (tid == 0) { \
        BAR_RELEASE(); \
        unsigned old_ = xb_add(&g_bar_shard[64u * bar_xcc], 1u);     \
        if (bar_epoch == 1u) asm volatile("s_waitcnt vmcnt(0)" : "+v"(old_) :: "memory");     \
        const unsigned tgt_ = bar_epoch * (unsigned)G; unsigned sp_ = 0u; \
        for (;;) { unsigned s_ = 0u; _Pragma("unroll") for (int j_ = 0; j_ < 16; ++j_) s_ += xb_ld(&g_bar_shard[64 * j_]); \
            if (bar_epoch == 1u && sp_ == 0u) bar_base = ((s_ - 1u) / (NSEAMS * (unsigned)G)) * (NSEAMS * (unsigned)G);     \
            if (s_ - bar_base >= tgt_) break; \
            __builtin_amdgcn_s_sleep(8); if (++sp_ > (1u << 22)) break; } \
        __builtin_amdgcn_fence(__ATOMIC_ACQUIRE, "agent"); asm volatile("s_waitcnt vmcnt(0)" ::: "memory"); } \
    __syncthreads(); } while (0)
    unsigned grp_epoch = 0u, grp_base = 0u;
#define GROUP_BAR(pm_) do { asm volatile("s_waitcnt vmcnt(0)" ::: "memory"); __syncthreads(); \
    ++grp_epoch; \
    if (tid == 0) { unsigned* pc_ = &g_panel_cnt[64 * (pm_)]; \
        BAR_RELEASE(); \
        const unsigned old_ = xb_add(pc_, 1u); \
        if (grp_epoch == 1u) grp_base = old_ - old_ % 12u; \
        const unsigned tgt_ = grp_epoch * 4u; unsigned sp_ = 0u; \
        while (xb_ld(pc_) - grp_base < tgt_) { __builtin_amdgcn_s_sleep(1); if (++sp_ > (1u << 22)) break; } \
        __builtin_amdgcn_fence(__ATOMIC_ACQUIRE, "agent"); asm volatile("s_waitcnt vmcnt(0)" ::: "memory"); } \
    __syncthreads(); } while (0)
#elif defined(GEN_BAR)
#define GRID_BAR() do { asm volatile("s_waitcnt vmcnt(0)" ::: "memory"); __syncthreads(); \
    if (tid == 0) { \
        __builtin_amdgcn_fence(__ATOMIC_RELEASE, "agent"); asm volatile("s_waitcnt vmcnt(0)" ::: "memory"); \
        unsigned g0_ = xb_ld(&g_bar_gen); asm volatile("s_waitcnt vmcnt(0)" : "+v"(g0_) :: "memory");            \
        unsigned old_ = xb_add(&g_bar_cnt, 1u); asm volatile("s_waitcnt vmcnt(0)" : "+v"(old_) :: "memory"); \
        if (old_ == (unsigned)G - 1u) { __hip_atomic_store(&g_bar_cnt, 0u, RLX_AGENT); asm volatile("s_waitcnt vmcnt(0)" ::: "memory"); xb_add(&g_bar_gen, 1u); } \
        else { unsigned sp_ = 0u; while (xb_ld(&g_bar_gen) == g0_) { __builtin_amdgcn_s_sleep(1); if (++sp_ > (1u << 22)) break; } } \
        __builtin_amdgcn_fence(__ATOMIC_ACQUIRE, "agent"); asm volatile("s_waitcnt vmcnt(0)" ::: "memory"); } \
    __syncthreads(); } while (0)
#elif defined(CG_ALL)
#define GRID_BAR() do { asm volatile("s_waitcnt vmcnt(0)" ::: "memory"); grid.sync(); } while (0)
#elif defined(SIMPLE_BAR)
    unsigned bar_epoch = 0u;
#define GRID_BAR() do { asm volatile("s_waitcnt vmcnt(0)" ::: "memory"); __syncthreads(); \
    ++bar_epoch; \
    if (tid == 0) { unsigned* cnt_ = (unsigned*)(ws + WS_CTL) + CW_BAR + XB_TOP; \
        __builtin_amdgcn_fence(__ATOMIC_RELEASE, "agent"); asm volatile("s_waitcnt vmcnt(0)" ::: "memory"); \
        xb_add(cnt_, 1u); unsigned sp_ = 0u; \
        while (xb_ld(cnt_) < bar_epoch * (unsigned)G) { __builtin_amdgcn_s_sleep(1); if (++sp_ > (1u << 22)) break; } \
        __builtin_amdgcn_fence(__ATOMIC_ACQUIRE, "agent"); asm volatile("s_waitcnt vmcnt(0)" ::: "memory"); } \
    __syncthreads(); } while (0)
#else
#define GRID_BAR() xcd_barrier(bar)
#endif

#ifndef DUP_P0
#define DUP_P0 1
#endif
    for (int rep0 = 0; rep0 < DUP_P0; ++rep0) {
        LAS float* scr = (LAS float*)(ldsp + wave * 16384);
        const int gw = vcu * NWAVES + wave, NGW = G * NWAVES;
        constexpr int I_1 = 16 * 256, I_S = 16 * 32, I_UP = 16 * 128, I_DN = 64 * 32, NITEMS = I_1 + 3 * I_S + I_UP + I_DN;
        for (int it = gw; it < NITEMS; it += NGW) {
            int r = it;
            if (r < I_1) { const int db = r & 255, kb = r >> 8, pn = db >> 3, pb = db & 7, bj = pb >> 2, wcc = pb & 3; const float* W = a.in[2]; int ldw = 6144, col;
                if (pn < 4) col = (4 * pn + wcc) * 64 + 32 * bj;
                else if (pn < 8) col = 1024 + (4 * (pn - 4) + wcc) * 64 + 32 * bj;
                else if (pn < 12) col = 2048 + 256 * (pn - 8) + 32 * pb;
                else if (pn < 16) col = 3072 + 256 * (pn - 12) + 32 * pb;
                else if (pn < 24) col = (bj ? 5120 : 4096) + 128 * (pn - 16) + 32 * wcc;
                else { W = a.in[10]; ldw = 2048; col = (bj ? 1024 : 0) + 128 * (pn - 24) + 32 * wcc; }
                tr_item(W, ldw, col, 64 * kb, W1, D, 32 * db, nullptr, scr, lane); continue; } r -= I_1;
            if (r < I_S) { tr_item(a.in[8], D, 32 * (r & 31), 64 * (r >> 5), WA, D, 32 * (r & 31), nullptr, scr, lane); continue; } r -= I_S;
            if (r < I_S) { tr_item(a.in[9], D, 32 * (r & 31), 64 * (r >> 5), WC, D, 32 * (r & 31), nullptr, scr, lane); continue; } r -= I_S;
            if (r < I_S) { tr_item(a.in[12], D, 32 * (r & 31), 64 * (r >> 5), WO, D, 32 * (r & 31), nullptr, scr, lane); continue; } r -= I_S;
            if (r < I_UP) { tr_item(a.in[14], FF, 32 * (r & 127), 64 * (r >> 7), WUP, D, 32 * (r & 127), a.in[13], scr, lane); continue; } r -= I_UP;
            tr_item(a.in[15], D, 32 * (r & 31), 64 * (r >> 5), WDN, FF, 32 * (r & 31), nullptr, scr, lane);
        }
        const float* g1 = a.in[1];
        f32x4 gv[2][2];
#pragma unroll
        for (int c = 0; c < 2; ++c)
#pragma unroll
            for (int hh = 0; hh < 2; ++hh) gv[c][hh] = ((const f32x4*)g1)[c * 128 + 2 * lane + hh];
        for (int m0 = gw; m0 < M; m0 += 2 * NGW) {
            const int m1 = m0 + NGW; const bool has1 = m1 < M;
            const f32x4* xr0 = (const f32x4*)(x + (size_t)m0 * D); const f32x4* xr1 = (const f32x4*)(x + (size_t)(has1 ? m1 : m0) * D);
            f32x4 v0[2][2], v1[2][2]; float s0 = 0.f, s1 = 0.f;
#pragma unroll
            for (int c = 0; c < 2; ++c)
#pragma unroll
                for (int hh = 0; hh < 2; ++hh) { v0[c][hh] = __builtin_nontemporal_load(xr0 + c * 128 + 2 * lane + hh); v1[c][hh] = __builtin_nontemporal_load(xr1 + c * 128 + 2 * lane + hh); }
#pragma unroll
            for (int c = 0; c < 2; ++c)
#pragma unroll
                for (int hh = 0; hh < 2; ++hh) { const f32x4 a0 = v0[c][hh], a1 = v1[c][hh];
                    s0 += (a0.x * a0.x + a0.y * a0.y) + (a0.z * a0.z + a0.w * a0.w); s1 += (a1.x * a1.x + a1.y * a1.y) + (a1.z * a1.z + a1.w * a1.w); }
            const float rs0 = __builtin_amdgcn_rsqf(wave_sum(s0) * (1.0f / D) + 1e-6f), rs1 = __builtin_amdgcn_rsqf(wave_sum(s1) * (1.0f / D) + 1e-6f);
#pragma unroll
            for (int c = 0; c < 2; ++c) { const f32x4 y0 = v0[c][0] * rs0 * gv[c][0], y1 = v0[c][1] * rs0 * gv[c][1];
                pg8::st16(Hb + (size_t)m0 * D + c * 512 + 8 * lane, (v4u){pk2(y0.x, y0.y), pk2(y0.z, y0.w), pk2(y1.x, y1.y), pk2(y1.z, y1.w)}); }
            if (has1) {
#pragma unroll
                for (int c = 0; c < 2; ++c) { const f32x4 y0 = v1[c][0] * rs1 * gv[c][0], y1 = v1[c][1] * rs1 * gv[c][1];
                    pg8::st16(Hb + (size_t)m1 * D + c * 512 + 8 * lane, (v4u){pk2(y0.x, y0.y), pk2(y0.z, y0.w), pk2(y1.x, y1.y), pk2(y1.z, y1.w)}); } }
        }
    }
    GRID_BAR();
#if !defined(SIMPLE_BAR) && !defined(CG_ALL) && !defined(GEN_BAR) && !defined(MONO_BAR)
    const XcdBarrier bar = xcd_barrier_post((unsigned*)(ws + WS_CTL) + CW_BAR, (volatile LAS unsigned*)(ldsp + MISC_OFF) + 8);
#endif

    if (PH_MASK & 2) {
        pg8::Gemm g{Hb, W1, M, NIN, D}; pg8::StaticOrder S; S.init(M, NIN, G, bx);
        pg8::EpiP1 E{Qb, Kb, Vb, BG, U1, Gt, a.in[3], a.in[4], a.in[11]};
        pg8::gemm_phase<pg8::EpiP1, pg8::StaticOrder, true, true>(ldsp, g, S, E);
#ifdef DUP_P1
        { pg8::Gemm g2{Hb, W1, M, NIN, D}; pg8::StaticOrder S2; S2.init(M, NIN, G, bx); pg8::gemm_phase<pg8::EpiP1, pg8::StaticOrder, true, true>(ldsp, g2, S2, E); }
#endif
    }
    GRID_BAR();

    if (PH_MASK & 4) {
        for (int L = vcu; L < 1024 * REP_ATT; L += G) { const int bh = (L & 255) >> 2, gq4 = (L & 3) + 4 * ((L >> 8) & 3);
            attn::attn_unit(bh >> 4, bh & 15, gq4, Qb, Kb, Vb, AO, a.in[5], a.in[3], a.in[4], (char*)lds); }
        const float* cw = a.in[6]; const float* cb = a.in[7];
        for (int item = vcu * 512 + tid; item < 131072; item += G * 512) {
            const int c8 = (item & 127) * 8, t0 = (item >> 7) * 16;
            float w0[8], w1[8], w2[8], b0[8], u1[8], u2[8];
#pragma unroll
            for (int e = 0; e < 8; ++e) { w0[e] = cw[c8 + e]; w1[e] = cw[1024 + c8 + e]; w2[e] = cw[2048 + c8 + e]; b0[e] = cb[c8 + e]; u1[e] = 0.f; u2[e] = 0.f; }
            if ((t0 & (SEQ - 1)) != 0) { f32x4 p, q; pg8::unpack8(*(const v4u*)(U1 + (size_t)(t0 - 2) * D + c8), p, q);
#pragma unroll
                for (int e = 0; e < 4; ++e) { u2[e] = p[e]; u2[4 + e] = q[e]; }
                pg8::unpack8(*(const v4u*)(U1 + (size_t)(t0 - 1) * D + c8), p, q);
#pragma unroll
                for (int e = 0; e < 4; ++e) { u1[e] = p[e]; u1[4 + e] = q[e]; } }
            v4u ur[16], br[16];
#pragma unroll
            for (int i = 0; i < 16; ++i) { const size_t off = (size_t)(t0 + i) * D + c8; ur[i] = __builtin_nontemporal_load((const v4u*)(U1 + off)); br[i] = __builtin_nontemporal_load((const v4u*)(BG + off)); }
#pragma unroll
            for (int i = 0; i < 16; ++i) { const size_t off = (size_t)(t0 + i) * D + c8; f32x4 p, q, bp, bq; float u0[8], bgv[8], y[8];
                pg8::unpack8(ur[i], p, q); pg8::unpack8(br[i], bp, bq);
#pragma unroll
                for (int e = 0; e < 4; ++e) { u0[e] = p[e]; u0[4 + e] = q[e]; bgv[e] = bp[e]; bgv[4 + e] = bq[e]; }
#pragma unroll
                for (int e = 0; e < 8; ++e) { y[e] = bgv[e] * (b0[e] + w0[e] * u2[e] + w1[e] * u1[e] + w2[e] * u0[e]); u2[e] = u1[e]; u1[e] = u0[e]; }
                v4u o; o.x = pk2(y[0], y[1]); o.y = pk2(y[2], y[3]); o.z = pk2(y[4], y[5]); o.w = pk2(y[6], y[7]); pg8::st16(YC + off, o); }
        }
    }
    GRID_BAR();

    if (PH_MASK & 8) {
        static_assert(WS_Q == WS_H + (size_t)M * D * 2 && WS_WA == WS_WC + (size_t)D * D * 2, "P3 reads the stacked [YC ; AO] and [Wc ; Wa]");
        pg8::PairOrder S; S.S.init(M, D, G, bx);
        pg8::Gemm g{YC, WC, 2 * M, 2 * D, D}; pg8::EpiGate2 E{Gt, MG};
        pg8::gemm_phase<pg8::EpiGate2, pg8::PairOrder, true, true>(ldsp, g, S, E);
    }
    { pg8::StaticOrder S; S.init(M, D, G, bx); pg8::Unit u0; S.next(0, u0); if (grouped) GROUP_BAR(u0.pm); else GRID_BAR(); }

    if (PH_MASK & 16) {
        pg8::Gemm g{MG, WO, M, D, D}; pg8::StaticOrder S; S.init(M, D, G, bx);
        pg8::EpiRes1 E{x, a.out, X1B, SS};
        pg8::gemm_phase<pg8::EpiRes1, pg8::StaticOrder, true, true>(ldsp, g, S, E);
#ifdef DUP_P4
        pg8::gemm_phase<pg8::EpiRes1, pg8::StaticOrder, true, true>(ldsp, g, S, E);
#endif
    }
    { pg8::StaticOrder S; S.init(M, D, G, bx); pg8::Unit u0; S.next(0, u0); if (grouped) GROUP_BAR(u0.pm); else GRID_BAR(); }

    if (PH_MASK & 32) {
        pg8::Gemm g{X1B, WUP, M, FF, D}; pg8::StaticOrder S; S.init(M, FF, G, bx);
        pg8::EpiUp E{SS, UU, (size_t)M * D};
        pg8::gemm_phase<pg8::EpiUp, pg8::StaticOrder, true, true>(ldsp, g, S, E);
#ifdef DUP_P5
        pg8::gemm_phase<pg8::EpiUp, pg8::StaticOrder, true, true>(ldsp, g, S, E);
#endif
    }
    { pg8::StaticOrder S; S.init(M, D, G, bx); pg8::Unit u0; S.next(0, u0); if (grouped) GROUP_BAR(u0.pm); else GRID_BAR(); }

    for (int i = 0; i < EXTRA_SYNC; ++i) GRID_BAR();
    if (PH_MASK & 64) {
        pg8::Gemm g{UU, WDN, M, D, FF, D, 4, (size_t)M * D * 2}; pg8::StaticOrder S; S.init(M, D, G, bx);
        pg8::EpiRes2 E{a.out, X1B};
        pg8::gemm_phase<pg8::EpiRes2, pg8::StaticOrder, true, true>(ldsp, g, S, E);
    }
#if defined(MONO_BAR)
    if (wave == 0) { unsigned old_ = 0u; if (lane == 0) old_ = xb_add(&g_done_cnt, 1u);
        old_ = (unsigned)__builtin_amdgcn_readfirstlane((int)old_);
        if (old_ == (unsigned)G - 1u) { __hip_atomic_store(&g_panel_cnt[64 * lane], 0u, RLX_AGENT);
            if (lane < 16) __hip_atomic_store(&g_bar_shard[64 * lane], 0u, RLX_AGENT);
            if (lane == 0) { __hip_atomic_store(&g_bar_cnt, 0u, RLX_AGENT); __hip_atomic_store(&g_done_cnt, 0u, RLX_AGENT); } } }
#endif
}

extern "C" void kernel_launch(void* const* d_in, const int* in_sizes, int n_in, void* d_out, int out_size, void* d_ws, size_t ws_size, hipStream_t stream) {
    static int grid = 0;
    if (grid == 0) {
        if (n_in != 16 || out_size != M * D || ws_size < WS_END) { fprintf(stderr, "kernel_launch: unexpected shapes (n_in %d, out %d, ws %zu)\n", n_in, out_size, ws_size); grid = -1; return; }
        int dev = 0, cus = 0, per_cu = 0;
        (void)hipGetDevice(&dev); (void)hipDeviceGetAttribute(&cus, hipDeviceAttributeMultiprocessorCount, dev);
        if (hipFuncSetAttribute((const void*)fwd, hipFuncAttributeMaxDynamicSharedMemorySize, LDS_BYTES) != hipSuccess) { fprintf(stderr, "kernel_launch: hipFuncSetAttribute failed\n"); grid = -1; return; }
        if (hipOccupancyMaxActiveBlocksPerMultiprocessor(&per_cu, (const void*)fwd, NWAVES * 64, LDS_BYTES) != hipSuccess || per_cu < 1) { fprintf(stderr, "kernel_launch: occupancy query says %d\n", per_cu); per_cu = 1; }
        (void)hipGetLastError();
        grid = cus * 1;
    }
    if (grid < 0) return;
#if !defined(GEN_BAR) && !defined(MONO_BAR)
    if (hipMemsetAsync((char*)d_ws + WS_CTL, 0, CTL_ZERO_BYTES, stream) != hipSuccess) { fprintf(stderr, "kernel_launch: memset of the barrier words failed\n"); return; }
#endif
    Args a{};
    for (int i = 0; i < 16; ++i) a.in[i] = (const float*)d_in[i];
    a.out = (float*)d_out; a.ws = (unsigned char*)d_ws;
    void* args[] = {&a};
    hipError_t e = hipLaunchCooperativeKernel((const void*)fwd, dim3(grid), dim3(NWAVES * 64), args, LDS_BYTES, stream);
    if (e != hipSuccess) fprintf(stderr, "kernel_launch: cooperative launch failed: %s (grid %d)\n", hipGetErrorString(e), grid);
}
```
